# Optimizing an MI355X kernel written in HIP

```python
import math
import jax, jax.numpy as jnp
from jax import lax
import numpy as np

D_MODEL = 1024
BATCH = 4
SEQ = 4096
DEPTH = 2

GRID_W = 64
CTX_LEN = 256
N_MIXERS = 4
W_GROUP = D_MODEL // N_MIXERS
MIX_W = N_MIXERS * W_GROUP
HG_HEADS = 4
HG_DK = W_GROUP // HG_HEADS
HG_CHUNK = 16
ML_HEADS = 4
ML_DH = W_GROUP // ML_HEADS
ML_CHUNK = 64
HY_ORDER = 2
HY_BANDS = 8
HY_EMB = 2 * HY_BANDS + 1
HY_FFN = 64
HY_FAST_DECAY = 0.3
HY_SLOW_DECAY = 1.5
HY_TARGET = 1e-2
GD_HEADS = 4
GD_DH = W_GROUP // GD_HEADS
GD_CHUNK = 64
SHORT_CONV = 3
N_EXPERTS = 32
TOP_K = 4
D_EXPERT = D_MODEL
SWIGLU_LIMIT = 7.0
SWIGLU_ALPHA = 1.702
MOE_BLOCK = 256
EPS = 1e-6
NEG = -1e30
HG_COLS = 5 * W_GROUP
ML_COLS = 4 * W_GROUP + 4 * ML_HEADS
HY_COLS = 3 * W_GROUP
GD_COLS = 4 * W_GROUP + 4 * GD_HEADS
IN_W = HG_COLS + ML_COLS + HY_COLS + GD_COLS

kernel_name = "hybrid_parallel_groups_diffusion_trunk"

F32 = jnp.float32


def _rms(x, gain):
    xf = x.astype(F32)
    y = xf * lax.rsqrt(jnp.mean(xf * xf, -1, keepdims=True) + EPS)
    return (y * gain.astype(F32)).astype(x.dtype)


def _head_rms(o, gain, n_heads):
    b, l, w = o.shape
    oh = o.reshape(b, l, n_heads, w // n_heads)
    oh = oh * lax.rsqrt(jnp.mean(oh * oh, -1, keepdims=True) + EPS)
    return oh.reshape(b, l, w) * gain.astype(F32)


def _heads(t, n_heads):
    b, l, w = t.shape
    return t.reshape(b, l, n_heads, w // n_heads).transpose(0, 2, 1, 3)


def _unheads(t):
    b, h, l, d = t.shape
    return t.transpose(0, 2, 1, 3).reshape(b, l, h * d)


def _l2(t):
    return t * lax.rsqrt(jnp.sum(t * t, -1, keepdims=True) + EPS)


def _short_conv(x, w, b=None):
    k = w.shape[0]
    y = lax.conv_general_dilated(x, w[:, None, :].astype(x.dtype), window_strides=(1,),
                                 padding=[(k // 2, k - 1 - k // 2)],
                                 dimension_numbers=('NWC', 'WIO', 'NWC'),
                                 feature_group_count=x.shape[-1])
    return y if b is None else y + b.astype(x.dtype)


def _to_colmajor(t, rows):
    b, l, w = t.shape
    return t.reshape(b, rows, GRID_W, w).swapaxes(1, 2).reshape(b, l, w)


def _from_colmajor(t, rows):
    b, l, w = t.shape
    return t.reshape(b, GRID_W, rows, w).swapaxes(1, 2).reshape(b, l, w)


def _bidirectional(scan_fn, ctx_fwd, ctx_bwd, lat_fwd, lat_bwd, state0):
    flip = lambda ts: tuple(jnp.flip(t, 2) for t in ts)
    o_cf, s_cf = scan_fn(*ctx_fwd, state0)
    o_cb, s_cb = scan_fn(*flip(ctx_bwd), state0)
    o_lf, _ = scan_fn(*lat_fwd, s_cf)
    o_lb, _ = scan_fn(*flip(lat_bwd), s_cb)
    return o_lf + jnp.flip(o_lb, 2), o_cf + jnp.flip(o_cb, 2)


def _gla_chunked(q, k, v, log_f, state):
    b, h, l, dk = q.shape
    dv = v.shape[-1]
    c = HG_CHUNK
    n = l // c
    q, k, log_f = (t.reshape(b, h, n, c, dk) for t in (q, k, log_f))
    v = v.reshape(b, h, n, c, dv)
    cum = jnp.cumsum(log_f, axis=3)
    causal = jnp.tril(jnp.ones((c, c), bool))[:, :, None]
    decay = jnp.exp(jnp.where(causal, cum[..., :, None, :] - cum[..., None, :, :], NEG))
    scores = jnp.einsum('bhntd,bhnsd,bhntsd->bhnts', q, k, decay)
    o = jnp.einsum('bhnts,bhnsv->bhntv', scores, v)
    last = cum[..., -1, :]
    u = jnp.einsum('bhnsd,bhnsv->bhndv', k * jnp.exp(last[..., None, :] - cum), v)

    def step(s, inp):
        a, uc = inp
        return a[..., None] * s + uc, s

    s_fin, s_start = lax.scan(step, state, (jnp.moveaxis(jnp.exp(last), 2, 0), jnp.moveaxis(u, 2, 0)))
    o = o + jnp.einsum('bhntd,bhndv->bhntv', q * jnp.exp(cum), jnp.moveaxis(s_start, 0, 2))
    return o.reshape(b, h, l, dv), s_fin


def _hgrn2(z, zc, lb, norm_g, need_ctx):
    def prep(t):
        q, i, ff, fb, g = jnp.split(t.astype(F32), 5, -1)
        out = [_heads(jax.nn.silu(q), HG_HEADS), _heads(i, HG_HEADS)]
        for zf in (ff, fb):
            f = lb + (1.0 - lb) * jax.nn.sigmoid(zf)
            key = (1.0 - lb) * jax.nn.sigmoid(-zf)
            out += [_heads(key, HG_HEADS), _heads(jnp.log(f), HG_HEADS)]
        return out, g
    (q, i, kf, lff, kb, lfb), g = prep(z)
    (qc, ic, kcf, lcf, kcb, lcb), gc = prep(zc)
    s0 = jnp.zeros((z.shape[0], HG_HEADS, HG_DK, HG_DK), F32)
    o, o_c = _bidirectional(_gla_chunked, (qc, kcf, ic, lcf), (qc, kcb, ic, lcb),
                            (q, kf, i, lff), (q, kb, i, lfb), s0)
    out = _head_rms(_unheads(o), norm_g, HG_HEADS) * jax.nn.silu(g)
    out_c = _head_rms(_unheads(o_c), norm_g, HG_HEADS) * jax.nn.silu(gc) if need_ctx else None
    return out, out_c


def _mlstm_chunked(q, k, v, log_i, log_f, state):
    b, h, l, d = q.shape
    c = ML_CHUNK
    n = l // c
    k = k * (d ** -0.5)
    q, k, v = (t.reshape(b, h, n, c, d) for t in (q, k, v))
    log_i, log_f = (t.reshape(b, h, n, c) for t in (log_i, log_f))
    fcum = jnp.cumsum(log_f, -1)
    causal = jnp.tril(jnp.ones((c, c), bool))
    a = jnp.where(causal, fcum[..., :, None] - fcum[..., None, :] + log_i[..., None, :], NEG)
    g = fcum[..., -1:] - fcum + log_i
    g_max = jnp.max(g, -1)
    kw = k * jnp.exp(g - g_max[..., None])[..., None]
    u_c = jnp.einsum('bhnsd,bhnse->bhnde', kw, v)
    u_n = jnp.sum(kw, 3)

    def step(carry, inp):
        c_mat, n_vec, m = carry
        f_last, gm, uc, un = inp
        m_new = jnp.maximum(f_last + m, gm)
        a_old = jnp.exp(f_last + m - m_new)
        a_new = jnp.exp(gm - m_new)
        new = (a_old[..., None, None] * c_mat + a_new[..., None, None] * uc,
               a_old[..., None] * n_vec + a_new[..., None] * un, m_new)
        return new, carry

    xs = tuple(jnp.moveaxis(t, 2, 0) for t in (fcum[..., -1], g_max, u_c, u_n))
    final, starts = lax.scan(step, state, xs)
    c0, n0, m0 = (jnp.moveaxis(t, 0, 2) for t in starts)
    a_init = fcum + m0[..., None]
    m_t = jnp.maximum(jnp.max(a, -1), a_init)
    p = jnp.exp(a - m_t[..., None]) * jnp.einsum('bhntd,bhnsd->bhnts', q, k)
    e0 = jnp.exp(a_init - m_t)
    num = jnp.einsum('bhnts,bhnse->bhnte', p, v) + e0[..., None] * jnp.einsum('bhntd,bhnde->bhnte', q, c0)
    den = jnp.sum(p, -1) + e0 * jnp.einsum('bhntd,bhnd->bhnt', q, n0)
    hout = num / jnp.maximum(jnp.abs(den), jnp.exp(-m_t))[..., None]
    return hout.reshape(b, h, l, d), final


def _mlstm(z, zc, gate_b, norm_g, rows, need_ctx):
    z = _to_colmajor(z, rows)
    def prep(t):
        t = t.astype(F32)
        q, k, v, o = jnp.split(t[..., :4 * W_GROUP], 4, -1)
        gates = t[..., 4 * W_GROUP:].reshape(t.shape[0], t.shape[1], 4, ML_HEADS) + gate_b.astype(F32)
        gates = gates.transpose(2, 0, 3, 1)
        qh, kh, vh = (_heads(a, ML_HEADS) for a in (q, k, v))
        fwd = (qh, kh, vh, gates[0], jax.nn.log_sigmoid(gates[1]))
        bwd = (qh, kh, vh, gates[2], jax.nn.log_sigmoid(gates[3]))
        return fwd, bwd, o
    lat_f, lat_b, o = prep(z)
    ctx_f, ctx_b, oc = prep(zc)
    bsz = z.shape[0]
    s0 = (jnp.zeros((bsz, ML_HEADS, ML_DH, ML_DH), F32), jnp.zeros((bsz, ML_HEADS, ML_DH), F32),
          jnp.zeros((bsz, ML_HEADS), F32))
    h, h_c = _bidirectional(_mlstm_chunked, ctx_f, ctx_b, lat_f, lat_b, s0)
    out = _from_colmajor(jax.nn.sigmoid(o) * _head_rms(_unheads(h), norm_g, ML_HEADS), rows)
    out_c = jax.nn.sigmoid(oc) * _head_rms(_unheads(h_c), norm_g, ML_HEADS) if need_ctx else None
    return out, out_c


def _hyena_filters(length, w1, b1, w2, b2, freq, w3):
    t = jnp.linspace(0.0, 1.0, length, dtype=F32)[:, None]
    pos = jnp.arange(length, dtype=F32)[:, None]
    band = jnp.linspace(1e-4, HY_BANDS - 1, HY_BANDS, dtype=F32)[None, :]
    ang = 2.0 * math.pi * pos * band / length
    feats = jnp.concatenate([t, jnp.cos(ang), -jnp.sin(ang)], -1)
    freq = freq.astype(F32)
    hdn = jnp.sin(freq[0] * (feats @ w1.astype(F32) + b1.astype(F32)))
    hdn = jnp.sin(freq[1] * (hdn @ w2.astype(F32) + b2.astype(F32)))
    filt = (hdn @ w3.astype(F32)).reshape(length, 2, HY_ORDER, W_GROUP)
    deltas = jnp.abs(jnp.linspace(math.log(HY_TARGET) / HY_SLOW_DECAY,
                                  math.log(HY_TARGET) / HY_FAST_DECAY, W_GROUP, dtype=F32))
    filt = filt * jnp.exp(-t * deltas)[:, None, None, :]
    fwd, bwd = filt[:, 0], filt[:, 1]
    two_sided = jnp.concatenate([fwd, jnp.zeros_like(fwd[:1]), jnp.flip(bwd[1:], 0)], 0)
    two_sided = two_sided * lax.rsqrt(jnp.sum(two_sided * two_sided, 0, keepdims=True) + EPS)
    return jnp.fft.rfft(two_sided, axis=0)


def _hyena(z, conv_w, conv_b, filt_params, bias):
    length = z.shape[1]
    u = _short_conv(z.astype(F32), conv_w.astype(F32), conv_b.astype(F32))
    v, x1, x2 = jnp.split(u, 3, -1)
    kf = _hyena_filters(length, *filt_params)
    bias = bias.astype(F32)
    y = v
    for n, gate in enumerate((x1, x2)):
        conv = jnp.fft.irfft(jnp.fft.rfft(y, n=2 * length, axis=1) * kf[:, n], n=2 * length, axis=1)[:, :length]
        y = gate * (conv + bias[n] * y)
    return y


def _gated_delta_chunked(q, k, v, log_a, beta, state):
    b, h, l, dk = q.shape
    dv = v.shape[-1]
    c = GD_CHUNK
    n = l // c
    q = q * dk ** -0.5
    q, k = (t.reshape(b, h, n, c, dk) for t in (q, k))
    v = v.reshape(b, h, n, c, dv)
    log_a, beta = (t.reshape(b, h, n, c) for t in (log_a, beta))
    g = jnp.cumsum(log_a, -1)
    causal = jnp.tril(jnp.ones((c, c), bool))
    strict = jnp.tril(jnp.ones((c, c), bool), -1)
    decay = jnp.exp(jnp.where(causal, g[..., :, None] - g[..., None, :], NEG))
    kb = k * beta[..., None]
    m = jnp.eye(c, dtype=q.dtype) + jnp.where(strict, jnp.einsum('bhnid,bhnjd->bhnij', kb, k) * decay, 0.0)
    rhs = jnp.concatenate([v * beta[..., None], kb * jnp.exp(g)[..., None]], -1)
    sol = lax.linalg.triangular_solve(m, rhs, left_side=True, lower=True, unit_diagonal=True)
    u, w = sol[..., :dv], sol[..., dv:]
    qk = jnp.einsum('bhnid,bhnjd->bhnij', q, k) * decay
    q_dec = q * jnp.exp(g)[..., None]
    g_last = g[..., -1]
    k_dec = k * jnp.exp(g_last[..., None] - g)[..., None]

    def step(s, inp):
        u_c, w_c, qk_c, qd_c, kd_c, gl_c = inp
        v_new = u_c - jnp.einsum('bhcd,bhde->bhce', w_c, s)
        o_c = jnp.einsum('bhcd,bhde->bhce', qd_c, s) + jnp.einsum('bhij,bhje->bhie', qk_c, v_new)
        s = jnp.exp(gl_c)[..., None, None] * s + jnp.einsum('bhcd,bhce->bhde', kd_c, v_new)
        return s, o_c

    xs = tuple(jnp.moveaxis(t, 2, 0) for t in (u, w, qk, q_dec, k_dec, g_last))
    s_fin, o = lax.scan(step, state, xs)
    return jnp.moveaxis(o, 0, 2).reshape(b, h, l, dv), s_fin


def _gdn(z, zc, conv_w, a_log, dt_bias, norm_g, need_ctx):
    a_log = a_log.astype(F32)
    dt_bias = dt_bias.astype(F32)
    def prep(t):
        t = t.astype(F32)
        qkv = jax.nn.silu(_short_conv(t[..., :3 * W_GROUP], conv_w.astype(F32)))
        q, k, v = jnp.split(qkv, 3, -1)
        q, k, v = _l2(_heads(q, GD_HEADS)), _l2(_heads(k, GD_HEADS)), _heads(v, GD_HEADS)
        gate = t[..., 3 * W_GROUP:4 * W_GROUP]
        ab = t[..., 4 * W_GROUP:].reshape(t.shape[0], t.shape[1], 4, GD_HEADS).transpose(2, 0, 3, 1)
        dirs = []
        for d in range(2):
            log_a = -jnp.exp(a_log[d])[:, None] * jax.nn.softplus(ab[2 * d] + dt_bias[d][:, None])
            dirs.append((q, k, v, log_a, jax.nn.sigmoid(ab[2 * d + 1])))
        return dirs[0], dirs[1], gate
    lat_f, lat_b, gate = prep(z)
    ctx_f, ctx_b, gate_c = prep(zc)
    s0 = jnp.zeros((z.shape[0], GD_HEADS, GD_DH, GD_DH), F32)
    o, o_c = _bidirectional(_gated_delta_chunked, ctx_f, ctx_b, lat_f, lat_b, s0)
    out = _head_rms(_unheads(o), norm_g, GD_HEADS) * jax.nn.silu(gate)
    out_c = _head_rms(_unheads(o_c), norm_g, GD_HEADS) * jax.nn.silu(gate_c) if need_ctx else None
    return out, out_c


def _moe(h, router_w, router_b, w1, b1, w2, b2):
    t_count, d = h.shape
    logits = (h @ router_w + router_b).astype(F32)
    top_v, top_i = lax.top_k(logits, TOP_K)
    gates = jax.nn.softmax(top_v, -1)
    n_pairs = t_count * TOP_K
    e_flat = top_i.reshape(-1)
    tok_flat = jnp.repeat(jnp.arange(t_count, dtype=jnp.int32), TOP_K)
    g_flat = gates.reshape(-1)
    order = jnp.argsort(e_flat)
    e_sorted = e_flat[order]
    counts = jnp.bincount(e_flat, length=N_EXPERTS)
    padded = (counts + MOE_BLOCK - 1) // MOE_BLOCK * MOE_BLOCK
    start = jnp.cumsum(counts) - counts
    pend = jnp.cumsum(padded)
    pstart = pend - padded
    dest = pstart[e_sorted] + (jnp.arange(n_pairs, dtype=jnp.int32) - start[e_sorted])
    n_blocks = -(-(n_pairs + N_EXPERTS * (MOE_BLOCK - 1)) // MOE_BLOCK)
    n_slots = n_blocks * MOE_BLOCK
    slot_tok = jnp.full((n_slots,), t_count, jnp.int32).at[dest].set(tok_flat[order])
    slot_gate = jnp.zeros((n_slots,), F32).at[dest].set(g_flat[order])
    block_exp = jnp.clip(jnp.searchsorted(pend, jnp.arange(n_blocks) * MOE_BLOCK, side='right'),
                         0, N_EXPERTS - 1)
    h_pad = jnp.concatenate([h, jnp.zeros((1, d), h.dtype)], 0)

    def expert_block(args):
        toks, e = args
        u = h_pad[toks] @ w1[e] + b1[e]
        gate, lin = jnp.split(u, 2, -1)
        gate = jnp.minimum(gate, SWIGLU_LIMIT)
        lin = jnp.clip(lin, -SWIGLU_LIMIT, SWIGLU_LIMIT)
        y = (lin + 1.0) * gate * jax.nn.sigmoid(SWIGLU_ALPHA * gate)
        return y @ w2[e] + b2[e]

    y = lax.map(expert_block, (slot_tok.reshape(n_blocks, MOE_BLOCK), block_exp))
    y = y.reshape(n_slots, d) * slot_gate[:, None].astype(y.dtype)
    return jnp.zeros((t_count + 1, d), y.dtype).at[slot_tok].add(y)[:t_count]


def _layer(x, xc, rows, last, mod, mod_c, n1, n2, w_in, w_out, hg, ml, hy, gd, moe):
    need_ctx = not last
    sh1, sc1, g1, sh2, sc2, g2 = jnp.split(mod[:, None, :], 6, -1)
    csh1, csc1, cg1, csh2, csc2, cg2 = jnp.split(mod_c, 6, -1)
    h = _rms(x, n1) * (1 + sc1) + sh1
    hc = _rms(xc, n1) * (1 + csc1) + csh1
    splits = [HG_COLS, HG_COLS + ML_COLS, HG_COLS + ML_COLS + HY_COLS]
    z_hg, z_ml, z_hy, z_gd = jnp.split(h @ w_in, splits, -1)
    zc_hg, zc_ml, zc_hy, zc_gd = jnp.split(hc @ w_in, splits, -1)
    a_lat, a_ctx = _hgrn2(z_hg, zc_hg, hg[0], hg[1], need_ctx)
    b_lat, b_ctx = _mlstm(z_ml, zc_ml, ml[0], ml[1], rows, need_ctx)
    c_lat = _hyena(z_hy, hy[0], hy[1], hy[2], hy[3])
    d_lat, d_ctx = _gdn(z_gd, zc_gd, gd[0], gd[1], gd[2], gd[3], need_ctx)
    mix = jnp.concatenate([a_lat, b_lat, c_lat, d_lat], -1).astype(x.dtype)
    x = x + g1 * (mix @ w_out)
    if need_ctx:
        c_ctx_out = _hyena(zc_hy, hy[0], hy[1], hy[2], hy[3])
        mix_c = jnp.concatenate([a_ctx, b_ctx, c_ctx_out, d_ctx], -1).astype(xc.dtype)
        xc = xc + cg1 * (mix_c @ w_out)
    h = _rms(x, n2) * (1 + sc2) + sh2
    if last:
        y = _moe(h.reshape(-1, D_MODEL), *moe).reshape(x.shape)
        return x + g2 * y, xc
    hc = _rms(xc, n2) * (1 + csc2) + csh2
    n_lat = x.shape[0] * x.shape[1]
    y = _moe(jnp.concatenate([h.reshape(-1, D_MODEL), hc.reshape(-1, D_MODEL)], 0), *moe)
    x = x + g2 * y[:n_lat].reshape(x.shape)
    xc = xc + cg2 * y[n_lat:].reshape(xc.shape)
    return x, xc


def setup_inputs(seed: int = 0) -> dict:
    key = jax.random.key(seed)
    ks = iter(jax.random.split(key, 48))
    nrm = lambda shape, s: jax.random.normal(next(ks), shape, F32) * s
    dt = jnp.exp(jax.random.uniform(next(ks), (DEPTH, 2, GD_HEADS), F32, math.log(1e-3), math.log(1e-1)))
    gate_base = jnp.array([0.0, 3.0, 0.0, 3.0], F32)[None, :, None]
    return {
        "x": nrm((BATCH, SEQ, D_MODEL), 1.0),
        "c": nrm((BATCH, D_MODEL), 1.0),
        "ctx": nrm((BATCH, CTX_LEN, D_MODEL), 1.0),
        "c_ctx": nrm((D_MODEL,), 1.0),
        "mod_w": nrm((DEPTH, D_MODEL, 6 * D_MODEL), 0.5 * D_MODEL ** -0.5),
        "mod_b": nrm((DEPTH, 6 * D_MODEL), 0.01),
        "norm1_g": 1.0 + nrm((DEPTH, D_MODEL), 0.02),
        "norm2_g": 1.0 + nrm((DEPTH, D_MODEL), 0.02),
        "w_in": nrm((DEPTH, D_MODEL, IN_W), D_MODEL ** -0.5),
        "w_out": nrm((DEPTH, MIX_W, D_MODEL), MIX_W ** -0.5),
        "hg_lb_logits": nrm((DEPTH, W_GROUP), 0.5),
        "hg_norm_g": 1.0 + nrm((DEPTH, W_GROUP), 0.02),
        "ml_gate_b": gate_base + nrm((DEPTH, 4, ML_HEADS), 0.3),
        "ml_norm_g": 1.0 + nrm((DEPTH, W_GROUP), 0.02),
        "hy_conv_w": nrm((DEPTH, SHORT_CONV, HY_COLS), SHORT_CONV ** -0.5),
        "hy_conv_b": nrm((DEPTH, HY_COLS), 0.01),
        "hy_w1": nrm((DEPTH, HY_EMB, HY_FFN), HY_EMB ** -0.5),
        "hy_b1": nrm((DEPTH, HY_FFN), 0.1),
        "hy_w2": nrm((DEPTH, HY_FFN, HY_FFN), HY_FFN ** -0.5),
        "hy_b2": nrm((DEPTH, HY_FFN), 0.1),
        "hy_freq": 1.0 + nrm((DEPTH, 2, HY_FFN), 0.1),
        "hy_w3": nrm((DEPTH, HY_FFN, 2 * HY_ORDER * W_GROUP), HY_FFN ** -0.5),
        "hy_bias": nrm((DEPTH, HY_ORDER, W_GROUP), 0.5),
        "gd_conv_w": nrm((DEPTH, SHORT_CONV, 3 * W_GROUP), SHORT_CONV ** -0.5),
        "gd_a_log": jnp.log(jax.random.uniform(next(ks), (DEPTH, 2, GD_HEADS), F32, 1.0, 16.0)),
        "gd_dt_bias": dt + jnp.log(-jnp.expm1(-dt)),
        "gd_norm_g": 1.0 + nrm((DEPTH, W_GROUP), 0.02),
        "router_w": nrm((DEPTH, D_MODEL, N_EXPERTS), D_MODEL ** -0.5),
        "router_b": nrm((DEPTH, N_EXPERTS), 0.01),
        "exp_w1": nrm((DEPTH, N_EXPERTS, D_MODEL, 2 * D_EXPERT), D_MODEL ** -0.5),
        "exp_b1": nrm((DEPTH, N_EXPERTS, 2 * D_EXPERT), 0.01),
        "exp_w2": nrm((DEPTH, N_EXPERTS, D_EXPERT, D_MODEL), D_EXPERT ** -0.5),
        "exp_b2": nrm((DEPTH, N_EXPERTS, D_MODEL), 0.01),
        "final_g": 1.0 + nrm((D_MODEL,), 0.02),
    }


def reference(x, c, ctx, c_ctx, mod_w, mod_b, norm1_g, norm2_g, w_in, w_out, hg_lb_logits, hg_norm_g,
              ml_gate_b, ml_norm_g, hy_conv_w, hy_conv_b, hy_w1, hy_b1, hy_w2, hy_b2, hy_freq, hy_w3,
              hy_bias, gd_conv_w, gd_a_log, gd_dt_bias, gd_norm_g, router_w, router_b, exp_w1, exp_b1,
              exp_w2, exp_b2, final_g):
    rows = x.shape[1] // GRID_W
    p = jax.nn.softmax(hg_lb_logits.astype(F32), axis=0)
    lower_bounds = jnp.cumsum(p, 0) - p[0]
    s_c = jax.nn.silu(c)
    s_cc = jax.nn.silu(c_ctx)
    xc = ctx
    for l in range(DEPTH):
        mod = s_c @ mod_w[l] + mod_b[l]
        mod_c = s_cc @ mod_w[l] + mod_b[l]
        x, xc = _layer(
            x, xc, rows, l == DEPTH - 1, mod, mod_c, norm1_g[l], norm2_g[l], w_in[l], w_out[l],
            (lower_bounds[l], hg_norm_g[l]),
            (ml_gate_b[l], ml_norm_g[l]),
            (hy_conv_w[l], hy_conv_b[l], (hy_w1[l], hy_b1[l], hy_w2[l], hy_b2[l], hy_freq[l], hy_w3[l]), hy_bias[l]),
            (gd_conv_w[l], gd_a_log[l], gd_dt_bias[l], gd_norm_g[l]),
            (router_w[l], router_b[l], exp_w1[l], exp_b1[l], exp_w2[l], exp_b2[l]))
    return _rms(x, final_g)
```

```cpp
#ifdef HOST_EMU
#include "host/emu.h"
#else
#include <hip/hip_runtime.h>
#include <hip/hip_cooperative_groups.h>
#endif
#include <cstdio>
#include <cstdint>
#include <cmath>

#ifndef CFG_B
#define CFG_B 4
#define CFG_L 4096
#define CFG_GW 64
#define CFG_LC 256
#define CFG_NE 32
#endif
constexpr int NB = CFG_B, SEQ = CFG_L, GW = CFG_GW, GROWS = SEQ / GW, LC = CFG_LC, NE = CFG_NE, TOPK = 4, DEPTH = 2;
constexpr int D = 1024, WG_ = 256, NH = 4, DH = 64;
constexpr int NLAT = NB * SEQ, NCTX = NB * LC, NT = NLAT + NCTX;
constexpr int IN_W = 4128, ZW = 4096;
constexpr int HGB = 0, MLB = 1280, HYB = 2304, GDB = 3072;
constexpr int DE = 1024;
constexpr float EPS = 1e-6f;
constexpr int FFTN = 2 * SEQ, FFTNC = 2 * LC, TWN = FFTN / 2;
static_assert(NT % 256 == 0 && NLAT % 256 == 0, "row counts must be multiples of 256");
static_assert(SEQ % 16 == 0 && LC % 16 == 0, "chunking");
constexpr int MAXTILES = (NT * TOPK + NE * 255) / 256 + 1;

constexpr size_t al256(size_t x) { return (x + 255) & ~(size_t)255; }
constexpr size_t WS_CTL = 0, CTL_BYTES = 1 << 20;
constexpr size_t WS_WIN = WS_CTL + CTL_BYTES;
constexpr size_t WS_WOUT = WS_WIN + (size_t)DEPTH * ZW * D * 2;
constexpr size_t WS_W1 = WS_WOUT + (size_t)DEPTH * D * D * 2;
constexpr size_t WS_W2 = WS_W1 + (size_t)DEPTH * NE * 2 * DE * D * 2;
constexpr size_t WS_WG = WS_W2 + (size_t)DEPTH * NE * D * DE * 2;
constexpr size_t WS_WR = WS_WG + (size_t)DEPTH * 32 * D * 4;
constexpr size_t WS_MOD = WS_WR + (size_t)DEPTH * NE * D * 4;
constexpr size_t WS_LB = WS_MOD + al256((size_t)DEPTH * (NB + 1) * 6 * D * 4);
constexpr size_t WS_HDN = WS_LB + (size_t)DEPTH * 256 * 4;
constexpr size_t WS_X = WS_HDN + (size_t)DEPTH * (SEQ + LC) * 64 * 4;
constexpr size_t WS_H = WS_X + (size_t)NT * D * 4;
constexpr size_t WS_Z = WS_H + (size_t)NT * D * 2;
constexpr size_t WS_ZG = WS_Z + (size_t)NT * ZW * 2;
constexpr size_t WS_MIX = WS_ZG + (size_t)NT * 32 * 4;
constexpr size_t WS_OB = WS_MIX + (size_t)NT * D * 2;
constexpr size_t WS_HYT = WS_OB + (size_t)6 * NT * 256 * 4;
constexpr size_t WS_KS = WS_HYT + (size_t)256 * NT * 4;
constexpr size_t WS_TOP = WS_KS + (size_t)256 * 2 * FFTN * 8;
constexpr size_t WS_HS = WS_TOP + (size_t)NT * 4 * 12;
constexpr size_t WS_A2 = WS_HS + (size_t)MAXTILES * 256 * D * 2;
constexpr size_t WS_Y = WS_A2 + (size_t)MAXTILES * 256 * DE * 2;
constexpr size_t WS_END = WS_Y + (size_t)MAXTILES * 256 * D * 2;
constexpr int CW_CNT = 64;
constexpr int CW_BAR = 4096;

constexpr int RING_BYTES = 131072, LDSX_OFF = RING_BYTES, LDS_BYTES = 147456;
constexpr int LX_MISC = 0, LX_TILE = 256;

#ifdef HOST_EMU
#define __expf expf
#define LAS
#define GAS
#define DEV_ASM(x) ((void)0)
#define VM_WAIT() ((void)0)
#define LDS_WAIT() do { int _s; (void)emu::wave_xchg(&_s, 4, _s); } while (0)
#else
#define LAS __attribute__((address_space(3)))
#define GAS __attribute__((address_space(1)))
#define VM_WAIT() asm volatile("s_waitcnt vmcnt(0)" ::: "memory")
#define LDS_WAIT() asm volatile("s_waitcnt lgkmcnt(0)" ::: "memory")
#endif
typedef unsigned short bf16_t;
typedef short bf16x8 __attribute__((ext_vector_type(8)));
typedef float f32x4 __attribute__((ext_vector_type(4)));
typedef float f32x2 __attribute__((ext_vector_type(2)));
typedef unsigned u32x4 __attribute__((ext_vector_type(4)));
typedef unsigned u32x2 __attribute__((ext_vector_type(2)));

__device__ __forceinline__ float u2f(unsigned u) { float f; __builtin_memcpy(&f, &u, 4); return f; }
__device__ __forceinline__ unsigned f2u(float f) { unsigned u; __builtin_memcpy(&u, &f, 4); return u; }
__device__ __forceinline__ float bf2f(bf16_t b) { return u2f((unsigned)b << 16); }
__device__ __forceinline__ unsigned f2bf(float f) { unsigned u = f2u(f); return (u + 0x7fffu + ((u >> 16) & 1u)) >> 16; }
__device__ __forceinline__ unsigned pk2(float lo, float hi) { return f2bf(lo) | (f2bf(hi) << 16); }
__device__ __forceinline__ unsigned cvt_pk_bf16(float lo, float hi) {
#ifdef HOST_EMU
    return pk2(lo, hi);
#else
    unsigned r; asm volatile("v_cvt_pk_bf16_f32 %0, %1, %2" : "=v"(r) : "v"(lo), "v"(hi)); return r;
#endif
}
__device__ __forceinline__ float wave_sum(float v) {
#pragma unroll
    for (int o = 1; o < 64; o <<= 1) v += __shfl_xor(v, o);
    return v;
}
__device__ __forceinline__ float sigmoidf_(float x) { return 1.f / (1.f + __expf(-x)); }
__device__ __forceinline__ float siluf_(float x) { return x * sigmoidf_(x); }
__device__ __forceinline__ float softplusf_(float x) { return x > 20.f ? x : log1pf(__expf(x)); }
__device__ __forceinline__ float logsigmoidf_(float x) { return x < -20.f ? x : -log1pf(__expf(-x)); }
#ifdef HOST_EMU
static inline void sincospi_(float x, float* s, float* c) { *s = (float)sin(M_PI * (double)x); *c = (float)cos(M_PI * (double)x); }
#else
__device__ __forceinline__ void sincospi_(float x, float* s, float* c) { sincospif(x, s, c); }
#endif

namespace pg8 {
constexpr int BM = 256, BK = 64, HALF = 128, HTB = HALF * BK * 2, STAGE_BYTES = 8 * HTB, NXCD = 8, WGM = 8;
__host__ __device__ __forceinline__ int lds_byte(int r, int c) { const int st = (r >> 4) * 2 + (c >> 5), rr = r & 15, cc = c & 31, ob = rr * 64 + cc * 2; return st * 1024 + (ob ^ (((ob >> 9) & 1) << 5)); }
__host__ __device__ __forceinline__ void stage_rc(int b, int& R, int& C) { const int st = b / 1024, sb = b % 1024, swz = sb ^ (((sb >> 9) & 1) << 5); R = (st >> 1) * 16 + swz / 64; C = (st & 1) * 32 + (swz % 64) / 2; }
__host__ __device__ __forceinline__ int perm32(int rho) { const int n = rho >> 4, i = rho & 15; return 8 * (i >> 2) + 4 * n + (i & 3); }

struct Unit { int pm, pn, e; };
struct Gemm { const bf16_t* A; const bf16_t* Bt; int K; size_t bexp; };

__host__ __device__ __forceinline__ int xcd_remap(int L, int nwg) { const int q = nwg / NXCD, r = nwg % NXCD, xcd = L % NXCD, off = L / NXCD; return (xcd < r ? xcd * (q + 1) : r * (q + 1) + (xcd - r) * q) + off; }
struct StaticOrder {
    int nM, nN, nwg, G, c;
    __host__ __device__ void init(int M, int N, int G_, int c_) { nM = M / BM; nN = N / BM; nwg = nM * nN; G = G_; c = c_; }
    __host__ __device__ bool next(int i, Unit& u) const {
        const long L = (long)i * G + c; if (L >= nwg) return false;
        const int wgid = xcd_remap((int)L, nwg);
        const int nig = WGM * nN, gid = wgid / nig, fm = gid * WGM, gsz = (nM - fm) < WGM ? (nM - fm) : WGM;
        u.pm = fm + ((wgid % nig) % gsz); u.pn = (wgid % nig) / gsz; u.e = 0; return true;
    }
};
struct MoeOrder {
    int ntiles, nN, nwg, G, c; const LAS int* tile_e;
    __device__ void init(int ntiles_, int N, int G_, int c_, const LAS int* te) { ntiles = ntiles_; nN = N / BM; nwg = ntiles * nN; G = G_; c = c_; tile_e = te; }
    __device__ bool next(int i, Unit& u) const {
        const long L = (long)i * G + c; if (L >= nwg) return false;
        const int wgid = xcd_remap((int)L, nwg);
        u.pm = wgid / nN; u.pn = wgid % nN; u.e = __builtin_amdgcn_readfirstlane(tile_e[u.pm]); return true;
    }
};

struct EpiBf16 {
    static constexpr bool PERM = true;
    bf16_t* O; int ldc; const float* bias; int bias_estride;
    __device__ __forceinline__ void operator()(const f32x4 (&acc)[2][2][4][2], const Unit& u, int wr, int wc, int fr, int fq) const {
        const int row0 = u.pm * BM + wr * 64 + fr, col0 = u.pn * BM + wc * 32 + 8 * fq;
        f32x4 bv[2][2];
#pragma unroll
        for (int bj = 0; bj < 2; ++bj)
#pragma unroll
            for (int n = 0; n < 2; ++n) bv[bj][n] = bias ? *(const f32x4*)(bias + (size_t)u.e * bias_estride + col0 + bj * HALF + 4 * n) : (f32x4){0.f, 0.f, 0.f, 0.f};
#pragma unroll
        for (int ai = 0; ai < 2; ++ai)
#pragma unroll
            for (int m = 0; m < 4; ++m) { bf16_t* rowp = O + (size_t)(row0 + ai * HALF + m * 16) * ldc + col0;
#pragma unroll
                for (int bj = 0; bj < 2; ++bj) { const f32x4 v0 = acc[ai][bj][m][0] + bv[bj][0], v1 = acc[ai][bj][m][1] + bv[bj][1];
                    u32x4 w; w.x = cvt_pk_bf16(v0[0], v0[1]); w.y = cvt_pk_bf16(v0[2], v0[3]); w.z = cvt_pk_bf16(v1[0], v1[1]); w.w = cvt_pk_bf16(v1[2], v1[3]);
                    *(u32x4*)(rowp + bj * HALF) = w; } }
    }
};
struct EpiSwiglu {
    static constexpr bool PERM = true;
    bf16_t* O; const float* b1;
    __device__ __forceinline__ void operator()(const f32x4 (&acc)[2][2][4][2], const Unit& u, int wr, int wc, int fr, int fq) const {
        const int row0 = u.pm * BM + wr * 64 + fr, cj = u.pn * HALF + wc * 32 + 8 * fq;
        const float* bb = b1 + (size_t)u.e * 2 * DE;
        f32x4 bg[2], bl[2];
#pragma unroll
        for (int n = 0; n < 2; ++n) { bg[n] = *(const f32x4*)(bb + cj + 4 * n); bl[n] = *(const f32x4*)(bb + DE + cj + 4 * n); }
#pragma unroll
        for (int ai = 0; ai < 2; ++ai)
#pragma unroll
            for (int m = 0; m < 4; ++m) { bf16_t* rowp = O + (size_t)(row0 + ai * HALF + m * 16) * DE + cj;
                float y[8];
#pragma unroll
                for (int n = 0; n < 2; ++n) { const f32x4 g = acc[ai][0][m][n] + bg[n], l = acc[ai][1][m][n] + bl[n];
#pragma unroll
                    for (int j = 0; j < 4; ++j) { const float gg = fminf(g[j], 7.0f), ll = fminf(fmaxf(l[j], -7.0f), 7.0f); y[4 * n + j] = (ll + 1.0f) * gg * (1.f / (1.f + __expf(-1.702f * gg))); } }
                u32x4 w; w.x = cvt_pk_bf16(y[0], y[1]); w.y = cvt_pk_bf16(y[2], y[3]); w.z = cvt_pk_bf16(y[4], y[5]); w.w = cvt_pk_bf16(y[6], y[7]);
                *(u32x4*)rowp = w; }
    }
};
struct EpiResid {
    static constexpr bool PERM = false;
    const float* base0; const float* base1; float* out; const float* g;
    __device__ __forceinline__ void operator()(const f32x4 (&acc)[2][2][4][2], const Unit& u, int wr, int wc, int fr, int fq) const {
        const int col0 = u.pn * BM + wc * 32 + 4 * fq;
#pragma unroll
        for (int ai = 0; ai < 2; ++ai)
#pragma unroll
            for (int m = 0; m < 4; ++m) { const int r = u.pm * BM + ai * HALF + wr * 64 + m * 16 + fr;
                const float* bp = (r < NLAT) ? base0 + (size_t)r * D : base1 + (size_t)(r - NLAT) * D; const int bb = (r < NLAT) ? r / SEQ : NB;
                const float* gp = g + (size_t)bb * 6 * D;
#pragma unroll
                for (int bj = 0; bj < 2; ++bj)
#pragma unroll
                    for (int n = 0; n < 2; ++n) { const int c = col0 + bj * HALF + n * 16; const f32x4 bs = *(const f32x4*)(bp + c), gv = *(const f32x4*)(gp + c);
                        *(f32x4*)(out + (size_t)r * D + c) = bs + gv * acc[ai][bj][m][n]; } }
    }
};

#ifdef HOST_EMU
#define PG8_WAIT_V(n) ((void)0)
#define PG8_WAIT_L(n) ((void)0)
#else
#define PG8_WAIT_V(n) asm volatile("s_waitcnt vmcnt(" #n ")" ::: "memory")
#define PG8_WAIT_L(n) asm volatile("s_waitcnt lgkmcnt(" #n ")" ::: "memory")
#endif
template <class Epi, class Sched>
__device__ __forceinline__ void gemm_phase(LAS unsigned char* lds, const Gemm g, const Sched& S, const Epi& E, const int tid) {
    const int wid = __builtin_amdgcn_readfirstlane(tid >> 6), lane = tid & 63, wr = wid >> 2, wc = wid & 3, fr = lane & 15, fq = lane >> 4;
    const int K = g.K, nt = K / BK;
    unsigned voffA[2], voffB[2];
#pragma unroll
    for (int i = 0; i < 2; ++i) { int R, C; stage_rc(tid * 16 + i * 8192, R, C); const int Rb = Epi::PERM ? ((R & ~31) + perm32(R & 31)) : R;
        voffA[i] = (unsigned)(R * K + C) * 2u; voffB[i] = (unsigned)(Rb * K + C) * 2u; }
    const size_t kstep = (size_t)(BK * 2);
    const size_t hstep = (size_t)HALF * K * 2;
    const size_t tstep = 2 * hstep;
    const unsigned ldsw = (unsigned)wid * 1024u;
    const int aoff = lds_byte(wr * 64 + fr, fq * 8), boff = lds_byte(wc * 32 + fr, fq * 8);
#define PG8_SA(b, h) (((b) * 2 + (h)) * HTB)
#define PG8_SB(b, h) ((4 + (b) * 2 + (h)) * HTB)
#define PG8_STAGE(bufoff, gbase, voff) do { _Pragma("unroll") for (int _i = 0; _i < 2; ++_i) \
        __builtin_amdgcn_global_load_lds((const unsigned*)((const char*)(gbase) + (voff)[_i]), (LAS unsigned*)(lds + (bufoff) + ldsw + _i * 8192), 16, 0, 0); } while (0)
#define PG8_LDA(dst, b, h) do { _Pragma("unroll") for (int m = 0; m < 4; ++m) _Pragma("unroll") for (int k = 0; k < 2; ++k) dst[m][k] = *(const LAS bf16x8*)(lds + PG8_SA(b, h) + aoff + m * 2048 + k * 1024); } while (0)
#define PG8_LDB(dst, b, h) do { _Pragma("unroll") for (int n = 0; n < 2; ++n) _Pragma("unroll") for (int k = 0; k < 2; ++k) dst[n][k] = *(const LAS bf16x8*)(lds + PG8_SB(b, h) + boff + n * 2048 + k * 1024); } while (0)
#define PG8_MMA(ai, bj, At, Bt) do { __builtin_amdgcn_s_setprio(1); _Pragma("unroll") for (int m = 0; m < 4; ++m) _Pragma("unroll") for (int n = 0; n < 2; ++n) _Pragma("unroll") for (int k = 0; k < 2; ++k) \
        acc[ai][bj][m][n] = __builtin_amdgcn_mfma_f32_16x16x32_bf16(Bt[n][k], At[m][k], acc[ai][bj][m][n], 0, 0, 0); __builtin_amdgcn_s_setprio(0); } while (0)
#define PG8_BAR __builtin_amdgcn_s_barrier()
#define PG8_SCHED __builtin_amdgcn_sched_barrier(0)
    Unit cur, nxt; int ui = 0;
    if (!S.next(0, cur)) return;
    f32x4 acc[2][2][4][2];
#pragma unroll
    for (int a = 0; a < 2; ++a)
#pragma unroll
        for (int b = 0; b < 2; ++b)
#pragma unroll
            for (int m = 0; m < 4; ++m)
#pragma unroll
                for (int n = 0; n < 2; ++n) acc[a][b][m][n] = (f32x4){0.f, 0.f, 0.f, 0.f};
    bf16x8 At[4][2], B0[2][2], B1[2][2];
    const char* cA = (const char*)g.A + (size_t)cur.pm * tstep; const char* cB = (const char*)(g.Bt + (size_t)cur.e * g.bexp) + (size_t)cur.pn * tstep;
    PG8_STAGE(PG8_SB(0, 0), cB, voffB); PG8_STAGE(PG8_SB(0, 1), cB + hstep, voffB); PG8_STAGE(PG8_SA(0, 0), cA, voffA); PG8_STAGE(PG8_SA(0, 1), cA + hstep, voffA);
    if (wr == 1) PG8_BAR;
    PG8_WAIT_V(2); PG8_BAR;
    PG8_STAGE(PG8_SB(1, 0), cB + kstep, voffB); PG8_STAGE(PG8_SA(1, 0), cA + kstep, voffA); PG8_STAGE(PG8_SB(1, 1), cB + hstep + kstep, voffB);
    PG8_WAIT_V(6); PG8_BAR;
    for (;;) {
        const bool has_next = S.next(ui + 1, nxt);
        const char* nA = has_next ? (const char*)g.A + (size_t)nxt.pm * tstep : cA; const char* nB = has_next ? (const char*)(g.Bt + (size_t)nxt.e * g.bexp) + (size_t)nxt.pn * tstep : cB;
        for (int t = 0; t < nt; t += 2) {
            const bool last = (t == nt - 2);
            const char* a1 = cA + (size_t)(t + 1) * kstep;
            const char* a2 = last ? nA : cA + (size_t)(t + 2) * kstep; const char* b2 = last ? nB : cB + (size_t)(t + 2) * kstep;
            const char* a3 = a2 + kstep; const char* b3 = b2 + kstep;
            PG8_LDB(B0, 0, 0); PG8_LDB(B1, 0, 1); PG8_SCHED; PG8_LDA(At, 0, 0); PG8_STAGE(PG8_SA(1, 1), a1 + hstep, voffA);
            PG8_WAIT_V(8); PG8_WAIT_L(0); PG8_BAR; PG8_MMA(0, 0, At, B0); PG8_MMA(0, 1, At, B1); PG8_BAR; PG8_SCHED;
            PG8_LDA(At, 0, 1); PG8_STAGE(PG8_SB(0, 0), b2, voffB); PG8_STAGE(PG8_SB(0, 1), b2 + hstep, voffB); PG8_STAGE(PG8_SA(0, 0), a2, voffA);
            PG8_WAIT_V(8); PG8_WAIT_L(0); PG8_BAR; PG8_MMA(1, 0, At, B0); PG8_MMA(1, 1, At, B1); PG8_BAR; PG8_SCHED;
            PG8_LDB(B0, 1, 0); PG8_LDB(B1, 1, 1); PG8_SCHED; PG8_LDA(At, 1, 0); PG8_STAGE(PG8_SA(0, 1), a2 + hstep, voffA);
            PG8_WAIT_V(8); PG8_WAIT_L(0); PG8_BAR; PG8_MMA(0, 0, At, B0); PG8_MMA(0, 1, At, B1); PG8_BAR; PG8_SCHED;
            PG8_LDA(At, 1, 1); PG8_STAGE(PG8_SB(1, 0), b3, voffB); PG8_STAGE(PG8_SB(1, 1), b3 + hstep, voffB); PG8_STAGE(PG8_SA(1, 0), a3, voffA);
            PG8_WAIT_V(8); PG8_WAIT_L(0); PG8_BAR; PG8_MMA(1, 0, At, B0); PG8_MMA(1, 1, At, B1); PG8_BAR; PG8_SCHED;
        }
        if (wr == 0) PG8_BAR;
        {
            int t2 = threadIdx.x;
#ifndef HOST_EMU
            asm volatile("" : "+v"(t2));
#endif
            const int wid2 = __builtin_amdgcn_readfirstlane(t2 >> 6), lane2 = t2 & 63;
            E(acc, cur, wid2 >> 2, wid2 & 3, lane2 & 15, lane2 >> 4);
        }
        if (!has_next) break;
#pragma unroll
        for (int a = 0; a < 2; ++a)
#pragma unroll
            for (int b = 0; b < 2; ++b)
#pragma unroll
                for (int m = 0; m < 4; ++m)
#pragma unroll
                    for (int n = 0; n < 2; ++n) acc[a][b][m][n] = (f32x4){0.f, 0.f, 0.f, 0.f};
        cur = nxt; cA = nA; cB = nB; ++ui;
        if (wr == 1) PG8_BAR;
    }
    PG8_WAIT_V(0);
    PG8_BAR;
#undef PG8_SA
#undef PG8_SB
#undef PG8_STAGE
#undef PG8_LDA
#undef PG8_LDB
#undef PG8_MMA
#undef PG8_BAR
#undef PG8_SCHED
}
}

#define XB_TMO      128
#define XB_XCNT(j)  (256  + 64 * (j))
#define XB_XSUB(j)  (1280 + 64 * (j))
#define XB_XGEN(j)  (2304 + 64 * (j))
#define XB_TOP      3328
#define XB_TOPGEN   3392
#define XCD_BAR_WORDS 3456
#define XB_SPIN_CAP (1u << 22)
#ifdef HOST_EMU
__device__ __forceinline__ unsigned xb_ld(unsigned* p) { return *(volatile unsigned*)p; }
__device__ __forceinline__ unsigned xb_add(unsigned* p, unsigned v) { unsigned o = *p; *p = o + v; return o; }
__device__ __forceinline__ unsigned xb_xcc_id() { return blockIdx.x % 8; }
__device__ __forceinline__ unsigned atomicAdd(unsigned* p, unsigned v) { unsigned o = *p; *p = o + v; return o; }
__device__ __forceinline__ int atomicAdd(int* p, int v) { int o = *p; *p = o + v; return o; }
#else
__device__ __forceinline__ unsigned xb_ld(unsigned* p)              { return __hip_atomic_load(p, __ATOMIC_RELAXED, __HIP_MEMORY_SCOPE_AGENT); }
__device__ __forceinline__ unsigned xb_add(unsigned* p, unsigned v) { return __hip_atomic_fetch_add(p, v, __ATOMIC_RELAXED, __HIP_MEMORY_SCOPE_AGENT); }
__device__ __forceinline__ unsigned xb_xcc_id() { return (unsigned)__builtin_amdgcn_s_getreg((3 << 11) | 20) & 0xFu; }
#endif
#define XB_SPIN(cond, bar) do { unsigned _sp = 0; while (cond) { __builtin_amdgcn_s_sleep(1); \
    if ((++_sp & 255u) == 0u) { if (xb_ld(&(bar)[XB_TMO])) break; if (_sp > XB_SPIN_CAP) { atomicAdd(&(bar)[XB_TMO], 1u); break; } } } } while (0)
struct XcdBarrier { unsigned* bar; unsigned x; volatile LAS unsigned* st; };
__device__ __forceinline__ XcdBarrier xcd_barrier_post(unsigned* bar, volatile LAS unsigned* st) {
    XcdBarrier b; b.bar = bar; b.x = xb_xcc_id(); b.st = st;
    if (threadIdx.x == 0) (void)xb_add(&bar[XB_XCNT(b.x)], 1u);
    return b;
}
__device__ __forceinline__ void xcd_barrier_complete(unsigned* bar, unsigned x, unsigned& nloc, unsigned& nx) {
    const unsigned G = gridDim.x;
    unsigned sum, cnt, mine, sp = 0u;
    for (;;) {
        sum = 0u; cnt = 0u; mine = 0u;
#pragma unroll
        for (unsigned j = 0; j < 16; ++j) { const unsigned c = xb_ld(&bar[XB_XCNT(j)]); sum += c; cnt += (c > 0u) ? 1u : 0u; mine = (j == x) ? c : mine; }
        if (sum == G) break;
        __builtin_amdgcn_s_sleep(1);
        if ((++sp & 255u) == 0u) { if (xb_ld(&bar[XB_TMO])) break; if (sp > XB_SPIN_CAP) { atomicAdd(&bar[XB_TMO], 1u); break; } }
    }
    nloc = mine > 0u ? mine : 1u; nx = cnt > 0u ? cnt : 1u;
}
__device__ __forceinline__ void xcd_barrier(const XcdBarrier& b) {
    VM_WAIT();
    __syncthreads();
    if (threadIdx.x == 0) {
        unsigned* bar = b.bar;
        __builtin_amdgcn_s_waitcnt(0);
        unsigned nloc = b.st[0], nx = b.st[1];
        if (nloc == 0u) { xcd_barrier_complete(bar, b.x, nloc, nx); b.st[0] = nloc; b.st[1] = nx; }
        const unsigned old = xb_add(&bar[XB_XSUB(b.x)], 1u);
        const unsigned gen = old / nloc;
        if (old + 1u == (gen + 1u) * nloc) {
            __builtin_amdgcn_fence(__ATOMIC_RELEASE, "agent");
            VM_WAIT();
            const unsigned og = xb_add(&bar[XB_TOP], 1u);
            const unsigned tg = og / nx;
            if (og + 1u == (tg + 1u) * nx) xb_add(&bar[XB_TOPGEN], 1u);
            else XB_SPIN(xb_ld(&bar[XB_TOPGEN]) == tg, bar);
            __builtin_amdgcn_fence(__ATOMIC_ACQUIRE, "agent");
            xb_add(&bar[XB_XGEN(b.x)], 1u);
            VM_WAIT();
        } else {
            XB_SPIN(xb_ld(&bar[XB_XGEN(b.x)]) == gen, bar);
            __builtin_amdgcn_fence(__ATOMIC_ACQUIRE, "agent");
            VM_WAIT();
        }
    }
    __syncthreads();
}

struct Args {
    const float* in[34]; float* out; unsigned char* ws; int ph_lo, ph_hi;
};
enum { I_X = 0, I_C, I_CTX, I_CCTX, I_MODW, I_MODB, I_N1, I_N2, I_WIN, I_WOUT, I_HGLB, I_HGNG, I_MLGB, I_MLNG, I_HYCW, I_HYCB, I_HYW1, I_HYB1, I_HYW2, I_HYB2, I_HYFR, I_HYW3,
       I_HYBI, I_GDCW, I_GDAL, I_GDDT, I_GDNG, I_RW, I_RB, I_EW1, I_EB1, I_EW2, I_EB2, I_FG };
struct Ctx {
#ifdef HOST_EMU
    LAS unsigned char* lds; const Args* a; unsigned char* ws;
#else
    LAS unsigned char* lds; const __attribute__((address_space(4))) Args* a; unsigned char* ws;
#endif
    int tid, lane, wave, vcu, G, bid;
};
#define WSP(T, off) ((T*)(C.ws + (off)))
#define INP(i) (C.a->in[i])

__device__ __forceinline__ const float* xrow_l0(const Ctx& C, int r) { return r < NLAT ? INP(I_X) + (size_t)r * D : INP(I_CTX) + (size_t)(r - NLAT) * D; }
__device__ __forceinline__ int row_batch(int r) { return r < NLAT ? r / SEQ : NB; }

__device__ __forceinline__ void transpose_item(const float* W, int ldw, int K, bf16_t* WT, int k0, int nsrc0, int ndst0, LAS float* scr, int lane) {
#pragma unroll 8
    for (int i = 0; i < 32; ++i) { const int kk = 2 * i + (lane >> 5); scr[kk * 33 + (lane & 31)] = W[(size_t)(k0 + kk) * ldw + nsrc0 + (lane & 31)]; }
    LDS_WAIT(); asm volatile("" ::: "memory");
    const int c = lane & 7;
#pragma unroll
    for (int j = 0; j < 4; ++j) { const int n = (lane >> 3) + 8 * j; const LAS float* s = scr + (8 * c) * 33 + n;
        u32x4 o; o.x = pk2(s[0 * 33], s[1 * 33]); o.y = pk2(s[2 * 33], s[3 * 33]); o.z = pk2(s[4 * 33], s[5 * 33]); o.w = pk2(s[6 * 33], s[7 * 33]);
        *(u32x4*)(WT + (size_t)(ndst0 + n) * K + k0 + 8 * c) = o; }
    LDS_WAIT(); asm volatile("" ::: "memory");
}
__device__ __forceinline__ void p0_prologue(Ctx& C) {
    LAS float* scr = (LAS float*)(C.lds + C.wave * 16384);
    const int gw = C.vcu * 8 + C.wave, NGW = C.G * 8, lane = C.lane;
    constexpr int I_IN = 16 * (ZW / 32), I_OUT = 16 * (D / 32), I_1 = 16 * (2 * DE / 32), I_2 = (DE / 64) * (D / 32);
    constexpr int PER_L = I_IN + I_OUT + NE * (I_1 + I_2);
    for (int it = gw; it < DEPTH * PER_L; it += NGW) {
        const int l = it / PER_L; int r = it % PER_L;
        if (r < I_IN) { const int kb = r / (ZW / 32), nb = r % (ZW / 32), nd = 32 * nb, ns = nd < 2304 ? nd : nd + 16;
            transpose_item(INP(I_WIN) + (size_t)l * D * IN_W, IN_W, D, WSP(bf16_t, WS_WIN) + (size_t)l * ZW * D, 64 * kb, ns, nd, scr, lane); continue; }
        r -= I_IN;
        if (r < I_OUT) { const int kb = r / (D / 32), nb = r % (D / 32);
            transpose_item(INP(I_WOUT) + (size_t)l * D * D, D, D, WSP(bf16_t, WS_WOUT) + (size_t)l * D * D, 64 * kb, 32 * nb, 32 * nb, scr, lane); continue; }
        r -= I_OUT;
        const int e = r / (I_1 + I_2); r %= (I_1 + I_2);
        if (r < I_1) { const int kb = r / (2 * DE / 32), nb = r % (2 * DE / 32), nd = 32 * nb;
            const int ntile = nd / 256, hh = (nd % 256) / 128, j = nd % 128, ns = DE * hh + 128 * ntile + j;
            transpose_item(INP(I_EW1) + ((size_t)l * NE + e) * D * 2 * DE, 2 * DE, D, WSP(bf16_t, WS_W1) + ((size_t)l * NE + e) * 2 * DE * D, 64 * kb, ns, nd, scr, lane); continue; }
        r -= I_1;
        { const int kb = r / (D / 32), nb = r % (D / 32);
            transpose_item(INP(I_EW2) + ((size_t)l * NE + e) * DE * D, D, DE, WSP(bf16_t, WS_W2) + ((size_t)l * NE + e) * D * DE, 64 * kb, 32 * nb, 32 * nb, scr, lane); }
    }
    for (int it = gw; it < DEPTH * (6 * D / 64); it += NGW) {
        const int l = it / (6 * D / 64), n = (it % (6 * D / 64)) * 64 + lane;
        const float* w = INP(I_MODW) + (size_t)l * D * 6 * D + n;
        float acc[NB + 1];
#pragma unroll
        for (int b = 0; b <= NB; ++b) acc[b] = 0.f;
#pragma unroll 8
        for (int k = 0; k < D; ++k) { const float wv = w[(size_t)k * 6 * D];
#pragma unroll
            for (int b = 0; b <= NB; ++b) { const float cv = b < NB ? INP(I_C)[b * D + k] : INP(I_CCTX)[k]; acc[b] += siluf_(cv) * wv; } }
        const float bias = INP(I_MODB)[l * 6 * D + n];
#pragma unroll
        for (int b = 0; b <= NB; ++b) WSP(float, WS_MOD)[((size_t)l * (NB + 1) + b) * 6 * D + n] = acc[b] + bias;
    }
    const int gt = gw * 64 + lane, NGT = NGW * 64;
    for (int i = gt; i < 256; i += NGT) { const float a0 = INP(I_HGLB)[i], a1 = INP(I_HGLB)[256 + i], mx = fmaxf(a0, a1), e0 = __expf(a0 - mx), e1 = __expf(a1 - mx);
        WSP(float, WS_LB)[i] = 0.f; WSP(float, WS_LB)[256 + i] = e1 / (e0 + e1); }
    for (int i = gt; i < DEPTH * 32 * D; i += NGT) { const int l = i / (32 * D), j = (i / D) % 32, k = i % D; const int col = j < 16 ? 2304 + j : 4112 + (j - 16);
        WSP(float, WS_WG)[i] = INP(I_WIN)[((size_t)l * D + k) * IN_W + col]; }
    for (int i = gt; i < DEPTH * NE * D; i += NGT) { const int l = i / (NE * D), e = (i / D) % NE, k = i % D;
        WSP(float, WS_WR)[i] = INP(I_RW)[((size_t)l * D + k) * NE + e]; }
    for (int i = gw; i < DEPTH * (SEQ + LC); i += NGW) {
        const int l = i / (SEQ + LC), p = i % (SEQ + LC); const bool isc = p >= SEQ; const int pos = isc ? p - SEQ : p, len = isc ? LC : SEQ;
        const float *w1 = INP(I_HYW1) + l * 17 * 64, *b1 = INP(I_HYB1) + l * 64, *w2 = INP(I_HYW2) + l * 64 * 64, *b2 = INP(I_HYB2) + l * 64, *fr = INP(I_HYFR) + l * 128;
        float s = b1[lane] + ((float)pos / (float)(len - 1)) * w1[lane];
#pragma unroll
        for (int j = 0; j < 8; ++j) { const float band = 1e-4f + (7.0f - 1e-4f) * (float)j / 7.0f; const float ang = 6.283185307179586f * (float)pos * band / (float)len;
            s += cosf(ang) * w1[(1 + j) * 64 + lane] - sinf(ang) * w1[(9 + j) * 64 + lane]; }
        scr[lane] = sinf(fr[lane] * s);
        LDS_WAIT(); asm volatile("" ::: "memory");
        float s2 = b2[lane];
#pragma unroll 8
        for (int q = 0; q < 64; ++q) s2 += scr[q] * w2[q * 64 + lane];
        WSP(float, WS_HDN)[((size_t)l * (SEQ + LC) + p) * 64 + lane] = sinf(fr[64 + lane] * s2);
        LDS_WAIT(); asm volatile("" ::: "memory");
    }
}

__device__ __forceinline__ void rms_mod_row(const f32x4 (&xv)[4], const float* gain, const float* sh, const float* sc, bf16_t* orow, int lane, f32x4 (&hv)[4]) {
    float s = 0.f;
#pragma unroll
    for (int j = 0; j < 4; ++j) s += (xv[j].x * xv[j].x + xv[j].y * xv[j].y) + (xv[j].z * xv[j].z + xv[j].w * xv[j].w);
    const float rstd = 1.f / sqrtf(wave_sum(s) * (1.f / D) + EPS);
#pragma unroll
    for (int j = 0; j < 4; ++j) { const int c = 4 * lane + 256 * j; const f32x4 g = *(const f32x4*)(gain + c), a = *(const f32x4*)(sc + c), b = *(const f32x4*)(sh + c);
        hv[j] = xv[j] * rstd * g * (a + 1.0f) + b;
        u32x2 w; w.x = pk2(hv[j].x, hv[j].y); w.y = pk2(hv[j].z, hv[j].w); *(u32x2*)(orow + c) = w; }
}
__device__ __forceinline__ float row_dots_lane(const f32x4 (&hv)[4], const float* W, int lane, int n) {
    float mine = 0.f;
#pragma unroll 2
    for (int jj = 0; jj < n; ++jj) { float s = 0.f;
#pragma unroll
        for (int j = 0; j < 4; ++j) { const f32x4 w = *(const f32x4*)(W + (size_t)jj * D + 4 * lane + 256 * j); s += (hv[j].x * w.x + hv[j].y * w.y) + (hv[j].z * w.z + hv[j].w * w.w); }
        s = wave_sum(s); mine = (lane == jj) ? s : mine; }
    return mine;
}
__device__ __forceinline__ void phase_rows_a(Ctx& C, int l) {
    const int gw = C.vcu * 8 + C.wave, NGW = C.G * 8, lane = C.lane;
    const int nrows = (l == DEPTH) ? NLAT : NT;
    float* xcur = WSP(float, WS_X);
    for (int r = gw; r < nrows; r += NGW) {
        f32x4 xv[4]; const int bb = row_batch(r);
        if (l == 0) { const float* xr = xrow_l0(C, r);
#pragma unroll
            for (int j = 0; j < 4; ++j) xv[j] = *(const f32x4*)(xr + 4 * lane + 256 * j); }
        else {
            const int lp = l - 1; const int ntok = (lp == DEPTH - 1) ? NLAT : NT;
            const float* xr = xcur + (size_t)r * D;
#pragma unroll
            for (int j = 0; j < 4; ++j) xv[j] = *(const f32x4*)(xr + 4 * lane + 256 * j);
            if (r < ntok) {
                const float* g2 = WSP(float, WS_MOD) + ((size_t)lp * (NB + 1) + bb) * 6 * D + 5 * D;
                const int* te = WSP(int, WS_TOP) + (size_t)r * 4; const int* tp = WSP(int, WS_TOP) + (size_t)NT * 4 + (size_t)r * 4; const float* tg = WSP(float, WS_TOP) + (size_t)NT * 8 + (size_t)r * 4;
                const LAS int* tbase = (const LAS int*)(C.lds + LDSX_OFF + LX_TILE) + MAXTILES;
                f32x4 ys[4];
#pragma unroll
                for (int j = 0; j < 4; ++j) ys[j] = (f32x4){0.f, 0.f, 0.f, 0.f};
#pragma unroll
                for (int k = 0; k < TOPK; ++k) { const int e = te[k]; const size_t yr = (size_t)tbase[e] * 256 + tp[k]; const float gk = tg[k]; const bf16_t* yp = WSP(bf16_t, WS_Y) + yr * D;
#pragma unroll
                    for (int j = 0; j < 4; ++j) { const u32x2 w = *(const u32x2*)(yp + 4 * lane + 256 * j);
                        ys[j].x += gk * u2f(w.x << 16); ys[j].y += gk * u2f(w.x & 0xffff0000u); ys[j].z += gk * u2f(w.y << 16); ys[j].w += gk * u2f(w.y & 0xffff0000u); } }
#pragma unroll
                for (int j = 0; j < 4; ++j) { const f32x4 g = *(const f32x4*)(g2 + 4 * lane + 256 * j); xv[j] = xv[j] + g * ys[j]; }
                if (l < DEPTH) {
#pragma unroll
                    for (int j = 0; j < 4; ++j) *(f32x4*)(xcur + (size_t)r * D + 4 * lane + 256 * j) = xv[j]; }
            }
        }
        if (l == DEPTH) {
            float s = 0.f;
#pragma unroll
            for (int j = 0; j < 4; ++j) s += (xv[j].x * xv[j].x + xv[j].y * xv[j].y) + (xv[j].z * xv[j].z + xv[j].w * xv[j].w);
            const float rstd = 1.f / sqrtf(wave_sum(s) * (1.f / D) + EPS);
#pragma unroll
            for (int j = 0; j < 4; ++j) { const f32x4 g = *(const f32x4*)(INP(I_FG) + 4 * lane + 256 * j); *(f32x4*)(C.a->out + (size_t)r * D + 4 * lane + 256 * j) = xv[j] * rstd * g; }
            continue;
        }
        const float* mod = WSP(float, WS_MOD) + ((size_t)l * (NB + 1) + bb) * 6 * D;
        f32x4 hv[4];
        rms_mod_row(xv, INP(I_N1) + l * D, mod, mod + D, WSP(bf16_t, WS_H) + (size_t)r * D, lane, hv);
        const float mine = row_dots_lane(hv, WSP(float, WS_WG) + (size_t)l * 32 * D, lane, 32);
        if (lane < 32) WSP(float, WS_ZG)[(size_t)r * 32 + lane] = mine;
    }
}
__device__ __forceinline__ int build_tiles(Ctx& C, int l) {
    LAS int* tile_e = (LAS int*)(C.lds + LDSX_OFF + LX_TILE); LAS int* tbase = tile_e + MAXTILES;
    const unsigned* cnt = WSP(unsigned, WS_CTL) + CW_CNT + l * NE;
    __syncthreads();
    if (C.tid == 0) { int t = 0;
        for (int e = 0; e < NE; ++e) { const int c = (int)cnt[e], n = (c + 255) / 256; tbase[e] = t; for (int i = 0; i < n; ++i) tile_e[t + i] = e; t += n; }
        tbase[NE] = t; }
    __syncthreads();
    return tbase[NE];
}
__device__ __forceinline__ void phase_rows_b(Ctx& C, int l) {
    const int gw = C.vcu * 8 + C.wave, NGW = C.G * 8, lane = C.lane;
    const int ntok = (l == DEPTH - 1) ? NLAT : NT;
    const float* xcur = WSP(float, WS_X);
    unsigned* cnt = WSP(unsigned, WS_CTL) + CW_CNT + l * NE;
    for (int r = gw; r < ntok; r += NGW) {
        f32x4 xv[4]; const int bb = row_batch(r);
#pragma unroll
        for (int j = 0; j < 4; ++j) xv[j] = *(const f32x4*)(xcur + (size_t)r * D + 4 * lane + 256 * j);
        const float* mod = WSP(float, WS_MOD) + ((size_t)l * (NB + 1) + bb) * 6 * D;
        f32x4 hv[4];
        rms_mod_row(xv, INP(I_N2) + l * D, mod + 3 * D, mod + 4 * D, WSP(bf16_t, WS_H) + (size_t)r * D, lane, hv);
        static_assert(NE <= 32, "router width");
        const float lgm = row_dots_lane(hv, WSP(float, WS_WR) + (size_t)l * NE * D, lane, NE);
        float v = (lane < NE) ? lgm + INP(I_RB)[l * NE + (lane < NE ? lane : 0)] : -3.0e38f;
        float tv[4]; int ti[4];
#pragma unroll
        for (int k = 0; k < 4; ++k) { float bv = v; int bi = lane;
#pragma unroll
            for (int o = 1; o < 64; o <<= 1) { const float ov = __shfl_xor(bv, o); const int oi = __shfl_xor(bi, o); const bool take = (ov > bv) || (ov == bv && oi < bi); bv = take ? ov : bv; bi = take ? oi : bi; }
            tv[k] = bv; ti[k] = bi; v = (lane == bi) ? -3.4e38f : v; }
        const float e1 = __expf(tv[1] - tv[0]), e2 = __expf(tv[2] - tv[0]), e3 = __expf(tv[3] - tv[0]), inv = 1.f / (1.f + e1 + e2 + e3);
        const float gk[4] = {inv, e1 * inv, e2 * inv, e3 * inv};
        if (lane < 4) {
            int e = ti[0]; float g = gk[0];
#pragma unroll
            for (int k = 1; k < 4; ++k) { e = (lane == k) ? ti[k] : e; g = (lane == k) ? gk[k] : g; }
            const int pos = (int)atomicAdd(cnt + e, 1u);
            WSP(int, WS_TOP)[(size_t)r * 4 + lane] = e; WSP(int, WS_TOP)[(size_t)NT * 4 + (size_t)r * 4 + lane] = pos; WSP(float, WS_TOP)[(size_t)NT * 8 + (size_t)r * 4 + lane] = g;
        }
    }
}
__device__ __forceinline__ void phase_gather(Ctx& C, int l) {
    const int gw = C.vcu * 8 + C.wave, NGW = C.G * 8, lane = C.lane;
    const int ntok = (l == DEPTH - 1) ? NLAT : NT;
    (void)build_tiles(C, l);
    const LAS int* tbase = (const LAS int*)(C.lds + LDSX_OFF + LX_TILE) + MAXTILES;
    const unsigned* cnt = WSP(unsigned, WS_CTL) + CW_CNT + l * NE;
    for (int it = gw; it < ntok * 4; it += NGW) { const int r = it >> 2, k = it & 3;
        const int e = WSP(int, WS_TOP)[(size_t)r * 4 + k], pos = WSP(int, WS_TOP)[(size_t)NT * 4 + (size_t)r * 4 + k];
        const u32x4* s = (const u32x4*)(WSP(bf16_t, WS_H) + (size_t)r * D); u32x4* d = (u32x4*)(WSP(bf16_t, WS_HS) + ((size_t)tbase[e] * 256 + pos) * D);
        d[lane] = s[lane]; d[lane + 64] = s[lane + 64]; }
    for (int it = gw; it < NE * 256; it += NGW) { const int e = it >> 8, p = it & 255; const int c = (int)cnt[e], pad0 = c, pad1 = ((c + 255) / 256) * 256;
        if (pad0 + p < pad1) { u32x4* d = (u32x4*)(WSP(bf16_t, WS_HS) + ((size_t)tbase[e] * 256 + pad0 + p) * D); d[lane] = (u32x4){0u, 0u, 0u, 0u}; d[lane + 64] = (u32x4){0u, 0u, 0u, 0u}; } }
}

template <int MIX> __device__ __forceinline__ int scan_row(int b, int dir, int s) {
    if (s < LC) { const int t = dir ? LC - 1 - s : s; return NLAT + b * LC + t; }
    const int i0 = s - LC, i = dir ? SEQ - 1 - i0 : i0;
    const int t = (MIX == 1) ? (i % GROWS) * GW + (i / GROWS) : i;
    return b * SEQ + t;
}
constexpr int TC = 16;
constexpr int SL_Q = 0, SL_K = TC * 64, SL_F = 2 * TC * 64, SL_V = 3 * TC * 64, SL_SC = 4 * TC * 64, SL_EM = SL_SC + TC * 4, SL_DP = SL_EM + TC, SL_OP = SL_DP + 8 * TC, SL_PT = SL_OP + 8 * TC * 64, SL_ROW = SL_PT + 2 * 8 * 64;
template <int MIX>
__device__ __forceinline__ void scan_job(Ctx& C, int l, int b, int h, int dir) {
    LAS float* F = (LAS float*)C.lds; LAS int* rowi = (LAS int*)(F + SL_ROW);
    const int tid = C.tid, lane = C.lane, w = C.wave;
    const bf16_t* zb = WSP(bf16_t, WS_Z); const float* zg = WSP(float, WS_ZG);
    float* ob = WSP(float, WS_OB) + ((size_t)(MIX * 2 + dir) * NT) * 256;
    float S[8], nn[8]; float m = 0.f;
#pragma unroll
    for (int i = 0; i < 8; ++i) { S[i] = 0.f; nn[i] = 0.f; }
    const bool need_ctx = (l == 0);
    for (int c0 = 0; c0 < LC + SEQ; c0 += TC) {
        { const int tk = tid >> 5, sub = tid & 31; const int row = scan_row<MIX>(b, dir, c0 + tk); const bf16_t* zr = zb + (size_t)row * ZW;
            if (sub == 0) rowi[tk] = row;
            if (MIX == 0) {
#pragma unroll
                for (int q = 0; q < 2; ++q) { const int d = sub + 32 * q, c = h * 64 + d;
                    const float qz = bf2f(zr[HGB + c]), iz = bf2f(zr[HGB + 256 + c]), fz = bf2f(zr[HGB + 512 + dir * 256 + c]), lb = WSP(float, WS_LB)[l * 256 + c];
                    const float sg = 1.f / (1.f + __expf(-fz)), sgn = 1.f / (1.f + __expf(fz));
                    F[SL_Q + tk * 64 + d] = siluf_(qz); F[SL_K + tk * 64 + d] = (1.f - lb) * sgn; F[SL_F + tk * 64 + d] = lb + (1.f - lb) * sg; F[SL_V + tk * 64 + d] = iz; }
            } else if (MIX == 1) {
#pragma unroll
                for (int q = 0; q < 2; ++q) { const int d = sub + 32 * q, c = h * 64 + d;
                    F[SL_Q + tk * 64 + d] = bf2f(zr[MLB + c]); F[SL_K + tk * 64 + d] = bf2f(zr[MLB + 256 + c]) * 0.125f; F[SL_V + tk * 64 + d] = bf2f(zr[MLB + 512 + c]); }
                if (sub == 0) { const float* gb = INP(I_MLGB) + l * 16; const float* g = zg + (size_t)row * 32;
                    F[SL_SC + tk * 4 + 0] = g[(2 * dir) * 4 + h] + gb[(2 * dir) * 4 + h]; F[SL_SC + tk * 4 + 1] = logsigmoidf_(g[(2 * dir + 1) * 4 + h] + gb[(2 * dir + 1) * 4 + h]); }
            } else {
                const bool isc = row >= NLAT; const int t = isc ? (row - NLAT) % LC : row % SEQ, len = isc ? LC : SEQ;
                const bool hp = t > 0, hn = t < len - 1; const float* cw = INP(I_GDCW) + l * 3 * 768;
                float v3[3][2];
#pragma unroll
                for (int a = 0; a < 3; ++a)
#pragma unroll
                    for (int q = 0; q < 2; ++q) { const int d = sub + 32 * q, c = a * 256 + h * 64 + d;
                        float s = cw[768 + c] * bf2f(zr[GDB + c]);
                        if (hp) s += cw[c] * bf2f(zr[GDB + c - ZW]);
                        if (hn) s += cw[1536 + c] * bf2f(zr[GDB + c + ZW]);
                        v3[a][q] = siluf_(s); }
                float sq = v3[0][0] * v3[0][0] + v3[0][1] * v3[0][1], sk = v3[1][0] * v3[1][0] + v3[1][1] * v3[1][1];
#pragma unroll
                for (int o = 1; o < 32; o <<= 1) { sq += __shfl_xor(sq, o); sk += __shfl_xor(sk, o); }
                const float rq = 0.125f / sqrtf(sq + EPS), rk = 1.f / sqrtf(sk + EPS);
#pragma unroll
                for (int q = 0; q < 2; ++q) { const int d = sub + 32 * q; F[SL_Q + tk * 64 + d] = v3[0][q] * rq; F[SL_K + tk * 64 + d] = v3[1][q] * rk; F[SL_V + tk * 64 + d] = v3[2][q]; }
                if (sub == 0) { const float* g = zg + (size_t)row * 32 + 16;
                    const float la = -__expf(INP(I_GDAL)[l * 8 + dir * 4 + h]) * softplusf_(g[(2 * dir) * 4 + h] + INP(I_GDDT)[l * 8 + dir * 4 + h]);
                    F[SL_SC + tk * 4 + 0] = __expf(la); F[SL_SC + tk * 4 + 1] = sigmoidf_(g[(2 * dir + 1) * 4 + h]); }
            }
        }
        __syncthreads();
#pragma unroll 1
        for (int tk = 0; tk < TC; ++tk) {
            const float ve = F[SL_V + tk * 64 + lane]; float po = 0.f;
            if (MIX == 0) {
#pragma unroll
                for (int i = 0; i < 8; ++i) { const int d = 8 * w + i; S[i] = F[SL_F + tk * 64 + d] * S[i] + F[SL_K + tk * 64 + d] * ve; po += F[SL_Q + tk * 64 + d] * S[i]; }
            } else if (MIX == 1) {
                const float li = F[SL_SC + tk * 4 + 0], lf = F[SL_SC + tk * 4 + 1];
                const float mn = fmaxf(lf + m, li), ao = __expf(lf + m - mn), an = __expf(li - mn); m = mn; float pd = 0.f;
#pragma unroll
                for (int i = 0; i < 8; ++i) { const int d = 8 * w + i; const float kk = an * F[SL_K + tk * 64 + d], qq = F[SL_Q + tk * 64 + d];
                    S[i] = ao * S[i] + kk * ve; nn[i] = ao * nn[i] + kk; po += qq * S[i]; pd += qq * nn[i]; }
                if (lane == 0) { F[SL_DP + w * TC + tk] = pd; if (w == 0) F[SL_EM + tk] = __expf(-mn); }
            } else {
                const float a = F[SL_SC + tk * 4 + 0], be = F[SL_SC + tk * 4 + 1]; float ks = 0.f;
#pragma unroll
                for (int i = 0; i < 8; ++i) { S[i] *= a; ks += F[SL_K + tk * 64 + 8 * w + i] * S[i]; }
                F[SL_PT + (tk & 1) * 512 + w * 64 + lane] = ks;
                __syncthreads();
                float kS = 0.f;
#pragma unroll
                for (int ww = 0; ww < 8; ++ww) kS += F[SL_PT + (tk & 1) * 512 + ww * 64 + lane];
                const float u = be * (ve - kS);
#pragma unroll
                for (int i = 0; i < 8; ++i) { const int d = 8 * w + i; S[i] += F[SL_K + tk * 64 + d] * u; po += F[SL_Q + tk * 64 + d] * S[i]; }
            }
            F[SL_OP + (w * TC + tk) * 64 + lane] = po;
        }
        __syncthreads();
        { const int tk = tid >> 5, e0 = (tid & 31) * 2; float o0 = 0.f, o1 = 0.f;
#pragma unroll
            for (int ww = 0; ww < 8; ++ww) { o0 += F[SL_OP + (ww * TC + tk) * 64 + e0]; o1 += F[SL_OP + (ww * TC + tk) * 64 + e0 + 1]; }
            if (MIX == 1) { float den = 0.f;
#pragma unroll
                for (int ww = 0; ww < 8; ++ww) den += F[SL_DP + ww * TC + tk];
                const float dn = 1.f / fmaxf(fabsf(den), F[SL_EM + tk]); o0 *= dn; o1 *= dn; }
            const int row = rowi[tk];
            if (need_ctx || row < NLAT) *(f32x2*)(ob + (size_t)row * 256 + h * 64 + e0) = (f32x2){o0, o1}; }
        __syncthreads();
    }
}

__device__ __forceinline__ void fft_fwd(LAS f32x2* X, const LAS f32x2* tw, int N, int tid) {
    for (int half = N >> 1; half >= 1; half >>= 1) { const int tws = TWN / half;
        for (int j = tid; j < (N >> 1); j += 512) { const int jm = j & (half - 1), i = ((j - jm) << 1) + jm; const f32x2 a = X[i], b = X[i + half], w = tw[jm * tws];
            const f32x2 d = a - b; X[i] = a + b; X[i + half] = (f32x2){d.x * w.x - d.y * w.y, d.x * w.y + d.y * w.x}; }
        __syncthreads(); }
}
__device__ __forceinline__ void fft_inv(LAS f32x2* X, const LAS f32x2* tw, int N, int tid) {
    for (int half = 1; half <= (N >> 1); half <<= 1) { const int tws = TWN / half;
        for (int j = tid; j < (N >> 1); j += 512) { const int jm = j & (half - 1), i = ((j - jm) << 1) + jm; const f32x2 a = X[i], b0 = X[i + half], w = tw[jm * tws];
            const f32x2 b = (f32x2){b0.x * w.x + b0.y * w.y, b0.y * w.x - b0.x * w.y}; X[i] = a + b; X[i + half] = a - b; }
        __syncthreads(); }
}
__device__ __forceinline__ float block_sum(Ctx& C, float v, LAS float* red) {
    v = wave_sum(v); __syncthreads(); if (C.lane == 0) red[C.wave] = v; __syncthreads();
    float s = 0.f;
#pragma unroll
    for (int i = 0; i < 8; ++i) s += red[i];
    return s;
}
__device__ __forceinline__ void hyena_channel(Ctx& C, int l, int c, int len, int row0, int hoff  ) {
    LAS f32x2* X = (LAS f32x2*)C.lds; LAS f32x2* Y1 = (LAS f32x2*)(C.lds + 65536); const LAS f32x2* tw = (const LAS f32x2*)(C.lds + 98304); LAS float* red = (LAS float*)(C.lds + LDSX_OFF + 128);
    const int tid = C.tid, N = 2 * len;
    f32x2* Ks = WSP(f32x2, WS_KS) + (size_t)C.bid * 2 * FFTN;
    const float* hd = WSP(float, WS_HDN) + ((size_t)l * (SEQ + LC) + hoff) * 64;
    const float* w3 = INP(I_HYW3) + (size_t)l * 64 * 1024;
    const float delta = (-4.605170185988091f / 1.5f + (-4.605170185988091f / 0.3f + 4.605170185988091f / 1.5f) * (float)c / 255.0f);
    const float ad = fabsf(delta);
    for (int n = 0; n < 2; ++n) {
        float ss = 0.f;
        for (int p = tid; p < len; p += 512) { const float* hr = hd + (size_t)p * 64; float f = 0.f, g = 0.f;
#pragma unroll 8
            for (int j = 0; j < 64; ++j) { const float hv = hr[j]; f += hv * w3[j * 1024 + n * 256 + c]; g += hv * w3[j * 1024 + 512 + n * 256 + c]; }
            const float win = __expf(-((float)p / (float)(len - 1)) * ad); f *= win; g *= win;
            X[p] = (f32x2){f, 0.f}; ss += f * f;
            if (p >= 1) { X[N - p] = (f32x2){g, 0.f}; ss += g * g; } }
        if (tid == 0) X[len] = (f32x2){0.f, 0.f};
        const float scale = 1.f / sqrtf(block_sum(C, ss, red) + EPS);
        __syncthreads();
        fft_fwd(X, tw, N, tid);
        for (int i = tid; i < N; i += 512) Ks[(size_t)n * FFTN + i] = X[i] * scale;
        __syncthreads();
    }
    const bf16_t* zb = WSP(bf16_t, WS_Z); const float* cw = INP(I_HYCW) + l * 3 * 768; const float* cb = INP(I_HYCB) + l * 768;
    const float bias0 = INP(I_HYBI)[l * 512 + c], bias1 = INP(I_HYBI)[l * 512 + 256 + c];
    float* hyt = WSP(float, WS_HYT) + (size_t)c * NT;
    const float inv_n = 1.0f / (float)N;
    const int nseq = NB;
    auto conv3 = [&](int row, int t, int col) -> float {
        const bf16_t* zr = zb + (size_t)row * ZW + HYB + col; float s = cb[col] + cw[768 + col] * bf2f(zr[0]);
        if (t > 0) s += cw[col] * bf2f(zr[-ZW]);
        if (t < len - 1) s += cw[1536 + col] * bf2f(zr[ZW]);
        return s; };
    for (int q = 0; q < nseq; q += 2) {
        const int ra = row0 + q * len, rb = ra + len;
        for (int t = tid; t < len; t += 512) { X[t] = (f32x2){conv3(ra + t, t, c), conv3(rb + t, t, c)}; X[len + t] = (f32x2){0.f, 0.f}; }
        __syncthreads();
        fft_fwd(X, tw, N, tid);
        for (int i = tid; i < N; i += 512) { const f32x2 k = Ks[i], x = X[i]; X[i] = (f32x2){x.x * k.x - x.y * k.y, x.x * k.y + x.y * k.x}; }
        __syncthreads();
        fft_inv(X, tw, N, tid);
        for (int t = tid; t < len; t += 512) { const f32x2 cv = X[t] * inv_n; const float va = conv3(ra + t, t, c), vb = conv3(rb + t, t, c), xa = conv3(ra + t, t, 256 + c), xb = conv3(rb + t, t, 256 + c);
            Y1[t] = (f32x2){xa * (cv.x + bias0 * va), xb * (cv.y + bias0 * vb)}; }
        __syncthreads();
        for (int t = tid; t < len; t += 512) { X[t] = Y1[t]; X[len + t] = (f32x2){0.f, 0.f}; }
        __syncthreads();
        fft_fwd(X, tw, N, tid);
        for (int i = tid; i < N; i += 512) { const f32x2 k = Ks[FFTN + i], x = X[i]; X[i] = (f32x2){x.x * k.x - x.y * k.y, x.x * k.y + x.y * k.x}; }
        __syncthreads();
        fft_inv(X, tw, N, tid);
        for (int t = tid; t < len; t += 512) { const f32x2 cv = X[t] * inv_n, y1 = Y1[t]; const float xa = conv3(ra + t, t, 512 + c), xb = conv3(rb + t, t, 512 + c);
            hyt[ra + t] = xa * (cv.x + bias1 * y1.x); hyt[rb + t] = xb * (cv.y + bias1 * y1.y); }
        __syncthreads();
    }
}
__device__ __forceinline__ void phase_mixers(Ctx& C, int l) {
    const int G = C.G, me = C.bid;
    const int nscan = 3 * NB * NH * 2, nsw = G > nscan ? nscan : G;
    for (int j = me; j < nscan; j += nsw) { if (me >= nsw) break;
        const int mix = j / (NB * NH * 2), r = j % (NB * NH * 2), b = r / (NH * 2), h = (r / 2) % NH, dir = r & 1;
        if (mix == 0) scan_job<0>(C, l, b, h, dir); else if (mix == 1) scan_job<1>(C, l, b, h, dir); else scan_job<2>(C, l, b, h, dir); }
    const int hy0 = G > nscan ? nscan : 0, nhw = G - hy0;
    if (me >= hy0) {
        LAS f32x2* tw = (LAS f32x2*)(C.lds + 98304);
        __syncthreads();
        for (int k = C.tid; k < TWN; k += 512) { float s, c; sincospi_((float)k / (float)TWN, &s, &c); tw[k] = (f32x2){c, -s}; }
        __syncthreads();
        for (int c = me - hy0; c < 256; c += nhw) { hyena_channel(C, l, c, SEQ, 0, 0); if (l == 0) hyena_channel(C, l, c, LC, NLAT, SEQ); }
    }
}
__device__ __forceinline__ void phase_finalize(Ctx& C, int l) {
    const int gw = C.vcu * 8 + C.wave, NGW = C.G * 8, lane = C.lane;
    const int nrows = (l == 0) ? NT : NLAT;
    const bf16_t* zb = WSP(bf16_t, WS_Z); bf16_t* mix = WSP(bf16_t, WS_MIX);
    for (int it = gw; it < nrows * 3; it += NGW) { const int r = it / 3, mx = it % 3;
        const float* of = WSP(float, WS_OB) + ((size_t)(mx * 2) * NT + r) * 256 + 4 * lane; const float* obk = of + (size_t)NT * 256;
        f32x4 o = *(const f32x4*)of + *(const f32x4*)obk;
        float s = (o.x * o.x + o.y * o.y) + (o.z * o.z + o.w * o.w);
#pragma unroll
        for (int k = 1; k < 16; k <<= 1) s += __shfl_xor(s, k);
        const float rs = 1.f / sqrtf(s * (1.f / 64.f) + EPS);
        const float* ng = INP(mx == 0 ? I_HGNG : (mx == 1 ? I_MLNG : I_GDNG)) + l * 256 + 4 * lane;
        const int gcol = (mx == 0 ? HGB + 1024 : (mx == 1 ? MLB + 768 : GDB + 768)) + 4 * lane, ocol = (mx == 2 ? 768 : mx * 256) + 4 * lane;
        const u32x2 gz = *(const u32x2*)(zb + (size_t)r * ZW + gcol);
        float g[4] = {u2f(gz.x << 16), u2f(gz.x & 0xffff0000u), u2f(gz.y << 16), u2f(gz.y & 0xffff0000u)};
#pragma unroll
        for (int k = 0; k < 4; ++k) g[k] = (mx == 1) ? sigmoidf_(g[k]) : siluf_(g[k]);
        u32x2 w; w.x = pk2(o.x * rs * ng[0] * g[0], o.y * rs * ng[1] * g[1]); w.y = pk2(o.z * rs * ng[2] * g[2], o.w * rs * ng[3] * g[3]);
        *(u32x2*)(mix + (size_t)r * D + ocol) = w; }
    LAS float* scr = (LAS float*)(C.lds + C.wave * 8448);
    const int ntr = nrows / 64;
    for (int it = gw; it < ntr * 8; it += NGW) { const int rt = it / 8, cb = (it % 8) * 32; const float* src = WSP(float, WS_HYT) + (size_t)cb * NT + rt * 64;
#pragma unroll 8
        for (int cc = 0; cc < 32; ++cc) scr[cc * 65 + lane] = src[(size_t)cc * NT + lane];
        LDS_WAIT(); asm volatile("" ::: "memory");
        for (int rr = 0; rr < 64; rr += 4) { const int r = rr + (lane >> 4), c2 = (lane & 15) * 2;
            *(unsigned*)(mix + (size_t)(rt * 64 + r) * D + 512 + cb + c2) = pk2(scr[c2 * 65 + r], scr[(c2 + 1) * 65 + r]); }
        LDS_WAIT(); asm volatile("" ::: "memory"); }
}

enum { PH_PRO = 0, PH_L0 = 1, PH_PER_LAYER = 9, PH_FINAL = PH_L0 + DEPTH * PH_PER_LAYER, PH_COUNT };
__global__ void __launch_bounds__(512, 2) fwd_kernel(Args args) {
#ifdef HOST_EMU
    unsigned char* lds = emu::cur->blk->lds;
#else
    extern __shared__ __attribute__((aligned(16))) unsigned char lds[];
#endif
#ifdef HOST_EMU
    Ctx C; C.lds = (LAS unsigned char*)lds; C.a = &args; C.ws = args.ws;
#else
    Ctx C; C.lds = (LAS unsigned char*)lds; C.a = (const __attribute__((address_space(4))) Args*)__builtin_amdgcn_kernarg_segment_ptr(); C.ws = C.a->ws;
#endif
    C.tid = threadIdx.x; C.lane = C.tid & 63; C.wave = __builtin_amdgcn_readfirstlane(C.tid >> 6);
    C.bid = blockIdx.x; C.G = gridDim.x; { const int bx = blockIdx.x; C.vcu = (C.G % 8 == 0) ? (bx % 8) * (C.G / 8) + bx / 8 : bx; }
    volatile LAS unsigned* MISC = (volatile LAS unsigned*)(C.lds + LDSX_OFF + LX_MISC);
    for (int u = C.tid; u < 64; u += 512) MISC[u] = 0u;
    __syncthreads();
    const int lo = C.a->ph_lo, hi = C.a->ph_hi;
    const bool multi = (hi - lo) > 1;
    XcdBarrier bar; bar.bar = WSP(unsigned, WS_CTL) + CW_BAR; bar.x = 0; bar.st = nullptr;
    if (multi) bar = xcd_barrier_post(WSP(unsigned, WS_CTL) + CW_BAR, MISC + 8);
#ifndef HOST_EMU
    if (multi) { cooperative_groups::this_grid().sync(); }
#endif
    const Ctx C0 = C;
#ifdef HOST_EMU
#define LAUNDER_CTX() Ctx C = C0; C.tid = threadIdx.x; C.lane = C.tid & 63; C.wave = C.tid >> 6;
#else
#define LAUNDER_CTX() Ctx C = C0; C.tid = threadIdx.x; \
        {   unsigned long long pw = (unsigned long long)C.ws, pa = (unsigned long long)C.a; unsigned w0 = (unsigned)pw, w1 = (unsigned)(pw >> 32), a0 = (unsigned)pa, a1 = (unsigned)(pa >> 32), v0 = (unsigned)C.vcu, g0 = (unsigned)C.G, b0 = (unsigned)C.bid; \
            asm volatile("" : "+v"(w0), "+v"(w1), "+v"(a0), "+v"(a1), "+v"(v0), "+v"(g0), "+v"(b0), "+v"(C.tid)); \
            w0 = __builtin_amdgcn_readfirstlane(w0); w1 = __builtin_amdgcn_readfirstlane(w1); a0 = __builtin_amdgcn_readfirstlane(a0); a1 = __builtin_amdgcn_readfirstlane(a1); \
            C.vcu = (int)__builtin_amdgcn_readfirstlane(v0); C.G = (int)__builtin_amdgcn_readfirstlane(g0); C.bid = (int)__builtin_amdgcn_readfirstlane(b0); \
            C.ws = (unsigned char*)(((unsigned long long)w1 << 32) | w0); C.a = (const __attribute__((address_space(4))) Args*)(((unsigned long long)a1 << 32) | a0); } \
        C.lane = C.tid & 63; C.wave = __builtin_amdgcn_readfirstlane(C.tid >> 6);
#endif
#define PH_BEGIN(k) if (lo <= (k) && (k) < hi) { LAUNDER_CTX()
#define PH_END(k) if ((k) + 1 < hi) { XcdBarrier b2 = bar; b2.bar = WSP(unsigned, WS_CTL) + CW_BAR; xcd_barrier(b2); } }
    PH_BEGIN(PH_PRO) p0_prologue(C); PH_END(PH_PRO)
#define LAYER_PHASES(l) { constexpr int pb = PH_L0 + (l) * PH_PER_LAYER; \
    PH_BEGIN(pb + 0) if ((l) > 0) (void)build_tiles(C, (l) > 0 ? (l) - 1 : 0); phase_rows_a(C, (l)); PH_END(pb + 0) \
    PH_BEGIN(pb + 1) pg8::Gemm g{WSP(bf16_t, WS_H), WSP(bf16_t, WS_WIN) + (size_t)(l) * ZW * D, D, 0}; pg8::StaticOrder S; S.init(NT, ZW, C.G, C.bid); \
        pg8::EpiBf16 E{WSP(bf16_t, WS_Z), ZW, nullptr, 0}; pg8::gemm_phase(C.lds, g, S, E, C.tid); PH_END(pb + 1) \
    PH_BEGIN(pb + 2) phase_mixers(C, (l)); PH_END(pb + 2) \
    PH_BEGIN(pb + 3) phase_finalize(C, (l)); PH_END(pb + 3) \
    PH_BEGIN(pb + 4) pg8::Gemm g{WSP(bf16_t, WS_MIX), WSP(bf16_t, WS_WOUT) + (size_t)(l) * D * D, D, 0}; pg8::StaticOrder S; S.init((l) == 0 ? NT : NLAT, D, C.G, C.bid); \
        pg8::EpiResid E{(l) == 0 ? INP(I_X) : WSP(float, WS_X), (l) == 0 ? INP(I_CTX) : WSP(float, WS_X) + (size_t)NLAT * D, WSP(float, WS_X), WSP(float, WS_MOD) + (size_t)(l) * (NB + 1) * 6 * D + 2 * D}; \
        pg8::gemm_phase(C.lds, g, S, E, C.tid); PH_END(pb + 4) \
    PH_BEGIN(pb + 5) phase_rows_b(C, (l)); PH_END(pb + 5) \
    PH_BEGIN(pb + 6) phase_gather(C, (l)); PH_END(pb + 6) \
    PH_BEGIN(pb + 7) const int ntiles = build_tiles(C, (l)); \
        pg8::Gemm g{WSP(bf16_t, WS_HS), WSP(bf16_t, WS_W1) + (size_t)(l) * NE * 2 * DE * D, D, (size_t)2 * DE * D}; pg8::MoeOrder S; S.init(ntiles, 2 * DE, C.G, C.bid, (const LAS int*)(C.lds + LDSX_OFF + LX_TILE)); \
        pg8::EpiSwiglu E{WSP(bf16_t, WS_A2), INP(I_EB1) + (size_t)(l) * NE * 2 * DE}; pg8::gemm_phase(C.lds, g, S, E, C.tid); PH_END(pb + 7) \
    PH_BEGIN(pb + 8) const int ntiles = build_tiles(C, (l)); \
        pg8::Gemm g{WSP(bf16_t, WS_A2), WSP(bf16_t, WS_W2) + (size_t)(l) * NE * D * DE, DE, (size_t)D * DE}; pg8::MoeOrder S; S.init(ntiles, D, C.G, C.bid, (const LAS int*)(C.lds + LDSX_OFF + LX_TILE)); \
        pg8::EpiBf16 E{WSP(bf16_t, WS_Y), D, INP(I_EB2) + (size_t)(l) * NE * D, D}; pg8::gemm_phase(C.lds, g, S, E, C.tid); PH_END(pb + 8) }
    LAYER_PHASES(0)
    LAYER_PHASES(1)
    static_assert(DEPTH == 2, "two layers written out");
    PH_BEGIN(PH_FINAL) (void)build_tiles(C, DEPTH - 1); phase_rows_a(C, DEPTH); PH_END(PH_FINAL)
}

#ifndef MK_PER_PHASE
#define MK_PER_PHASE 1
#endif
extern "C" void kernel_launch(void* const* d_in, const int* in_sizes, int n_in, void* d_out, int out_size, void* d_ws, size_t ws_size, hipStream_t stream) {
    static int grid = 0;
#ifndef HOST_EMU
    if (grid == 0) {
        if (n_in != 34 || ws_size < WS_END) { fprintf(stderr, "kernel_launch: unexpected n_in %d / ws %zu (need %zu)\n", n_in, ws_size, (size_t)WS_END); grid = -1; return; }
        int dev = 0, cus = 0, per_cu = 0;
        hipGetDevice(&dev); hipDeviceGetAttribute(&cus, hipDeviceAttributeMultiprocessorCount, dev);
        hipFuncSetAttribute((const void*)fwd_kernel, hipFuncAttributeMaxDynamicSharedMemorySize, LDS_BYTES);
        hipOccupancyMaxActiveBlocksPerMultiprocessor(&per_cu, (const void*)fwd_kernel, 512, LDS_BYTES);
        if (per_cu < 1) { fprintf(stderr, "kernel_launch: occupancy query says %d blocks per CU\n", per_cu); per_cu = 1; }
        grid = cus;
        (void)hipGetLastError();
    }
    if (grid < 0) return;
#else
    grid = EMU_GRID;
#endif
    hipMemsetAsync((char*)d_ws + WS_CTL, 0, CTL_BYTES, stream);
    Args a{};
    for (int i = 0; i < 34; ++i) a.in[i] = (const float*)d_in[i];
    a.out = (float*)d_out; a.ws = (unsigned char*)d_ws;
#ifdef HOST_EMU
    a.ph_lo = 0; a.ph_hi = PH_COUNT;
    if (getenv("EMU_PH_HI")) a.ph_hi = atoi(getenv("EMU_PH_HI"));
    emu::launch([&]() { fwd_kernel(a); }, dim3(grid), dim3(512), LDS_BYTES);
#else
#if MK_PER_PHASE
    for (int ph = 0; ph < PH_COUNT; ++ph) { a.ph_lo = ph; a.ph_hi = ph + 1; hipLaunchKernelGGL(fwd_kernel, dim3(grid), dim3(512), LDS_BYTES, stream, a); }
#else
    a.ph_lo = 0; a.ph_hi = PH_COUNT;
    void* kargs[] = {&a};
    hipError_t e = hipLaunchCooperativeKernel((const void*)fwd_kernel, dim3(grid), dim3(512), kargs, LDS_BYTES, stream);
    if (e != hipSuccess) fprintf(stderr, "cooperative launch failed: %s (grid %d)\n", hipGetErrorString(e), grid);
#endif
#endif
}
```

```cpp
#ifdef HOST_EMU
#include "host/emu.h"
#else
#include <hip/hip_runtime.h>
#include <hip/hip_cooperative_groups.h>
#endif
#include <cstdio>
#include <cstdint>
#include <cmath>

#ifndef CFG_B
#define CFG_B 4
#define CFG_L 4096
#define CFG_GW 64
#define CFG_LC 256
#define CFG_NE 32
#endif
constexpr int NB = CFG_B, SEQ = CFG_L, GW = CFG_GW, GROWS = SEQ / GW, LC = CFG_LC, NE = CFG_NE, TOPK = 4, DEPTH = 2;
constexpr int D = 1024, WG_ = 256, NH = 4, DH = 64;
constexpr int NLAT = NB * SEQ, NCTX = NB * LC, NT = NLAT + NCTX;
constexpr int IN_W = 4128, ZW = 4096;
constexpr int HGB = 0, MLB = 1280, HYB = 2304, GDB = 3072;
constexpr int DE = 1024;
constexpr float EPS = 1e-6f;
constexpr int FFTN = 2 * SEQ, FFTNC = 2 * LC, TWN = FFTN / 2;
static_assert(NT % 256 == 0 && NLAT % 256 == 0, "row counts must be multiples of 256");
static_assert(SEQ % 16 == 0 && LC % 16 == 0, "chunking");
constexpr int MAXTILES = (NT * TOPK + NE * 255) / 256 + 1;

constexpr size_t al256(size_t x) { return (x + 255) & ~(size_t)255; }
constexpr size_t WS_CTL = 0, CTL_BYTES = 1 << 20;
constexpr size_t WS_WIN = WS_CTL + CTL_BYTES;
constexpr size_t WS_WOUT = WS_WIN + (size_t)DEPTH * ZW * D * 2;
constexpr size_t WS_W1 = WS_WOUT + (size_t)DEPTH * D * D * 2;
constexpr size_t WS_W2 = WS_W1 + (size_t)DEPTH * NE * 2 * DE * D * 2;
constexpr size_t WS_WG = WS_W2 + (size_t)DEPTH * NE * D * DE * 2;
constexpr size_t WS_WR = WS_WG + (size_t)DEPTH * 32 * D * 4;
constexpr size_t WS_MOD = WS_WR + (size_t)DEPTH * NE * D * 4;
constexpr size_t WS_LB = WS_MOD + al256((size_t)DEPTH * (NB + 1) * 6 * D * 4);
constexpr size_t WS_HDN = WS_LB + (size_t)DEPTH * 256 * 4;
constexpr size_t WS_X = WS_HDN + (size_t)DEPTH * (SEQ + LC) * 64 * 4;
constexpr size_t WS_H = WS_X + (size_t)NT * D * 4;
constexpr size_t WS_Z = WS_H + (size_t)NT * D * 2;
constexpr size_t WS_ZG = WS_Z + (size_t)NT * ZW * 2;
constexpr size_t WS_MIX = WS_ZG + (size_t)NT * 32 * 4;
constexpr size_t WS_OB = WS_MIX + (size_t)NT * D * 2;
constexpr size_t WS_HYT = WS_OB + (size_t)6 * NT * 256 * 4;
constexpr size_t WS_KS = WS_HYT + (size_t)256 * NT * 4;
constexpr size_t WS_TOP = WS_KS + (size_t)256 * 2 * FFTN * 8;
constexpr size_t WS_HS = WS_TOP + (size_t)NT * 4 * 12;
constexpr size_t WS_A2 = WS_HS + (size_t)MAXTILES * 256 * D * 2;
constexpr size_t WS_Y = WS_A2 + (size_t)MAXTILES * 256 * DE * 2;
constexpr int NCH = (LC + SEQ) / 64, NCHC = LC / 64, NSCAN = NB * NH * 2;
constexpr size_t GD_BLOB = 49152;
constexpr size_t WS_GD = WS_Y + (size_t)MAXTILES * 256 * D * 2;
constexpr size_t WS_GST = WS_GD + (size_t)NSCAN * NCH * GD_BLOB;
constexpr size_t ML_BLOB = 34816;
constexpr size_t WS_ML = WS_GST + (size_t)NSCAN * NCH * 8192;
constexpr size_t ML_ST = 8192 + 512;
constexpr size_t WS_MST = WS_ML + (size_t)NSCAN * NCH * ML_BLOB;
constexpr size_t HG_BLOB = 58368;
constexpr size_t WS_HG = WS_MST + (size_t)NSCAN * NCH * ML_ST;
constexpr size_t WS_HST = WS_HG + (size_t)NSCAN * NCH * HG_BLOB;
constexpr size_t WS_ZT = WS_HST + (size_t)NSCAN * NCH * 4 * 8192;
constexpr size_t WS_END = WS_ZT + (size_t)768 * NT * 2;
static_assert(SEQ % 64 == 0 && LC % 64 == 0, "64-token chunks");
constexpr int CW_CNT = 64;
constexpr int CW_HYQ = 192;
constexpr int CW_BAR = 4096;

constexpr int RING_BYTES = 131072, LDSX_OFF = RING_BYTES, LDS_BYTES = 147456;
constexpr int LX_MISC = 0, LX_TILE = 256;

#ifdef HOST_EMU
#define __expf expf
#define __logf logf
#define LAS
#define GAS
#define DEV_ASM(x) ((void)0)
#define VM_WAIT() ((void)0)
#define LDS_WAIT() do { int _s; (void)emu::wave_xchg(&_s, 4, _s); } while (0)
#else
#define LAS __attribute__((address_space(3)))
#define GAS __attribute__((address_space(1)))
#define VM_WAIT() asm volatile("s_waitcnt vmcnt(0)" ::: "memory")
#define LDS_WAIT() asm volatile("s_waitcnt lgkmcnt(0)" ::: "memory")
#endif
typedef unsigned short bf16_t;
typedef short bf16x8 __attribute__((ext_vector_type(8)));
typedef float f32x4 __attribute__((ext_vector_type(4)));
typedef float f32x2 __attribute__((ext_vector_type(2)));
typedef unsigned u32x4 __attribute__((ext_vector_type(4)));
typedef unsigned u32x2 __attribute__((ext_vector_type(2)));

__device__ __forceinline__ float u2f(unsigned u) { float f; __builtin_memcpy(&f, &u, 4); return f; }
__device__ __forceinline__ unsigned f2u(float f) { unsigned u; __builtin_memcpy(&u, &f, 4); return u; }
__device__ __forceinline__ float bf2f(bf16_t b) { return u2f((unsigned)b << 16); }
__device__ __forceinline__ unsigned f2bf(float f) { unsigned u = f2u(f); return (u + 0x7fffu + ((u >> 16) & 1u)) >> 16; }
__device__ __forceinline__ unsigned pk2(float lo, float hi) { return f2bf(lo) | (f2bf(hi) << 16); }
__device__ __forceinline__ unsigned cvt_pk_bf16(float lo, float hi) {
#ifdef HOST_EMU
    return pk2(lo, hi);
#else
    unsigned r; asm volatile("v_cvt_pk_bf16_f32 %0, %1, %2" : "=v"(r) : "v"(lo), "v"(hi)); return r;
#endif
}
__device__ __forceinline__ float wave_sum(float v) {
#pragma unroll
    for (int o = 1; o < 64; o <<= 1) v += __shfl_xor(v, o);
    return v;
}
__device__ __forceinline__ float sigmoidf_(float x) { return 1.f / (1.f + __expf(-x)); }
__device__ __forceinline__ float siluf_(float x) { return x * sigmoidf_(x); }
__device__ __forceinline__ float softplusf_(float x) { return x > 20.f ? x : log1pf(__expf(x)); }
__device__ __forceinline__ float logsigmoidf_(float x) { return x < -20.f ? x : -log1pf(__expf(-x)); }
#ifdef HOST_EMU
static inline void sincospi_(float x, float* s, float* c) { *s = (float)sin(M_PI * (double)x); *c = (float)cos(M_PI * (double)x); }
#else
__device__ __forceinline__ void sincospi_(float x, float* s, float* c) { sincospif(x, s, c); }
#endif

namespace pg8 {
constexpr int BM = 256, BK = 64, HALF = 128, HTB = HALF * BK * 2, STAGE_BYTES = 8 * HTB, NXCD = 8, WGM = 8;
__host__ __device__ __forceinline__ int lds_byte(int r, int c) { const int st = (r >> 4) * 2 + (c >> 5), rr = r & 15, cc = c & 31, ob = rr * 64 + cc * 2; return st * 1024 + (ob ^ (((ob >> 9) & 1) << 5)); }
__host__ __device__ __forceinline__ void stage_rc(int b, int& R, int& C) { const int st = b / 1024, sb = b % 1024, swz = sb ^ (((sb >> 9) & 1) << 5); R = (st >> 1) * 16 + swz / 64; C = (st & 1) * 32 + (swz % 64) / 2; }
__host__ __device__ __forceinline__ int perm32(int rho) { const int n = rho >> 4, i = rho & 15; return 8 * (i >> 2) + 4 * n + (i & 3); }

struct Unit { int pm, pn, e; };
struct Gemm { const bf16_t* A; const bf16_t* Bt; int K; size_t bexp; };

__host__ __device__ __forceinline__ int xcd_remap(int L, int nwg) { const int q = nwg / NXCD, r = nwg % NXCD, xcd = L % NXCD, off = L / NXCD; return (xcd < r ? xcd * (q + 1) : r * (q + 1) + (xcd - r) * q) + off; }
struct StaticOrder {
    int nM, nN, nwg, G, c;
    __host__ __device__ void init(int M, int N, int G_, int c_) { nM = M / BM; nN = N / BM; nwg = nM * nN; G = G_; c = c_; }
    __host__ __device__ bool next(int i, Unit& u) const {
        const long L = (long)i * G + c; if (L >= nwg) return false;
        const int wgid = xcd_remap((int)L, nwg);
        const int nig = WGM * nN, gid = wgid / nig, fm = gid * WGM, gsz = (nM - fm) < WGM ? (nM - fm) : WGM;
        u.pm = fm + ((wgid % nig) % gsz); u.pn = (wgid % nig) / gsz; u.e = 0; return true;
    }
};
struct MoeOrder {
    int ntiles, nN, nwg, G, c; const LAS int* tile_e;
    __device__ void init(int ntiles_, int N, int G_, int c_, const LAS int* te) { ntiles = ntiles_; nN = N / BM; nwg = ntiles * nN; G = G_; c = c_; tile_e = te; }
    __device__ bool next(int i, Unit& u) const {
        const long L = (long)i * G + c; if (L >= nwg) return false;
        const int wgid = xcd_remap((int)L, nwg);
        u.pm = wgid / nN; u.pn = wgid % nN; u.e = __builtin_amdgcn_readfirstlane(tile_e[u.pm]); return true;
    }
};

struct EpiBf16 {
    static constexpr bool PERM = true;
    bf16_t* O; int ldc; const float* bias; int bias_estride;
    __device__ __forceinline__ void operator()(const f32x4 (&acc)[2][2][4][2], const Unit& u, int wr, int wc, int fr, int fq) const {
        const int row0 = u.pm * BM + wr * 64 + fr, col0 = u.pn * BM + wc * 32 + 8 * fq;
        f32x4 bv[2][2];
#pragma unroll
        for (int bj = 0; bj < 2; ++bj)
#pragma unroll
            for (int n = 0; n < 2; ++n) bv[bj][n] = bias ? *(const f32x4*)(bias + (size_t)u.e * bias_estride + col0 + bj * HALF + 4 * n) : (f32x4){0.f, 0.f, 0.f, 0.f};
#pragma unroll
        for (int ai = 0; ai < 2; ++ai)
#pragma unroll
            for (int m = 0; m < 4; ++m) { bf16_t* rowp = O + (size_t)(row0 + ai * HALF + m * 16) * ldc + col0;
#pragma unroll
                for (int bj = 0; bj < 2; ++bj) { const f32x4 v0 = acc[ai][bj][m][0] + bv[bj][0], v1 = acc[ai][bj][m][1] + bv[bj][1];
                    u32x4 w; w.x = cvt_pk_bf16(v0[0], v0[1]); w.y = cvt_pk_bf16(v0[2], v0[3]); w.z = cvt_pk_bf16(v1[0], v1[1]); w.w = cvt_pk_bf16(v1[2], v1[3]);
                    *(u32x4*)(rowp + bj * HALF) = w; } }
    }
};
struct EpiSwiglu {
    static constexpr bool PERM = true;
    bf16_t* O; const float* b1;
    __device__ __forceinline__ void operator()(const f32x4 (&acc)[2][2][4][2], const Unit& u, int wr, int wc, int fr, int fq) const {
        const int row0 = u.pm * BM + wr * 64 + fr, cj = u.pn * HALF + wc * 32 + 8 * fq;
        const float* bb = b1 + (size_t)u.e * 2 * DE;
        f32x4 bg[2], bl[2];
#pragma unroll
        for (int n = 0; n < 2; ++n) { bg[n] = *(const f32x4*)(bb + cj + 4 * n); bl[n] = *(const f32x4*)(bb + DE + cj + 4 * n); }
#pragma unroll
        for (int ai = 0; ai < 2; ++ai)
#pragma unroll
            for (int m = 0; m < 4; ++m) { bf16_t* rowp = O + (size_t)(row0 + ai * HALF + m * 16) * DE + cj;
                float y[8];
#pragma unroll
                for (int n = 0; n < 2; ++n) { const f32x4 g = acc[ai][0][m][n] + bg[n], l = acc[ai][1][m][n] + bl[n];
#pragma unroll
                    for (int j = 0; j < 4; ++j) { const float gg = fminf(g[j], 7.0f), ll = fminf(fmaxf(l[j], -7.0f), 7.0f); y[4 * n + j] = (ll + 1.0f) * gg * (1.f / (1.f + __expf(-1.702f * gg))); } }
                u32x4 w; w.x = cvt_pk_bf16(y[0], y[1]); w.y = cvt_pk_bf16(y[2], y[3]); w.z = cvt_pk_bf16(y[4], y[5]); w.w = cvt_pk_bf16(y[6], y[7]);
                *(u32x4*)rowp = w; }
    }
};
struct EpiResid {
    static constexpr bool PERM = false;
    const float* base0; const float* base1; float* out; const float* g;
    __device__ __forceinline__ void operator()(const f32x4 (&acc)[2][2][4][2], const Unit& u, int wr, int wc, int fr, int fq) const {
        const int col0 = u.pn * BM + wc * 32 + 4 * fq;
#pragma unroll
        for (int ai = 0; ai < 2; ++ai)
#pragma unroll
            for (int m = 0; m < 4; ++m) { const int r = u.pm * BM + ai * HALF + wr * 64 + m * 16 + fr;
                const float* bp = (r < NLAT) ? base0 + (size_t)r * D : base1 + (size_t)(r - NLAT) * D; const int bb = (r < NLAT) ? r / SEQ : NB;
                const float* gp = g + (size_t)bb * 6 * D;
#pragma unroll
                for (int bj = 0; bj < 2; ++bj)
#pragma unroll
                    for (int n = 0; n < 2; ++n) { const int c = col0 + bj * HALF + n * 16; const f32x4 bs = *(const f32x4*)(bp + c), gv = *(const f32x4*)(gp + c);
                        *(f32x4*)(out + (size_t)r * D + c) = bs + gv * acc[ai][bj][m][n]; } }
    }
};

#ifdef HOST_EMU
#define PG8_WAIT_V(n) ((void)0)
#define PG8_WAIT_L(n) ((void)0)
#else
#define PG8_WAIT_V(n) asm volatile("s_waitcnt vmcnt(" #n ")" ::: "memory")
#define PG8_WAIT_L(n) asm volatile("s_waitcnt lgkmcnt(" #n ")" ::: "memory")
#endif
template <class Epi, class Sched>
__device__ __forceinline__ void gemm_phase(LAS unsigned char* lds, const Gemm g, const Sched& S, const Epi& E, const int tid) {
    const int wid = __builtin_amdgcn_readfirstlane(tid >> 6), lane = tid & 63, wr = wid >> 2, wc = wid & 3, fr = lane & 15, fq = lane >> 4;
    const int K = g.K, nt = K / BK;
    unsigned voffA[2], voffB[2];
#pragma unroll
    for (int i = 0; i < 2; ++i) { int R, C; stage_rc(tid * 16 + i * 8192, R, C); const int Rb = Epi::PERM ? ((R & ~31) + perm32(R & 31)) : R;
        voffA[i] = (unsigned)(R * K + C) * 2u; voffB[i] = (unsigned)(Rb * K + C) * 2u; }
    const size_t kstep = (size_t)(BK * 2);
    const size_t hstep = (size_t)HALF * K * 2;
    const size_t tstep = 2 * hstep;
    const unsigned ldsw = (unsigned)wid * 1024u;
    const int aoff = lds_byte(wr * 64 + fr, fq * 8), boff = lds_byte(wc * 32 + fr, fq * 8);
#define PG8_SA(b, h) (((b) * 2 + (h)) * HTB)
#define PG8_SB(b, h) ((4 + (b) * 2 + (h)) * HTB)
#define PG8_STAGE(bufoff, gbase, voff) do { _Pragma("unroll") for (int _i = 0; _i < 2; ++_i) \
        __builtin_amdgcn_global_load_lds((const unsigned*)((const char*)(gbase) + (voff)[_i]), (LAS unsigned*)(lds + (bufoff) + ldsw + _i * 8192), 16, 0, 0); } while (0)
#define PG8_LDA(dst, b, h) do { _Pragma("unroll") for (int m = 0; m < 4; ++m) _Pragma("unroll") for (int k = 0; k < 2; ++k) dst[m][k] = *(const LAS bf16x8*)(lds + PG8_SA(b, h) + aoff + m * 2048 + k * 1024); } while (0)
#define PG8_LDB(dst, b, h) do { _Pragma("unroll") for (int n = 0; n < 2; ++n) _Pragma("unroll") for (int k = 0; k < 2; ++k) dst[n][k] = *(const LAS bf16x8*)(lds + PG8_SB(b, h) + boff + n * 2048 + k * 1024); } while (0)
#define PG8_MMA(ai, bj, At, Bt) do { __builtin_amdgcn_s_setprio(1); _Pragma("unroll") for (int m = 0; m < 4; ++m) _Pragma("unroll") for (int n = 0; n < 2; ++n) _Pragma("unroll") for (int k = 0; k < 2; ++k) \
        acc[ai][bj][m][n] = __builtin_amdgcn_mfma_f32_16x16x32_bf16(Bt[n][k], At[m][k], acc[ai][bj][m][n], 0, 0, 0); __builtin_amdgcn_s_setprio(0); } while (0)
#define PG8_BAR __builtin_amdgcn_s_barrier()
#define PG8_SCHED __builtin_amdgcn_sched_barrier(0)
    Unit cur, nxt; int ui = 0;
    if (!S.next(0, cur)) return;
    f32x4 acc[2][2][4][2];
#pragma unroll
    for (int a = 0; a < 2; ++a)
#pragma unroll
        for (int b = 0; b < 2; ++b)
#pragma unroll
            for (int m = 0; m < 4; ++m)
#pragma unroll
                for (int n = 0; n < 2; ++n) acc[a][b][m][n] = (f32x4){0.f, 0.f, 0.f, 0.f};
    bf16x8 At[4][2], B0[2][2], B1[2][2];
    const char* cA = (const char*)g.A + (size_t)cur.pm * tstep; const char* cB = (const char*)(g.Bt + (size_t)cur.e * g.bexp) + (size_t)cur.pn * tstep;
    PG8_STAGE(PG8_SB(0, 0), cB, voffB); PG8_STAGE(PG8_SB(0, 1), cB + hstep, voffB); PG8_STAGE(PG8_SA(0, 0), cA, voffA); PG8_STAGE(PG8_SA(0, 1), cA + hstep, voffA);
    if (wr == 1) PG8_BAR;
    PG8_WAIT_V(2); PG8_BAR;
    PG8_STAGE(PG8_SB(1, 0), cB + kstep, voffB); PG8_STAGE(PG8_SA(1, 0), cA + kstep, voffA); PG8_STAGE(PG8_SB(1, 1), cB + hstep + kstep, voffB);
    PG8_WAIT_V(6); PG8_BAR;
    for (;;) {
        const bool has_next = S.next(ui + 1, nxt);
        const char* nA = has_next ? (const char*)g.A + (size_t)nxt.pm * tstep : cA; const char* nB = has_next ? (const char*)(g.Bt + (size_t)nxt.e * g.bexp) + (size_t)nxt.pn * tstep : cB;
        for (int t = 0; t < nt; t += 2) {
            const bool last = (t == nt - 2);
            const char* a1 = cA + (size_t)(t + 1) * kstep;
            const char* a2 = last ? nA : cA + (size_t)(t + 2) * kstep; const char* b2 = last ? nB : cB + (size_t)(t + 2) * kstep;
            const char* a3 = a2 + kstep; const char* b3 = b2 + kstep;
            PG8_LDB(B0, 0, 0); PG8_LDB(B1, 0, 1); PG8_SCHED; PG8_LDA(At, 0, 0); PG8_STAGE(PG8_SA(1, 1), a1 + hstep, voffA);
            PG8_WAIT_V(8); PG8_WAIT_L(0); PG8_BAR; PG8_MMA(0, 0, At, B0); PG8_MMA(0, 1, At, B1); PG8_BAR; PG8_SCHED;
            PG8_LDA(At, 0, 1); PG8_STAGE(PG8_SB(0, 0), b2, voffB); PG8_STAGE(PG8_SB(0, 1), b2 + hstep, voffB); PG8_STAGE(PG8_SA(0, 0), a2, voffA);
            PG8_WAIT_V(8); PG8_WAIT_L(0); PG8_BAR; PG8_MMA(1, 0, At, B0); PG8_MMA(1, 1, At, B1); PG8_BAR; PG8_SCHED;
            PG8_LDB(B0, 1, 0); PG8_LDB(B1, 1, 1); PG8_SCHED; PG8_LDA(At, 1, 0); PG8_STAGE(PG8_SA(0, 1), a2 + hstep, voffA);
            PG8_WAIT_V(8); PG8_WAIT_L(0); PG8_BAR; PG8_MMA(0, 0, At, B0); PG8_MMA(0, 1, At, B1); PG8_BAR; PG8_SCHED;
            PG8_LDA(At, 1, 1); PG8_STAGE(PG8_SB(1, 0), b3, voffB); PG8_STAGE(PG8_SB(1, 1), b3 + hstep, voffB); PG8_STAGE(PG8_SA(1, 0), a3, voffA);
            PG8_WAIT_V(8); PG8_WAIT_L(0); PG8_BAR; PG8_MMA(1, 0, At, B0); PG8_MMA(1, 1, At, B1); PG8_BAR; PG8_SCHED;
        }
        if (wr == 0) PG8_BAR;
        {
            int t2 = threadIdx.x;
#ifndef HOST_EMU
            asm volatile("" : "+v"(t2));
#endif
            const int wid2 = __builtin_amdgcn_readfirstlane(t2 >> 6), lane2 = t2 & 63;
            E(acc, cur, wid2 >> 2, wid2 & 3, lane2 & 15, lane2 >> 4);
        }
        if (!has_next) break;
#pragma unroll
        for (int a = 0; a < 2; ++a)
#pragma unroll
            for (int b = 0; b < 2; ++b)
#pragma unroll
                for (int m = 0; m < 4; ++m)
#pragma unroll
                    for (int n = 0; n < 2; ++n) acc[a][b][m][n] = (f32x4){0.f, 0.f, 0.f, 0.f};
        cur = nxt; cA = nA; cB = nB; ++ui;
        if (wr == 1) PG8_BAR;
    }
    PG8_WAIT_V(0);
    PG8_BAR;
#undef PG8_SA
#undef PG8_SB
#undef PG8_STAGE
#undef PG8_LDA
#undef PG8_LDB
#undef PG8_MMA
#undef PG8_BAR
#undef PG8_SCHED
}
}

#define XB_TMO      128
#define XB_XCNT(j)  (256  + 64 * (j))
#define XB_XSUB(j)  (1280 + 64 * (j))
#define XB_XGEN(j)  (2304 + 64 * (j))
#define XB_TOP      3328
#define XB_TOPGEN   3392
#define XCD_BAR_WORDS 3456
#define XB_SPIN_CAP (1u << 22)
#ifdef HOST_EMU
__device__ __forceinline__ unsigned xb_ld(unsigned* p) { return *(volatile unsigned*)p; }
__device__ __forceinline__ unsigned xb_add(unsigned* p, unsigned v) { unsigned o = *p; *p = o + v; return o; }
__device__ __forceinline__ unsigned xb_xcc_id() { return blockIdx.x % 8; }
__device__ __forceinline__ unsigned atomicAdd(unsigned* p, unsigned v) { unsigned o = *p; *p = o + v; return o; }
__device__ __forceinline__ int atomicAdd(int* p, int v) { int o = *p; *p = o + v; return o; }
#else
__device__ __forceinline__ unsigned xb_ld(unsigned* p)              { return __hip_atomic_load(p, __ATOMIC_RELAXED, __HIP_MEMORY_SCOPE_AGENT); }
__device__ __forceinline__ unsigned xb_add(unsigned* p, unsigned v) { return __hip_atomic_fetch_add(p, v, __ATOMIC_RELAXED, __HIP_MEMORY_SCOPE_AGENT); }
__device__ __forceinline__ unsigned xb_xcc_id() { return (unsigned)__builtin_amdgcn_s_getreg((3 << 11) | 20) & 0xFu; }
#endif
#define XB_SPIN(cond, bar) do { unsigned _sp = 0; while (cond) { __builtin_amdgcn_s_sleep(1); \
    if ((++_sp & 255u) == 0u) { if (xb_ld(&(bar)[XB_TMO])) break; if (_sp > XB_SPIN_CAP) { atomicAdd(&(bar)[XB_TMO], 1u); break; } } } } while (0)
struct XcdBarrier { unsigned* bar; unsigned x; volatile LAS unsigned* st; };
__device__ __forceinline__ XcdBarrier xcd_barrier_post(unsigned* bar, volatile LAS unsigned* st) {
    XcdBarrier b; b.bar = bar; b.x = xb_xcc_id(); b.st = st;
    if (threadIdx.x == 0) (void)xb_add(&bar[XB_XCNT(b.x)], 1u);
    return b;
}
__device__ __forceinline__ void xcd_barrier_complete(unsigned* bar, unsigned x, unsigned& nloc, unsigned& nx) {
    const unsigned G = gridDim.x;
    unsigned sum, cnt, mine, sp = 0u;
    for (;;) {
        sum = 0u; cnt = 0u; mine = 0u;
#pragma unroll
        for (unsigned j = 0; j < 16; ++j) { const unsigned c = xb_ld(&bar[XB_XCNT(j)]); sum += c; cnt += (c > 0u) ? 1u : 0u; mine = (j == x) ? c : mine; }
        if (sum == G) break;
        __builtin_amdgcn_s_sleep(1);
        if ((++sp & 255u) == 0u) { if (xb_ld(&bar[XB_TMO])) break; if (sp > XB_SPIN_CAP) { atomicAdd(&bar[XB_TMO], 1u); break; } }
    }
    nloc = mine > 0u ? mine : 1u; nx = cnt > 0u ? cnt : 1u;
}
__device__ __forceinline__ void xcd_barrier(const XcdBarrier& b) {
    VM_WAIT();
    __syncthreads();
    if (threadIdx.x == 0) {
        unsigned* bar = b.bar;
        __builtin_amdgcn_s_waitcnt(0);
        unsigned nloc = b.st[0], nx = b.st[1];
        if (nloc == 0u) { xcd_barrier_complete(bar, b.x, nloc, nx); b.st[0] = nloc; b.st[1] = nx; }
        const unsigned old = xb_add(&bar[XB_XSUB(b.x)], 1u);
        const unsigned gen = old / nloc;
        if (old + 1u == (gen + 1u) * nloc) {
            __builtin_amdgcn_fence(__ATOMIC_RELEASE, "agent");
            VM_WAIT();
            const unsigned og = xb_add(&bar[XB_TOP], 1u);
            const unsigned tg = og / nx;
            if (og + 1u == (tg + 1u) * nx) xb_add(&bar[XB_TOPGEN], 1u);
            else XB_SPIN(xb_ld(&bar[XB_TOPGEN]) == tg, bar);
            __builtin_amdgcn_fence(__ATOMIC_ACQUIRE, "agent");
            xb_add(&bar[XB_XGEN(b.x)], 1u);
            VM_WAIT();
        } else {
            XB_SPIN(xb_ld(&bar[XB_XGEN(b.x)]) == gen, bar);
            __builtin_amdgcn_fence(__ATOMIC_ACQUIRE, "agent");
            VM_WAIT();
        }
    }
    __syncthreads();
}

struct Args {
    const float* in[34]; float* out; unsigned char* ws; int ph_lo, ph_hi;
};
enum { I_X = 0, I_C, I_CTX, I_CCTX, I_MODW, I_MODB, I_N1, I_N2, I_WIN, I_WOUT, I_HGLB, I_HGNG, I_MLGB, I_MLNG, I_HYCW, I_HYCB, I_HYW1, I_HYB1, I_HYW2, I_HYB2, I_HYFR, I_HYW3,
       I_HYBI, I_GDCW, I_GDAL, I_GDDT, I_GDNG, I_RW, I_RB, I_EW1, I_EB1, I_EW2, I_EB2, I_FG };
struct Ctx {
#ifdef HOST_EMU
    LAS unsigned char* lds; const Args* a; unsigned char* ws;
#else
    LAS unsigned char* lds; const __attribute__((address_space(4))) Args* a; unsigned char* ws;
#endif
    int tid, lane, wave, vcu, G, bid;
};
#define WSP(T, off) ((T*)(C.ws + (off)))
#define INP(i) (C.a->in[i])

__device__ __forceinline__ const float* xrow_l0(const Ctx& C, int r) { return r < NLAT ? INP(I_X) + (size_t)r * D : INP(I_CTX) + (size_t)(r - NLAT) * D; }
__device__ __forceinline__ int row_batch(int r) { return r < NLAT ? r / SEQ : NB; }

__device__ __forceinline__ void transpose_item(const float* W, int ldw, int K, bf16_t* WT, int k0, int nsrc0, int ndst0, LAS float* scr, int lane) {
#pragma unroll 8
    for (int i = 0; i < 32; ++i) { const int kk = 2 * i + (lane >> 5); scr[kk * 33 + (lane & 31)] = W[(size_t)(k0 + kk) * ldw + nsrc0 + (lane & 31)]; }
    LDS_WAIT(); asm volatile("" ::: "memory");
    const int c = lane & 7;
#pragma unroll
    for (int j = 0; j < 4; ++j) { const int n = (lane >> 3) + 8 * j; const LAS float* s = scr + (8 * c) * 33 + n;
        u32x4 o; o.x = pk2(s[0 * 33], s[1 * 33]); o.y = pk2(s[2 * 33], s[3 * 33]); o.z = pk2(s[4 * 33], s[5 * 33]); o.w = pk2(s[6 * 33], s[7 * 33]);
        *(u32x4*)(WT + (size_t)(ndst0 + n) * K + k0 + 8 * c) = o; }
    LDS_WAIT(); asm volatile("" ::: "memory");
}
__device__ __forceinline__ void p0_prologue(Ctx& C) {
    LAS float* scr = (LAS float*)(C.lds + C.wave * 16384);
    const int gw = C.vcu * 8 + C.wave, NGW = C.G * 8, lane = C.lane;
    constexpr int I_IN = 16 * (ZW / 32), I_OUT = 16 * (D / 32), I_1 = 16 * (2 * DE / 32), I_2 = (DE / 64) * (D / 32);
    constexpr int PER_L = I_IN + I_OUT + NE * (I_1 + I_2);
    for (int it = gw; it < DEPTH * PER_L; it += NGW) {
        const int l = it / PER_L; int r = it % PER_L;
        if (r < I_IN) { const int kb = r / (ZW / 32), nb = r % (ZW / 32), nd = 32 * nb, ns = nd < 2304 ? nd : nd + 16;
            transpose_item(INP(I_WIN) + (size_t)l * D * IN_W, IN_W, D, WSP(bf16_t, WS_WIN) + (size_t)l * ZW * D, 64 * kb, ns, nd, scr, lane); continue; }
        r -= I_IN;
        if (r < I_OUT) { const int kb = r / (D / 32), nb = r % (D / 32);
            transpose_item(INP(I_WOUT) + (size_t)l * D * D, D, D, WSP(bf16_t, WS_WOUT) + (size_t)l * D * D, 64 * kb, 32 * nb, 32 * nb, scr, lane); continue; }
        r -= I_OUT;
        const int e = r / (I_1 + I_2); r %= (I_1 + I_2);
        if (r < I_1) { const int kb = r / (2 * DE / 32), nb = r % (2 * DE / 32), nd = 32 * nb;
            const int ntile = nd / 256, hh = (nd % 256) / 128, j = nd % 128, ns = DE * hh + 128 * ntile + j;
            transpose_item(INP(I_EW1) + ((size_t)l * NE + e) * D * 2 * DE, 2 * DE, D, WSP(bf16_t, WS_W1) + ((size_t)l * NE + e) * 2 * DE * D, 64 * kb, ns, nd, scr, lane); continue; }
        r -= I_1;
        { const int kb = r / (D / 32), nb = r % (D / 32);
            transpose_item(INP(I_EW2) + ((size_t)l * NE + e) * DE * D, D, DE, WSP(bf16_t, WS_W2) + ((size_t)l * NE + e) * D * DE, 64 * kb, 32 * nb, 32 * nb, scr, lane); }
    }
    for (int it = gw; it < DEPTH * (6 * D / 64); it += NGW) {
        const int l = it / (6 * D / 64), n = (it % (6 * D / 64)) * 64 + lane;
        const float* w = INP(I_MODW) + (size_t)l * D * 6 * D + n;
        float acc[NB + 1];
#pragma unroll
        for (int b = 0; b <= NB; ++b) acc[b] = 0.f;
#pragma unroll 8
        for (int k = 0; k < D; ++k) { const float wv = w[(size_t)k * 6 * D];
#pragma unroll
            for (int b = 0; b <= NB; ++b) { const float cv = b < NB ? INP(I_C)[b * D + k] : INP(I_CCTX)[k]; acc[b] += siluf_(cv) * wv; } }
        const float bias = INP(I_MODB)[l * 6 * D + n];
#pragma unroll
        for (int b = 0; b <= NB; ++b) WSP(float, WS_MOD)[((size_t)l * (NB + 1) + b) * 6 * D + n] = acc[b] + bias;
    }
    const int gt = gw * 64 + lane, NGT = NGW * 64;
    for (int i = gt; i < 256; i += NGT) { const float a0 = INP(I_HGLB)[i], a1 = INP(I_HGLB)[256 + i], mx = fmaxf(a0, a1), e0 = __expf(a0 - mx), e1 = __expf(a1 - mx);
        WSP(float, WS_LB)[i] = 0.f; WSP(float, WS_LB)[256 + i] = e1 / (e0 + e1); }
    for (int i = gt; i < DEPTH * 32 * D; i += NGT) { const int l = i / (32 * D), j = (i / D) % 32, k = i % D; const int col = j < 16 ? 2304 + j : 4112 + (j - 16);
        WSP(float, WS_WG)[i] = INP(I_WIN)[((size_t)l * D + k) * IN_W + col]; }
    for (int i = gt; i < DEPTH * NE * D; i += NGT) { const int l = i / (NE * D), e = (i / D) % NE, k = i % D;
        WSP(float, WS_WR)[i] = INP(I_RW)[((size_t)l * D + k) * NE + e]; }
    for (int i = gw; i < DEPTH * (SEQ + LC); i += NGW) {
        const int l = i / (SEQ + LC), p = i % (SEQ + LC); const bool isc = p >= SEQ; const int pos = isc ? p - SEQ : p, len = isc ? LC : SEQ;
        const float *w1 = INP(I_HYW1) + l * 17 * 64, *b1 = INP(I_HYB1) + l * 64, *w2 = INP(I_HYW2) + l * 64 * 64, *b2 = INP(I_HYB2) + l * 64, *fr = INP(I_HYFR) + l * 128;
        float s = b1[lane] + ((float)pos / (float)(len - 1)) * w1[lane];
#pragma unroll
        for (int j = 0; j < 8; ++j) { const float band = 1e-4f + (7.0f - 1e-4f) * (float)j / 7.0f; const float ang = 6.283185307179586f * (float)pos * band / (float)len;
            s += cosf(ang) * w1[(1 + j) * 64 + lane] - sinf(ang) * w1[(9 + j) * 64 + lane]; }
        scr[lane] = sinf(fr[lane] * s);
        LDS_WAIT(); asm volatile("" ::: "memory");
        float s2 = b2[lane];
#pragma unroll 8
        for (int q = 0; q < 64; ++q) s2 += scr[q] * w2[q * 64 + lane];
        WSP(float, WS_HDN)[((size_t)l * (SEQ + LC) + p) * 64 + lane] = sinf(fr[64 + lane] * s2);
        LDS_WAIT(); asm volatile("" ::: "memory");
    }
}

__device__ __forceinline__ void rms_mod_row(const f32x4 (&xv)[4], const float* gain, const float* sh, const float* sc, bf16_t* orow, int lane, f32x4 (&hv)[4]) {
    float s = 0.f;
#pragma unroll
    for (int j = 0; j < 4; ++j) s += (xv[j].x * xv[j].x + xv[j].y * xv[j].y) + (xv[j].z * xv[j].z + xv[j].w * xv[j].w);
    const float rstd = 1.f / sqrtf(wave_sum(s) * (1.f / D) + EPS);
#pragma unroll
    for (int j = 0; j < 4; ++j) { const int c = 4 * lane + 256 * j; const f32x4 g = *(const f32x4*)(gain + c), a = *(const f32x4*)(sc + c), b = *(const f32x4*)(sh + c);
        hv[j] = xv[j] * rstd * g * (a + 1.0f) + b;
        u32x2 w; w.x = pk2(hv[j].x, hv[j].y); w.y = pk2(hv[j].z, hv[j].w); *(u32x2*)(orow + c) = w; }
}
__device__ __forceinline__ float row_dots_lane(const f32x4 (&hv)[4], const float* W, int lane, int n) {
    float mine = 0.f;
#pragma unroll 2
    for (int jj = 0; jj < n; ++jj) { float s = 0.f;
#pragma unroll
        for (int j = 0; j < 4; ++j) { const f32x4 w = *(const f32x4*)(W + (size_t)jj * D + 4 * lane + 256 * j); s += (hv[j].x * w.x + hv[j].y * w.y) + (hv[j].z * w.z + hv[j].w * w.w); }
        s = wave_sum(s); mine = (lane == jj) ? s : mine; }
    return mine;
}
__device__ __forceinline__ void phase_rows_a(Ctx& C, int l) {
    const int gw = C.vcu * 8 + C.wave, NGW = C.G * 8, lane = C.lane;
    const int nrows = (l == DEPTH) ? NLAT : NT;
    float* xcur = WSP(float, WS_X);
    for (int r = gw; r < nrows; r += NGW) {
        f32x4 xv[4]; const int bb = row_batch(r);
        if (l == 0) { const float* xr = xrow_l0(C, r);
#pragma unroll
            for (int j = 0; j < 4; ++j) xv[j] = *(const f32x4*)(xr + 4 * lane + 256 * j); }
        else {
            const int lp = l - 1; const int ntok = (lp == DEPTH - 1) ? NLAT : NT;
            const float* xr = xcur + (size_t)r * D;
#pragma unroll
            for (int j = 0; j < 4; ++j) xv[j] = *(const f32x4*)(xr + 4 * lane + 256 * j);
            if (r < ntok) {
                const float* g2 = WSP(float, WS_MOD) + ((size_t)lp * (NB + 1) + bb) * 6 * D + 5 * D;
                const int* te = WSP(int, WS_TOP) + (size_t)r * 4; const int* tp = WSP(int, WS_TOP) + (size_t)NT * 4 + (size_t)r * 4; const float* tg = WSP(float, WS_TOP) + (size_t)NT * 8 + (size_t)r * 4;
                const LAS int* tbase = (const LAS int*)(C.lds + LDSX_OFF + LX_TILE) + MAXTILES;
                f32x4 ys[4];
#pragma unroll
                for (int j = 0; j < 4; ++j) ys[j] = (f32x4){0.f, 0.f, 0.f, 0.f};
#pragma unroll
                for (int k = 0; k < TOPK; ++k) { const int e = te[k]; const size_t yr = (size_t)tbase[e] * 256 + tp[k]; const float gk = tg[k]; const bf16_t* yp = WSP(bf16_t, WS_Y) + yr * D;
#pragma unroll
                    for (int j = 0; j < 4; ++j) { const u32x2 w = *(const u32x2*)(yp + 4 * lane + 256 * j);
                        ys[j].x += gk * u2f(w.x << 16); ys[j].y += gk * u2f(w.x & 0xffff0000u); ys[j].z += gk * u2f(w.y << 16); ys[j].w += gk * u2f(w.y & 0xffff0000u); } }
#pragma unroll
                for (int j = 0; j < 4; ++j) { const f32x4 g = *(const f32x4*)(g2 + 4 * lane + 256 * j); xv[j] = xv[j] + g * ys[j]; }
                if (l < DEPTH) {
#pragma unroll
                    for (int j = 0; j < 4; ++j) *(f32x4*)(xcur + (size_t)r * D + 4 * lane + 256 * j) = xv[j]; }
            }
        }
        if (l == DEPTH) {
            float s = 0.f;
#pragma unroll
            for (int j = 0; j < 4; ++j) s += (xv[j].x * xv[j].x + xv[j].y * xv[j].y) + (xv[j].z * xv[j].z + xv[j].w * xv[j].w);
            const float rstd = 1.f / sqrtf(wave_sum(s) * (1.f / D) + EPS);
#pragma unroll
            for (int j = 0; j < 4; ++j) { const f32x4 g = *(const f32x4*)(INP(I_FG) + 4 * lane + 256 * j); *(f32x4*)(C.a->out + (size_t)r * D + 4 * lane + 256 * j) = xv[j] * rstd * g; }
            continue;
        }
        const float* mod = WSP(float, WS_MOD) + ((size_t)l * (NB + 1) + bb) * 6 * D;
        f32x4 hv[4];
        rms_mod_row(xv, INP(I_N1) + l * D, mod, mod + D, WSP(bf16_t, WS_H) + (size_t)r * D, lane, hv);
        const float mine = row_dots_lane(hv, WSP(float, WS_WG) + (size_t)l * 32 * D, lane, 32);
        if (lane < 32) WSP(float, WS_ZG)[(size_t)r * 32 + lane] = mine;
    }
}
__device__ __forceinline__ int build_tiles(Ctx& C, int l) {
    LAS int* tile_e = (LAS int*)(C.lds + LDSX_OFF + LX_TILE); LAS int* tbase = tile_e + MAXTILES;
    const unsigned* cnt = WSP(unsigned, WS_CTL) + CW_CNT + l * NE;
    __syncthreads();
    if (C.tid == 0) { int t = 0;
        for (int e = 0; e < NE; ++e) { const int c = (int)cnt[e], n = (c + 255) / 256; tbase[e] = t; for (int i = 0; i < n; ++i) tile_e[t + i] = e; t += n; }
        tbase[NE] = t; }
    __syncthreads();
    return tbase[NE];
}
__device__ __forceinline__ void phase_rows_b(Ctx& C, int l) {
    const int gw = C.vcu * 8 + C.wave, NGW = C.G * 8, lane = C.lane;
    const int ntok = (l == DEPTH - 1) ? NLAT : NT;
    const float* xcur = WSP(float, WS_X);
    unsigned* cnt = WSP(unsigned, WS_CTL) + CW_CNT + l * NE;
    for (int r = gw; r < ntok; r += NGW) {
        f32x4 xv[4]; const int bb = row_batch(r);
#pragma unroll
        for (int j = 0; j < 4; ++j) xv[j] = *(const f32x4*)(xcur + (size_t)r * D + 4 * lane + 256 * j);
        const float* mod = WSP(float, WS_MOD) + ((size_t)l * (NB + 1) + bb) * 6 * D;
        f32x4 hv[4];
        rms_mod_row(xv, INP(I_N2) + l * D, mod + 3 * D, mod + 4 * D, WSP(bf16_t, WS_H) + (size_t)r * D, lane, hv);
        static_assert(NE <= 32, "router width");
        const float lgm = row_dots_lane(hv, WSP(float, WS_WR) + (size_t)l * NE * D, lane, NE);
        float v = (lane < NE) ? lgm + INP(I_RB)[l * NE + (lane < NE ? lane : 0)] : -3.0e38f;
        float tv[4]; int ti[4];
#pragma unroll
        for (int k = 0; k < 4; ++k) { float bv = v; int bi = lane;
#pragma unroll
            for (int o = 1; o < 64; o <<= 1) { const float ov = __shfl_xor(bv, o); const int oi = __shfl_xor(bi, o); const bool take = (ov > bv) || (ov == bv && oi < bi); bv = take ? ov : bv; bi = take ? oi : bi; }
            tv[k] = bv; ti[k] = bi; v = (lane == bi) ? -3.4e38f : v; }
        const float e1 = __expf(tv[1] - tv[0]), e2 = __expf(tv[2] - tv[0]), e3 = __expf(tv[3] - tv[0]), inv = 1.f / (1.f + e1 + e2 + e3);
        const float gk[4] = {inv, e1 * inv, e2 * inv, e3 * inv};
        if (lane < 4) {
            int e = ti[0]; float g = gk[0];
#pragma unroll
            for (int k = 1; k < 4; ++k) { e = (lane == k) ? ti[k] : e; g = (lane == k) ? gk[k] : g; }
            const int pos = (int)atomicAdd(cnt + e, 1u);
            WSP(int, WS_TOP)[(size_t)r * 4 + lane] = e; WSP(int, WS_TOP)[(size_t)NT * 4 + (size_t)r * 4 + lane] = pos; WSP(float, WS_TOP)[(size_t)NT * 8 + (size_t)r * 4 + lane] = g;
        }
    }
}
__device__ __forceinline__ void phase_gather(Ctx& C, int l) {
    const int gw = C.vcu * 8 + C.wave, NGW = C.G * 8, lane = C.lane;
    const int ntok = (l == DEPTH - 1) ? NLAT : NT;
    (void)build_tiles(C, l);
    const LAS int* tbase = (const LAS int*)(C.lds + LDSX_OFF + LX_TILE) + MAXTILES;
    const unsigned* cnt = WSP(unsigned, WS_CTL) + CW_CNT + l * NE;
    for (int it = gw; it < ntok * 4; it += NGW) { const int r = it >> 2, k = it & 3;
        const int e = WSP(int, WS_TOP)[(size_t)r * 4 + k], pos = WSP(int, WS_TOP)[(size_t)NT * 4 + (size_t)r * 4 + k];
        const u32x4* s = (const u32x4*)(WSP(bf16_t, WS_H) + (size_t)r * D); u32x4* d = (u32x4*)(WSP(bf16_t, WS_HS) + ((size_t)tbase[e] * 256 + pos) * D);
        d[lane] = s[lane]; d[lane + 64] = s[lane + 64]; }
    for (int it = gw; it < NE * 256; it += NGW) { const int e = it >> 8, p = it & 255; const int c = (int)cnt[e], pad0 = c, pad1 = ((c + 255) / 256) * 256;
        if (pad0 + p < pad1) { u32x4* d = (u32x4*)(WSP(bf16_t, WS_HS) + ((size_t)tbase[e] * 256 + pad0 + p) * D); d[lane] = (u32x4){0u, 0u, 0u, 0u}; d[lane + 64] = (u32x4){0u, 0u, 0u, 0u}; } }
}

template <int MIX> __device__ __forceinline__ int scan_row(int b, int dir, int s) {
    if (s < LC) { const int t = dir ? LC - 1 - s : s; return NLAT + b * LC + t; }
    const int i0 = s - LC, i = dir ? SEQ - 1 - i0 : i0;
    const int t = (MIX == 1) ? (i % GROWS) * GW + (i / GROWS) : i;
    return b * SEQ + t;
}
typedef float f32x16 __attribute__((ext_vector_type(16)));
template <int NT_, int KS>
__device__ __forceinline__ void mm_nt(const LAS bf16_t* A, int lda, const LAS bf16_t* B, int ldb, f32x16 (&acc)[NT_], int lane) {
    const int r = lane & 31, kh = (lane >> 5) * 8;
#pragma unroll
    for (int kk = 0; kk < KS; ++kk) {
        const bf16x8 a = *(const LAS bf16x8*)(A + r * lda + 16 * kk + kh);
#pragma unroll
        for (int n = 0; n < NT_; ++n) { const bf16x8 b = *(const LAS bf16x8*)(B + (32 * n + r) * ldb + 16 * kk + kh); acc[n] = __builtin_amdgcn_mfma_f32_32x32x16_bf16(a, b, acc[n], 0, 0, 0); }
    }
}
#ifdef HOST_EMU
#define ITEM_IDS() const int tid = C.tid, lane = C.lane, w = C.wave
#else
#define ITEM_IDS() int tid_ = C.tid; asm volatile("" : "+v"(tid_)); const int tid = tid_, lane = tid_ & 63, w = __builtin_amdgcn_readfirstlane(tid_ >> 6)
#endif
#define CROW(ri, lane) (((ri) & 3) + 8 * ((ri) >> 2) + 4 * ((lane) >> 5))
constexpr int LS = 72, LF = 65;
constexpr int GA_Q = 0, GA_K = 9216, GA_BVT = 18432, GA_BKGT = 27648, GA_KDT = 36864, GA_QKM = 46080, GA_TB = 55296, GA_UT = 64512, GA_WT = 73728, GA_AM = 82944, GA_TM = 99584, GA_X = 116224  , GA_G = 124928;
__device__ __forceinline__ void gdn_a_item(Ctx& C, int l, int b, int h, int dir, int c) {
    LAS unsigned char* lds = C.lds; ITEM_IDS();
    LAS bf16_t* Qb = (LAS bf16_t*)(lds + GA_Q); LAS bf16_t* Kb = (LAS bf16_t*)(lds + GA_K); LAS bf16_t* BVT = (LAS bf16_t*)(lds + GA_BVT); LAS bf16_t* BKGT = (LAS bf16_t*)(lds + GA_BKGT);
    LAS bf16_t* KDT = (LAS bf16_t*)(lds + GA_KDT); LAS bf16_t* QKM = (LAS bf16_t*)(lds + GA_QKM); LAS bf16_t* TB = (LAS bf16_t*)(lds + GA_TB); LAS bf16_t* UT = (LAS bf16_t*)(lds + GA_UT); LAS bf16_t* WT = (LAS bf16_t*)(lds + GA_WT);
    LAS float* AM = (LAS float*)(lds + GA_AM); LAS float* TM = (LAS float*)(lds + GA_TM); LAS float* X = (LAS float*)(lds + GA_X); LAS float* G = (LAS float*)(lds + GA_G);
    const bf16_t* zb = WSP(bf16_t, WS_Z); const float* zg = WSP(float, WS_ZG);
    unsigned char* blob = C.ws + WS_GD + ((size_t)((b * NH + h) * 2 + dir) * NCH + c) * GD_BLOB;
    const int i = tid >> 3, d0 = (tid & 7) * 8; const int row = scan_row<2>(b, dir, 64 * c + i);
    float qv[8], kv[8], vv[8];
    { const bf16_t* zr = zb + (size_t)row * ZW; const bool isc = row >= NLAT; const int t = isc ? (row - NLAT) % LC : row % SEQ, len = isc ? LC : SEQ;
        const bool hp = t > 0, hn = t < len - 1; const float* cw = INP(I_GDCW) + l * 3 * 768;
        float sq = 0.f, sk = 0.f;
#pragma unroll
        for (int a = 0; a < 3; ++a) { const int cc = a * 256 + h * 64 + d0; const bf16_t* zp = zr + GDB + cc;
            const u32x4 z1 = *(const u32x4*)zp, z0 = hp ? *(const u32x4*)(zp - ZW) : (u32x4){0u, 0u, 0u, 0u}, z2 = hn ? *(const u32x4*)(zp + ZW) : (u32x4){0u, 0u, 0u, 0u};
            const unsigned u0[4] = {z0.x, z0.y, z0.z, z0.w}, u1[4] = {z1.x, z1.y, z1.z, z1.w}, u2[4] = {z2.x, z2.y, z2.z, z2.w};
#pragma unroll
            for (int j = 0; j < 8; ++j) { const int jj = j >> 1; const bool hi = j & 1;
                const float x0 = hi ? u2f(u0[jj] & 0xffff0000u) : u2f(u0[jj] << 16), x1 = hi ? u2f(u1[jj] & 0xffff0000u) : u2f(u1[jj] << 16), x2 = hi ? u2f(u2[jj] & 0xffff0000u) : u2f(u2[jj] << 16);
                float sacc = cw[cc + j] * x0 + cw[768 + cc + j] * x1 + cw[1536 + cc + j] * x2;
                sacc = siluf_(sacc);
                if (a == 0) { qv[j] = sacc; sq += sacc * sacc; } else if (a == 1) { kv[j] = sacc; sk += sacc * sacc; } else vv[j] = sacc; } }
#pragma unroll
        for (int o = 1; o < 8; o <<= 1) { sq += __shfl_xor(sq, o); sk += __shfl_xor(sk, o); }
        const float rq = 0.125f / sqrtf(sq + EPS), rk = 1.f / sqrtf(sk + EPS);
#pragma unroll
        for (int j = 0; j < 8; ++j) { qv[j] *= rq; kv[j] *= rk; }
        if ((tid & 7) == 0) { const float* g = zg + (size_t)row * 32 + 16;
            G[128 + i] = -__expf(INP(I_GDAL)[l * 8 + dir * 4 + h]) * softplusf_(g[(2 * dir) * 4 + h] + INP(I_GDDT)[l * 8 + dir * 4 + h]); G[64 + i] = sigmoidf_(g[(2 * dir + 1) * 4 + h]); }
        u32x4 wq, wk; wq.x = pk2(qv[0], qv[1]); wq.y = pk2(qv[2], qv[3]); wq.z = pk2(qv[4], qv[5]); wq.w = pk2(qv[6], qv[7]); wk.x = pk2(kv[0], kv[1]); wk.y = pk2(kv[2], kv[3]); wk.z = pk2(kv[4], kv[5]); wk.w = pk2(kv[6], kv[7]);
        *(LAS u32x4*)(Qb + i * LS + d0) = wq; *(LAS u32x4*)(Kb + i * LS + d0) = wk;
    }
    __syncthreads();
    if (w == 0) { float gsum = G[128 + lane];
#pragma unroll
        for (int o = 1; o < 64; o <<= 1) { const float t = __shfl(gsum, lane - o); if (lane >= o) gsum += t; }
        G[lane] = gsum; }
    __syncthreads();
    { const float gi = G[i], be = G[64 + i], gl = G[63]; const float eg = __expf(gi), ed = __expf(gl - gi);
#pragma unroll
        for (int j = 0; j < 8; ++j) { BVT[(d0 + j) * LS + i] = (bf16_t)f2bf(be * vv[j]); BKGT[(d0 + j) * LS + i] = (bf16_t)f2bf(be * kv[j] * eg); KDT[(d0 + j) * LS + i] = (bf16_t)f2bf(kv[j] * ed); } }
    if (w < 4) { f32x16 acc[2]; acc[0] = (f32x16)(0.f); acc[1] = (f32x16)(0.f);
        const int rh = (w & 1) * 32; mm_nt<2, 4>((w >> 1) ? Qb + rh * LS : Kb + rh * LS, LS, Kb, LS, acc, lane);
#pragma unroll
        for (int n = 0; n < 2; ++n)
#pragma unroll
            for (int ri = 0; ri < 16; ++ri) { const int ii = rh + CROW(ri, lane), jj = 32 * n + (lane & 31); const float dec = __expf(G[ii] - G[jj]);
                if (w >> 1) QKM[ii * LS + jj] = (bf16_t)f2bf(jj <= ii ? acc[n][ri] * dec : 0.f); else AM[ii * LF + jj] = (jj < ii) ? G[64 + ii] * acc[n][ri] * dec : 0.f; } }
    __syncthreads();
    LAS float* Dg = X + 16 * LF;
    if (w == 0) { const int bb = lane >> 4, cc = lane & 15; float t[16];
#pragma unroll
        for (int r = 0; r < 16; ++r) { float x = (r == cc) ? 1.f : 0.f;
#pragma unroll
            for (int r2 = 0; r2 < r; ++r2) x -= AM[(16 * bb + r) * LF + 16 * bb + r2] * t[r2];
            t[r] = x; Dg[(bb * 16 + r) * 17 + cc] = x; asm volatile("" ::: "memory"); } }
    __syncthreads();
    for (int bb = 0; bb < 4; ++bb) {
        for (int o = tid; o < 1024; o += 512) { const int r = o >> 6, cc = o & 63, ii = 16 * bb + r; float x = (ii == cc) ? 1.f : 0.f;
#pragma unroll 8
            for (int j = 0; j < 16 * bb; ++j) x -= AM[ii * LF + j] * TM[j * LF + cc];
            X[r * LF + cc] = x; }
        __syncthreads();
        for (int o = tid; o < 1024; o += 512) { const int r = o >> 6, cc = o & 63; float x = 0.f;
#pragma unroll
            for (int r2 = 0; r2 < 16; ++r2) x += Dg[(bb * 16 + r) * 17 + r2] * X[r2 * LF + cc];
            TM[(16 * bb + r) * LF + cc] = x; }
        __syncthreads();
    }
    for (int o = tid; o < 4096; o += 512) { const int ii = o >> 6, jj = o & 63; TB[ii * LS + jj] = (bf16_t)f2bf(TM[ii * LF + jj]); }
    __syncthreads();
    if (w < 4) { f32x16 acc[2]; acc[0] = (f32x16)(0.f); acc[1] = (f32x16)(0.f);
        const int rh = (w & 1) * 32; mm_nt<2, 4>(((w >> 1) ? BKGT : BVT) + rh * LS, LS, TB, LS, acc, lane);
        LAS bf16_t* dst = (w >> 1) ? WT : UT;
#pragma unroll
        for (int n = 0; n < 2; ++n)
#pragma unroll
            for (int ri = 0; ri < 16; ++ri) dst[(rh + CROW(ri, lane)) * LS + 32 * n + (lane & 31)] = (bf16_t)f2bf(acc[n][ri]); }
    __syncthreads();
    { f32x16 acc[2]; acc[0] = (f32x16)(0.f); acc[1] = (f32x16)(0.f);
        const int pr = w >> 1, rh = (w & 1) * 32;
        const LAS bf16_t* Ap = (pr == 0 || pr == 1) ? QKM : (pr == 2 ? KDT : UT); const LAS bf16_t* Bp = (pr == 0 || pr == 2) ? WT : (pr == 1 ? UT : KDT);
        mm_nt<2, 4>(Ap + rh * LS, LS, Bp, LS, acc, lane);
        const float egl = __expf(G[63]);
#pragma unroll
        for (int n = 0; n < 2; ++n)
#pragma unroll
            for (int ri = 0; ri < 16; ++ri) { const int rr = rh + CROW(ri, lane), cc = 32 * n + (lane & 31); const float a = acc[n][ri];
                if (pr == 0) ((bf16_t*)(blob + 8192))[rr * 64 + cc] = (bf16_t)f2bf(bf2f(Qb[rr * LS + cc]) * __expf(G[rr]) - a);
                else if (pr == 1) ((float*)(blob + 32768))[rr * 64 + cc] = a;
                else if (pr == 2) ((bf16_t*)blob)[rr * 64 + cc] = (bf16_t)f2bf((rr == cc ? egl : 0.f) - a);
                else ((float*)(blob + 16384))[rr * 64 + cc] = a; } }
    __syncthreads();
}
__device__ __forceinline__ void gdn_b_scan(Ctx& C, int sidx) {
    LAS unsigned char* lds = C.lds; const int tid = C.tid, lane = C.lane, w = C.wave;
    LAS bf16_t* STb = (LAS bf16_t*)lds;
    LAS bf16_t* Pb = (LAS bf16_t*)(lds + 18432);
    for (int o = tid; o < 2 * 64 * LS; o += 512) STb[o] = 0;
    __syncthreads();
    int cur = 0;
    for (int c = 0; c < NCH; ++c) {
        const unsigned char* blob = C.ws + WS_GD + ((size_t)sidx * NCH + c) * GD_BLOB;
        bf16_t* gst = WSP(bf16_t, WS_GST) + ((size_t)sidx * NCH + c) * 4096;
        { const int r = tid >> 3, c8 = (tid & 7) * 8;
            *(LAS u32x4*)(Pb + r * LS + c8) = *(const u32x4*)((const bf16_t*)blob + r * 64 + c8);
            *(u32x4*)(gst + r * 64 + c8) = *(const LAS u32x4*)(STb + cur * 64 * LS + r * LS + c8); }
        __syncthreads();
        if (w < 4) { const int eh = (w & 1) * 32, dh = (w >> 1) * 32; f32x16 acc[1]; const float* qt = (const float*)(blob + 16384);
#pragma unroll
            for (int ri = 0; ri < 16; ++ri) acc[0][ri] = qt[(eh + CROW(ri, lane)) * 64 + dh + (lane & 31)];
            mm_nt<1, 4>(STb + cur * 64 * LS + eh * LS, LS, Pb + dh * LS, LS, acc, lane);
#pragma unroll
            for (int ri = 0; ri < 16; ++ri) STb[(cur ^ 1) * 64 * LS + (eh + CROW(ri, lane)) * LS + dh + (lane & 31)] = (bf16_t)f2bf(acc[0][ri]); }
        __syncthreads();
        cur ^= 1;
    }
}
__device__ __forceinline__ void gdn_c_item(Ctx& C, int l, int b, int h, int jt) {
    LAS unsigned char* lds = C.lds; ITEM_IDS();
    LAS bf16_t* Rb = (LAS bf16_t*)lds;
    LAS bf16_t* Sb = (LAS bf16_t*)(lds + 18432);
    LAS float* OF = (LAS float*)(lds + 36864);
    const bool isc = jt < NCHC; const int jl = jt - NCHC;
    int cidx[2]; cidx[0] = jt; cidx[1] = isc ? (NCHC - 1 - jt) : NCHC + (SEQ / 64 - 1 - jl);
    const unsigned char* blob[2];
#pragma unroll
    for (int dir = 0; dir < 2; ++dir) { const size_t sc = (size_t)((b * NH + h) * 2 + dir) * NCH + cidx[dir]; blob[dir] = C.ws + WS_GD + sc * GD_BLOB;
        const bf16_t* gst = WSP(bf16_t, WS_GST) + sc * 4096; const int r = tid >> 3, c8 = (tid & 7) * 8;
        *(LAS u32x4*)(Rb + dir * 64 * LS + r * LS + c8) = *(const u32x4*)((const bf16_t*)(blob[dir] + 8192) + r * 64 + c8);
        *(LAS u32x4*)(Sb + dir * 64 * LS + r * LS + c8) = *(const u32x4*)(gst + r * 64 + c8); }
    __syncthreads();
    { const int dir = w >> 2, q = w & 3, ih = (q & 1) * 32, eh = (q >> 1) * 32; f32x16 acc[1]; const float* ol = (const float*)(blob[dir] + 32768);
#pragma unroll
        for (int ri = 0; ri < 16; ++ri) acc[0][ri] = ol[(ih + CROW(ri, lane)) * 64 + eh + (lane & 31)];
        mm_nt<1, 4>(Rb + dir * 64 * LS + ih * LS, LS, Sb + dir * 64 * LS + eh * LS, LS, acc, lane);
#pragma unroll
        for (int ri = 0; ri < 16; ++ri) { const int ii = ih + CROW(ri, lane), tok = dir ? 63 - ii : ii; OF[dir * 64 * LF + tok * LF + eh + (lane & 31)] = acc[0][ri]; } }
    __syncthreads();
    { const int tok = tid >> 3, e0 = (tid & 7) * 8; const int row = isc ? NLAT + b * LC + 64 * jt + tok : b * SEQ + 64 * jl + tok;
        float o[8]; float ss = 0.f;
#pragma unroll
        for (int j = 0; j < 8; ++j) { o[j] = OF[tok * LF + e0 + j] + OF[64 * LF + tok * LF + e0 + j]; ss += o[j] * o[j]; }
#pragma unroll
        for (int k = 1; k < 8; k <<= 1) ss += __shfl_xor(ss, k);
        const float rs = 1.f / sqrtf(ss * (1.f / 64.f) + EPS);
        const float* ng = INP(I_GDNG) + l * 256 + h * 64 + e0; const bf16_t* gz = WSP(bf16_t, WS_Z) + (size_t)row * ZW + GDB + 768 + h * 64 + e0;
        unsigned pk[4];
#pragma unroll
        for (int j = 0; j < 4; ++j) pk[j] = pk2(o[2 * j] * rs * ng[2 * j] * siluf_(bf2f(gz[2 * j])), o[2 * j + 1] * rs * ng[2 * j + 1] * siluf_(bf2f(gz[2 * j + 1])));
        *(u32x4*)(WSP(bf16_t, WS_MIX) + (size_t)row * D + 768 + h * 64 + e0) = (u32x4){pk[0], pk[1], pk[2], pk[3]}; }
    __syncthreads();
}
constexpr int MA_Q = 0, MA_K = 9216, MA_VT = 18432, MA_KWT = 27648, MA_P = 36864, MA_ONE = 46080  , MA_S = 50688  ;
__device__ __forceinline__ void mlstm_a_item(Ctx& C, int l, int b, int h, int dir, int c) {
    LAS unsigned char* lds = C.lds; ITEM_IDS();
    LAS bf16_t* Qb = (LAS bf16_t*)(lds + MA_Q); LAS bf16_t* Kb = (LAS bf16_t*)(lds + MA_K); LAS bf16_t* VT = (LAS bf16_t*)(lds + MA_VT); LAS bf16_t* KWT = (LAS bf16_t*)(lds + MA_KWT);
    LAS bf16_t* Pm = (LAS bf16_t*)(lds + MA_P); LAS bf16_t* ONE = (LAS bf16_t*)(lds + MA_ONE); LAS float* Sc = (LAS float*)(lds + MA_S);
    const bf16_t* zb = WSP(bf16_t, WS_Z); const float* zg = WSP(float, WS_ZG);
    unsigned char* blob = C.ws + WS_ML + ((size_t)((b * NH + h) * 2 + dir) * NCH + c) * ML_BLOB;
    const int i = tid >> 3, d0 = (tid & 7) * 8; const int row = scan_row<1>(b, dir, 64 * c + i);
    float kv[8];
    { const bf16_t* zr = zb + (size_t)row * ZW + MLB + h * 64 + d0;
        *(LAS u32x4*)(Qb + i * LS + d0) = *(const u32x4*)zr;
        const u32x4 kr = *(const u32x4*)(zr + 256), vr = *(const u32x4*)(zr + 512);
        const unsigned ku[4] = {kr.x, kr.y, kr.z, kr.w}, vu[4] = {vr.x, vr.y, vr.z, vr.w};
#pragma unroll
        for (int j = 0; j < 4; ++j) { kv[2 * j] = u2f(ku[j] << 16) * 0.125f; kv[2 * j + 1] = u2f(ku[j] & 0xffff0000u) * 0.125f; VT[(d0 + 2 * j) * LS + i] = (bf16_t)(vu[j] & 0xffffu); VT[(d0 + 2 * j + 1) * LS + i] = (bf16_t)(vu[j] >> 16); }
        u32x4 wk; wk.x = pk2(kv[0], kv[1]); wk.y = pk2(kv[2], kv[3]); wk.z = pk2(kv[4], kv[5]); wk.w = pk2(kv[6], kv[7]); *(LAS u32x4*)(Kb + i * LS + d0) = wk;
        if ((tid & 7) == 0) { const float* gb = INP(I_MLGB) + l * 16; const float* g = zg + (size_t)row * 32;
            Sc[i] = g[(2 * dir) * 4 + h] + gb[(2 * dir) * 4 + h]; Sc[64 + i] = logsigmoidf_(g[(2 * dir + 1) * 4 + h] + gb[(2 * dir + 1) * 4 + h]); }
        for (int o = tid; o < 32 * LS; o += 512) ONE[o] = (bf16_t)((o < LS) ? 0x3f80 : 0);
    }
    __syncthreads();
    if (w == 0) { float fc = Sc[64 + lane];
#pragma unroll
        for (int o = 1; o < 64; o <<= 1) { const float t = __shfl(fc, lane - o); if (lane >= o) fc += t; }
        const float li = Sc[lane]; float pm = li - fc;
#pragma unroll
        for (int o = 1; o < 64; o <<= 1) { const float t = __shfl(pm, lane - o); if (lane >= o) pm = fmaxf(pm, t); }
        const float fl = __shfl(fc, 63); const float gg = fl - fc + li; float gm = gg;
#pragma unroll
        for (int o = 1; o < 64; o <<= 1) gm = fmaxf(gm, __shfl_xor(gm, o));
        Sc[128 + lane] = fc; Sc[192 + lane] = gg - gm; Sc[256 + lane] = fc + pm;
        if (lane == 0) { ((float*)(blob + 33792))[0] = gm; ((float*)(blob + 33792))[1] = fl; }
        ((float*)(blob + 32768))[64 + lane] = fc + pm; ((float*)(blob + 32768))[128 + lane] = fc; }
    __syncthreads();
    { const float e = __expf(Sc[192 + i]);
#pragma unroll
        for (int j = 0; j < 8; ++j) KWT[(d0 + j) * LS + i] = (bf16_t)f2bf(kv[j] * e); }
    if (w < 2) { f32x16 acc[2]; acc[0] = (f32x16)(0.f); acc[1] = (f32x16)(0.f);
        const int rh = w * 32; mm_nt<2, 4>(Qb + rh * LS, LS, Kb, LS, acc, lane);
#pragma unroll
        for (int n = 0; n < 2; ++n)
#pragma unroll
            for (int ri = 0; ri < 16; ++ri) { const int ii = rh + CROW(ri, lane), jj = 32 * n + (lane & 31);
                Pm[ii * LS + jj] = (bf16_t)f2bf(jj <= ii ? acc[n][ri] * __expf(Sc[128 + ii] - Sc[128 + jj] + Sc[jj] - Sc[256 + ii]) : 0.f); } }
    __syncthreads();
    { const int pr = w >> 2, q = w & 3, rh = (q & 1) * 32, ch = (q >> 1) * 32; f32x16 acc[1]; acc[0] = (f32x16)(0.f);
        const LAS bf16_t* Ap = pr ? VT : Pm; const LAS bf16_t* Bp = pr ? KWT : VT;
        mm_nt<1, 4>(Ap + rh * LS, LS, Bp + ch * LS, LS, acc, lane);
        float* dst = (float*)(blob + (pr ? 16384 : 0));
#pragma unroll
        for (int ri = 0; ri < 16; ++ri) dst[(rh + CROW(ri, lane)) * 64 + ch + (lane & 31)] = acc[0][ri];
        if (q < 2) {
            f32x16 a2[1]; a2[0] = (f32x16)(0.f);
            if (pr == 0) { mm_nt<1, 4>(Pm + (q * 32) * LS, LS, ONE, LS, a2, lane);
                if ((lane & 31) == 0) {
#pragma unroll
                    for (int ri = 0; ri < 16; ++ri) ((float*)(blob + 32768))[q * 32 + CROW(ri, lane)] = a2[0][ri]; } }
            else { mm_nt<1, 4>(ONE, LS, KWT + (q * 32) * LS, LS, a2, lane);
                if (lane < 32) ((float*)(blob + 32768))[192 + q * 32 + lane] = a2[0][0]; } } }
    __syncthreads();
}
__device__ __forceinline__ void mlstm_b_scan(Ctx& C, int sidx) {
    const int tid = C.tid, e = tid >> 3, d0 = (tid & 7) * 8;
    float ct[8], nn[8]; float m = 0.f;
#pragma unroll
    for (int j = 0; j < 8; ++j) { ct[j] = 0.f; nn[j] = 0.f; }
    for (int c = 0; c < NCH; ++c) {
        const unsigned char* blob = C.ws + WS_ML + ((size_t)sidx * NCH + c) * ML_BLOB; unsigned char* st = C.ws + WS_MST + ((size_t)sidx * NCH + c) * ML_ST;
        const f32x4 u0 = *(const f32x4*)((const float*)(blob + 16384) + e * 64 + d0), u1 = *(const f32x4*)((const float*)(blob + 16384) + e * 64 + d0 + 4);
        const f32x4 n0 = *(const f32x4*)((const float*)(blob + 32768) + 192 + d0), n1 = *(const f32x4*)((const float*)(blob + 32768) + 192 + d0 + 4);
        const float gm = ((const float*)(blob + 33792))[0], fl = ((const float*)(blob + 33792))[1];
        u32x4 wv; wv.x = pk2(ct[0], ct[1]); wv.y = pk2(ct[2], ct[3]); wv.z = pk2(ct[4], ct[5]); wv.w = pk2(ct[6], ct[7]);
        *(u32x4*)((bf16_t*)st + e * 64 + d0) = wv;
        if (e == 0) { *(f32x4*)((float*)(st + 8192) + d0) = (f32x4){nn[0], nn[1], nn[2], nn[3]}; *(f32x4*)((float*)(st + 8192) + d0 + 4) = (f32x4){nn[4], nn[5], nn[6], nn[7]}; if (d0 == 0) ((float*)(st + 8192))[64] = m; }
        const float mn = fmaxf(fl + m, gm), ao = __expf(fl + m - mn), an = __expf(gm - mn); m = mn;
        const float uu[8] = {u0.x, u0.y, u0.z, u0.w, u1.x, u1.y, u1.z, u1.w}, un[8] = {n0.x, n0.y, n0.z, n0.w, n1.x, n1.y, n1.z, n1.w};
#pragma unroll
        for (int j = 0; j < 8; ++j) { ct[j] = ao * ct[j] + an * uu[j]; nn[j] = ao * nn[j] + an * un[j]; }
    }
}
__device__ __forceinline__ void mlstm_c_item(Ctx& C, int l, int b, int h, int jt) {
    LAS unsigned char* lds = C.lds; ITEM_IDS();
    LAS bf16_t* Qb = (LAS bf16_t*)lds;
    LAS bf16_t* Sb = (LAS bf16_t*)(lds + 18432);
    LAS float* OF = (LAS float*)(lds + 36864);
    LAS float* Sc = (LAS float*)(lds + 70144);
    const bool isc = jt < NCHC; const int jl = jt - NCHC;
    int cidx[2]; cidx[0] = jt; cidx[1] = isc ? (NCHC - 1 - jt) : NCHC + (SEQ / 64 - 1 - jl);
    const unsigned char* blob[2]; const bf16_t* zb = WSP(bf16_t, WS_Z);
    const int i = tid >> 3, d0 = (tid & 7) * 8;
#pragma unroll
    for (int dir = 0; dir < 2; ++dir) { const size_t sc = (size_t)((b * NH + h) * 2 + dir) * NCH + cidx[dir]; blob[dir] = C.ws + WS_ML + sc * ML_BLOB;
        const unsigned char* st = C.ws + WS_MST + sc * ML_ST; const int row = scan_row<1>(b, dir, 64 * cidx[dir] + i);
        const u32x4 qr = *(const u32x4*)(zb + (size_t)row * ZW + MLB + h * 64 + d0);
        *(LAS u32x4*)(Qb + dir * 64 * LS + i * LS + d0) = qr;
        *(LAS u32x4*)(Sb + dir * 64 * LS + i * LS + d0) = *(const u32x4*)((const bf16_t*)st + i * 64 + d0);
        const float* n0 = (const float*)(st + 8192) + d0; const unsigned qu[4] = {qr.x, qr.y, qr.z, qr.w}; float qn = 0.f;
#pragma unroll
        for (int j = 0; j < 4; ++j) qn += u2f(qu[j] << 16) * n0[2 * j] + u2f(qu[j] & 0xffff0000u) * n0[2 * j + 1];
#pragma unroll
        for (int k = 1; k < 8; k <<= 1) qn += __shfl_xor(qn, k);
        if ((tid & 7) == 0) { const float* sv = (const float*)(blob[dir] + 32768); const float m0 = ((const float*)(st + 8192))[64];
            const float mloc = sv[64 + i], ainit = sv[128 + i] + m0, M = fmaxf(mloc, ainit), s1 = __expf(mloc - M), s2 = __expf(ainit - M);
            LAS float* o = Sc + dir * 256; o[i] = s1; o[64 + i] = s2; o[128 + i] = s1 * sv[i] + s2 * qn; o[192 + i] = __expf(-M); } }
    __syncthreads();
    { const int dir = w >> 2, q = w & 3, ih = (q & 1) * 32, eh = (q >> 1) * 32; f32x16 acc[1]; acc[0] = (f32x16)(0.f); const float* nl = (const float*)blob[dir];
        mm_nt<1, 4>(Qb + dir * 64 * LS + ih * LS, LS, Sb + dir * 64 * LS + eh * LS, LS, acc, lane);
        const LAS float* o = Sc + dir * 256;
#pragma unroll
        for (int ri = 0; ri < 16; ++ri) { const int ii = ih + CROW(ri, lane), tok = dir ? 63 - ii : ii, ee = eh + (lane & 31);
            const float num = o[ii] * nl[ii * 64 + ee] + o[64 + ii] * acc[0][ri];
            OF[dir * 64 * LF + tok * LF + ee] = num / fmaxf(fabsf(o[128 + ii]), o[192 + ii]); } }
    __syncthreads();
    { const int tok = tid >> 3, e0 = (tid & 7) * 8; const int row = scan_row<1>(b, 0, 64 * cidx[0] + tok);
        float o[8]; float ss = 0.f;
#pragma unroll
        for (int j = 0; j < 8; ++j) { o[j] = OF[tok * LF + e0 + j] + OF[64 * LF + tok * LF + e0 + j]; ss += o[j] * o[j]; }
#pragma unroll
        for (int k = 1; k < 8; k <<= 1) ss += __shfl_xor(ss, k);
        const float rs = 1.f / sqrtf(ss * (1.f / 64.f) + EPS);
        const float* ng = INP(I_MLNG) + l * 256 + h * 64 + e0; const bf16_t* gz = zb + (size_t)row * ZW + MLB + 768 + h * 64 + e0;
        unsigned pk[4];
#pragma unroll
        for (int j = 0; j < 4; ++j) pk[j] = pk2(o[2 * j] * rs * ng[2 * j] * sigmoidf_(bf2f(gz[2 * j])), o[2 * j + 1] * rs * ng[2 * j + 1] * sigmoidf_(bf2f(gz[2 * j + 1])));
        *(u32x4*)(WSP(bf16_t, WS_MIX) + (size_t)row * D + 256 + h * 64 + e0) = (u32x4){pk[0], pk[1], pk[2], pk[3]}; }
    __syncthreads();
}
constexpr int HA_Q = 0, HA_K = 16640, HA_CUM = 33280, HA_V = 49920, HA_SC = 66560  , HA_VT = 70912, HA_KDT = 80128;
__device__ __forceinline__ void hgrn_a_item(Ctx& C, int l, int b, int h, int dir, int c) {
    LAS unsigned char* lds = C.lds; ITEM_IDS();
    LAS float* Qf = (LAS float*)(lds + HA_Q); LAS float* Kf = (LAS float*)(lds + HA_K); LAS float* CUM = (LAS float*)(lds + HA_CUM); LAS float* Vf = (LAS float*)(lds + HA_V); LAS float* SC = (LAS float*)(lds + HA_SC);
    LAS bf16_t* VT = (LAS bf16_t*)(lds + HA_VT); LAS bf16_t* KDT = (LAS bf16_t*)(lds + HA_KDT);
    const bf16_t* zb = WSP(bf16_t, WS_Z);
    unsigned char* blob = C.ws + WS_HG + ((size_t)((b * NH + h) * 2 + dir) * NCH + c) * HG_BLOB;
    const int i = tid >> 3, d0 = (tid & 7) * 8; const int row = scan_row<0>(b, dir, 64 * c + i);
    { const bf16_t* zr = zb + (size_t)row * ZW + HGB + h * 64 + d0; const float* lbp = WSP(float, WS_LB) + l * 256 + h * 64 + d0;
#pragma unroll
        for (int j = 0; j < 8; ++j) { const float qz = bf2f(zr[j]), iz = bf2f(zr[256 + j]), fz = bf2f(zr[512 + dir * 256 + j]), lb = lbp[j];
            const float sg = 1.f / (1.f + __expf(-fz)), sgn = 1.f / (1.f + __expf(fz));
            Qf[i * LF + d0 + j] = siluf_(qz); Kf[i * LF + d0 + j] = (1.f - lb) * sgn; CUM[i * LF + d0 + j] = __logf(lb + (1.f - lb) * sg); Vf[i * LF + d0 + j] = iz; VT[(d0 + j) * LS + i] = (bf16_t)f2bf(iz); } }
    __syncthreads();
    if (tid < 256) { const int sub = tid >> 6, d = tid & 63; float a = 0.f;
#pragma unroll
        for (int t = 0; t < 16; ++t) { a += CUM[(16 * sub + t) * LF + d]; CUM[(16 * sub + t) * LF + d] = a; } }
    __syncthreads();
    for (int p = tid; p < 544; p += 512) { const int sub = p / 136, r = p % 136; int t = 0; while ((t + 1) * (t + 2) / 2 <= r) ++t; const int s2 = r - t * (t + 1) / 2;
        const LAS float* qp = Qf + (16 * sub + t) * LF; const LAS float* kp = Kf + (16 * sub + s2) * LF; const LAS float* ct = CUM + (16 * sub + t) * LF; const LAS float* cs = CUM + (16 * sub + s2) * LF; float a = 0.f;
#pragma unroll 8
        for (int d = 0; d < 64; ++d) a += qp[d] * kp[d] * __expf(ct[d] - cs[d]);
        SC[(sub * 16 + t) * 17 + s2] = a; }
    { const int sub = i >> 4; u32x4 wq; float qt[8];
#pragma unroll
        for (int j = 0; j < 8; ++j) { const float cm = CUM[i * LF + d0 + j], last = CUM[(16 * sub + 15) * LF + d0 + j];
            KDT[(d0 + j) * LS + i] = (bf16_t)f2bf(Kf[i * LF + d0 + j] * __expf(last - cm)); qt[j] = Qf[i * LF + d0 + j] * __expf(cm);
            if ((i & 15) == 15) ((float*)(blob + 32768))[sub * 64 + d0 + j] = __expf(last); }
        wq.x = pk2(qt[0], qt[1]); wq.y = pk2(qt[2], qt[3]); wq.z = pk2(qt[4], qt[5]); wq.w = pk2(qt[6], qt[7]);
        *(u32x4*)((bf16_t*)(blob + 33792) + i * 64 + d0) = wq; }
    __syncthreads();
    { const int sub = i >> 4, t = i & 15; float o[8];
#pragma unroll
        for (int j = 0; j < 8; ++j) o[j] = 0.f;
        for (int s2 = 0; s2 <= t; ++s2) { const float sc = SC[(sub * 16 + t) * 17 + s2];
#pragma unroll
            for (int j = 0; j < 8; ++j) o[j] += sc * Vf[(16 * sub + s2) * LF + d0 + j]; }
        float* op = (float*)(blob + 41984) + i * 64 + d0; *(f32x4*)op = (f32x4){o[0], o[1], o[2], o[3]}; *(f32x4*)(op + 4) = (f32x4){o[4], o[5], o[6], o[7]}; }
    { const int sub = w >> 1, eh = (w & 1) * 32; f32x16 acc[2]; acc[0] = (f32x16)(0.f); acc[1] = (f32x16)(0.f);
        mm_nt<2, 1>(VT + eh * LS + 16 * sub, LS, KDT + 16 * sub, LS, acc, lane);
        bf16_t* ut = (bf16_t*)blob + sub * 4096;
#pragma unroll
        for (int n = 0; n < 2; ++n)
#pragma unroll
            for (int ri = 0; ri < 16; ++ri) ut[(eh + CROW(ri, lane)) * 64 + 32 * n + (lane & 31)] = (bf16_t)f2bf(acc[n][ri]); }
    __syncthreads();
}
__device__ __forceinline__ void hgrn_b_scan(Ctx& C, int sidx) {
    const int tid = C.tid, e = tid >> 3, d0 = (tid & 7) * 8;
    float st[8];
#pragma unroll
    for (int j = 0; j < 8; ++j) st[j] = 0.f;
    for (int c = 0; c < NCH; ++c) {
        const unsigned char* blob = C.ws + WS_HG + ((size_t)sidx * NCH + c) * HG_BLOB; bf16_t* so = WSP(bf16_t, WS_HST) + ((size_t)sidx * NCH + c) * 4 * 4096;
#pragma unroll
        for (int sub = 0; sub < 4; ++sub) {
            const u32x4 ur = *(const u32x4*)((const bf16_t*)blob + sub * 4096 + e * 64 + d0);
            const f32x4 l0 = *(const f32x4*)((const float*)(blob + 32768) + sub * 64 + d0), l1 = *(const f32x4*)((const float*)(blob + 32768) + sub * 64 + d0 + 4);
            u32x4 wv; wv.x = pk2(st[0], st[1]); wv.y = pk2(st[2], st[3]); wv.z = pk2(st[4], st[5]); wv.w = pk2(st[6], st[7]);
            *(u32x4*)(so + sub * 4096 + e * 64 + d0) = wv;
            const unsigned uu[4] = {ur.x, ur.y, ur.z, ur.w}; const float lam[8] = {l0.x, l0.y, l0.z, l0.w, l1.x, l1.y, l1.z, l1.w};
#pragma unroll
            for (int j = 0; j < 4; ++j) { st[2 * j] = lam[2 * j] * st[2 * j] + u2f(uu[j] << 16); st[2 * j + 1] = lam[2 * j + 1] * st[2 * j + 1] + u2f(uu[j] & 0xffff0000u); } }
    }
}
__device__ __forceinline__ void hgrn_c_item(Ctx& C, int l, int b, int h, int jt) {
    LAS unsigned char* lds = C.lds; ITEM_IDS();
    LAS bf16_t* STw = (LAS bf16_t*)(lds + w * 11520);
    LAS bf16_t* QTw = STw + 64 * LS;
    LAS float* OF = (LAS float*)(lds + 92160);
    const bool isc = jt < NCHC; const int jl = jt - NCHC;
    int cidx[2]; cidx[0] = jt; cidx[1] = isc ? (NCHC - 1 - jt) : NCHC + (SEQ / 64 - 1 - jl);
    { const int dir = w >> 2, sub = w & 3; const size_t sc = (size_t)((b * NH + h) * 2 + dir) * NCH + cidx[dir]; const unsigned char* blob = C.ws + WS_HG + sc * HG_BLOB;
        const bf16_t* st = WSP(bf16_t, WS_HST) + (sc * 4 + sub) * 4096; const bf16_t* qt = (const bf16_t*)(blob + 33792) + (16 * sub) * 64;
#pragma unroll
        for (int k = 0; k < 8; ++k) { const int o = lane + 64 * k, r = o >> 3, c8 = (o & 7) * 8; *(LAS u32x4*)(STw + r * LS + c8) = *(const u32x4*)(st + r * 64 + c8); }
#pragma unroll
        for (int k = 0; k < 2; ++k) { const int o = lane + 64 * k, r = o >> 3, c8 = (o & 7) * 8; *(LAS u32x4*)(QTw + r * LS + c8) = *(const u32x4*)(qt + r * 64 + c8); }
        LDS_WAIT(); asm volatile("" ::: "memory");
        const float* oi = (const float*)(blob + 41984) + (16 * sub) * 64;
        const int tr = lane & 15, kq = (lane >> 4) * 8;
#pragma unroll
        for (int nt = 0; nt < 4; ++nt) { f32x4 acc = (f32x4){0.f, 0.f, 0.f, 0.f};
#pragma unroll
            for (int kk = 0; kk < 2; ++kk) { const bf16x8 a = *(const LAS bf16x8*)(QTw + tr * LS + 32 * kk + kq), bb = *(const LAS bf16x8*)(STw + (16 * nt + tr) * LS + 32 * kk + kq);
                acc = __builtin_amdgcn_mfma_f32_16x16x32_bf16(a, bb, acc, 0, 0, 0); }
#pragma unroll
            for (int r = 0; r < 4; ++r) { const int t = 4 * (lane >> 4) + r, ii = 16 * sub + t, tok = dir ? 63 - ii : ii, ee = 16 * nt + (lane & 15);
                OF[dir * 64 * LF + tok * LF + ee] = acc[r] + oi[t * 64 + ee]; } } }
    __syncthreads();
    { const int tok = tid >> 3, e0 = (tid & 7) * 8; const int row = scan_row<0>(b, 0, 64 * cidx[0] + tok);
        float o[8]; float ss = 0.f;
#pragma unroll
        for (int j = 0; j < 8; ++j) { o[j] = OF[tok * LF + e0 + j] + OF[64 * LF + tok * LF + e0 + j]; ss += o[j] * o[j]; }
#pragma unroll
        for (int k = 1; k < 8; k <<= 1) ss += __shfl_xor(ss, k);
        const float rs = 1.f / sqrtf(ss * (1.f / 64.f) + EPS);
        const float* ng = INP(I_HGNG) + l * 256 + h * 64 + e0; const bf16_t* gz = WSP(bf16_t, WS_Z) + (size_t)row * ZW + HGB + 1024 + h * 64 + e0;
        unsigned pk[4];
#pragma unroll
        for (int j = 0; j < 4; ++j) pk[j] = pk2(o[2 * j] * rs * ng[2 * j] * siluf_(bf2f(gz[2 * j])), o[2 * j + 1] * rs * ng[2 * j + 1] * siluf_(bf2f(gz[2 * j + 1])));
        *(u32x4*)(WSP(bf16_t, WS_MIX) + (size_t)row * D + h * 64 + e0) = (u32x4){pk[0], pk[1], pk[2], pk[3]}; }
    __syncthreads();
}
#ifndef REPMASK
#define REPMASK 0
#endif
__device__ __forceinline__ void phase_gdn_a(Ctx& C, int l) {
    for (int rep = 0; rep < 1 + ((REPMASK >> 10) & 1); ++rep)
    for (int it = C.bid; it < NSCAN * NCH; it += C.G) { const int sidx = it / NCH, c = it % NCH; gdn_a_item(C, l, sidx / (NH * 2), (sidx / 2) % NH, sidx & 1, c); }
    for (int rep = 0; rep < 1 + ((REPMASK >> 11) & 1); ++rep)
    for (int it = C.bid; it < NSCAN * NCH; it += C.G) { const int sidx = it / NCH, c = it % NCH; mlstm_a_item(C, l, sidx / (NH * 2), (sidx / 2) % NH, sidx & 1, c); }
    for (int rep = 0; rep < 1 + ((REPMASK >> 12) & 1); ++rep)
    for (int it = C.bid; it < NSCAN * NCH; it += C.G) { const int sidx = it / NCH, c = it % NCH; hgrn_a_item(C, l, sidx / (NH * 2), (sidx / 2) % NH, sidx & 1, c); }
}
__device__ __forceinline__ void phase_hy_transpose(Ctx& C) {
    const int gw = C.vcu * 8 + C.wave, NGW = C.G * 8, lane = C.lane;
    LAS bf16_t* scr = (LAS bf16_t*)(C.lds + C.wave * 8448);
    const bf16_t* zb = WSP(bf16_t, WS_Z); bf16_t* zt = WSP(bf16_t, WS_ZT);
    for (int it = gw; it < (NT / 64) * 12; it += NGW) { const int r0 = (it / 12) * 64, cb = (it % 12) * 64;
#pragma unroll 8
        for (int rr = 0; rr < 64; rr += 2) { const int r = rr + (lane >> 5), c2 = (lane & 31) * 2; const unsigned v = *(const unsigned*)(zb + (size_t)(r0 + r) * ZW + HYB + cb + c2);
            scr[r * 66 + c2] = (bf16_t)(v & 0xffffu); scr[r * 66 + c2 + 1] = (bf16_t)(v >> 16); }
        LDS_WAIT(); asm volatile("" ::: "memory");
#pragma unroll 8
        for (int cc = 0; cc < 64; cc += 2) { const int c = cc + (lane >> 5), r2 = (lane & 31) * 2;
            *(unsigned*)(zt + (size_t)(cb + c) * NT + r0 + r2) = (unsigned)scr[r2 * 66 + c] | ((unsigned)scr[(r2 + 1) * 66 + c] << 16); }
        LDS_WAIT(); asm volatile("" ::: "memory"); }
}
__device__ __forceinline__ void phase_gdn_c(Ctx& C, int l) {
    const int j0 = (l == 0) ? 0 : NCHC, nj = NCH - j0;
    for (int it = C.bid; it < NB * NH * nj; it += C.G) { const int bh = it / nj, jt = j0 + it % nj; gdn_c_item(C, l, bh / NH, bh % NH, jt); }
    for (int it = C.bid; it < NB * NH * nj; it += C.G) { const int bh = it / nj, jt = j0 + it % nj; mlstm_c_item(C, l, bh / NH, bh % NH, jt); }
    for (int it = C.bid; it < NB * NH * nj; it += C.G) { const int bh = it / nj, jt = j0 + it % nj; hgrn_c_item(C, l, bh / NH, bh % NH, jt); }
}

__device__ __forceinline__ void fft_fwd(LAS f32x2* X, const LAS f32x2* tw, int N, int tid) {
    for (int half = N >> 1; half >= 1; half >>= 1) { const int tws = TWN / half;
        for (int j = tid; j < (N >> 1); j += 512) { const int jm = j & (half - 1), i = ((j - jm) << 1) + jm; const f32x2 a = X[i], b = X[i + half], w = tw[jm * tws];
            const f32x2 d = a - b; X[i] = a + b; X[i + half] = (f32x2){d.x * w.x - d.y * w.y, d.x * w.y + d.y * w.x}; }
        __syncthreads(); }
}
__device__ __forceinline__ void fft_inv(LAS f32x2* X, const LAS f32x2* tw, int N, int tid) {
    for (int half = 1; half <= (N >> 1); half <<= 1) { const int tws = TWN / half;
        for (int j = tid; j < (N >> 1); j += 512) { const int jm = j & (half - 1), i = ((j - jm) << 1) + jm; const f32x2 a = X[i], b0 = X[i + half], w = tw[jm * tws];
            const f32x2 b = (f32x2){b0.x * w.x + b0.y * w.y, b0.y * w.x - b0.x * w.y}; X[i] = a + b; X[i + half] = a - b; }
        __syncthreads(); }
}
__device__ __forceinline__ float block_sum(Ctx& C, float v, LAS float* red) {
    v = wave_sum(v); __syncthreads(); if (C.lane == 0) red[C.wave] = v; __syncthreads();
    float s = 0.f;
#pragma unroll
    for (int i = 0; i < 8; ++i) s += red[i];
    return s;
}
__device__ __forceinline__ void hyena_channel(Ctx& C, int l, int c, int len, int row0, int hoff  ) {
    LAS f32x2* X = (LAS f32x2*)C.lds; LAS f32x2* Y1 = (LAS f32x2*)(C.lds + 65536); const LAS f32x2* tw = (const LAS f32x2*)(C.lds + 98304); LAS float* red = (LAS float*)(C.lds + LDSX_OFF + 128);
    const int tid = C.tid, N = 2 * len;
    f32x2* Ks = WSP(f32x2, WS_KS) + (size_t)C.bid * 2 * FFTN;
    const float* hd = WSP(float, WS_HDN) + ((size_t)l * (SEQ + LC) + hoff) * 64;
    const float* w3 = INP(I_HYW3) + (size_t)l * 64 * 1024;
    const float delta = (-4.605170185988091f / 1.5f + (-4.605170185988091f / 0.3f + 4.605170185988091f / 1.5f) * (float)c / 255.0f);
    const float ad = fabsf(delta);
    for (int n = 0; n < 2; ++n) {
        float ss = 0.f;
        for (int p = tid; p < len; p += 512) { const float* hr = hd + (size_t)p * 64; float f = 0.f, g = 0.f;
#pragma unroll 8
            for (int j = 0; j < 64; ++j) { const float hv = hr[j]; f += hv * w3[j * 1024 + n * 256 + c]; g += hv * w3[j * 1024 + 512 + n * 256 + c]; }
            const float win = __expf(-((float)p / (float)(len - 1)) * ad); f *= win; g *= win;
            X[p] = (f32x2){f, 0.f}; ss += f * f;
            if (p >= 1) { X[N - p] = (f32x2){g, 0.f}; ss += g * g; } }
        if (tid == 0) X[len] = (f32x2){0.f, 0.f};
        const float scale = 1.f / sqrtf(block_sum(C, ss, red) + EPS);
        __syncthreads();
        fft_fwd(X, tw, N, tid);
        for (int i = tid; i < N; i += 512) Ks[(size_t)n * FFTN + i] = X[i] * scale;
        __syncthreads();
    }
    const bf16_t* zt = WSP(bf16_t, WS_ZT); const float* cw = INP(I_HYCW) + l * 3 * 768; const float* cb = INP(I_HYCB) + l * 768;
    const float bias0 = INP(I_HYBI)[l * 512 + c], bias1 = INP(I_HYBI)[l * 512 + 256 + c];
    float* hyt = WSP(float, WS_HYT) + (size_t)c * NT;
    const float inv_n = 1.0f / (float)N;
    const int nseq = NB;
    auto conv3 = [&](int row, int t, int col) -> float {
        const bf16_t* zr = zt + (size_t)col * NT + row; float s = cb[col] + cw[768 + col] * bf2f(zr[0]);
        if (t > 0) s += cw[col] * bf2f(zr[-1]);
        if (t < len - 1) s += cw[1536 + col] * bf2f(zr[1]);
        return s; };
    for (int q = 0; q < nseq; q += 2) {
        const int ra = row0 + q * len, rb = ra + len;
        for (int t = tid; t < len; t += 512) { X[t] = (f32x2){conv3(ra + t, t, c), conv3(rb + t, t, c)}; X[len + t] = (f32x2){0.f, 0.f}; }
        __syncthreads();
        fft_fwd(X, tw, N, tid);
        for (int i = tid; i < N; i += 512) { const f32x2 k = Ks[i], x = X[i]; X[i] = (f32x2){x.x * k.x - x.y * k.y, x.x * k.y + x.y * k.x}; }
        __syncthreads();
        fft_inv(X, tw, N, tid);
        for (int t = tid; t < len; t += 512) { const f32x2 cv = X[t] * inv_n; const float va = conv3(ra + t, t, c), vb = conv3(rb + t, t, c), xa = conv3(ra + t, t, 256 + c), xb = conv3(rb + t, t, 256 + c);
            Y1[t] = (f32x2){xa * (cv.x + bias0 * va), xb * (cv.y + bias0 * vb)}; }
        __syncthreads();
        for (int t = tid; t < len; t += 512) { X[t] = Y1[t]; X[len + t] = (f32x2){0.f, 0.f}; }
        __syncthreads();
        fft_fwd(X, tw, N, tid);
        for (int i = tid; i < N; i += 512) { const f32x2 k = Ks[FFTN + i], x = X[i]; X[i] = (f32x2){x.x * k.x - x.y * k.y, x.x * k.y + x.y * k.x}; }
        __syncthreads();
        fft_inv(X, tw, N, tid);
        for (int t = tid; t < len; t += 512) { const f32x2 cv = X[t] * inv_n, y1 = Y1[t]; const float xa = conv3(ra + t, t, 512 + c), xb = conv3(rb + t, t, 512 + c);
            hyt[ra + t] = xa * (cv.x + bias1 * y1.x); hyt[rb + t] = xb * (cv.y + bias1 * y1.y); }
        __syncthreads();
    }
}
__device__ __forceinline__ void phase_mixers(Ctx& C, int l, int parts = 3) {
    const int G = C.G, me = C.bid;
    const int nscan = 3 * NSCAN, nsw = G > nscan ? nscan : G;
    if (parts & 1) for (int j = me; j < nscan; j += nsw) { if (me >= nsw) break;
        const int mix = j / NSCAN, r = j % NSCAN;
        if (mix == 0) hgrn_b_scan(C, r); else if (mix == 1) mlstm_b_scan(C, r); else gdn_b_scan(C, r); }
    if (parts & 2) {
        LAS f32x2* tw = (LAS f32x2*)(C.lds + 98304); volatile LAS int* jobw = (volatile LAS int*)(C.lds + LDSX_OFF + 192);
        __syncthreads();
        for (int k = C.tid; k < TWN; k += 512) { float s, c; sincospi_((float)k / (float)TWN, &s, &c); tw[k] = (f32x2){c, -s}; }
        __syncthreads();
        unsigned* qh = WSP(unsigned, WS_CTL) + CW_HYQ + 64 * l + ((parts == 2) ? 32 : 0);
        for (;;) {
            if (C.tid == 0) jobw[0] = (int)atomicAdd(qh, 1u);
            __syncthreads();
            const int c = jobw[0];
            __syncthreads();
            if (c >= 256) break;
            hyena_channel(C, l, c, SEQ, 0, 0); if (l == 0) hyena_channel(C, l, c, LC, NLAT, SEQ);
        }
    }
}
__device__ __forceinline__ void phase_finalize(Ctx& C, int l) {
    const int gw = C.vcu * 8 + C.wave, NGW = C.G * 8, lane = C.lane;
    const int nrows = (l == 0) ? NT : NLAT;
    const bf16_t* zb = WSP(bf16_t, WS_Z); bf16_t* mix = WSP(bf16_t, WS_MIX);
    LAS float* scr = (LAS float*)(C.lds + C.wave * 8448);
    const int ntr = nrows / 64;
    for (int it = gw; it < ntr * 8; it += NGW) { const int rt = it / 8, cb = (it % 8) * 32; const float* src = WSP(float, WS_HYT) + (size_t)cb * NT + rt * 64;
#pragma unroll 8
        for (int cc = 0; cc < 32; ++cc) scr[cc * 65 + lane] = src[(size_t)cc * NT + lane];
        LDS_WAIT(); asm volatile("" ::: "memory");
        for (int rr = 0; rr < 64; rr += 4) { const int r = rr + (lane >> 4), c2 = (lane & 15) * 2;
            *(unsigned*)(mix + (size_t)(rt * 64 + r) * D + 512 + cb + c2) = pk2(scr[c2 * 65 + r], scr[(c2 + 1) * 65 + r]); }
        LDS_WAIT(); asm volatile("" ::: "memory"); }
}

enum { PH_PRO = 0, PH_L0 = 1, PH_PER_LAYER = 10, PH_FINAL = PH_L0 + DEPTH * PH_PER_LAYER, PH_COUNT };
__global__ void __launch_bounds__(512, 2) fwd_kernel(Args args) {
#ifdef HOST_EMU
    unsigned char* lds = emu::cur->blk->lds;
#else
    extern __shared__ __attribute__((aligned(16))) unsigned char lds[];
#endif
#ifdef HOST_EMU
    Ctx C; C.lds = (LAS unsigned char*)lds; C.a = &args; C.ws = args.ws;
#else
    Ctx C; C.lds = (LAS unsigned char*)lds; C.a = (const __attribute__((address_space(4))) Args*)__builtin_amdgcn_kernarg_segment_ptr(); C.ws = C.a->ws;
#endif
    C.tid = threadIdx.x; C.lane = C.tid & 63; C.wave = __builtin_amdgcn_readfirstlane(C.tid >> 6);
    C.bid = blockIdx.x; C.G = gridDim.x; { const int bx = blockIdx.x; C.vcu = (C.G % 8 == 0) ? (bx % 8) * (C.G / 8) + bx / 8 : bx; }
    volatile LAS unsigned* MISC = (volatile LAS unsigned*)(C.lds + LDSX_OFF + LX_MISC);
    for (int u = C.tid; u < 64; u += 512) MISC[u] = 0u;
    __syncthreads();
    const int lo = C.a->ph_lo, hi = C.a->ph_hi;
    const bool multi = (hi - lo) > 1;
    XcdBarrier bar; bar.bar = WSP(unsigned, WS_CTL) + CW_BAR; bar.x = 0; bar.st = nullptr;
    if (multi) bar = xcd_barrier_post(WSP(unsigned, WS_CTL) + CW_BAR, MISC + 8);
#ifndef HOST_EMU
    if (multi) { cooperative_groups::this_grid().sync(); }
#endif
    const Ctx C0 = C;
#ifdef HOST_EMU
#define LAUNDER_CTX() Ctx C = C0; C.tid = threadIdx.x; C.lane = C.tid & 63; C.wave = C.tid >> 6;
#else
#define LAUNDER_CTX() Ctx C = C0; C.tid = threadIdx.x; \
        {   unsigned long long pw = (unsigned long long)C.ws, pa = (unsigned long long)C.a; unsigned w0 = (unsigned)pw, w1 = (unsigned)(pw >> 32), a0 = (unsigned)pa, a1 = (unsigned)(pa >> 32), v0 = (unsigned)C.vcu, g0 = (unsigned)C.G, b0 = (unsigned)C.bid; \
            asm volatile("" : "+v"(w0), "+v"(w1), "+v"(a0), "+v"(a1), "+v"(v0), "+v"(g0), "+v"(b0), "+v"(C.tid)); \
            w0 = __builtin_amdgcn_readfirstlane(w0); w1 = __builtin_amdgcn_readfirstlane(w1); a0 = __builtin_amdgcn_readfirstlane(a0); a1 = __builtin_amdgcn_readfirstlane(a1); \
            C.vcu = (int)__builtin_amdgcn_readfirstlane(v0); C.G = (int)__builtin_amdgcn_readfirstlane(g0); C.bid = (int)__builtin_amdgcn_readfirstlane(b0); \
            C.ws = (unsigned char*)(((unsigned long long)w1 << 32) | w0); C.a = (const __attribute__((address_space(4))) Args*)(((unsigned long long)a1 << 32) | a0); } \
        C.lane = C.tid & 63; C.wave = __builtin_amdgcn_readfirstlane(C.tid >> 6);
#endif
#define PH_BEGIN(k) if (lo <= (k) && (k) < hi) { LAUNDER_CTX()
#define PH_END(k) if ((k) + 1 < hi) { XcdBarrier b2 = bar; b2.bar = WSP(unsigned, WS_CTL) + CW_BAR; xcd_barrier(b2); } }
#define REP(b) ((REPMASK >> (b)) & 1)
    PH_BEGIN(PH_PRO) p0_prologue(C); if (REP(0)) { __syncthreads(); p0_prologue(C); } PH_END(PH_PRO)
#define LAYER_PHASES(l) { constexpr int pb = PH_L0 + (l) * PH_PER_LAYER; \
    PH_BEGIN(pb + 0) if ((l) > 0) (void)build_tiles(C, (l) > 0 ? (l) - 1 : 0); phase_rows_a(C, (l)); PH_END(pb + 0) \
    PH_BEGIN(pb + 1) pg8::Gemm g{WSP(bf16_t, WS_H), WSP(bf16_t, WS_WIN) + (size_t)(l) * ZW * D, D, 0}; pg8::StaticOrder S; S.init(NT, ZW, C.G, C.bid); \
        pg8::EpiBf16 E{WSP(bf16_t, WS_Z), ZW, nullptr, 0}; pg8::gemm_phase(C.lds, g, S, E, C.tid); if (REP(1)) { __syncthreads(); pg8::gemm_phase(C.lds, g, S, E, C.tid); } PH_END(pb + 1) \
    PH_BEGIN(pb + 2) phase_hy_transpose(C); __syncthreads(); phase_gdn_a(C, (l)); if (REP(8)) { __syncthreads(); phase_gdn_a(C, (l)); } PH_END(pb + 2) \
    PH_BEGIN(pb + 3) phase_mixers(C, (l)); if (REP(2)) { __syncthreads(); phase_mixers(C, (l), 1); } if (REP(3)) { __syncthreads(); phase_mixers(C, (l), 2); } PH_END(pb + 3) \
    PH_BEGIN(pb + 4) phase_finalize(C, (l)); __syncthreads(); phase_gdn_c(C, (l)); if (REP(4)) { __syncthreads(); phase_finalize(C, (l)); } if (REP(9)) { __syncthreads(); phase_gdn_c(C, (l)); } PH_END(pb + 4) \
    PH_BEGIN(pb + 5) pg8::Gemm g{WSP(bf16_t, WS_MIX), WSP(bf16_t, WS_WOUT) + (size_t)(l) * D * D, D, 0}; pg8::StaticOrder S; S.init((l) == 0 ? NT : NLAT, D, C.G, C.bid); \
        pg8::EpiResid E{(l) == 0 ? INP(I_X) : WSP(float, WS_X), (l) == 0 ? INP(I_CTX) : WSP(float, WS_X) + (size_t)NLAT * D, WSP(float, WS_X), WSP(float, WS_MOD) + (size_t)(l) * (NB + 1) * 6 * D + 2 * D}; \
        pg8::gemm_phase(C.lds, g, S, E, C.tid); PH_END(pb + 5) \
    PH_BEGIN(pb + 6) phase_rows_b(C, (l)); PH_END(pb + 6) \
    PH_BEGIN(pb + 7) phase_gather(C, (l)); if (REP(5)) { __syncthreads(); phase_gather(C, (l)); } PH_END(pb + 7) \
    PH_BEGIN(pb + 8) const int ntiles = build_tiles(C, (l)); \
        pg8::Gemm g{WSP(bf16_t, WS_HS), WSP(bf16_t, WS_W1) + (size_t)(l) * NE * 2 * DE * D, D, (size_t)2 * DE * D}; pg8::MoeOrder S; S.init(ntiles, 2 * DE, C.G, C.bid, (const LAS int*)(C.lds + LDSX_OFF + LX_TILE)); \
        pg8::EpiSwiglu E{WSP(bf16_t, WS_A2), INP(I_EB1) + (size_t)(l) * NE * 2 * DE}; pg8::gemm_phase(C.lds, g, S, E, C.tid); if (REP(6)) { __syncthreads(); pg8::gemm_phase(C.lds, g, S, E, C.tid); } PH_END(pb + 8) \
    PH_BEGIN(pb + 9) const int ntiles = build_tiles(C, (l)); \
        pg8::Gemm g{WSP(bf16_t, WS_A2), WSP(bf16_t, WS_W2) + (size_t)(l) * NE * D * DE, DE, (size_t)D * DE}; pg8::MoeOrder S; S.init(ntiles, D, C.G, C.bid, (const LAS int*)(C.lds + LDSX_OFF + LX_TILE)); \
        pg8::EpiBf16 E{WSP(bf16_t, WS_Y), D, INP(I_EB2) + (size_t)(l) * NE * D, D}; pg8::gemm_phase(C.lds, g, S, E, C.tid); if (REP(7)) { __syncthreads(); pg8::gemm_phase(C.lds, g, S, E, C.tid); } PH_END(pb + 9) }
    LAYER_PHASES(0)
    LAYER_PHASES(1)
    static_assert(DEPTH == 2, "two layers written out");
    PH_BEGIN(PH_FINAL) (void)build_tiles(C, DEPTH - 1); phase_rows_a(C, DEPTH); PH_END(PH_FINAL)
}

#ifndef MK_PER_PHASE
#define MK_PER_PHASE 0
#endif
extern "C" void kernel_launch(void* const* d_in, const int* in_sizes, int n_in, void* d_out, int out_size, void* d_ws, size_t ws_size, hipStream_t stream) {
    static int grid = 0;
#ifndef HOST_EMU
    if (grid == 0) {
        if (n_in != 34 || ws_size < WS_END) { fprintf(stderr, "kernel_launch: unexpected n_in %d / ws %zu (need %zu)\n", n_in, ws_size, (size_t)WS_END); grid = -1; return; }
        int dev = 0, cus = 0, per_cu = 0;
        hipGetDevice(&dev); hipDeviceGetAttribute(&cus, hipDeviceAttributeMultiprocessorCount, dev);
        hipFuncSetAttribute((const void*)fwd_kernel, hipFuncAttributeMaxDynamicSharedMemorySize, LDS_BYTES);
        hipOccupancyMaxActiveBlocksPerMultiprocessor(&per_cu, (const void*)fwd_kernel, 512, LDS_BYTES);
        if (per_cu < 1) { fprintf(stderr, "kernel_launch: occupancy query says %d blocks per CU\n", per_cu); per_cu = 1; }
        grid = cus;
        (void)hipGetLastError();
    }
    if (grid < 0) return;
#else
    grid = EMU_GRID;
#endif
    hipMemsetAsync((char*)d_ws + WS_CTL, 0, CTL_BYTES, stream);
    Args a{};
    for (int i = 0; i < 34; ++i) a.in[i] = (const float*)d_in[i];
    a.out = (float*)d_out; a.ws = (unsigned char*)d_ws;
#ifdef HOST_EMU
    a.ph_lo = 0; a.ph_hi = PH_COUNT;
    if (getenv("EMU_PH_HI")) a.ph_hi = atoi(getenv("EMU_PH_HI"));
    emu::launch([&]() { fwd_kernel(a); }, dim3(grid), dim3(512), LDS_BYTES);
#else
#if MK_PER_PHASE
    for (int ph = 0; ph < PH_COUNT; ++ph) { a.ph_lo = ph; a.ph_hi = ph + 1; hipLaunchKernelGGL(fwd_kernel, dim3(grid), dim3(512), LDS_BYTES, stream, a); }
#else
    a.ph_lo = 0; a.ph_hi = PH_COUNT;
    void* kargs[] = {&a};
    hipError_t e = hipLaunchCooperativeKernel((const void*)fwd_kernel, dim3(grid), dim3(512), kargs, LDS_BYTES, stream);
    if (e != hipSuccess) fprintf(stderr, "cooperative launch failed: %s (grid %d)\n", hipGetErrorString(e), grid);
#endif
#endif
}
```

```cpp
#ifdef HOST_EMU
#include "host/emu.h"
#else
#include <hip/hip_runtime.h>
#include <hip/hip_cooperative_groups.h>
#endif
#include <cstdio>
#include <cstdint>
#include <cmath>

#ifndef CFG_B
#define CFG_B 4
#define CFG_L 4096
#define CFG_GW 64
#define CFG_LC 256
#define CFG_NE 32
#endif
constexpr int NB = CFG_B, SEQ = CFG_L, GW = CFG_GW, GROWS = SEQ / GW, LC = CFG_LC, NE = CFG_NE, TOPK = 4, DEPTH = 2;
constexpr int D = 1024, WG_ = 256, NH = 4, DH = 64;
constexpr int NLAT = NB * SEQ, NCTX = NB * LC, NT = NLAT + NCTX;
constexpr int IN_W = 4128, ZW = 4096;
constexpr int HGB = 0, MLB = 1280, HYB = 2304, GDB = 3072;
constexpr int DE = 1024;
constexpr float EPS = 1e-6f;
constexpr int FFTN = 2 * SEQ, FFTNC = 2 * LC, TWN = FFTN / 2;
static_assert(NT % 256 == 0 && NLAT % 256 == 0, "row counts must be multiples of 256");
static_assert(SEQ % 16 == 0 && LC % 16 == 0, "chunking");
constexpr int MAXTILES = (NT * TOPK + NE * 255) / 256 + 1;

constexpr size_t al256(size_t x) { return (x + 255) & ~(size_t)255; }
constexpr size_t WS_CTL = 0, CTL_BYTES = 1 << 20;
constexpr size_t WS_WIN = WS_CTL + CTL_BYTES;
constexpr size_t WS_WOUT = WS_WIN + (size_t)DEPTH * ZW * D * 2;
constexpr size_t WS_W1 = WS_WOUT + (size_t)DEPTH * D * D * 2;
constexpr size_t WS_W2 = WS_W1 + (size_t)DEPTH * NE * 2 * DE * D * 2;
constexpr size_t WS_WG = WS_W2 + (size_t)DEPTH * NE * D * DE * 2;
constexpr size_t WS_WR = WS_WG + (size_t)DEPTH * 32 * D * 4;
constexpr size_t WS_MOD = WS_WR + (size_t)DEPTH * NE * D * 4;
constexpr size_t WS_LB = WS_MOD + al256((size_t)DEPTH * (NB + 1) * 6 * D * 4);
constexpr size_t WS_HDN = WS_LB + (size_t)DEPTH * 256 * 4;
constexpr size_t WS_X = WS_HDN + (size_t)DEPTH * (SEQ + LC) * 64 * 4;
constexpr size_t WS_H = WS_X + (size_t)NT * D * 4;
constexpr size_t WS_Z = WS_H + (size_t)NT * D * 2;
constexpr size_t WS_ZG = WS_Z + (size_t)NT * ZW * 2;
constexpr size_t WS_MIX = WS_ZG + (size_t)NT * 32 * 4;
constexpr size_t WS_OB = WS_MIX + (size_t)NT * D * 2;
constexpr size_t WS_HYT = WS_OB + (size_t)6 * NT * 256 * 4;
constexpr size_t WS_KS = WS_HYT + (size_t)256 * NT * 4;
constexpr size_t WS_TOP = WS_KS + (size_t)256 * 2 * FFTN * 8;
constexpr size_t WS_HS = WS_TOP + (size_t)NT * 4 * 12;
constexpr size_t WS_A2 = WS_HS + (size_t)MAXTILES * 256 * D * 2;
constexpr size_t WS_Y = WS_A2 + (size_t)MAXTILES * 256 * DE * 2;
constexpr int NCH = (LC + SEQ) / 64, NCHC = LC / 64, NSCAN = NB * NH * 2;
constexpr size_t GD_BLOB = 49152;
constexpr size_t WS_GD = WS_Y + (size_t)MAXTILES * 256 * D * 2;
constexpr size_t WS_GST = WS_GD + (size_t)NSCAN * NCH * GD_BLOB;
constexpr size_t ML_BLOB = 34816;
constexpr size_t WS_ML = WS_GST + (size_t)NSCAN * NCH * 8192;
constexpr size_t ML_ST = 8192 + 512;
constexpr size_t WS_MST = WS_ML + (size_t)NSCAN * NCH * ML_BLOB;
constexpr size_t HG_BLOB = 58368;
constexpr size_t WS_HG = WS_MST + (size_t)NSCAN * NCH * ML_ST;
constexpr size_t WS_HST = WS_HG + (size_t)NSCAN * NCH * HG_BLOB;
constexpr size_t WS_ZT = WS_HST + (size_t)NSCAN * NCH * 4 * 8192;
constexpr size_t WS_END = WS_ZT + (size_t)768 * NT * 2;
static_assert(SEQ % 64 == 0 && LC % 64 == 0, "64-token chunks");
constexpr int CW_CNT = 64;
constexpr int CW_HYQ = 192;
constexpr int CW_BAR = 4096;

constexpr int RING_BYTES = 131072, LDSX_OFF = RING_BYTES, LDS_BYTES = 147456;
constexpr int LX_MISC = 0, LX_TILE = 256;

#ifdef HOST_EMU
#define __expf expf
#define __logf logf
#define __sinf sinf
#define __cosf cosf
#define LAS
#define GAS
#define DEV_ASM(x) ((void)0)
#define VM_WAIT() ((void)0)
#define LDS_WAIT() do { int _s; (void)emu::wave_xchg(&_s, 4, _s); } while (0)
#else
#define LAS __attribute__((address_space(3)))
#define GAS __attribute__((address_space(1)))
#define VM_WAIT() asm volatile("s_waitcnt vmcnt(0)" ::: "memory")
#define LDS_WAIT() asm volatile("s_waitcnt lgkmcnt(0)" ::: "memory")
#endif
typedef unsigned short bf16_t;
typedef short bf16x8 __attribute__((ext_vector_type(8)));
typedef float f32x4 __attribute__((ext_vector_type(4)));
typedef float f32x2 __attribute__((ext_vector_type(2)));
typedef unsigned u32x4 __attribute__((ext_vector_type(4)));
typedef unsigned u32x2 __attribute__((ext_vector_type(2)));

__device__ __forceinline__ float u2f(unsigned u) { float f; __builtin_memcpy(&f, &u, 4); return f; }
__device__ __forceinline__ unsigned f2u(float f) { unsigned u; __builtin_memcpy(&u, &f, 4); return u; }
__device__ __forceinline__ float bf2f(bf16_t b) { return u2f((unsigned)b << 16); }
__device__ __forceinline__ unsigned f2bf(float f) { unsigned u = f2u(f); return (u + 0x7fffu + ((u >> 16) & 1u)) >> 16; }
__device__ __forceinline__ unsigned pk2(float lo, float hi) { return f2bf(lo) | (f2bf(hi) << 16); }
__device__ __forceinline__ unsigned cvt_pk_bf16(float lo, float hi) {
#ifdef HOST_EMU
    return pk2(lo, hi);
#else
    unsigned r; asm volatile("v_cvt_pk_bf16_f32 %0, %1, %2" : "=v"(r) : "v"(lo), "v"(hi)); return r;
#endif
}
__device__ __forceinline__ float wave_sum(float v) {
#pragma unroll
    for (int o = 1; o < 64; o <<= 1) v += __shfl_xor(v, o);
    return v;
}
__device__ __forceinline__ float sigmoidf_(float x) { return 1.f / (1.f + __expf(-x)); }
__device__ __forceinline__ float siluf_(float x) { return x * sigmoidf_(x); }
__device__ __forceinline__ float softplusf_(float x) { return x > 20.f ? x : log1pf(__expf(x)); }
__device__ __forceinline__ float logsigmoidf_(float x) { return x < -20.f ? x : -log1pf(__expf(-x)); }
#ifdef HOST_EMU
static inline void sincospi_(float x, float* s, float* c) { *s = (float)sin(M_PI * (double)x); *c = (float)cos(M_PI * (double)x); }
#else
__device__ __forceinline__ void sincospi_(float x, float* s, float* c) { sincospif(x, s, c); }
#endif

namespace pg8 {
constexpr int BM = 256, BK = 64, HALF = 128, HTB = HALF * BK * 2, STAGE_BYTES = 8 * HTB, NXCD = 8, WGM = 8;
__host__ __device__ __forceinline__ int lds_byte(int r, int c) { const int st = (r >> 4) * 2 + (c >> 5), rr = r & 15, cc = c & 31, ob = rr * 64 + cc * 2; return st * 1024 + (ob ^ (((ob >> 9) & 1) << 5)); }
__host__ __device__ __forceinline__ void stage_rc(int b, int& R, int& C) { const int st = b / 1024, sb = b % 1024, swz = sb ^ (((sb >> 9) & 1) << 5); R = (st >> 1) * 16 + swz / 64; C = (st & 1) * 32 + (swz % 64) / 2; }
__host__ __device__ __forceinline__ int perm32(int rho) { const int n = rho >> 4, i = rho & 15; return 8 * (i >> 2) + 4 * n + (i & 3); }

struct Unit { int pm, pn, e; };
struct Gemm { const bf16_t* A; const bf16_t* Bt; int K; size_t bexp; };

__host__ __device__ __forceinline__ int xcd_remap(int L, int nwg) { const int q = nwg / NXCD, r = nwg % NXCD, xcd = L % NXCD, off = L / NXCD; return (xcd < r ? xcd * (q + 1) : r * (q + 1) + (xcd - r) * q) + off; }
struct StaticOrder {
    int nM, nN, nwg, G, c;
    __host__ __device__ void init(int M, int N, int G_, int c_) { nM = M / BM; nN = N / BM; nwg = nM * nN; G = G_; c = c_; }
    __host__ __device__ bool next(int i, Unit& u) const {
        const long L = (long)i * G + c; if (L >= nwg) return false;
        const int wgid = xcd_remap((int)L, nwg);
        const int nig = WGM * nN, gid = wgid / nig, fm = gid * WGM, gsz = (nM - fm) < WGM ? (nM - fm) : WGM;
        u.pm = fm + ((wgid % nig) % gsz); u.pn = (wgid % nig) / gsz; u.e = 0; return true;
    }
};
struct MoeOrder {
    int ntiles, nN, nwg, G, c; const LAS int* tile_e;
    __device__ void init(int ntiles_, int N, int G_, int c_, const LAS int* te) { ntiles = ntiles_; nN = N / BM; nwg = ntiles * nN; G = G_; c = c_; tile_e = te; }
    __device__ bool next(int i, Unit& u) const {
        const long L = (long)i * G + c; if (L >= nwg) return false;
        const int wgid = xcd_remap((int)L, nwg);
        u.pm = wgid / nN; u.pn = wgid % nN; u.e = __builtin_amdgcn_readfirstlane(tile_e[u.pm]); return true;
    }
};

struct EpiBf16 {
    static constexpr bool PERM = true;
    bf16_t* O; int ldc; const float* bias; int bias_estride;
    __device__ __forceinline__ void operator()(const f32x4 (&acc)[2][2][4][2], const Unit& u, int wr, int wc, int fr, int fq) const {
        const int row0 = u.pm * BM + wr * 64 + fr, col0 = u.pn * BM + wc * 32 + 8 * fq;
        f32x4 bv[2][2];
#pragma unroll
        for (int bj = 0; bj < 2; ++bj)
#pragma unroll
            for (int n = 0; n < 2; ++n) bv[bj][n] = bias ? *(const f32x4*)(bias + (size_t)u.e * bias_estride + col0 + bj * HALF + 4 * n) : (f32x4){0.f, 0.f, 0.f, 0.f};
#pragma unroll
        for (int ai = 0; ai < 2; ++ai)
#pragma unroll
            for (int m = 0; m < 4; ++m) { bf16_t* rowp = O + (size_t)(row0 + ai * HALF + m * 16) * ldc + col0;
#pragma unroll
                for (int bj = 0; bj < 2; ++bj) { const f32x4 v0 = acc[ai][bj][m][0] + bv[bj][0], v1 = acc[ai][bj][m][1] + bv[bj][1];
                    u32x4 w; w.x = cvt_pk_bf16(v0[0], v0[1]); w.y = cvt_pk_bf16(v0[2], v0[3]); w.z = cvt_pk_bf16(v1[0], v1[1]); w.w = cvt_pk_bf16(v1[2], v1[3]);
                    *(u32x4*)(rowp + bj * HALF) = w; } }
    }
};
struct EpiSwiglu {
    static constexpr bool PERM = true;
    bf16_t* O; const float* b1;
    __device__ __forceinline__ void operator()(const f32x4 (&acc)[2][2][4][2], const Unit& u, int wr, int wc, int fr, int fq) const {
        const int row0 = u.pm * BM + wr * 64 + fr, cj = u.pn * HALF + wc * 32 + 8 * fq;
        const float* bb = b1 + (size_t)u.e * 2 * DE;
        f32x4 bg[2], bl[2];
#pragma unroll
        for (int n = 0; n < 2; ++n) { bg[n] = *(const f32x4*)(bb + cj + 4 * n); bl[n] = *(const f32x4*)(bb + DE + cj + 4 * n); }
#pragma unroll
        for (int ai = 0; ai < 2; ++ai)
#pragma unroll
            for (int m = 0; m < 4; ++m) { bf16_t* rowp = O + (size_t)(row0 + ai * HALF + m * 16) * DE + cj;
                float y[8];
#pragma unroll
                for (int n = 0; n < 2; ++n) { const f32x4 g = acc[ai][0][m][n] + bg[n], l = acc[ai][1][m][n] + bl[n];
#pragma unroll
                    for (int j = 0; j < 4; ++j) { const float gg = fminf(g[j], 7.0f), ll = fminf(fmaxf(l[j], -7.0f), 7.0f); y[4 * n + j] = (ll + 1.0f) * gg * (1.f / (1.f + __expf(-1.702f * gg))); } }
                u32x4 w; w.x = cvt_pk_bf16(y[0], y[1]); w.y = cvt_pk_bf16(y[2], y[3]); w.z = cvt_pk_bf16(y[4], y[5]); w.w = cvt_pk_bf16(y[6], y[7]);
                *(u32x4*)rowp = w; }
    }
};
struct EpiResid {
    static constexpr bool PERM = false;
    const float* base0; const float* base1; float* out; const float* g;
    __device__ __forceinline__ void operator()(const f32x4 (&acc)[2][2][4][2], const Unit& u, int wr, int wc, int fr, int fq) const {
        const int col0 = u.pn * BM + wc * 32 + 4 * fq;
#pragma unroll
        for (int ai = 0; ai < 2; ++ai)
#pragma unroll
            for (int m = 0; m < 4; ++m) { const int r = u.pm * BM + ai * HALF + wr * 64 + m * 16 + fr;
                const float* bp = (r < NLAT) ? base0 + (size_t)r * D : base1 + (size_t)(r - NLAT) * D; const int bb = (r < NLAT) ? r / SEQ : NB;
                const float* gp = g + (size_t)bb * 6 * D;
#pragma unroll
                for (int bj = 0; bj < 2; ++bj)
#pragma unroll
                    for (int n = 0; n < 2; ++n) { const int c = col0 + bj * HALF + n * 16; const f32x4 bs = *(const f32x4*)(bp + c), gv = *(const f32x4*)(gp + c);
                        *(f32x4*)(out + (size_t)r * D + c) = bs + gv * acc[ai][bj][m][n]; } }
    }
};

#ifdef HOST_EMU
#define PG8_WAIT_V(n) ((void)0)
#define PG8_WAIT_L(n) ((void)0)
#else
#define PG8_WAIT_V(n) asm volatile("s_waitcnt vmcnt(" #n ")" ::: "memory")
#define PG8_WAIT_L(n) asm volatile("s_waitcnt lgkmcnt(" #n ")" ::: "memory")
#endif
template <class Epi, class Sched>
__device__ __forceinline__ void gemm_phase(LAS unsigned char* lds, const Gemm g, const Sched& S, const Epi& E, const int tid) {
    const int wid = __builtin_amdgcn_readfirstlane(tid >> 6), lane = tid & 63, wr = wid >> 2, wc = wid & 3, fr = lane & 15, fq = lane >> 4;
    const int K = g.K, nt = K / BK;
    unsigned voffA[2], voffB[2];
#pragma unroll
    for (int i = 0; i < 2; ++i) { int R, C; stage_rc(tid * 16 + i * 8192, R, C); const int Rb = Epi::PERM ? ((R & ~31) + perm32(R & 31)) : R;
        voffA[i] = (unsigned)(R * K + C) * 2u; voffB[i] = (unsigned)(Rb * K + C) * 2u; }
    const size_t kstep = (size_t)(BK * 2);
    const size_t hstep = (size_t)HALF * K * 2;
    const size_t tstep = 2 * hstep;
    const unsigned ldsw = (unsigned)wid * 1024u;
    const int aoff = lds_byte(wr * 64 + fr, fq * 8), boff = lds_byte(wc * 32 + fr, fq * 8);
#define PG8_SA(b, h) (((b) * 2 + (h)) * HTB)
#define PG8_SB(b, h) ((4 + (b) * 2 + (h)) * HTB)
#define PG8_STAGE(bufoff, gbase, voff) do { _Pragma("unroll") for (int _i = 0; _i < 2; ++_i) \
        __builtin_amdgcn_global_load_lds((const unsigned*)((const char*)(gbase) + (voff)[_i]), (LAS unsigned*)(lds + (bufoff) + ldsw + _i * 8192), 16, 0, 0); } while (0)
#define PG8_LDA(dst, b, h) do { _Pragma("unroll") for (int m = 0; m < 4; ++m) _Pragma("unroll") for (int k = 0; k < 2; ++k) dst[m][k] = *(const LAS bf16x8*)(lds + PG8_SA(b, h) + aoff + m * 2048 + k * 1024); } while (0)
#define PG8_LDB(dst, b, h) do { _Pragma("unroll") for (int n = 0; n < 2; ++n) _Pragma("unroll") for (int k = 0; k < 2; ++k) dst[n][k] = *(const LAS bf16x8*)(lds + PG8_SB(b, h) + boff + n * 2048 + k * 1024); } while (0)
#define PG8_MMA(ai, bj, At, Bt) do { __builtin_amdgcn_s_setprio(1); _Pragma("unroll") for (int m = 0; m < 4; ++m) _Pragma("unroll") for (int n = 0; n < 2; ++n) _Pragma("unroll") for (int k = 0; k < 2; ++k) \
        acc[ai][bj][m][n] = __builtin_amdgcn_mfma_f32_16x16x32_bf16(Bt[n][k], At[m][k], acc[ai][bj][m][n], 0, 0, 0); __builtin_amdgcn_s_setprio(0); } while (0)
#define PG8_BAR __builtin_amdgcn_s_barrier()
#define PG8_SCHED __builtin_amdgcn_sched_barrier(0)
    Unit cur, nxt; int ui = 0;
    if (!S.next(0, cur)) return;
    f32x4 acc[2][2][4][2];
#pragma unroll
    for (int a = 0; a < 2; ++a)
#pragma unroll
        for (int b = 0; b < 2; ++b)
#pragma unroll
            for (int m = 0; m < 4; ++m)
#pragma unroll
                for (int n = 0; n < 2; ++n) acc[a][b][m][n] = (f32x4){0.f, 0.f, 0.f, 0.f};
    bf16x8 At[4][2], B0[2][2], B1[2][2];
    const char* cA = (const char*)g.A + (size_t)cur.pm * tstep; const char* cB = (const char*)(g.Bt + (size_t)cur.e * g.bexp) + (size_t)cur.pn * tstep;
    PG8_STAGE(PG8_SB(0, 0), cB, voffB); PG8_STAGE(PG8_SB(0, 1), cB + hstep, voffB); PG8_STAGE(PG8_SA(0, 0), cA, voffA); PG8_STAGE(PG8_SA(0, 1), cA + hstep, voffA);
    if (wr == 1) PG8_BAR;
    PG8_WAIT_V(2); PG8_BAR;
    PG8_STAGE(PG8_SB(1, 0), cB + kstep, voffB); PG8_STAGE(PG8_SA(1, 0), cA + kstep, voffA); PG8_STAGE(PG8_SB(1, 1), cB + hstep + kstep, voffB);
    PG8_WAIT_V(6); PG8_BAR;
    for (;;) {
        const bool has_next = S.next(ui + 1, nxt);
        const char* nA = has_next ? (const char*)g.A + (size_t)nxt.pm * tstep : cA; const char* nB = has_next ? (const char*)(g.Bt + (size_t)nxt.e * g.bexp) + (size_t)nxt.pn * tstep : cB;
        for (int t = 0; t < nt; t += 2) {
            const bool last = (t == nt - 2);
            const char* a1 = cA + (size_t)(t + 1) * kstep;
            const char* a2 = last ? nA : cA + (size_t)(t + 2) * kstep; const char* b2 = last ? nB : cB + (size_t)(t + 2) * kstep;
            const char* a3 = a2 + kstep; const char* b3 = b2 + kstep;
            PG8_LDB(B0, 0, 0); PG8_LDB(B1, 0, 1); PG8_SCHED; PG8_LDA(At, 0, 0); PG8_STAGE(PG8_SA(1, 1), a1 + hstep, voffA);
            PG8_WAIT_V(8); PG8_WAIT_L(0); PG8_BAR; PG8_MMA(0, 0, At, B0); PG8_MMA(0, 1, At, B1); PG8_BAR; PG8_SCHED;
            PG8_LDA(At, 0, 1); PG8_STAGE(PG8_SB(0, 0), b2, voffB); PG8_STAGE(PG8_SB(0, 1), b2 + hstep, voffB); PG8_STAGE(PG8_SA(0, 0), a2, voffA);
            PG8_WAIT_V(8); PG8_WAIT_L(0); PG8_BAR; PG8_MMA(1, 0, At, B0); PG8_MMA(1, 1, At, B1); PG8_BAR; PG8_SCHED;
            PG8_LDB(B0, 1, 0); PG8_LDB(B1, 1, 1); PG8_SCHED; PG8_LDA(At, 1, 0); PG8_STAGE(PG8_SA(0, 1), a2 + hstep, voffA);
            PG8_WAIT_V(8); PG8_WAIT_L(0); PG8_BAR; PG8_MMA(0, 0, At, B0); PG8_MMA(0, 1, At, B1); PG8_BAR; PG8_SCHED;
            PG8_LDA(At, 1, 1); PG8_STAGE(PG8_SB(1, 0), b3, voffB); PG8_STAGE(PG8_SB(1, 1), b3 + hstep, voffB); PG8_STAGE(PG8_SA(1, 0), a3, voffA);
            PG8_WAIT_V(8); PG8_WAIT_L(0); PG8_BAR; PG8_MMA(1, 0, At, B0); PG8_MMA(1, 1, At, B1); PG8_BAR; PG8_SCHED;
        }
        if (wr == 0) PG8_BAR;
        {
            int t2 = threadIdx.x;
#ifndef HOST_EMU
            asm volatile("" : "+v"(t2));
#endif
            const int wid2 = __builtin_amdgcn_readfirstlane(t2 >> 6), lane2 = t2 & 63;
            E(acc, cur, wid2 >> 2, wid2 & 3, lane2 & 15, lane2 >> 4);
        }
        if (!has_next) break;
#pragma unroll
        for (int a = 0; a < 2; ++a)
#pragma unroll
            for (int b = 0; b < 2; ++b)
#pragma unroll
                for (int m = 0; m < 4; ++m)
#pragma unroll
                    for (int n = 0; n < 2; ++n) acc[a][b][m][n] = (f32x4){0.f, 0.f, 0.f, 0.f};
        cur = nxt; cA = nA; cB = nB; ++ui;
        if (wr == 1) PG8_BAR;
    }
    PG8_WAIT_V(0);
    PG8_BAR;
#undef PG8_SA
#undef PG8_SB
#undef PG8_STAGE
#undef PG8_LDA
#undef PG8_LDB
#undef PG8_MMA
#undef PG8_BAR
#undef PG8_SCHED
}
}

#define XB_TMO      128
#define XB_XCNT(j)  (256  + 64 * (j))
#define XB_XSUB(j)  (1280 + 64 * (j))
#define XB_XGEN(j)  (2304 + 64 * (j))
#define XB_TOP      3328
#define XB_TOPGEN   3392
#define XCD_BAR_WORDS 3456
#define XB_SPIN_CAP (1u << 22)
#ifdef HOST_EMU
__device__ __forceinline__ unsigned xb_ld(unsigned* p) { return *(volatile unsigned*)p; }
__device__ __forceinline__ unsigned xb_add(unsigned* p, unsigned v) { unsigned o = *p; *p = o + v; return o; }
__device__ __forceinline__ unsigned xb_xcc_id() { return blockIdx.x % 8; }
__device__ __forceinline__ unsigned atomicAdd(unsigned* p, unsigned v) { unsigned o = *p; *p = o + v; return o; }
__device__ __forceinline__ int atomicAdd(int* p, int v) { int o = *p; *p = o + v; return o; }
#else
__device__ __forceinline__ unsigned xb_ld(unsigned* p)              { return __hip_atomic_load(p, __ATOMIC_RELAXED, __HIP_MEMORY_SCOPE_AGENT); }
__device__ __forceinline__ unsigned xb_add(unsigned* p, unsigned v) { return __hip_atomic_fetch_add(p, v, __ATOMIC_RELAXED, __HIP_MEMORY_SCOPE_AGENT); }
__device__ __forceinline__ unsigned xb_xcc_id() { return (unsigned)__builtin_amdgcn_s_getreg((3 << 11) | 20) & 0xFu; }
#endif
#define XB_SPIN(cond, bar) do { unsigned _sp = 0; while (cond) { __builtin_amdgcn_s_sleep(1); \
    if ((++_sp & 255u) == 0u) { if (xb_ld(&(bar)[XB_TMO])) break; if (_sp > XB_SPIN_CAP) { atomicAdd(&(bar)[XB_TMO], 1u); break; } } } } while (0)
struct XcdBarrier { unsigned* bar; unsigned x; volatile LAS unsigned* st; };
__device__ __forceinline__ XcdBarrier xcd_barrier_post(unsigned* bar, volatile LAS unsigned* st) {
    XcdBarrier b; b.bar = bar; b.x = xb_xcc_id(); b.st = st;
    if (threadIdx.x == 0) (void)xb_add(&bar[XB_XCNT(b.x)], 1u);
    return b;
}
__device__ __forceinline__ void xcd_barrier_complete(unsigned* bar, unsigned x, unsigned& nloc, unsigned& nx) {
    const unsigned G = gridDim.x;
    unsigned sum, cnt, mine, sp = 0u;
    for (;;) {
        sum = 0u; cnt = 0u; mine = 0u;
#pragma unroll
        for (unsigned j = 0; j < 16; ++j) { const unsigned c = xb_ld(&bar[XB_XCNT(j)]); sum += c; cnt += (c > 0u) ? 1u : 0u; mine = (j == x) ? c : mine; }
        if (sum == G) break;
        __builtin_amdgcn_s_sleep(1);
        if ((++sp & 255u) == 0u) { if (xb_ld(&bar[XB_TMO])) break; if (sp > XB_SPIN_CAP) { atomicAdd(&bar[XB_TMO], 1u); break; } }
    }
    nloc = mine > 0u ? mine : 1u; nx = cnt > 0u ? cnt : 1u;
}
__device__ __forceinline__ void xcd_barrier(const XcdBarrier& b) {
    VM_WAIT();
    __syncthreads();
    if (threadIdx.x == 0) {
        unsigned* bar = b.bar;
        __builtin_amdgcn_s_waitcnt(0);
        unsigned nloc = b.st[0], nx = b.st[1];
        if (nloc == 0u) { xcd_barrier_complete(bar, b.x, nloc, nx); b.st[0] = nloc; b.st[1] = nx; }
        const unsigned old = xb_add(&bar[XB_XSUB(b.x)], 1u);
        const unsigned gen = old / nloc;
        if (old + 1u == (gen + 1u) * nloc) {
            __builtin_amdgcn_fence(__ATOMIC_RELEASE, "agent");
            VM_WAIT();
            const unsigned og = xb_add(&bar[XB_TOP], 1u);
            const unsigned tg = og / nx;
            if (og + 1u == (tg + 1u) * nx) xb_add(&bar[XB_TOPGEN], 1u);
            else XB_SPIN(xb_ld(&bar[XB_TOPGEN]) == tg, bar);
            __builtin_amdgcn_fence(__ATOMIC_ACQUIRE, "agent");
            xb_add(&bar[XB_XGEN(b.x)], 1u);
            VM_WAIT();
        } else {
            XB_SPIN(xb_ld(&bar[XB_XGEN(b.x)]) == gen, bar);
            __builtin_amdgcn_fence(__ATOMIC_ACQUIRE, "agent");
            VM_WAIT();
        }
    }
    __syncthreads();
}

struct Args {
    const float* in[34]; float* out; unsigned char* ws; int ph_lo, ph_hi;
};
enum { I_X = 0, I_C, I_CTX, I_CCTX, I_MODW, I_MODB, I_N1, I_N2, I_WIN, I_WOUT, I_HGLB, I_HGNG, I_MLGB, I_MLNG, I_HYCW, I_HYCB, I_HYW1, I_HYB1, I_HYW2, I_HYB2, I_HYFR, I_HYW3,
       I_HYBI, I_GDCW, I_GDAL, I_GDDT, I_GDNG, I_RW, I_RB, I_EW1, I_EB1, I_EW2, I_EB2, I_FG };
struct Ctx {
#ifdef HOST_EMU
    LAS unsigned char* lds; const Args* a; unsigned char* ws;
#else
    LAS unsigned char* lds; const __attribute__((address_space(4))) Args* a; unsigned char* ws;
#endif
    int tid, lane, wave, vcu, G, bid;
};
#define WSP(T, off) ((T*)(C.ws + (off)))
#define INP(i) (C.a->in[i])

__device__ __forceinline__ const float* xrow_l0(const Ctx& C, int r) { return r < NLAT ? INP(I_X) + (size_t)r * D : INP(I_CTX) + (size_t)(r - NLAT) * D; }
__device__ __forceinline__ int row_batch(int r) { return r < NLAT ? r / SEQ : NB; }

__device__ __forceinline__ void transpose_item(const float* W, int ldw, int K, bf16_t* WT, int k0, int nsrc0, int ndst0, LAS float* scr, int lane) {
#pragma unroll 8
    for (int i = 0; i < 32; ++i) { const int kk = 2 * i + (lane >> 5); scr[kk * 33 + (lane & 31)] = W[(size_t)(k0 + kk) * ldw + nsrc0 + (lane & 31)]; }
    LDS_WAIT(); asm volatile("" ::: "memory");
    const int c = lane & 7;
#pragma unroll
    for (int j = 0; j < 4; ++j) { const int n = (lane >> 3) + 8 * j; const LAS float* s = scr + (8 * c) * 33 + n;
        u32x4 o; o.x = pk2(s[0 * 33], s[1 * 33]); o.y = pk2(s[2 * 33], s[3 * 33]); o.z = pk2(s[4 * 33], s[5 * 33]); o.w = pk2(s[6 * 33], s[7 * 33]);
        *(u32x4*)(WT + (size_t)(ndst0 + n) * K + k0 + 8 * c) = o; }
    LDS_WAIT(); asm volatile("" ::: "memory");
}
__device__ __forceinline__ void p0_prologue(Ctx& C) {
    LAS float* scr = (LAS float*)(C.lds + C.wave * 16384);
    const int gw = C.vcu * 8 + C.wave, NGW = C.G * 8, lane = C.lane;
    constexpr int I_IN = 16 * (ZW / 32), I_OUT = 16 * (D / 32), I_1 = 16 * (2 * DE / 32), I_2 = (DE / 64) * (D / 32);
    constexpr int PER_L = I_IN + I_OUT + NE * (I_1 + I_2);
    for (int it = gw; it < DEPTH * PER_L; it += NGW) {
        const int l = it / PER_L; int r = it % PER_L;
        if (r < I_IN) { const int kb = r / (ZW / 32), nb = r % (ZW / 32), nd = 32 * nb, ns = nd < 2304 ? nd : nd + 16;
            transpose_item(INP(I_WIN) + (size_t)l * D * IN_W, IN_W, D, WSP(bf16_t, WS_WIN) + (size_t)l * ZW * D, 64 * kb, ns, nd, scr, lane); continue; }
        r -= I_IN;
        if (r < I_OUT) { const int kb = r / (D / 32), nb = r % (D / 32);
            transpose_item(INP(I_WOUT) + (size_t)l * D * D, D, D, WSP(bf16_t, WS_WOUT) + (size_t)l * D * D, 64 * kb, 32 * nb, 32 * nb, scr, lane); continue; }
        r -= I_OUT;
        const int e = r / (I_1 + I_2); r %= (I_1 + I_2);
        if (r < I_1) { const int kb = r / (2 * DE / 32), nb = r % (2 * DE / 32), nd = 32 * nb;
            const int ntile = nd / 256, hh = (nd % 256) / 128, j = nd % 128, ns = DE * hh + 128 * ntile + j;
            transpose_item(INP(I_EW1) + ((size_t)l * NE + e) * D * 2 * DE, 2 * DE, D, WSP(bf16_t, WS_W1) + ((size_t)l * NE + e) * 2 * DE * D, 64 * kb, ns, nd, scr, lane); continue; }
        r -= I_1;
        { const int kb = r / (D / 32), nb = r % (D / 32);
            transpose_item(INP(I_EW2) + ((size_t)l * NE + e) * DE * D, D, DE, WSP(bf16_t, WS_W2) + ((size_t)l * NE + e) * D * DE, 64 * kb, 32 * nb, 32 * nb, scr, lane); }
    }
    for (int it = gw; it < DEPTH * (NB + 1) * (6 * D / 64); it += NGW) {
        const int l = it / ((NB + 1) * (6 * D / 64)), b = (it / (6 * D / 64)) % (NB + 1), n = (it % (6 * D / 64)) * 64 + lane;
        const float* w = INP(I_MODW) + (size_t)l * D * 6 * D + n; const float* cv = b < NB ? INP(I_C) + b * D : INP(I_CCTX);
        float acc = 0.f;
#pragma unroll 16
        for (int k = 0; k < D; ++k) acc += siluf_(cv[k]) * w[(size_t)k * 6 * D];
        WSP(float, WS_MOD)[((size_t)l * (NB + 1) + b) * 6 * D + n] = acc + INP(I_MODB)[l * 6 * D + n];
    }
    const int gt = gw * 64 + lane, NGT = NGW * 64;
    for (int i = gt; i < 256; i += NGT) { const float a0 = INP(I_HGLB)[i], a1 = INP(I_HGLB)[256 + i], mx = fmaxf(a0, a1), e0 = __expf(a0 - mx), e1 = __expf(a1 - mx);
        WSP(float, WS_LB)[i] = 0.f; WSP(float, WS_LB)[256 + i] = e1 / (e0 + e1); }
    for (int i = gt; i < DEPTH * 32 * D; i += NGT) { const int l = i / (32 * D), j = (i / D) % 32, k = i % D; const int col = j < 16 ? 2304 + j : 4112 + (j - 16);
        WSP(float, WS_WG)[i] = INP(I_WIN)[((size_t)l * D + k) * IN_W + col]; }
    for (int i = gt; i < DEPTH * NE * D; i += NGT) { const int l = i / (NE * D), e = (i / D) % NE, k = i % D;
        WSP(float, WS_WR)[i] = INP(I_RW)[((size_t)l * D + k) * NE + e]; }
    for (int i = gw; i < DEPTH * (SEQ + LC); i += NGW) {
        const int l = i / (SEQ + LC), p = i % (SEQ + LC); const bool isc = p >= SEQ; const int pos = isc ? p - SEQ : p, len = isc ? LC : SEQ;
        const float *w1 = INP(I_HYW1) + l * 17 * 64, *b1 = INP(I_HYB1) + l * 64, *w2 = INP(I_HYW2) + l * 64 * 64, *b2 = INP(I_HYB2) + l * 64, *fr = INP(I_HYFR) + l * 128;
        float s = b1[lane] + ((float)pos / (float)(len - 1)) * w1[lane];
#pragma unroll
        for (int j = 0; j < 8; ++j) { const float band = 1e-4f + (7.0f - 1e-4f) * (float)j / 7.0f; const float ang = 6.283185307179586f * (float)pos * band / (float)len;
            s += cosf(ang) * w1[(1 + j) * 64 + lane] - sinf(ang) * w1[(9 + j) * 64 + lane]; }
        scr[lane] = sinf(fr[lane] * s);
        LDS_WAIT(); asm volatile("" ::: "memory");
        float s2 = b2[lane];
#pragma unroll 8
        for (int q = 0; q < 64; ++q) s2 += scr[q] * w2[q * 64 + lane];
        WSP(float, WS_HDN)[((size_t)l * (SEQ + LC) + p) * 64 + lane] = sinf(fr[64 + lane] * s2);
        LDS_WAIT(); asm volatile("" ::: "memory");
    }
}

__device__ __forceinline__ void rms_mod_row(const f32x4 (&xv)[4], const float* gain, const float* sh, const float* sc, bf16_t* orow, int lane, f32x4 (&hv)[4]) {
    float s = 0.f;
#pragma unroll
    for (int j = 0; j < 4; ++j) s += (xv[j].x * xv[j].x + xv[j].y * xv[j].y) + (xv[j].z * xv[j].z + xv[j].w * xv[j].w);
    const float rstd = 1.f / sqrtf(wave_sum(s) * (1.f / D) + EPS);
#pragma unroll
    for (int j = 0; j < 4; ++j) { const int c = 4 * lane + 256 * j; const f32x4 g = *(const f32x4*)(gain + c), a = *(const f32x4*)(sc + c), b = *(const f32x4*)(sh + c);
        hv[j] = xv[j] * rstd * g * (a + 1.0f) + b;
        u32x2 w; w.x = pk2(hv[j].x, hv[j].y); w.y = pk2(hv[j].z, hv[j].w); *(u32x2*)(orow + c) = w; }
}
__device__ __forceinline__ void load_w32(Ctx& C, const float* W, int n) {
    __syncthreads();
    for (int o = C.tid; o < n * 256; o += 512) *(LAS f32x4*)(C.lds + (size_t)o * 16) = *(const f32x4*)(W + (size_t)o * 4);
    __syncthreads();
}
__device__ __forceinline__ float row2_dots(LAS unsigned char* lds, const f32x4 (&hv)[2][4], int lane, int n) {
    float v[64];
#pragma unroll
    for (int jj = 0; jj < 32; ++jj) { float s0 = 0.f, s1 = 0.f;
        if (jj < n) {
#pragma unroll
            for (int j = 0; j < 4; ++j) { const f32x4 w = *(const LAS f32x4*)(lds + (size_t)jj * 4096 + (size_t)(4 * lane + 256 * j) * 4);
                s0 += (hv[0][j].x * w.x + hv[0][j].y * w.y) + (hv[0][j].z * w.z + hv[0][j].w * w.w); s1 += (hv[1][j].x * w.x + hv[1][j].y * w.y) + (hv[1][j].z * w.z + hv[1][j].w * w.w); } }
        v[jj] = s0; v[32 + jj] = s1; }
#pragma unroll
    for (int st = 0; st < 6; ++st) { const int m = 32 >> st, nh = 32 >> st; const bool up = (lane & m) != 0;
#pragma unroll
        for (int i = 0; i < nh; ++i) { const float a = v[i], bb = v[i + nh]; const float send = up ? a : bb, keep = up ? bb : a; v[i] = keep + __shfl_xor(send, m); } }
    return v[0];
}
__device__ __forceinline__ void phase_rows_a(Ctx& C, int l) {
    const int gw = C.vcu * 8 + C.wave, NGW = C.G * 8, lane = C.lane;
    const int nrows = (l == DEPTH) ? NLAT : NT;
    float* xcur = WSP(float, WS_X);
    if (l < DEPTH) load_w32(C, WSP(float, WS_WG) + (size_t)l * 32 * D, 32);
    for (int r0 = 2 * gw; r0 < nrows; r0 += 2 * NGW) {
        f32x4 xv[2][4];
#pragma unroll
        for (int q = 0; q < 2; ++q) { const int r = r0 + q; const int bb = row_batch(r);
            if (l == 0) { const float* xr = xrow_l0(C, r);
#pragma unroll
                for (int j = 0; j < 4; ++j) xv[q][j] = *(const f32x4*)(xr + 4 * lane + 256 * j); }
            else {
                const int lp = l - 1; const int ntok = (lp == DEPTH - 1) ? NLAT : NT;
                const float* xr = xcur + (size_t)r * D;
#pragma unroll
                for (int j = 0; j < 4; ++j) xv[q][j] = *(const f32x4*)(xr + 4 * lane + 256 * j);
                if (r < ntok) {
                    const float* g2 = WSP(float, WS_MOD) + ((size_t)lp * (NB + 1) + bb) * 6 * D + 5 * D;
                    const int* te = WSP(int, WS_TOP) + (size_t)r * 4; const int* tp = WSP(int, WS_TOP) + (size_t)NT * 4 + (size_t)r * 4; const float* tg = WSP(float, WS_TOP) + (size_t)NT * 8 + (size_t)r * 4;
                    const LAS int* tbase = (const LAS int*)(C.lds + LDSX_OFF + LX_TILE) + MAXTILES;
                    f32x4 ys[4];
#pragma unroll
                    for (int j = 0; j < 4; ++j) ys[j] = (f32x4){0.f, 0.f, 0.f, 0.f};
#pragma unroll
                    for (int k = 0; k < TOPK; ++k) { const int e = te[k]; const size_t yr = (size_t)tbase[e] * 256 + tp[k]; const float gk = tg[k]; const bf16_t* yp = WSP(bf16_t, WS_Y) + yr * D;
#pragma unroll
                        for (int j = 0; j < 4; ++j) { const u32x2 w = *(const u32x2*)(yp + 4 * lane + 256 * j);
                            ys[j].x += gk * u2f(w.x << 16); ys[j].y += gk * u2f(w.x & 0xffff0000u); ys[j].z += gk * u2f(w.y << 16); ys[j].w += gk * u2f(w.y & 0xffff0000u); } }
#pragma unroll
                    for (int j = 0; j < 4; ++j) { const f32x4 g = *(const f32x4*)(g2 + 4 * lane + 256 * j); xv[q][j] = xv[q][j] + g * ys[j]; }
                    if (l < DEPTH) {
#pragma unroll
                        for (int j = 0; j < 4; ++j) *(f32x4*)(xcur + (size_t)r * D + 4 * lane + 256 * j) = xv[q][j]; }
                }
            }
        }
        if (l == DEPTH) {
#pragma unroll
            for (int q = 0; q < 2; ++q) { float s = 0.f;
#pragma unroll
                for (int j = 0; j < 4; ++j) s += (xv[q][j].x * xv[q][j].x + xv[q][j].y * xv[q][j].y) + (xv[q][j].z * xv[q][j].z + xv[q][j].w * xv[q][j].w);
                const float rstd = 1.f / sqrtf(wave_sum(s) * (1.f / D) + EPS);
#pragma unroll
                for (int j = 0; j < 4; ++j) { const f32x4 g = *(const f32x4*)(INP(I_FG) + 4 * lane + 256 * j); *(f32x4*)(C.a->out + (size_t)(r0 + q) * D + 4 * lane + 256 * j) = xv[q][j] * rstd * g; } }
            continue;
        }
        f32x4 hv[2][4];
#pragma unroll
        for (int q = 0; q < 2; ++q) { const int r = r0 + q; const float* mod = WSP(float, WS_MOD) + ((size_t)l * (NB + 1) + row_batch(r)) * 6 * D;
            rms_mod_row(xv[q], INP(I_N1) + l * D, mod, mod + D, WSP(bf16_t, WS_H) + (size_t)r * D, lane, hv[q]); }
        const float mine = row2_dots(C.lds, hv, lane, 32);
        WSP(float, WS_ZG)[(size_t)(r0 + (lane >> 5)) * 32 + (lane & 31)] = mine;
    }
}
__device__ __forceinline__ int build_tiles(Ctx& C, int l) {
    LAS int* tile_e = (LAS int*)(C.lds + LDSX_OFF + LX_TILE); LAS int* tbase = tile_e + MAXTILES;
    const unsigned* cnt = WSP(unsigned, WS_CTL) + CW_CNT + l * NE;
    __syncthreads();
    if (C.tid == 0) { int t = 0;
        for (int e = 0; e < NE; ++e) { const int c = (int)cnt[e], n = (c + 255) / 256; tbase[e] = t; for (int i = 0; i < n; ++i) tile_e[t + i] = e; t += n; }
        tbase[NE] = t; }
    __syncthreads();
    return tbase[NE];
}
__device__ __forceinline__ void phase_rows_b(Ctx& C, int l) {
    const int gw = C.vcu * 8 + C.wave, NGW = C.G * 8, lane = C.lane;
    const int ntok = (l == DEPTH - 1) ? NLAT : NT;
    const float* xcur = WSP(float, WS_X);
    unsigned* cnt = WSP(unsigned, WS_CTL) + CW_CNT + l * NE;
    static_assert(NE <= 32, "router width");
    load_w32(C, WSP(float, WS_WR) + (size_t)l * NE * D, NE);
    for (int r0 = 2 * gw; r0 < ntok; r0 += 2 * NGW) {
        f32x4 hv[2][4];
#pragma unroll
        for (int q = 0; q < 2; ++q) { const int r = r0 + q; f32x4 xv[4];
#pragma unroll
            for (int j = 0; j < 4; ++j) xv[j] = *(const f32x4*)(xcur + (size_t)r * D + 4 * lane + 256 * j);
            const float* mod = WSP(float, WS_MOD) + ((size_t)l * (NB + 1) + row_batch(r)) * 6 * D;
            rms_mod_row(xv, INP(I_N2) + l * D, mod + 3 * D, mod + 4 * D, WSP(bf16_t, WS_H) + (size_t)r * D, lane, hv[q]); }
        const float lgm = row2_dots(C.lds, hv, lane, NE);
        const int jl = lane & 31, r = r0 + (lane >> 5);
        float v = (jl < NE) ? lgm + INP(I_RB)[l * NE + (jl < NE ? jl : 0)] : -3.0e38f;
        float tv[4]; int ti[4];
#pragma unroll
        for (int k = 0; k < 4; ++k) { float bv = v; int bi = jl;
#pragma unroll
            for (int o = 1; o < 32; o <<= 1) { const float ov = __shfl_xor(bv, o); const int oi = __shfl_xor(bi, o); const bool take = (ov > bv) || (ov == bv && oi < bi); bv = take ? ov : bv; bi = take ? oi : bi; }
            tv[k] = bv; ti[k] = bi; v = (jl == bi) ? -3.4e38f : v; }
        const float e1 = __expf(tv[1] - tv[0]), e2 = __expf(tv[2] - tv[0]), e3 = __expf(tv[3] - tv[0]), inv = 1.f / (1.f + e1 + e2 + e3);
        const float gk[4] = {inv, e1 * inv, e2 * inv, e3 * inv};
        if (jl < 4) {
            int e = ti[0]; float g = gk[0];
#pragma unroll
            for (int k = 1; k < 4; ++k) { e = (jl == k) ? ti[k] : e; g = (jl == k) ? gk[k] : g; }
            const int pos = (int)atomicAdd(cnt + e, 1u);
            WSP(int, WS_TOP)[(size_t)r * 4 + jl] = e; WSP(int, WS_TOP)[(size_t)NT * 4 + (size_t)r * 4 + jl] = pos; WSP(float, WS_TOP)[(size_t)NT * 8 + (size_t)r * 4 + jl] = g;
        }
    }
}
__device__ __forceinline__ void phase_gather(Ctx& C, int l) {
    const int gw = C.vcu * 8 + C.wave, NGW = C.G * 8, lane = C.lane;
    const int ntok = (l == DEPTH - 1) ? NLAT : NT;
    (void)build_tiles(C, l);
    const LAS int* tbase = (const LAS int*)(C.lds + LDSX_OFF + LX_TILE) + MAXTILES;
    const unsigned* cnt = WSP(unsigned, WS_CTL) + CW_CNT + l * NE;
    for (int it = gw; it < ntok * 4; it += NGW) { const int r = it >> 2, k = it & 3;
        const int e = WSP(int, WS_TOP)[(size_t)r * 4 + k], pos = WSP(int, WS_TOP)[(size_t)NT * 4 + (size_t)r * 4 + k];
        const u32x4* s = (const u32x4*)(WSP(bf16_t, WS_H) + (size_t)r * D); u32x4* d = (u32x4*)(WSP(bf16_t, WS_HS) + ((size_t)tbase[e] * 256 + pos) * D);
        d[lane] = s[lane]; d[lane + 64] = s[lane + 64]; }
    for (int it = gw; it < NE * 256; it += NGW) { const int e = it >> 8, p = it & 255; const int c = (int)cnt[e], pad0 = c, pad1 = ((c + 255) / 256) * 256;
        if (pad0 + p < pad1) { u32x4* d = (u32x4*)(WSP(bf16_t, WS_HS) + ((size_t)tbase[e] * 256 + pad0 + p) * D); d[lane] = (u32x4){0u, 0u, 0u, 0u}; d[lane + 64] = (u32x4){0u, 0u, 0u, 0u}; } }
}

template <int MIX> __device__ __forceinline__ int scan_row(int b, int dir, int s) {
    if (s < LC) { const int t = dir ? LC - 1 - s : s; return NLAT + b * LC + t; }
    const int i0 = s - LC, i = dir ? SEQ - 1 - i0 : i0;
    const int t = (MIX == 1) ? (i % GROWS) * GW + (i / GROWS) : i;
    return b * SEQ + t;
}
typedef float f32x16 __attribute__((ext_vector_type(16)));
template <int NT_, int KS>
__device__ __forceinline__ void mm_nt(const LAS bf16_t* A, int lda, const LAS bf16_t* B, int ldb, f32x16 (&acc)[NT_], int lane) {
    const int r = lane & 31, kh = (lane >> 5) * 8;
#pragma unroll
    for (int kk = 0; kk < KS; ++kk) {
        const bf16x8 a = *(const LAS bf16x8*)(A + r * lda + 16 * kk + kh);
#pragma unroll
        for (int n = 0; n < NT_; ++n) { const bf16x8 b = *(const LAS bf16x8*)(B + (32 * n + r) * ldb + 16 * kk + kh); acc[n] = __builtin_amdgcn_mfma_f32_32x32x16_bf16(a, b, acc[n], 0, 0, 0); }
    }
}
#ifdef HOST_EMU
#define ITEM_IDS() const int tid = C.tid, lane = C.lane, w = C.wave
#else
#define ITEM_IDS() int tid_ = C.tid; asm volatile("" : "+v"(tid_)); const int tid = tid_, lane = tid_ & 63, w = __builtin_amdgcn_readfirstlane(tid_ >> 6)
#endif
#define CROW(ri, lane) (((ri) & 3) + 8 * ((ri) >> 2) + 4 * ((lane) >> 5))
constexpr int LS = 72, LF = 65;
constexpr int GA_Q = 0, GA_K = 9216, GA_BVT = 18432, GA_BKGT = 27648, GA_KDT = 36864, GA_QKM = 46080, GA_TB = 55296, GA_UT = 64512, GA_WT = 73728, GA_AM = 82944, GA_TM = 99584, GA_X = 116224  , GA_G = 124928;
__device__ __forceinline__ void gdn_a_item(Ctx& C, int l, int b, int h, int dir, int c) {
    LAS unsigned char* lds = C.lds; ITEM_IDS();
    LAS bf16_t* Qb = (LAS bf16_t*)(lds + GA_Q); LAS bf16_t* Kb = (LAS bf16_t*)(lds + GA_K); LAS bf16_t* BVT = (LAS bf16_t*)(lds + GA_BVT); LAS bf16_t* BKGT = (LAS bf16_t*)(lds + GA_BKGT);
    LAS bf16_t* KDT = (LAS bf16_t*)(lds + GA_KDT); LAS bf16_t* QKM = (LAS bf16_t*)(lds + GA_QKM); LAS bf16_t* TB = (LAS bf16_t*)(lds + GA_TB); LAS bf16_t* UT = (LAS bf16_t*)(lds + GA_UT); LAS bf16_t* WT = (LAS bf16_t*)(lds + GA_WT);
    LAS float* AM = (LAS float*)(lds + GA_AM); LAS float* TM = (LAS float*)(lds + GA_TM); LAS float* X = (LAS float*)(lds + GA_X); LAS float* G = (LAS float*)(lds + GA_G);
    const bf16_t* zb = WSP(bf16_t, WS_Z); const float* zg = WSP(float, WS_ZG);
    unsigned char* blob = C.ws + WS_GD + ((size_t)((b * NH + h) * 2 + dir) * NCH + c) * GD_BLOB;
    const int i = tid >> 3, d0 = (tid & 7) * 8; const int row = scan_row<2>(b, dir, 64 * c + i);
    float qv[8], kv[8], vv[8];
    { const bf16_t* zr = zb + (size_t)row * ZW; const bool isc = row >= NLAT; const int t = isc ? (row - NLAT) % LC : row % SEQ, len = isc ? LC : SEQ;
        const bool hp = t > 0, hn = t < len - 1; const float* cw = INP(I_GDCW) + l * 3 * 768;
        float sq = 0.f, sk = 0.f;
#pragma unroll
        for (int a = 0; a < 3; ++a) { const int cc = a * 256 + h * 64 + d0; const bf16_t* zp = zr + GDB + cc;
            const u32x4 z1 = *(const u32x4*)zp, z0 = hp ? *(const u32x4*)(zp - ZW) : (u32x4){0u, 0u, 0u, 0u}, z2 = hn ? *(const u32x4*)(zp + ZW) : (u32x4){0u, 0u, 0u, 0u};
            const unsigned u0[4] = {z0.x, z0.y, z0.z, z0.w}, u1[4] = {z1.x, z1.y, z1.z, z1.w}, u2[4] = {z2.x, z2.y, z2.z, z2.w};
#pragma unroll
            for (int j = 0; j < 8; ++j) { const int jj = j >> 1; const bool hi = j & 1;
                const float x0 = hi ? u2f(u0[jj] & 0xffff0000u) : u2f(u0[jj] << 16), x1 = hi ? u2f(u1[jj] & 0xffff0000u) : u2f(u1[jj] << 16), x2 = hi ? u2f(u2[jj] & 0xffff0000u) : u2f(u2[jj] << 16);
                float sacc = cw[cc + j] * x0 + cw[768 + cc + j] * x1 + cw[1536 + cc + j] * x2;
                sacc = siluf_(sacc);
                if (a == 0) { qv[j] = sacc; sq += sacc * sacc; } else if (a == 1) { kv[j] = sacc; sk += sacc * sacc; } else vv[j] = sacc; } }
#pragma unroll
        for (int o = 1; o < 8; o <<= 1) { sq += __shfl_xor(sq, o); sk += __shfl_xor(sk, o); }
        const float rq = 0.125f / sqrtf(sq + EPS), rk = 1.f / sqrtf(sk + EPS);
#pragma unroll
        for (int j = 0; j < 8; ++j) { qv[j] *= rq; kv[j] *= rk; }
        if ((tid & 7) == 0) { const float* g = zg + (size_t)row * 32 + 16;
            G[128 + i] = -__expf(INP(I_GDAL)[l * 8 + dir * 4 + h]) * softplusf_(g[(2 * dir) * 4 + h] + INP(I_GDDT)[l * 8 + dir * 4 + h]); G[64 + i] = sigmoidf_(g[(2 * dir + 1) * 4 + h]); }
        u32x4 wq, wk; wq.x = pk2(qv[0], qv[1]); wq.y = pk2(qv[2], qv[3]); wq.z = pk2(qv[4], qv[5]); wq.w = pk2(qv[6], qv[7]); wk.x = pk2(kv[0], kv[1]); wk.y = pk2(kv[2], kv[3]); wk.z = pk2(kv[4], kv[5]); wk.w = pk2(kv[6], kv[7]);
        *(LAS u32x4*)(Qb + i * LS + d0) = wq; *(LAS u32x4*)(Kb + i * LS + d0) = wk;
    }
    __syncthreads();
    if (w == 0) { float gsum = G[128 + lane];
#pragma unroll
        for (int o = 1; o < 64; o <<= 1) { const float t = __shfl(gsum, lane - o); if (lane >= o) gsum += t; }
        G[lane] = gsum; }
    __syncthreads();
    { const float gi = G[i], be = G[64 + i], gl = G[63]; const float eg = __expf(gi), ed = __expf(gl - gi);
#pragma unroll
        for (int j = 0; j < 8; ++j) { BVT[(d0 + j) * LS + i] = (bf16_t)f2bf(be * vv[j]); BKGT[(d0 + j) * LS + i] = (bf16_t)f2bf(be * kv[j] * eg); KDT[(d0 + j) * LS + i] = (bf16_t)f2bf(kv[j] * ed); } }
    if (w < 4) { f32x16 acc[2]; acc[0] = (f32x16)(0.f); acc[1] = (f32x16)(0.f);
        const int rh = (w & 1) * 32; mm_nt<2, 4>((w >> 1) ? Qb + rh * LS : Kb + rh * LS, LS, Kb, LS, acc, lane);
#pragma unroll
        for (int n = 0; n < 2; ++n)
#pragma unroll
            for (int ri = 0; ri < 16; ++ri) { const int ii = rh + CROW(ri, lane), jj = 32 * n + (lane & 31); const float dec = __expf(G[ii] - G[jj]);
                if (w >> 1) QKM[ii * LS + jj] = (bf16_t)f2bf(jj <= ii ? acc[n][ri] * dec : 0.f); else AM[ii * LF + jj] = (jj < ii) ? G[64 + ii] * acc[n][ri] * dec : 0.f; } }
    __syncthreads();
    LAS float* Dg = X + 16 * LF;
    if (w == 0) { const int bb = lane >> 4, cc = lane & 15; float t[16];
#pragma unroll
        for (int r = 0; r < 16; ++r) { float x = (r == cc) ? 1.f : 0.f;
#pragma unroll
            for (int r2 = 0; r2 < r; ++r2) x -= AM[(16 * bb + r) * LF + 16 * bb + r2] * t[r2];
            t[r] = x; Dg[(bb * 16 + r) * 17 + cc] = x; asm volatile("" ::: "memory"); } }
    __syncthreads();
    for (int bb = 0; bb < 4; ++bb) {
        for (int o = tid; o < 1024; o += 512) { const int r = o >> 6, cc = o & 63, ii = 16 * bb + r; float x = (ii == cc) ? 1.f : 0.f;
#pragma unroll 8
            for (int j = 0; j < 16 * bb; ++j) x -= AM[ii * LF + j] * TM[j * LF + cc];
            X[r * LF + cc] = x; }
        __syncthreads();
        for (int o = tid; o < 1024; o += 512) { const int r = o >> 6, cc = o & 63; float x = 0.f;
#pragma unroll
            for (int r2 = 0; r2 < 16; ++r2) x += Dg[(bb * 16 + r) * 17 + r2] * X[r2 * LF + cc];
            TM[(16 * bb + r) * LF + cc] = x; }
        __syncthreads();
    }
    for (int o = tid; o < 4096; o += 512) { const int ii = o >> 6, jj = o & 63; TB[ii * LS + jj] = (bf16_t)f2bf(TM[ii * LF + jj]); }
    __syncthreads();
    if (w < 4) { f32x16 acc[2]; acc[0] = (f32x16)(0.f); acc[1] = (f32x16)(0.f);
        const int rh = (w & 1) * 32; mm_nt<2, 4>(((w >> 1) ? BKGT : BVT) + rh * LS, LS, TB, LS, acc, lane);
        LAS bf16_t* dst = (w >> 1) ? WT : UT;
#pragma unroll
        for (int n = 0; n < 2; ++n)
#pragma unroll
            for (int ri = 0; ri < 16; ++ri) dst[(rh + CROW(ri, lane)) * LS + 32 * n + (lane & 31)] = (bf16_t)f2bf(acc[n][ri]); }
    __syncthreads();
    { f32x16 acc[2]; acc[0] = (f32x16)(0.f); acc[1] = (f32x16)(0.f);
        const int pr = w >> 1, rh = (w & 1) * 32;
        const LAS bf16_t* Ap = (pr == 0 || pr == 1) ? QKM : (pr == 2 ? KDT : UT); const LAS bf16_t* Bp = (pr == 0 || pr == 2) ? WT : (pr == 1 ? UT : KDT);
        mm_nt<2, 4>(Ap + rh * LS, LS, Bp, LS, acc, lane);
        const float egl = __expf(G[63]);
#pragma unroll
        for (int n = 0; n < 2; ++n)
#pragma unroll
            for (int ri = 0; ri < 16; ++ri) { const int rr = rh + CROW(ri, lane), cc = 32 * n + (lane & 31); const float a = acc[n][ri];
                if (pr == 0) ((bf16_t*)(blob + 8192))[rr * 64 + cc] = (bf16_t)f2bf(bf2f(Qb[rr * LS + cc]) * __expf(G[rr]) - a);
                else if (pr == 1) ((float*)(blob + 32768))[rr * 64 + cc] = a;
                else if (pr == 2) ((bf16_t*)blob)[rr * 64 + cc] = (bf16_t)f2bf((rr == cc ? egl : 0.f) - a);
                else ((float*)(blob + 16384))[rr * 64 + cc] = a; } }
    __syncthreads();
}
__device__ __forceinline__ void gdn_b_scan(Ctx& C, int sidx) {
    LAS unsigned char* lds = C.lds; const int tid = C.tid, lane = C.lane, w = C.wave;
    LAS bf16_t* STb = (LAS bf16_t*)lds;
    LAS bf16_t* Pb = (LAS bf16_t*)(lds + 18432);
    for (int o = tid; o < 2 * 64 * LS; o += 512) STb[o] = 0;
    __syncthreads();
    int cur = 0;
    const int pr = tid >> 3, pc8 = (tid & 7) * 8, eh = (w & 1) * 32, dh = (w >> 1) * 32;
    u32x4 pv = *(const u32x4*)((const bf16_t*)(C.ws + WS_GD + ((size_t)sidx * NCH) * GD_BLOB) + pr * 64 + pc8);
    f32x16 qv = (f32x16)(0.f);
    if (w < 4) { const float* qt = (const float*)(C.ws + WS_GD + ((size_t)sidx * NCH) * GD_BLOB + 16384);
#pragma unroll
        for (int ri = 0; ri < 16; ++ri) qv[ri] = qt[(eh + CROW(ri, lane)) * 64 + dh + (lane & 31)]; }
    for (int c = 0; c < NCH; ++c) {
        bf16_t* gst = WSP(bf16_t, WS_GST) + ((size_t)sidx * NCH + c) * 4096;
        *(LAS u32x4*)(Pb + pr * LS + pc8) = pv;
        *(u32x4*)(gst + pr * 64 + pc8) = *(const LAS u32x4*)(STb + cur * 64 * LS + pr * LS + pc8);
        const int cn = (c + 1 < NCH) ? c + 1 : c; const unsigned char* nblob = C.ws + WS_GD + ((size_t)sidx * NCH + cn) * GD_BLOB;
        pv = *(const u32x4*)((const bf16_t*)nblob + pr * 64 + pc8);
        f32x16 nq = (f32x16)(0.f);
        if (w < 4) { const float* qt = (const float*)(nblob + 16384);
#pragma unroll
            for (int ri = 0; ri < 16; ++ri) nq[ri] = qt[(eh + CROW(ri, lane)) * 64 + dh + (lane & 31)]; }
        __syncthreads();
        if (w < 4) { f32x16 acc[1]; acc[0] = qv;
            mm_nt<1, 4>(STb + cur * 64 * LS + eh * LS, LS, Pb + dh * LS, LS, acc, lane);
#pragma unroll
            for (int ri = 0; ri < 16; ++ri) STb[(cur ^ 1) * 64 * LS + (eh + CROW(ri, lane)) * LS + dh + (lane & 31)] = (bf16_t)f2bf(acc[0][ri]); }
        __syncthreads();
        cur ^= 1; qv = nq;
    }
}
__device__ __forceinline__ void gdn_c_item(Ctx& C, int l, int b, int h, int jt) {
    LAS unsigned char* lds = C.lds; ITEM_IDS();
    LAS bf16_t* Rb = (LAS bf16_t*)lds;
    LAS bf16_t* Sb = (LAS bf16_t*)(lds + 18432);
    LAS float* OF = (LAS float*)(lds + 36864);
    const bool isc = jt < NCHC; const int jl = jt - NCHC;
    int cidx[2]; cidx[0] = jt; cidx[1] = isc ? (NCHC - 1 - jt) : NCHC + (SEQ / 64 - 1 - jl);
    const unsigned char* blob[2];
#pragma unroll
    for (int dir = 0; dir < 2; ++dir) { const size_t sc = (size_t)((b * NH + h) * 2 + dir) * NCH + cidx[dir]; blob[dir] = C.ws + WS_GD + sc * GD_BLOB;
        const bf16_t* gst = WSP(bf16_t, WS_GST) + sc * 4096; const int r = tid >> 3, c8 = (tid & 7) * 8;
        *(LAS u32x4*)(Rb + dir * 64 * LS + r * LS + c8) = *(const u32x4*)((const bf16_t*)(blob[dir] + 8192) + r * 64 + c8);
        *(LAS u32x4*)(Sb + dir * 64 * LS + r * LS + c8) = *(const u32x4*)(gst + r * 64 + c8); }
    __syncthreads();
    { const int dir = w >> 2, q = w & 3, ih = (q & 1) * 32, eh = (q >> 1) * 32; f32x16 acc[1]; const float* ol = (const float*)(blob[dir] + 32768);
#pragma unroll
        for (int ri = 0; ri < 16; ++ri) acc[0][ri] = ol[(ih + CROW(ri, lane)) * 64 + eh + (lane & 31)];
        mm_nt<1, 4>(Rb + dir * 64 * LS + ih * LS, LS, Sb + dir * 64 * LS + eh * LS, LS, acc, lane);
#pragma unroll
        for (int ri = 0; ri < 16; ++ri) { const int ii = ih + CROW(ri, lane), tok = dir ? 63 - ii : ii; OF[dir * 64 * LF + tok * LF + eh + (lane & 31)] = acc[0][ri]; } }
    __syncthreads();
    { const int tok = tid >> 3, e0 = (tid & 7) * 8; const int row = isc ? NLAT + b * LC + 64 * jt + tok : b * SEQ + 64 * jl + tok;
        float o[8]; float ss = 0.f;
#pragma unroll
        for (int j = 0; j < 8; ++j) { o[j] = OF[tok * LF + e0 + j] + OF[64 * LF + tok * LF + e0 + j]; ss += o[j] * o[j]; }
#pragma unroll
        for (int k = 1; k < 8; k <<= 1) ss += __shfl_xor(ss, k);
        const float rs = 1.f / sqrtf(ss * (1.f / 64.f) + EPS);
        const float* ng = INP(I_GDNG) + l * 256 + h * 64 + e0; const bf16_t* gz = WSP(bf16_t, WS_Z) + (size_t)row * ZW + GDB + 768 + h * 64 + e0;
        unsigned pk[4];
#pragma unroll
        for (int j = 0; j < 4; ++j) pk[j] = pk2(o[2 * j] * rs * ng[2 * j] * siluf_(bf2f(gz[2 * j])), o[2 * j + 1] * rs * ng[2 * j + 1] * siluf_(bf2f(gz[2 * j + 1])));
        *(u32x4*)(WSP(bf16_t, WS_MIX) + (size_t)row * D + 768 + h * 64 + e0) = (u32x4){pk[0], pk[1], pk[2], pk[3]}; }
    __syncthreads();
}
constexpr int MA_Q = 0, MA_K = 9216, MA_VT = 18432, MA_KWT = 27648, MA_P = 36864, MA_ONE = 46080  , MA_S = 50688  ;
__device__ __forceinline__ void mlstm_a_item(Ctx& C, int l, int b, int h, int dir, int c) {
    LAS unsigned char* lds = C.lds; ITEM_IDS();
    LAS bf16_t* Qb = (LAS bf16_t*)(lds + MA_Q); LAS bf16_t* Kb = (LAS bf16_t*)(lds + MA_K); LAS bf16_t* VT = (LAS bf16_t*)(lds + MA_VT); LAS bf16_t* KWT = (LAS bf16_t*)(lds + MA_KWT);
    LAS bf16_t* Pm = (LAS bf16_t*)(lds + MA_P); LAS bf16_t* ONE = (LAS bf16_t*)(lds + MA_ONE); LAS float* Sc = (LAS float*)(lds + MA_S);
    const bf16_t* zb = WSP(bf16_t, WS_Z); const float* zg = WSP(float, WS_ZG);
    unsigned char* blob = C.ws + WS_ML + ((size_t)((b * NH + h) * 2 + dir) * NCH + c) * ML_BLOB;
    const int i = tid >> 3, d0 = (tid & 7) * 8; const int row = scan_row<1>(b, dir, 64 * c + i);
    float kv[8];
    { const bf16_t* zr = zb + (size_t)row * ZW + MLB + h * 64 + d0;
        *(LAS u32x4*)(Qb + i * LS + d0) = *(const u32x4*)zr;
        const u32x4 kr = *(const u32x4*)(zr + 256), vr = *(const u32x4*)(zr + 512);
        const unsigned ku[4] = {kr.x, kr.y, kr.z, kr.w}, vu[4] = {vr.x, vr.y, vr.z, vr.w};
#pragma unroll
        for (int j = 0; j < 4; ++j) { kv[2 * j] = u2f(ku[j] << 16) * 0.125f; kv[2 * j + 1] = u2f(ku[j] & 0xffff0000u) * 0.125f; VT[(d0 + 2 * j) * LS + i] = (bf16_t)(vu[j] & 0xffffu); VT[(d0 + 2 * j + 1) * LS + i] = (bf16_t)(vu[j] >> 16); }
        u32x4 wk; wk.x = pk2(kv[0], kv[1]); wk.y = pk2(kv[2], kv[3]); wk.z = pk2(kv[4], kv[5]); wk.w = pk2(kv[6], kv[7]); *(LAS u32x4*)(Kb + i * LS + d0) = wk;
        if ((tid & 7) == 0) { const float* gb = INP(I_MLGB) + l * 16; const float* g = zg + (size_t)row * 32;
            Sc[i] = g[(2 * dir) * 4 + h] + gb[(2 * dir) * 4 + h]; Sc[64 + i] = logsigmoidf_(g[(2 * dir + 1) * 4 + h] + gb[(2 * dir + 1) * 4 + h]); }
        for (int o = tid; o < 32 * LS; o += 512) ONE[o] = (bf16_t)((o < LS) ? 0x3f80 : 0);
    }
    __syncthreads();
    if (w == 0) { float fc = Sc[64 + lane];
#pragma unroll
        for (int o = 1; o < 64; o <<= 1) { const float t = __shfl(fc, lane - o); if (lane >= o) fc += t; }
        const float li = Sc[lane]; float pm = li - fc;
#pragma unroll
        for (int o = 1; o < 64; o <<= 1) { const float t = __shfl(pm, lane - o); if (lane >= o) pm = fmaxf(pm, t); }
        const float fl = __shfl(fc, 63); const float gg = fl - fc + li; float gm = gg;
#pragma unroll
        for (int o = 1; o < 64; o <<= 1) gm = fmaxf(gm, __shfl_xor(gm, o));
        Sc[128 + lane] = fc; Sc[192 + lane] = gg - gm; Sc[256 + lane] = fc + pm;
        if (lane == 0) { ((float*)(blob + 33792))[0] = gm; ((float*)(blob + 33792))[1] = fl; }
        ((float*)(blob + 32768))[64 + lane] = fc + pm; ((float*)(blob + 32768))[128 + lane] = fc; }
    __syncthreads();
    { const float e = __expf(Sc[192 + i]);
#pragma unroll
        for (int j = 0; j < 8; ++j) KWT[(d0 + j) * LS + i] = (bf16_t)f2bf(kv[j] * e); }
    if (w < 2) { f32x16 acc[2]; acc[0] = (f32x16)(0.f); acc[1] = (f32x16)(0.f);
        const int rh = w * 32; mm_nt<2, 4>(Qb + rh * LS, LS, Kb, LS, acc, lane);
#pragma unroll
        for (int n = 0; n < 2; ++n)
#pragma unroll
            for (int ri = 0; ri < 16; ++ri) { const int ii = rh + CROW(ri, lane), jj = 32 * n + (lane & 31);
                Pm[ii * LS + jj] = (bf16_t)f2bf(jj <= ii ? acc[n][ri] * __expf(Sc[128 + ii] - Sc[128 + jj] + Sc[jj] - Sc[256 + ii]) : 0.f); } }
    __syncthreads();
    { const int pr = w >> 2, q = w & 3, rh = (q & 1) * 32, ch = (q >> 1) * 32; f32x16 acc[1]; acc[0] = (f32x16)(0.f);
        const LAS bf16_t* Ap = pr ? VT : Pm; const LAS bf16_t* Bp = pr ? KWT : VT;
        mm_nt<1, 4>(Ap + rh * LS, LS, Bp + ch * LS, LS, acc, lane);
        float* dst = (float*)(blob + (pr ? 16384 : 0));
#pragma unroll
        for (int ri = 0; ri < 16; ++ri) dst[(rh + CROW(ri, lane)) * 64 + ch + (lane & 31)] = acc[0][ri];
        if (q < 2) {
            f32x16 a2[1]; a2[0] = (f32x16)(0.f);
            if (pr == 0) { mm_nt<1, 4>(Pm + (q * 32) * LS, LS, ONE, LS, a2, lane);
                if ((lane & 31) == 0) {
#pragma unroll
                    for (int ri = 0; ri < 16; ++ri) ((float*)(blob + 32768))[q * 32 + CROW(ri, lane)] = a2[0][ri]; } }
            else { mm_nt<1, 4>(ONE, LS, KWT + (q * 32) * LS, LS, a2, lane);
                if (lane < 32) ((float*)(blob + 32768))[192 + q * 32 + lane] = a2[0][0]; } } }
    __syncthreads();
}
__device__ __forceinline__ void mlstm_b_scan(Ctx& C, int sidx) {
    const int tid = C.tid, e = tid >> 3, d0 = (tid & 7) * 8;
    float ct[8], nn[8]; float m = 0.f;
#pragma unroll
    for (int j = 0; j < 8; ++j) { ct[j] = 0.f; nn[j] = 0.f; }
    f32x4 u0, u1, n0, n1; float gm, fl;
    { const unsigned char* blob = C.ws + WS_ML + ((size_t)sidx * NCH) * ML_BLOB;
        u0 = *(const f32x4*)((const float*)(blob + 16384) + e * 64 + d0); u1 = *(const f32x4*)((const float*)(blob + 16384) + e * 64 + d0 + 4);
        n0 = *(const f32x4*)((const float*)(blob + 32768) + 192 + d0); n1 = *(const f32x4*)((const float*)(blob + 32768) + 192 + d0 + 4); gm = ((const float*)(blob + 33792))[0]; fl = ((const float*)(blob + 33792))[1]; }
    for (int c = 0; c < NCH; ++c) {
        unsigned char* st = C.ws + WS_MST + ((size_t)sidx * NCH + c) * ML_ST;
        const int cn = (c + 1 < NCH) ? c + 1 : c; const unsigned char* blob = C.ws + WS_ML + ((size_t)sidx * NCH + cn) * ML_BLOB;
        const f32x4 pu0 = *(const f32x4*)((const float*)(blob + 16384) + e * 64 + d0), pu1 = *(const f32x4*)((const float*)(blob + 16384) + e * 64 + d0 + 4);
        const f32x4 pn0 = *(const f32x4*)((const float*)(blob + 32768) + 192 + d0), pn1 = *(const f32x4*)((const float*)(blob + 32768) + 192 + d0 + 4);
        const float pgm = ((const float*)(blob + 33792))[0], pfl = ((const float*)(blob + 33792))[1];
        u32x4 wv; wv.x = pk2(ct[0], ct[1]); wv.y = pk2(ct[2], ct[3]); wv.z = pk2(ct[4], ct[5]); wv.w = pk2(ct[6], ct[7]);
        *(u32x4*)((bf16_t*)st + e * 64 + d0) = wv;
        if (e == 0) { *(f32x4*)((float*)(st + 8192) + d0) = (f32x4){nn[0], nn[1], nn[2], nn[3]}; *(f32x4*)((float*)(st + 8192) + d0 + 4) = (f32x4){nn[4], nn[5], nn[6], nn[7]}; if (d0 == 0) ((float*)(st + 8192))[64] = m; }
        const float mn = fmaxf(fl + m, gm), ao = __expf(fl + m - mn), an = __expf(gm - mn); m = mn;
        const float uu[8] = {u0.x, u0.y, u0.z, u0.w, u1.x, u1.y, u1.z, u1.w}, un[8] = {n0.x, n0.y, n0.z, n0.w, n1.x, n1.y, n1.z, n1.w};
#pragma unroll
        for (int j = 0; j < 8; ++j) { ct[j] = ao * ct[j] + an * uu[j]; nn[j] = ao * nn[j] + an * un[j]; }
        u0 = pu0; u1 = pu1; n0 = pn0; n1 = pn1; gm = pgm; fl = pfl;
    }
}
__device__ __forceinline__ void mlstm_c_item(Ctx& C, int l, int b, int h, int jt) {
    LAS unsigned char* lds = C.lds; ITEM_IDS();
    LAS bf16_t* Qb = (LAS bf16_t*)lds;
    LAS bf16_t* Sb = (LAS bf16_t*)(lds + 18432);
    LAS float* OF = (LAS float*)(lds + 36864);
    LAS float* Sc = (LAS float*)(lds + 70144);
    const bool isc = jt < NCHC; const int jl = jt - NCHC;
    int cidx[2]; cidx[0] = jt; cidx[1] = isc ? (NCHC - 1 - jt) : NCHC + (SEQ / 64 - 1 - jl);
    const unsigned char* blob[2]; const bf16_t* zb = WSP(bf16_t, WS_Z);
    const int i = tid >> 3, d0 = (tid & 7) * 8;
#pragma unroll
    for (int dir = 0; dir < 2; ++dir) { const size_t sc = (size_t)((b * NH + h) * 2 + dir) * NCH + cidx[dir]; blob[dir] = C.ws + WS_ML + sc * ML_BLOB;
        const unsigned char* st = C.ws + WS_MST + sc * ML_ST; const int row = scan_row<1>(b, dir, 64 * cidx[dir] + i);
        const u32x4 qr = *(const u32x4*)(zb + (size_t)row * ZW + MLB + h * 64 + d0);
        *(LAS u32x4*)(Qb + dir * 64 * LS + i * LS + d0) = qr;
        *(LAS u32x4*)(Sb + dir * 64 * LS + i * LS + d0) = *(const u32x4*)((const bf16_t*)st + i * 64 + d0);
        const float* n0 = (const float*)(st + 8192) + d0; const unsigned qu[4] = {qr.x, qr.y, qr.z, qr.w}; float qn = 0.f;
#pragma unroll
        for (int j = 0; j < 4; ++j) qn += u2f(qu[j] << 16) * n0[2 * j] + u2f(qu[j] & 0xffff0000u) * n0[2 * j + 1];
#pragma unroll
        for (int k = 1; k < 8; k <<= 1) qn += __shfl_xor(qn, k);
        if ((tid & 7) == 0) { const float* sv = (const float*)(blob[dir] + 32768); const float m0 = ((const float*)(st + 8192))[64];
            const float mloc = sv[64 + i], ainit = sv[128 + i] + m0, M = fmaxf(mloc, ainit), s1 = __expf(mloc - M), s2 = __expf(ainit - M);
            LAS float* o = Sc + dir * 256; o[i] = s1; o[64 + i] = s2; o[128 + i] = s1 * sv[i] + s2 * qn; o[192 + i] = __expf(-M); } }
    __syncthreads();
    { const int dir = w >> 2, q = w & 3, ih = (q & 1) * 32, eh = (q >> 1) * 32; f32x16 acc[1]; acc[0] = (f32x16)(0.f); const float* nl = (const float*)blob[dir];
        mm_nt<1, 4>(Qb + dir * 64 * LS + ih * LS, LS, Sb + dir * 64 * LS + eh * LS, LS, acc, lane);
        const LAS float* o = Sc + dir * 256;
#pragma unroll
        for (int ri = 0; ri < 16; ++ri) { const int ii = ih + CROW(ri, lane), tok = dir ? 63 - ii : ii, ee = eh + (lane & 31);
            const float num = o[ii] * nl[ii * 64 + ee] + o[64 + ii] * acc[0][ri];
            OF[dir * 64 * LF + tok * LF + ee] = num / fmaxf(fabsf(o[128 + ii]), o[192 + ii]); } }
    __syncthreads();
    { const int tok = tid >> 3, e0 = (tid & 7) * 8; const int row = scan_row<1>(b, 0, 64 * cidx[0] + tok);
        float o[8]; float ss = 0.f;
#pragma unroll
        for (int j = 0; j < 8; ++j) { o[j] = OF[tok * LF + e0 + j] + OF[64 * LF + tok * LF + e0 + j]; ss += o[j] * o[j]; }
#pragma unroll
        for (int k = 1; k < 8; k <<= 1) ss += __shfl_xor(ss, k);
        const float rs = 1.f / sqrtf(ss * (1.f / 64.f) + EPS);
        const float* ng = INP(I_MLNG) + l * 256 + h * 64 + e0; const bf16_t* gz = zb + (size_t)row * ZW + MLB + 768 + h * 64 + e0;
        unsigned pk[4];
#pragma unroll
        for (int j = 0; j < 4; ++j) pk[j] = pk2(o[2 * j] * rs * ng[2 * j] * sigmoidf_(bf2f(gz[2 * j])), o[2 * j + 1] * rs * ng[2 * j + 1] * sigmoidf_(bf2f(gz[2 * j + 1])));
        *(u32x4*)(WSP(bf16_t, WS_MIX) + (size_t)row * D + 256 + h * 64 + e0) = (u32x4){pk[0], pk[1], pk[2], pk[3]}; }
    __syncthreads();
}
constexpr int HA_Q = 0, HA_K = 16640, HA_CUM = 33280, HA_V = 49920, HA_SC = 66560  , HA_VT = 70912, HA_KDT = 80128;
__device__ __forceinline__ void hgrn_a_item(Ctx& C, int l, int b, int h, int dir, int c) {
    LAS unsigned char* lds = C.lds; ITEM_IDS();
    LAS float* Qf = (LAS float*)(lds + HA_Q); LAS float* Kf = (LAS float*)(lds + HA_K); LAS float* CUM = (LAS float*)(lds + HA_CUM); LAS float* Vf = (LAS float*)(lds + HA_V); LAS float* SC = (LAS float*)(lds + HA_SC);
    LAS bf16_t* VT = (LAS bf16_t*)(lds + HA_VT); LAS bf16_t* KDT = (LAS bf16_t*)(lds + HA_KDT);
    const bf16_t* zb = WSP(bf16_t, WS_Z);
    unsigned char* blob = C.ws + WS_HG + ((size_t)((b * NH + h) * 2 + dir) * NCH + c) * HG_BLOB;
    const int i = tid >> 3, d0 = (tid & 7) * 8; const int row = scan_row<0>(b, dir, 64 * c + i);
    { const bf16_t* zr = zb + (size_t)row * ZW + HGB + h * 64 + d0; const float* lbp = WSP(float, WS_LB) + l * 256 + h * 64 + d0;
#pragma unroll
        for (int j = 0; j < 8; ++j) { const float qz = bf2f(zr[j]), iz = bf2f(zr[256 + j]), fz = bf2f(zr[512 + dir * 256 + j]), lb = lbp[j];
            const float sg = 1.f / (1.f + __expf(-fz)), sgn = 1.f / (1.f + __expf(fz));
            Qf[i * LF + d0 + j] = siluf_(qz); Kf[i * LF + d0 + j] = (1.f - lb) * sgn; CUM[i * LF + d0 + j] = __logf(lb + (1.f - lb) * sg); Vf[i * LF + d0 + j] = iz; VT[(d0 + j) * LS + i] = (bf16_t)f2bf(iz); } }
    __syncthreads();
    if (tid < 256) { const int sub = tid >> 6, d = tid & 63; float a = 0.f;
#pragma unroll
        for (int t = 0; t < 16; ++t) { a += CUM[(16 * sub + t) * LF + d]; CUM[(16 * sub + t) * LF + d] = a; } }
    __syncthreads();
    for (int p = tid; p < 544; p += 512) { const int sub = p / 136, r = p % 136; int t = 0; while ((t + 1) * (t + 2) / 2 <= r) ++t; const int s2 = r - t * (t + 1) / 2;
        const LAS float* qp = Qf + (16 * sub + t) * LF; const LAS float* kp = Kf + (16 * sub + s2) * LF; const LAS float* ct = CUM + (16 * sub + t) * LF; const LAS float* cs = CUM + (16 * sub + s2) * LF; float a = 0.f;
#pragma unroll 8
        for (int d = 0; d < 64; ++d) a += qp[d] * kp[d] * __expf(ct[d] - cs[d]);
        SC[(sub * 16 + t) * 17 + s2] = a; }
    { const int sub = i >> 4; u32x4 wq; float qt[8];
#pragma unroll
        for (int j = 0; j < 8; ++j) { const float cm = CUM[i * LF + d0 + j], last = CUM[(16 * sub + 15) * LF + d0 + j];
            KDT[(d0 + j) * LS + i] = (bf16_t)f2bf(Kf[i * LF + d0 + j] * __expf(last - cm)); qt[j] = Qf[i * LF + d0 + j] * __expf(cm);
            if ((i & 15) == 15) ((float*)(blob + 32768))[sub * 64 + d0 + j] = __expf(last); }
        wq.x = pk2(qt[0], qt[1]); wq.y = pk2(qt[2], qt[3]); wq.z = pk2(qt[4], qt[5]); wq.w = pk2(qt[6], qt[7]);
        *(u32x4*)((bf16_t*)(blob + 33792) + i * 64 + d0) = wq; }
    __syncthreads();
    { const int sub = i >> 4, t = i & 15; float o[8];
#pragma unroll
        for (int j = 0; j < 8; ++j) o[j] = 0.f;
        for (int s2 = 0; s2 <= t; ++s2) { const float sc = SC[(sub * 16 + t) * 17 + s2];
#pragma unroll
            for (int j = 0; j < 8; ++j) o[j] += sc * Vf[(16 * sub + s2) * LF + d0 + j]; }
        float* op = (float*)(blob + 41984) + i * 64 + d0; *(f32x4*)op = (f32x4){o[0], o[1], o[2], o[3]}; *(f32x4*)(op + 4) = (f32x4){o[4], o[5], o[6], o[7]}; }
    { const int sub = w >> 1, eh = (w & 1) * 32; f32x16 acc[2]; acc[0] = (f32x16)(0.f); acc[1] = (f32x16)(0.f);
        mm_nt<2, 1>(VT + eh * LS + 16 * sub, LS, KDT + 16 * sub, LS, acc, lane);
        bf16_t* ut = (bf16_t*)blob + sub * 4096;
#pragma unroll
        for (int n = 0; n < 2; ++n)
#pragma unroll
            for (int ri = 0; ri < 16; ++ri) ut[(eh + CROW(ri, lane)) * 64 + 32 * n + (lane & 31)] = (bf16_t)f2bf(acc[n][ri]); }
    __syncthreads();
}
__device__ __forceinline__ void hgrn_b_scan(Ctx& C, int sidx) {
    const int tid = C.tid, e = tid >> 3, d0 = (tid & 7) * 8;
    float st[8];
#pragma unroll
    for (int j = 0; j < 8; ++j) st[j] = 0.f;
    u32x4 ur[4]; f32x4 l0[4], l1[4];
    { const unsigned char* blob = C.ws + WS_HG + ((size_t)sidx * NCH) * HG_BLOB;
#pragma unroll
        for (int sub = 0; sub < 4; ++sub) { ur[sub] = *(const u32x4*)((const bf16_t*)blob + sub * 4096 + e * 64 + d0); l0[sub] = *(const f32x4*)((const float*)(blob + 32768) + sub * 64 + d0); l1[sub] = *(const f32x4*)((const float*)(blob + 32768) + sub * 64 + d0 + 4); } }
    for (int c = 0; c < NCH; ++c) {
        bf16_t* so = WSP(bf16_t, WS_HST) + ((size_t)sidx * NCH + c) * 4 * 4096;
        u32x4 nur[4]; f32x4 nl0[4], nl1[4];
        { const int cn = (c + 1 < NCH) ? c + 1 : c; const unsigned char* blob = C.ws + WS_HG + ((size_t)sidx * NCH + cn) * HG_BLOB;
#pragma unroll
            for (int sub = 0; sub < 4; ++sub) { nur[sub] = *(const u32x4*)((const bf16_t*)blob + sub * 4096 + e * 64 + d0); nl0[sub] = *(const f32x4*)((const float*)(blob + 32768) + sub * 64 + d0); nl1[sub] = *(const f32x4*)((const float*)(blob + 32768) + sub * 64 + d0 + 4); } }
#pragma unroll
        for (int sub = 0; sub < 4; ++sub) {
            u32x4 wv; wv.x = pk2(st[0], st[1]); wv.y = pk2(st[2], st[3]); wv.z = pk2(st[4], st[5]); wv.w = pk2(st[6], st[7]);
            *(u32x4*)(so + sub * 4096 + e * 64 + d0) = wv;
            const unsigned uu[4] = {ur[sub].x, ur[sub].y, ur[sub].z, ur[sub].w}; const float lam[8] = {l0[sub].x, l0[sub].y, l0[sub].z, l0[sub].w, l1[sub].x, l1[sub].y, l1[sub].z, l1[sub].w};
#pragma unroll
            for (int j = 0; j < 4; ++j) { st[2 * j] = lam[2 * j] * st[2 * j] + u2f(uu[j] << 16); st[2 * j + 1] = lam[2 * j + 1] * st[2 * j + 1] + u2f(uu[j] & 0xffff0000u); } }
#pragma unroll
        for (int sub = 0; sub < 4; ++sub) { ur[sub] = nur[sub]; l0[sub] = nl0[sub]; l1[sub] = nl1[sub]; }
    }
}
__device__ __forceinline__ void hgrn_c_item(Ctx& C, int l, int b, int h, int jt) {
    LAS unsigned char* lds = C.lds; ITEM_IDS();
    LAS bf16_t* STw = (LAS bf16_t*)(lds + w * 11520);
    LAS bf16_t* QTw = STw + 64 * LS;
    LAS float* OF = (LAS float*)(lds + 92160);
    const bool isc = jt < NCHC; const int jl = jt - NCHC;
    int cidx[2]; cidx[0] = jt; cidx[1] = isc ? (NCHC - 1 - jt) : NCHC + (SEQ / 64 - 1 - jl);
    { const int dir = w >> 2, sub = w & 3; const size_t sc = (size_t)((b * NH + h) * 2 + dir) * NCH + cidx[dir]; const unsigned char* blob = C.ws + WS_HG + sc * HG_BLOB;
        const bf16_t* st = WSP(bf16_t, WS_HST) + (sc * 4 + sub) * 4096; const bf16_t* qt = (const bf16_t*)(blob + 33792) + (16 * sub) * 64;
#pragma unroll
        for (int k = 0; k < 8; ++k) { const int o = lane + 64 * k, r = o >> 3, c8 = (o & 7) * 8; *(LAS u32x4*)(STw + r * LS + c8) = *(const u32x4*)(st + r * 64 + c8); }
#pragma unroll
        for (int k = 0; k < 2; ++k) { const int o = lane + 64 * k, r = o >> 3, c8 = (o & 7) * 8; *(LAS u32x4*)(QTw + r * LS + c8) = *(const u32x4*)(qt + r * 64 + c8); }
        LDS_WAIT(); asm volatile("" ::: "memory");
        const float* oi = (const float*)(blob + 41984) + (16 * sub) * 64;
        const int tr = lane & 15, kq = (lane >> 4) * 8;
#pragma unroll
        for (int nt = 0; nt < 4; ++nt) { f32x4 acc = (f32x4){0.f, 0.f, 0.f, 0.f};
#pragma unroll
            for (int kk = 0; kk < 2; ++kk) { const bf16x8 a = *(const LAS bf16x8*)(QTw + tr * LS + 32 * kk + kq), bb = *(const LAS bf16x8*)(STw + (16 * nt + tr) * LS + 32 * kk + kq);
                acc = __builtin_amdgcn_mfma_f32_16x16x32_bf16(a, bb, acc, 0, 0, 0); }
#pragma unroll
            for (int r = 0; r < 4; ++r) { const int t = 4 * (lane >> 4) + r, ii = 16 * sub + t, tok = dir ? 63 - ii : ii, ee = 16 * nt + (lane & 15);
                OF[dir * 64 * LF + tok * LF + ee] = acc[r] + oi[t * 64 + ee]; } } }
    __syncthreads();
    { const int tok = tid >> 3, e0 = (tid & 7) * 8; const int row = scan_row<0>(b, 0, 64 * cidx[0] + tok);
        float o[8]; float ss = 0.f;
#pragma unroll
        for (int j = 0; j < 8; ++j) { o[j] = OF[tok * LF + e0 + j] + OF[64 * LF + tok * LF + e0 + j]; ss += o[j] * o[j]; }
#pragma unroll
        for (int k = 1; k < 8; k <<= 1) ss += __shfl_xor(ss, k);
        const float rs = 1.f / sqrtf(ss * (1.f / 64.f) + EPS);
        const float* ng = INP(I_HGNG) + l * 256 + h * 64 + e0; const bf16_t* gz = WSP(bf16_t, WS_Z) + (size_t)row * ZW + HGB + 1024 + h * 64 + e0;
        unsigned pk[4];
#pragma unroll
        for (int j = 0; j < 4; ++j) pk[j] = pk2(o[2 * j] * rs * ng[2 * j] * siluf_(bf2f(gz[2 * j])), o[2 * j + 1] * rs * ng[2 * j + 1] * siluf_(bf2f(gz[2 * j + 1])));
        *(u32x4*)(WSP(bf16_t, WS_MIX) + (size_t)row * D + h * 64 + e0) = (u32x4){pk[0], pk[1], pk[2], pk[3]}; }
    __syncthreads();
}
#ifndef REPMASK
#define REPMASK 0
#endif
__device__ __forceinline__ void phase_gdn_a(Ctx& C, int l) {
    for (int rep = 0; rep < 1 + ((REPMASK >> 10) & 1); ++rep)
    for (int it = C.bid; it < NSCAN * NCH; it += C.G) { const int sidx = it / NCH, c = it % NCH; gdn_a_item(C, l, sidx / (NH * 2), (sidx / 2) % NH, sidx & 1, c); }
    for (int rep = 0; rep < 1 + ((REPMASK >> 11) & 1); ++rep)
    for (int it = C.bid; it < NSCAN * NCH; it += C.G) { const int sidx = it / NCH, c = it % NCH; mlstm_a_item(C, l, sidx / (NH * 2), (sidx / 2) % NH, sidx & 1, c); }
    for (int rep = 0; rep < 1 + ((REPMASK >> 12) & 1); ++rep)
    for (int it = C.bid; it < NSCAN * NCH; it += C.G) { const int sidx = it / NCH, c = it % NCH; hgrn_a_item(C, l, sidx / (NH * 2), (sidx / 2) % NH, sidx & 1, c); }
}
__device__ __forceinline__ void phase_hy_transpose(Ctx& C) {
    const int gw = C.vcu * 8 + C.wave, NGW = C.G * 8, lane = C.lane;
    LAS bf16_t* scr = (LAS bf16_t*)(C.lds + C.wave * 8448);
    const bf16_t* zb = WSP(bf16_t, WS_Z); bf16_t* zt = WSP(bf16_t, WS_ZT);
    for (int it = gw; it < (NT / 64) * 12; it += NGW) { const int r0 = (it / 12) * 64, cb = (it % 12) * 64;
#pragma unroll 8
        for (int rr = 0; rr < 64; rr += 2) { const int r = rr + (lane >> 5), c2 = (lane & 31) * 2; const unsigned v = *(const unsigned*)(zb + (size_t)(r0 + r) * ZW + HYB + cb + c2);
            scr[r * 66 + c2] = (bf16_t)(v & 0xffffu); scr[r * 66 + c2 + 1] = (bf16_t)(v >> 16); }
        LDS_WAIT(); asm volatile("" ::: "memory");
#pragma unroll 8
        for (int cc = 0; cc < 64; cc += 2) { const int c = cc + (lane >> 5), r2 = (lane & 31) * 2;
            *(unsigned*)(zt + (size_t)(cb + c) * NT + r0 + r2) = (unsigned)scr[r2 * 66 + c] | ((unsigned)scr[(r2 + 1) * 66 + c] << 16); }
        LDS_WAIT(); asm volatile("" ::: "memory"); }
}
__device__ __forceinline__ void phase_gdn_c(Ctx& C, int l) {
    const int j0 = (l == 0) ? 0 : NCHC, nj = NCH - j0;
    for (int it = C.bid; it < NB * NH * nj; it += C.G) { const int bh = it / nj, jt = j0 + it % nj; gdn_c_item(C, l, bh / NH, bh % NH, jt); }
    for (int it = C.bid; it < NB * NH * nj; it += C.G) { const int bh = it / nj, jt = j0 + it % nj; mlstm_c_item(C, l, bh / NH, bh % NH, jt); }
    for (int it = C.bid; it < NB * NH * nj; it += C.G) { const int bh = it / nj, jt = j0 + it % nj; hgrn_c_item(C, l, bh / NH, bh % NH, jt); }
}

__device__ __forceinline__ f32x2 cmul(f32x2 a, f32x2 w) { return (f32x2){a.x * w.x - a.y * w.y, a.x * w.y + a.y * w.x}; }
__device__ __forceinline__ f32x2 cmulc(f32x2 a, f32x2 w) { return (f32x2){a.x * w.x + a.y * w.y, a.y * w.x - a.x * w.y}; }
template <int N> __device__ __forceinline__ void fft_fwd(LAS f32x2* X, const LAS f32x2* tw, int tid) {
    constexpr int NG = (N / 4 + 511) / 512, NB2 = (N / 2 + 511) / 512;
    int h = N >> 1;
#pragma unroll 1
    for (; h >= 2; h >>= 2) { const float tf = 3.14159265358979f / (float)h; const int hh = h >> 1;
        f32x2 x0[NG], x1[NG], x2[NG], x3[NG], w1[NG]; int bs[NG];
#pragma unroll
        for (int q = 0; q < NG; ++q) { const int j = tid + 512 * q; const int jm = j & (hh - 1); bs[q] = ((j - jm) << 2) + jm;
            if (j < (N >> 2)) { x0[q] = X[bs[q]]; x1[q] = X[bs[q] + hh]; x2[q] = X[bs[q] + h]; x3[q] = X[bs[q] + h + hh]; const float ang = (float)jm * tf; w1[q] = (f32x2){__cosf(ang), -__sinf(ang)}; } }
#pragma unroll
        for (int q = 0; q < NG; ++q) { const int j = tid + 512 * q; if (j < (N >> 2)) {
            const f32x2 w2 = cmul(w1[q], w1[q]);
            const f32x2 a0 = x0[q] + x2[q], a2 = cmul(x0[q] - x2[q], w1[q]), a1 = x1[q] + x3[q]; const f32x2 d13 = cmul(x1[q] - x3[q], w1[q]); const f32x2 a3 = (f32x2){d13.y, -d13.x};
            X[bs[q]] = a0 + a1; X[bs[q] + hh] = cmul(a0 - a1, w2); X[bs[q] + h] = a2 + a3; X[bs[q] + h + hh] = cmul(a2 - a3, w2); } }
        __syncthreads(); }
    if (h == 1) {
        f32x2 a[NB2], b[NB2];
#pragma unroll
        for (int q = 0; q < NB2; ++q) { const int j = tid + 512 * q; if (j < (N >> 1)) { a[q] = X[2 * j]; b[q] = X[2 * j + 1]; } }
#pragma unroll
        for (int q = 0; q < NB2; ++q) { const int j = tid + 512 * q; if (j < (N >> 1)) { X[2 * j] = a[q] + b[q]; X[2 * j + 1] = a[q] - b[q]; } }
        __syncthreads(); }
}
template <int N> __device__ __forceinline__ void fft_inv(LAS f32x2* X, const LAS f32x2* tw, int tid) {
    constexpr int NG = (N / 4 + 511) / 512, NB2 = (N / 2 + 511) / 512;
    constexpr int LOG2N = (N == 8192) ? 13 : (N == 4096) ? 12 : (N == 2048) ? 11 : (N == 1024) ? 10 : (N == 512) ? 9 : (N == 256) ? 8 : (N == 128) ? 7 : (N == 64) ? 6 : -1;
    static_assert(LOG2N > 0, "fft size");
    int h = 2;
    if (LOG2N & 1) {
        f32x2 a[NB2], b[NB2];
#pragma unroll
        for (int q = 0; q < NB2; ++q) { const int j = tid + 512 * q; if (j < (N >> 1)) { a[q] = X[2 * j]; b[q] = X[2 * j + 1]; } }
#pragma unroll
        for (int q = 0; q < NB2; ++q) { const int j = tid + 512 * q; if (j < (N >> 1)) { X[2 * j] = a[q] + b[q]; X[2 * j + 1] = a[q] - b[q]; } }
        __syncthreads(); h = 4; }
#pragma unroll 1
    for (; h <= (N >> 1); h <<= 2) { const float tf = 3.14159265358979f / (float)h; const int hh = h >> 1;
        f32x2 x0[NG], x1[NG], x2[NG], x3[NG], w1[NG]; int bs[NG];
#pragma unroll
        for (int q = 0; q < NG; ++q) { const int j = tid + 512 * q; const int jm = j & (hh - 1); bs[q] = ((j - jm) << 2) + jm;
            if (j < (N >> 2)) { x0[q] = X[bs[q]]; x1[q] = X[bs[q] + hh]; x2[q] = X[bs[q] + h]; x3[q] = X[bs[q] + h + hh]; const float ang = (float)jm * tf; w1[q] = (f32x2){__cosf(ang), -__sinf(ang)}; } }
#pragma unroll
        for (int q = 0; q < NG; ++q) { const int j = tid + 512 * q; if (j < (N >> 2)) {
            const f32x2 w2 = cmul(w1[q], w1[q]);
            const f32x2 b1 = cmulc(x1[q], w2), b3 = cmulc(x3[q], w2); const f32x2 a0 = x0[q] + b1, a1 = x0[q] - b1, a2 = x2[q] + b3, a3 = x2[q] - b3;
            const f32x2 c2 = cmulc(a2, w1[q]); const f32x2 t3 = cmulc(a3, w1[q]); const f32x2 c3 = (f32x2){-t3.y, t3.x};
            X[bs[q]] = a0 + c2; X[bs[q] + h] = a0 - c2; X[bs[q] + hh] = a1 + c3; X[bs[q] + h + hh] = a1 - c3; } }
        __syncthreads(); }
}
__device__ __forceinline__ float block_sum(Ctx& C, float v, LAS float* red) {
    v = wave_sum(v); __syncthreads(); if (C.lane == 0) red[C.wave] = v; __syncthreads();
    float s = 0.f;
#pragma unroll
    for (int i = 0; i < 8; ++i) s += red[i];
    return s;
}
#define FFT_FWD_P(X) do { fft_fwd<N>(X, tw, tid); if ((REPMASK >> 15) & 1) { fft_inv<N>(X, tw, tid); for (int i_ = tid; i_ < N; i_ += 512) X[i_] = X[i_] * (1.0f / (float)N); __syncthreads(); fft_fwd<N>(X, tw, tid); } } while (0)
template <int LEN>
__device__ __forceinline__ void hyena_channel(Ctx& C, int l, int c, int row0, int hoff  ) {
    LAS f32x2* X = (LAS f32x2*)C.lds; LAS f32x2* Y1 = (LAS f32x2*)(C.lds + 65536); const LAS f32x2* tw = (const LAS f32x2*)(C.lds + 98304); LAS float* red = (LAS float*)(C.lds + LDSX_OFF + 128);
    constexpr int N = 2 * LEN, len = LEN, NI = (LEN + 511) / 512;
    const int tid = C.tid;
    f32x2* Ks = WSP(f32x2, WS_KS) + (size_t)C.bid * 2 * FFTN;
    const float* hd = WSP(float, WS_HDN) + ((size_t)l * (SEQ + LC) + hoff) * 64;
    const float* w3 = INP(I_HYW3) + (size_t)l * 64 * 1024;
    const float delta = (-4.605170185988091f / 1.5f + (-4.605170185988091f / 0.3f + 4.605170185988091f / 1.5f) * (float)c / 255.0f);
    const float ad = fabsf(delta);
    LAS f32x4* W3c = (LAS f32x4*)(C.lds + 98304);
    __syncthreads();
    if (tid < 256) { const int j = tid >> 2, q = tid & 3; ((LAS float*)W3c)[tid] = w3[j * 1024 + (q & 1) * 512 + (q >> 1) * 256 + c]; }
    __syncthreads();
    float ss0 = 0.f, ss1 = 0.f;
    for (int p = tid; p < len; p += 512) { const float* hr = hd + (size_t)p * 64; f32x4 acc = (f32x4){0.f, 0.f, 0.f, 0.f};
#pragma unroll 16
        for (int j = 0; j < 64; ++j) acc = acc + W3c[j] * hr[j];
        const float win = __expf(-((float)p / (float)(len - 1)) * ad); acc = acc * win;
        X[p] = (f32x2){acc.x, 0.f}; ss0 += acc.x * acc.x; ss1 += acc.z * acc.z;
        if (p >= 1) { X[N - p] = (f32x2){acc.y, 0.f}; ss0 += acc.y * acc.y; ss1 += acc.w * acc.w; }
        Y1[p] = (f32x2){acc.z, acc.w}; }
    if (tid == 0) X[len] = (f32x2){0.f, 0.f};
    const float scale0 = 1.f / sqrtf(block_sum(C, ss0, red) + EPS), scale1 = 1.f / sqrtf(block_sum(C, ss1, red) + EPS);
    __syncthreads();
    for (int n = 0; n < 2 + 2 * ((REPMASK >> 16) & 1); ++n) {
        if (n & 1) { for (int p = tid; p < len; p += 512) { const f32x2 t1 = Y1[p]; X[p] = (f32x2){t1.x, 0.f}; if (p >= 1) X[N - p] = (f32x2){t1.y, 0.f}; } if (tid == 0) X[len] = (f32x2){0.f, 0.f}; __syncthreads(); }
        FFT_FWD_P(X);
        const float scale = (n & 1) ? scale1 : scale0;
        for (int i = tid; i < N; i += 512) Ks[(size_t)(n & 1) * FFTN + i] = X[i] * scale;
        __syncthreads();
    }
    const bf16_t* zt = WSP(bf16_t, WS_ZT); const float* cw = INP(I_HYCW) + l * 3 * 768; const float* cb = INP(I_HYCB) + l * 768;
    const float bias0 = INP(I_HYBI)[l * 512 + c], bias1 = INP(I_HYBI)[l * 512 + 256 + c];
    float* hyt = WSP(float, WS_HYT) + (size_t)c * NT;
    const float inv_n = 1.0f / (float)N;
    const float cw0[3] = {cw[c], cw[768 + c], cw[1536 + c]}, cw1[3] = {cw[256 + c], cw[768 + 256 + c], cw[1536 + 256 + c]}, cw2[3] = {cw[512 + c], cw[768 + 512 + c], cw[1536 + 512 + c]};
    const float cb0 = cb[c], cb1 = cb[256 + c], cb2 = cb[512 + c];
    auto conv3 = [&](const bf16_t* zc, int row, int t, const float (&wv)[3], float bv) -> float {
        const bf16_t* zr = zc + row; float s = bv + wv[1] * bf2f(zr[0]);
        if (t > 0) s += wv[0] * bf2f(zr[-1]);
        if (t < len - 1) s += wv[2] * bf2f(zr[1]);
        return s; };
    const bf16_t* z0 = zt + (size_t)c * NT; const bf16_t* z1 = zt + (size_t)(256 + c) * NT; const bf16_t* z2 = zt + (size_t)(512 + c) * NT;
    for (int q2 = 0; q2 < NB * (1 + ((REPMASK >> 17) & 1)); q2 += 2) { const int q = q2 % NB;
        const int ra = row0 + q * len, rb = ra + len;
        float va[NI], vb[NI];
#pragma unroll
        for (int k = 0; k < NI; ++k) { const int t = tid + 512 * k; if (t < len) { va[k] = conv3(z0, ra + t, t, cw0, cb0); vb[k] = conv3(z0, rb + t, t, cw0, cb0); X[t] = (f32x2){va[k], vb[k]}; X[len + t] = (f32x2){0.f, 0.f}; } }
        __syncthreads();
        FFT_FWD_P(X);
#pragma unroll
        for (int k = 0; k < 2 * NI; ++k) { const int i = tid + 512 * k; if (i < N) { const f32x2 kk = Ks[i], x = X[i]; X[i] = (f32x2){x.x * kk.x - x.y * kk.y, x.x * kk.y + x.y * kk.x}; } }
        __syncthreads();
        fft_inv<N>(X, tw, tid);
        f32x2 y1[NI];
#pragma unroll
        for (int k = 0; k < NI; ++k) { const int t = tid + 512 * k; if (t < len) { const f32x2 cv = X[t] * inv_n; const float xa = conv3(z1, ra + t, t, cw1, cb1), xb = conv3(z1, rb + t, t, cw1, cb1);
            y1[k] = (f32x2){xa * (cv.x + bias0 * va[k]), xb * (cv.y + bias0 * vb[k])}; } }
        __syncthreads();
#pragma unroll
        for (int k = 0; k < NI; ++k) { const int t = tid + 512 * k; if (t < len) { Y1[t] = y1[k]; X[t] = y1[k]; X[len + t] = (f32x2){0.f, 0.f}; } }
        __syncthreads();
        FFT_FWD_P(X);
#pragma unroll
        for (int k = 0; k < 2 * NI; ++k) { const int i = tid + 512 * k; if (i < N) { const f32x2 kk = Ks[FFTN + i], x = X[i]; X[i] = (f32x2){x.x * kk.x - x.y * kk.y, x.x * kk.y + x.y * kk.x}; } }
        __syncthreads();
        fft_inv<N>(X, tw, tid);
#pragma unroll
        for (int k = 0; k < NI; ++k) { const int t = tid + 512 * k; if (t < len) { const f32x2 cv = X[t] * inv_n, yy = Y1[t]; const float xa = conv3(z2, ra + t, t, cw2, cb2), xb = conv3(z2, rb + t, t, cw2, cb2);
            hyt[ra + t] = xa * (cv.x + bias1 * yy.x); hyt[rb + t] = xb * (cv.y + bias1 * yy.y); } }
        __syncthreads();
    }
}
__device__ __forceinline__ void phase_mixers(Ctx& C, int l, int parts = 3) {
    const int G = C.G, me = C.bid;
    const int nscan = 3 * NSCAN, nsw = G > nscan ? nscan : G;
    if (parts & 1) for (int j = me; j < nscan; j += nsw) { if (me >= nsw) break;
        const int mix = j / NSCAN, r = j % NSCAN;
        if (mix == 0) hgrn_b_scan(C, r); else if (mix == 1) mlstm_b_scan(C, r); else gdn_b_scan(C, r); }
    if (parts & 2) {
        LAS f32x2* tw = (LAS f32x2*)(C.lds + 98304); volatile LAS int* jobw = (volatile LAS int*)(C.lds + LDSX_OFF + 192);
        __syncthreads();
        for (int k = C.tid; k < TWN; k += 512) { float s, c; sincospi_((float)k / (float)TWN, &s, &c); tw[k] = (f32x2){c, -s}; }
        __syncthreads();
        unsigned* qh = WSP(unsigned, WS_CTL) + CW_HYQ + 64 * l + ((parts == 2) ? 32 : 0);
        for (;;) {
            if (C.tid == 0) jobw[0] = (int)atomicAdd(qh, 1u);
            __syncthreads();
            const int c = jobw[0];
            __syncthreads();
            if (c >= 256) break;
            hyena_channel<SEQ>(C, l, c, 0, 0); if (l == 0) hyena_channel<LC>(C, l, c, NLAT, SEQ);
        }
    }
}
__device__ __forceinline__ void phase_finalize(Ctx& C, int l) {
    const int gw = C.vcu * 8 + C.wave, NGW = C.G * 8, lane = C.lane;
    const int nrows = (l == 0) ? NT : NLAT;
    const bf16_t* zb = WSP(bf16_t, WS_Z); bf16_t* mix = WSP(bf16_t, WS_MIX);
    LAS float* scr = (LAS float*)(C.lds + C.wave * 8448);
    const int ntr = nrows / 64;
    for (int it = gw; it < ntr * 8; it += NGW) { const int rt = it / 8, cb = (it % 8) * 32; const float* src = WSP(float, WS_HYT) + (size_t)cb * NT + rt * 64;
#pragma unroll 8
        for (int cc = 0; cc < 32; ++cc) scr[cc * 65 + lane] = src[(size_t)cc * NT + lane];
        LDS_WAIT(); asm volatile("" ::: "memory");
        for (int rr = 0; rr < 64; rr += 4) { const int r = rr + (lane >> 4), c2 = (lane & 15) * 2;
            *(unsigned*)(mix + (size_t)(rt * 64 + r) * D + 512 + cb + c2) = pk2(scr[c2 * 65 + r], scr[(c2 + 1) * 65 + r]); }
        LDS_WAIT(); asm volatile("" ::: "memory"); }
}

enum { PH_PRO = 0, PH_L0 = 1, PH_PER_LAYER = 10, PH_FINAL = PH_L0 + DEPTH * PH_PER_LAYER, PH_COUNT };
__global__ void __launch_bounds__(512, 2) fwd_kernel(Args args) {
#ifdef HOST_EMU
    unsigned char* lds = emu::cur->blk->lds;
#else
    extern __shared__ __attribute__((aligned(16))) unsigned char lds[];
#endif
#ifdef HOST_EMU
    Ctx C; C.lds = (LAS unsigned char*)lds; C.a = &args; C.ws = args.ws;
#else
    Ctx C; C.lds = (LAS unsigned char*)lds; C.a = (const __attribute__((address_space(4))) Args*)__builtin_amdgcn_kernarg_segment_ptr(); C.ws = C.a->ws;
#endif
    C.tid = threadIdx.x; C.lane = C.tid & 63; C.wave = __builtin_amdgcn_readfirstlane(C.tid >> 6);
    C.bid = blockIdx.x; C.G = gridDim.x; { const int bx = blockIdx.x; C.vcu = (C.G % 8 == 0) ? (bx % 8) * (C.G / 8) + bx / 8 : bx; }
    volatile LAS unsigned* MISC = (volatile LAS unsigned*)(C.lds + LDSX_OFF + LX_MISC);
    for (int u = C.tid; u < 64; u += 512) MISC[u] = 0u;
    __syncthreads();
    const int lo = C.a->ph_lo, hi = C.a->ph_hi;
    const bool multi = (hi - lo) > 1;
    XcdBarrier bar; bar.bar = WSP(unsigned, WS_CTL) + CW_BAR; bar.x = 0; bar.st = nullptr;
    if (multi) bar = xcd_barrier_post(WSP(unsigned, WS_CTL) + CW_BAR, MISC + 8);
#ifndef HOST_EMU
    if (multi) { cooperative_groups::this_grid().sync(); }
#endif
    const Ctx C0 = C;
#ifdef HOST_EMU
#define LAUNDER_CTX() Ctx C = C0; C.tid = threadIdx.x; C.lane = C.tid & 63; C.wave = C.tid >> 6;
#else
#define LAUNDER_CTX() Ctx C = C0; C.tid = threadIdx.x; \
        {   unsigned long long pw = (unsigned long long)C.ws, pa = (unsigned long long)C.a; unsigned w0 = (unsigned)pw, w1 = (unsigned)(pw >> 32), a0 = (unsigned)pa, a1 = (unsigned)(pa >> 32), v0 = (unsigned)C.vcu, g0 = (unsigned)C.G, b0 = (unsigned)C.bid; \
            asm volatile("" : "+v"(w0), "+v"(w1), "+v"(a0), "+v"(a1), "+v"(v0), "+v"(g0), "+v"(b0), "+v"(C.tid)); \
            w0 = __builtin_amdgcn_readfirstlane(w0); w1 = __builtin_amdgcn_readfirstlane(w1); a0 = __builtin_amdgcn_readfirstlane(a0); a1 = __builtin_amdgcn_readfirstlane(a1); \
            C.vcu = (int)__builtin_amdgcn_readfirstlane(v0); C.G = (int)__builtin_amdgcn_readfirstlane(g0); C.bid = (int)__builtin_amdgcn_readfirstlane(b0); \
            C.ws = (unsigned char*)(((unsigned long long)w1 << 32) | w0); C.a = (const __attribute__((address_space(4))) Args*)(((unsigned long long)a1 << 32) | a0); } \
        C.lane = C.tid & 63; C.wave = __builtin_amdgcn_readfirstlane(C.tid >> 6);
#endif
#define PH_BEGIN(k) if (lo <= (k) && (k) < hi) { LAUNDER_CTX()
#define PH_END(k) if ((k) + 1 < hi) { XcdBarrier b2 = bar; b2.bar = WSP(unsigned, WS_CTL) + CW_BAR; xcd_barrier(b2); } }
#define REP(b) ((REPMASK >> (b)) & 1)
    PH_BEGIN(PH_PRO) p0_prologue(C); if (REP(0)) { __syncthreads(); p0_prologue(C); } PH_END(PH_PRO)
#define LAYER_PHASES(l) { constexpr int pb = PH_L0 + (l) * PH_PER_LAYER; \
    PH_BEGIN(pb + 0) if ((l) > 0) (void)build_tiles(C, (l) > 0 ? (l) - 1 : 0); phase_rows_a(C, (l)); if (REP(13) && (l) == 0) { __syncthreads(); phase_rows_a(C, (l)); } PH_END(pb + 0) \
    PH_BEGIN(pb + 1) pg8::Gemm g{WSP(bf16_t, WS_H), WSP(bf16_t, WS_WIN) + (size_t)(l) * ZW * D, D, 0}; pg8::StaticOrder S; S.init(NT, ZW, C.G, C.bid); \
        pg8::EpiBf16 E{WSP(bf16_t, WS_Z), ZW, nullptr, 0}; pg8::gemm_phase(C.lds, g, S, E, C.tid); if (REP(1)) { __syncthreads(); pg8::gemm_phase(C.lds, g, S, E, C.tid); } PH_END(pb + 1) \
    PH_BEGIN(pb + 2) phase_hy_transpose(C); __syncthreads(); phase_gdn_a(C, (l)); if (REP(8)) { __syncthreads(); phase_gdn_a(C, (l)); } PH_END(pb + 2) \
    PH_BEGIN(pb + 3) phase_mixers(C, (l)); if (REP(2)) { __syncthreads(); phase_mixers(C, (l), 1); } if (REP(3)) { __syncthreads(); phase_mixers(C, (l), 2); } PH_END(pb + 3) \
    PH_BEGIN(pb + 4) phase_finalize(C, (l)); __syncthreads(); phase_gdn_c(C, (l)); if (REP(4)) { __syncthreads(); phase_finalize(C, (l)); } if (REP(9)) { __syncthreads(); phase_gdn_c(C, (l)); } PH_END(pb + 4) \
    PH_BEGIN(pb + 5) pg8::Gemm g{WSP(bf16_t, WS_MIX), WSP(bf16_t, WS_WOUT) + (size_t)(l) * D * D, D, 0}; pg8::StaticOrder S; S.init((l) == 0 ? NT : NLAT, D, C.G, C.bid); \
        pg8::EpiResid E{(l) == 0 ? INP(I_X) : WSP(float, WS_X), (l) == 0 ? INP(I_CTX) : WSP(float, WS_X) + (size_t)NLAT * D, WSP(float, WS_X), WSP(float, WS_MOD) + (size_t)(l) * (NB + 1) * 6 * D + 2 * D}; \
        pg8::gemm_phase(C.lds, g, S, E, C.tid); if (REP(14) && (l) == 0) { __syncthreads(); pg8::gemm_phase(C.lds, g, S, E, C.tid); } PH_END(pb + 5) \
    PH_BEGIN(pb + 6) phase_rows_b(C, (l)); PH_END(pb + 6) \
    PH_BEGIN(pb + 7) phase_gather(C, (l)); if (REP(5)) { __syncthreads(); phase_gather(C, (l)); } PH_END(pb + 7) \
    PH_BEGIN(pb + 8) const int ntiles = build_tiles(C, (l)); \
        pg8::Gemm g{WSP(bf16_t, WS_HS), WSP(bf16_t, WS_W1) + (size_t)(l) * NE * 2 * DE * D, D, (size_t)2 * DE * D}; pg8::MoeOrder S; S.init(ntiles, 2 * DE, C.G, C.bid, (const LAS int*)(C.lds + LDSX_OFF + LX_TILE)); \
        pg8::EpiSwiglu E{WSP(bf16_t, WS_A2), INP(I_EB1) + (size_t)(l) * NE * 2 * DE}; pg8::gemm_phase(C.lds, g, S, E, C.tid); if (REP(6)) { __syncthreads(); pg8::gemm_phase(C.lds, g, S, E, C.tid); } PH_END(pb + 8) \
    PH_BEGIN(pb + 9) const int ntiles = build_tiles(C, (l)); \
        pg8::Gemm g{WSP(bf16_t, WS_A2), WSP(bf16_t, WS_W2) + (size_t)(l) * NE * D * DE, DE, (size_t)D * DE}; pg8::MoeOrder S; S.init(ntiles, D, C.G, C.bid, (const LAS int*)(C.lds + LDSX_OFF + LX_TILE)); \
        pg8::EpiBf16 E{WSP(bf16_t, WS_Y), D, INP(I_EB2) + (size_t)(l) * NE * D, D}; pg8::gemm_phase(C.lds, g, S, E, C.tid); if (REP(7)) { __syncthreads(); pg8::gemm_phase(C.lds, g, S, E, C.tid); } PH_END(pb + 9) }
    LAYER_PHASES(0)
    LAYER_PHASES(1)
    static_assert(DEPTH == 2, "two layers written out");
    PH_BEGIN(PH_FINAL) (void)build_tiles(C, DEPTH - 1); phase_rows_a(C, DEPTH); PH_END(PH_FINAL)
}

#ifndef MK_PER_PHASE
#define MK_PER_PHASE 0
#endif
extern "C" void kernel_launch(void* const* d_in, const int* in_sizes, int n_in, void* d_out, int out_size, void* d_ws, size_t ws_size, hipStream_t stream) {
    static int grid = 0;
#ifndef HOST_EMU
    if (grid == 0) {
        if (n_in != 34 || ws_size < WS_END) { fprintf(stderr, "kernel_launch: unexpected n_in %d / ws %zu (need %zu)\n", n_in, ws_size, (size_t)WS_END); grid = -1; return; }
        int dev = 0, cus = 0, per_cu = 0;
        hipGetDevice(&dev); hipDeviceGetAttribute(&cus, hipDeviceAttributeMultiprocessorCount, dev);
        hipFuncSetAttribute((const void*)fwd_kernel, hipFuncAttributeMaxDynamicSharedMemorySize, LDS_BYTES);
        hipOccupancyMaxActiveBlocksPerMultiprocessor(&per_cu, (const void*)fwd_kernel, 512, LDS_BYTES);
        if (per_cu < 1) { fprintf(stderr, "kernel_launch: occupancy query says %d blocks per CU\n", per_cu); per_cu = 1; }
        grid = cus;
        (void)hipGetLastError();
    }
    if (grid < 0) return;
#else
    grid = EMU_GRID;
#endif
    hipMemsetAsync((char*)d_ws + WS_CTL, 0, CTL_BYTES, stream);
    Args a{};
    for (int i = 0; i < 34; ++i) a.in[i] = (const float*)d_in[i];
    a.out = (float*)d_out; a.ws = (unsigned char*)d_ws;
#ifdef HOST_EMU
    a.ph_lo = 0; a.ph_hi = PH_COUNT;
    if (getenv("EMU_PH_HI")) a.ph_hi = atoi(getenv("EMU_PH_HI"));
    emu::launch([&]() { fwd_kernel(a); }, dim3(grid), dim3(512), LDS_BYTES);
#else
#if MK_PER_PHASE
    for (int ph = 0; ph < PH_COUNT; ++ph) { a.ph_lo = ph; a.ph_hi = ph + 1; hipLaunchKernelGGL(fwd_kernel, dim3(grid), dim3(512), LDS_BYTES, stream, a); }
#else
    a.ph_lo = 0; a.ph_hi = PH_COUNT;
    void* kargs[] = {&a};
    hipError_t e = hipLaunchCooperativeKernel((const void*)fwd_kernel, dim3(grid), dim3(512), kargs, LDS_BYTES, stream);
    if (e != hipSuccess) fprintf(stderr, "cooperative launch failed: %s (grid %d)\n", hipGetErrorString(e), grid);
#endif
#endif
}
```

```cpp
#ifdef HOST_EMU
#include "host/emu.h"
#else
#include <hip/hip_runtime.h>
#include <hip/hip_cooperative_groups.h>
#endif
#include <cstdio>
#include <cstdint>
#include <cmath>
#ifndef REPMASK
#define REPMASK 0
#endif

#ifndef CFG_B
#define CFG_B 4
#define CFG_L 4096
#define CFG_GW 64
#define CFG_LC 256
#define CFG_NE 32
#endif
constexpr int NB = CFG_B, SEQ = CFG_L, GW = CFG_GW, GROWS = SEQ / GW, LC = CFG_LC, NE = CFG_NE, TOPK = 4, DEPTH = 2;
constexpr int D = 1024, WG_ = 256, NH = 4, DH = 64;
constexpr int NLAT = NB * SEQ, NCTX = NB * LC, NT = NLAT + NCTX;
constexpr int IN_W = 4128, ZW = 4096;
constexpr int HGB = 0, MLB = 1280, HYB = 2304, GDB = 3072;
constexpr int DE = 1024;
constexpr float EPS = 1e-6f;
constexpr int FFTN = 2 * SEQ, FFTNC = 2 * LC, TWN = FFTN / 2;
static_assert(NT % 256 == 0 && NLAT % 256 == 0, "row counts must be multiples of 256");
static_assert(SEQ % 16 == 0 && LC % 16 == 0, "chunking");
constexpr int MAXTILES = (NT * TOPK + NE * 255) / 256 + 1;

constexpr size_t al256(size_t x) { return (x + 255) & ~(size_t)255; }
constexpr size_t WS_CTL = 0, CTL_BYTES = 1 << 20;
constexpr size_t WS_WIN = WS_CTL + CTL_BYTES;
constexpr size_t WS_WOUT = WS_WIN + (size_t)DEPTH * ZW * D * 2;
constexpr size_t WS_W1 = WS_WOUT + (size_t)DEPTH * D * D * 2;
constexpr size_t WS_W2 = WS_W1 + (size_t)DEPTH * NE * 2 * DE * D * 2;
constexpr size_t WS_WG = WS_W2 + (size_t)DEPTH * NE * D * DE * 2;
constexpr size_t WS_WR = WS_WG + (size_t)DEPTH * 32 * D * 4;
constexpr size_t WS_MOD = WS_WR + (size_t)DEPTH * NE * D * 4;
constexpr size_t WS_LB = WS_MOD + al256((size_t)DEPTH * (NB + 1) * 6 * D * 4);
constexpr size_t WS_HDN = WS_LB + (size_t)DEPTH * 256 * 4;
constexpr size_t WS_X = WS_HDN + (size_t)DEPTH * (SEQ + LC) * 64 * 4;
constexpr size_t WS_H = WS_X + (size_t)NT * D * 4;
constexpr size_t WS_Z = WS_H + (size_t)NT * D * 2;
constexpr size_t WS_ZG = WS_Z + (size_t)NT * ZW * 2;
constexpr size_t WS_MIX = WS_ZG + (size_t)NT * 32 * 4;
constexpr size_t WS_OB = WS_MIX + (size_t)NT * D * 2;
constexpr size_t WS_HYT = WS_OB + (size_t)6 * NT * 256 * 4;
constexpr size_t WS_KS = WS_HYT + (size_t)256 * NT * 4;
constexpr size_t WS_TOP = WS_KS + (size_t)256 * 2 * FFTN * 8;
constexpr size_t WS_HS = WS_TOP + (size_t)NT * 4 * 12;
constexpr size_t WS_A2 = WS_HS + (size_t)MAXTILES * 256 * D * 2;
constexpr size_t WS_Y = WS_A2 + (size_t)MAXTILES * 256 * DE * 2;
constexpr int NCH = (LC + SEQ) / 64, NCHC = LC / 64, NSCAN = NB * NH * 2;
constexpr size_t GD_BLOB = 49152;
constexpr size_t WS_GD = WS_Y + (size_t)MAXTILES * 256 * D * 2;
constexpr size_t WS_GST = WS_GD + (size_t)NSCAN * NCH * GD_BLOB;
constexpr size_t ML_BLOB = 34816;
constexpr size_t WS_ML = WS_GST + (size_t)NSCAN * NCH * 8192;
constexpr size_t ML_ST = 8192 + 512;
constexpr size_t WS_MST = WS_ML + (size_t)NSCAN * NCH * ML_BLOB;
constexpr size_t HG_BLOB = 58368;
constexpr size_t WS_HG = WS_MST + (size_t)NSCAN * NCH * ML_ST;
constexpr size_t WS_HST = WS_HG + (size_t)NSCAN * NCH * HG_BLOB;
constexpr size_t WS_ZT = WS_HST + (size_t)NSCAN * NCH * 4 * 8192;
constexpr size_t WS_END = WS_ZT + (size_t)768 * NT * 2;
static_assert(SEQ % 64 == 0 && LC % 64 == 0, "64-token chunks");
constexpr int CW_CNT = 64;
constexpr int CW_HYQ = 192;
constexpr int CW_BAR = 4096;

constexpr int RING_BYTES = 131072, LDSX_OFF = RING_BYTES, LDS_BYTES = 147456;
constexpr int LX_MISC = 0, LX_TILE = 256;

#ifdef HOST_EMU
#define __expf expf
#define __logf logf
#define __sinf sinf
#define __cosf cosf
#define LAS
#define GAS
#define DEV_ASM(x) ((void)0)
#define VM_WAIT() ((void)0)
#define LDS_WAIT() do { int _s; (void)emu::wave_xchg(&_s, 4, _s); } while (0)
#else
#define LAS __attribute__((address_space(3)))
#define GAS __attribute__((address_space(1)))
#define VM_WAIT() asm volatile("s_waitcnt vmcnt(0)" ::: "memory")
#define LDS_WAIT() asm volatile("s_waitcnt lgkmcnt(0)" ::: "memory")
#endif
typedef unsigned short bf16_t;
typedef short bf16x8 __attribute__((ext_vector_type(8)));
typedef float f32x4 __attribute__((ext_vector_type(4)));
typedef float f32x2 __attribute__((ext_vector_type(2)));
typedef unsigned u32x4 __attribute__((ext_vector_type(4)));
typedef unsigned u32x2 __attribute__((ext_vector_type(2)));

__device__ __forceinline__ float u2f(unsigned u) { float f; __builtin_memcpy(&f, &u, 4); return f; }
__device__ __forceinline__ unsigned f2u(float f) { unsigned u; __builtin_memcpy(&u, &f, 4); return u; }
__device__ __forceinline__ float bf2f(bf16_t b) { return u2f((unsigned)b << 16); }
__device__ __forceinline__ unsigned f2bf(float f) { unsigned u = f2u(f); return (u + 0x7fffu + ((u >> 16) & 1u)) >> 16; }
__device__ __forceinline__ unsigned pk2(float lo, float hi) { return f2bf(lo) | (f2bf(hi) << 16); }
__device__ __forceinline__ unsigned cvt_pk_bf16(float lo, float hi) {
#ifdef HOST_EMU
    return pk2(lo, hi);
#else
    unsigned r; asm volatile("v_cvt_pk_bf16_f32 %0, %1, %2" : "=v"(r) : "v"(lo), "v"(hi)); return r;
#endif
}
__device__ __forceinline__ float wave_sum(float v) {
#pragma unroll
    for (int o = 1; o < 64; o <<= 1) v += __shfl_xor(v, o);
    return v;
}
__device__ __forceinline__ float sigmoidf_(float x) { return 1.f / (1.f + __expf(-x)); }
__device__ __forceinline__ float siluf_(float x) { return x * sigmoidf_(x); }
__device__ __forceinline__ float softplusf_(float x) { return x > 20.f ? x : log1pf(__expf(x)); }
__device__ __forceinline__ float logsigmoidf_(float x) { return x < -20.f ? x : -log1pf(__expf(-x)); }
#ifdef HOST_EMU
static inline void sincospi_(float x, float* s, float* c) { *s = (float)sin(M_PI * (double)x); *c = (float)cos(M_PI * (double)x); }
#else
__device__ __forceinline__ void sincospi_(float x, float* s, float* c) { sincospif(x, s, c); }
#endif

namespace pg8 {
constexpr int BM = 256, BK = 64, HALF = 128, HTB = HALF * BK * 2, STAGE_BYTES = 8 * HTB, NXCD = 8, WGM = 8;
__host__ __device__ __forceinline__ int lds_byte(int r, int c) { const int st = (r >> 4) * 2 + (c >> 5), rr = r & 15, cc = c & 31, ob = rr * 64 + cc * 2; return st * 1024 + (ob ^ (((ob >> 9) & 1) << 5)); }
__host__ __device__ __forceinline__ void stage_rc(int b, int& R, int& C) { const int st = b / 1024, sb = b % 1024, swz = sb ^ (((sb >> 9) & 1) << 5); R = (st >> 1) * 16 + swz / 64; C = (st & 1) * 32 + (swz % 64) / 2; }
__host__ __device__ __forceinline__ int perm32(int rho) { const int n = rho >> 4, i = rho & 15; return 8 * (i >> 2) + 4 * n + (i & 3); }

struct Unit { int pm, pn, e; };
struct Gemm { const bf16_t* A; const bf16_t* Bt; int K; size_t bexp; };

__host__ __device__ __forceinline__ int xcd_remap(int L, int nwg) { const int q = nwg / NXCD, r = nwg % NXCD, xcd = L % NXCD, off = L / NXCD; return (xcd < r ? xcd * (q + 1) : r * (q + 1) + (xcd - r) * q) + off; }
struct StaticOrder {
    int nM, nN, nwg, G, c;
    __host__ __device__ void init(int M, int N, int G_, int c_) { nM = M / BM; nN = N / BM; nwg = nM * nN; G = G_; c = c_; }
    __host__ __device__ bool next(int i, Unit& u) const {
        const long L = (long)i * G + c; if (L >= nwg) return false;
        const int wgid = xcd_remap((int)L, nwg);
        const int nig = WGM * nN, gid = wgid / nig, fm = gid * WGM, gsz = (nM - fm) < WGM ? (nM - fm) : WGM;
        u.pm = fm + ((wgid % nig) % gsz); u.pn = (wgid % nig) / gsz; u.e = 0; return true;
    }
};
struct MoeOrder {
    int ntiles, nN, nwg, G, c; const LAS int* tile_e;
    __device__ void init(int ntiles_, int N, int G_, int c_, const LAS int* te) { ntiles = ntiles_; nN = N / BM; nwg = ntiles * nN; G = G_; c = c_; tile_e = te; }
    __device__ bool next(int i, Unit& u) const {
        const long L = (long)i * G + c; if (L >= nwg) return false;
        const int wgid = xcd_remap((int)L, nwg);
        u.pm = wgid / nN; u.pn = wgid % nN; u.e = __builtin_amdgcn_readfirstlane(tile_e[u.pm]); return true;
    }
};

struct EpiBf16 {
    static constexpr bool PERM = true;
    bf16_t* O; int ldc; const float* bias; int bias_estride;
    __device__ __forceinline__ void operator()(const f32x4 (&acc)[2][2][4][2], const Unit& u, int wr, int wc, int fr, int fq) const {
        const int row0 = u.pm * BM + wr * 64 + fr, col0 = u.pn * BM + wc * 32 + 8 * fq;
        f32x4 bv[2][2];
#pragma unroll
        for (int bj = 0; bj < 2; ++bj)
#pragma unroll
            for (int n = 0; n < 2; ++n) bv[bj][n] = bias ? *(const f32x4*)(bias + (size_t)u.e * bias_estride + col0 + bj * HALF + 4 * n) : (f32x4){0.f, 0.f, 0.f, 0.f};
#pragma unroll
        for (int ai = 0; ai < 2; ++ai)
#pragma unroll
            for (int m = 0; m < 4; ++m) { bf16_t* rowp = O + (size_t)(row0 + ai * HALF + m * 16) * ldc + col0;
#pragma unroll
                for (int bj = 0; bj < 2; ++bj) { const f32x4 v0 = acc[ai][bj][m][0] + bv[bj][0], v1 = acc[ai][bj][m][1] + bv[bj][1];
                    u32x4 w; w.x = cvt_pk_bf16(v0[0], v0[1]); w.y = cvt_pk_bf16(v0[2], v0[3]); w.z = cvt_pk_bf16(v1[0], v1[1]); w.w = cvt_pk_bf16(v1[2], v1[3]);
                    *(u32x4*)(rowp + bj * HALF) = w; } }
    }
};
struct EpiSwiglu {
    static constexpr bool PERM = true;
    bf16_t* O; const float* b1;
    __device__ __forceinline__ void operator()(const f32x4 (&acc)[2][2][4][2], const Unit& u, int wr, int wc, int fr, int fq) const {
        const int row0 = u.pm * BM + wr * 64 + fr, cj = u.pn * HALF + wc * 32 + 8 * fq;
        const float* bb = b1 + (size_t)u.e * 2 * DE;
        f32x4 bg[2], bl[2];
#pragma unroll
        for (int n = 0; n < 2; ++n) { bg[n] = *(const f32x4*)(bb + cj + 4 * n); bl[n] = *(const f32x4*)(bb + DE + cj + 4 * n); }
#pragma unroll
        for (int ai = 0; ai < 2; ++ai)
#pragma unroll
            for (int m = 0; m < 4; ++m) { bf16_t* rowp = O + (size_t)(row0 + ai * HALF + m * 16) * DE + cj;
                float y[8];
#pragma unroll
                for (int n = 0; n < 2; ++n) { const f32x4 g = acc[ai][0][m][n] + bg[n], l = acc[ai][1][m][n] + bl[n];
#pragma unroll
                    for (int j = 0; j < 4; ++j) { const float gg = fminf(g[j], 7.0f), ll = fminf(fmaxf(l[j], -7.0f), 7.0f); y[4 * n + j] = (ll + 1.0f) * gg * (1.f / (1.f + __expf(-1.702f * gg))); } }
                u32x4 w; w.x = cvt_pk_bf16(y[0], y[1]); w.y = cvt_pk_bf16(y[2], y[3]); w.z = cvt_pk_bf16(y[4], y[5]); w.w = cvt_pk_bf16(y[6], y[7]);
                *(u32x4*)rowp = w; }
    }
};
struct EpiResid {
    static constexpr bool PERM = false;
    const float* base0; const float* base1; float* out; const float* g;
    __device__ __forceinline__ void operator()(const f32x4 (&acc)[2][2][4][2], const Unit& u, int wr, int wc, int fr, int fq) const {
        const int col0 = u.pn * BM + wc * 32 + 4 * fq;
#pragma unroll
        for (int ai = 0; ai < 2; ++ai)
#pragma unroll
            for (int m = 0; m < 4; ++m) { const int r = u.pm * BM + ai * HALF + wr * 64 + m * 16 + fr;
                const float* bp = (r < NLAT) ? base0 + (size_t)r * D : base1 + (size_t)(r - NLAT) * D; const int bb = (r < NLAT) ? r / SEQ : NB;
                const float* gp = g + (size_t)bb * 6 * D;
#pragma unroll
                for (int bj = 0; bj < 2; ++bj)
#pragma unroll
                    for (int n = 0; n < 2; ++n) { const int c = col0 + bj * HALF + n * 16; const f32x4 bs = *(const f32x4*)(bp + c), gv = *(const f32x4*)(gp + c);
                        *(f32x4*)(out + (size_t)r * D + c) = bs + gv * acc[ai][bj][m][n]; } }
    }
};

#ifdef HOST_EMU
#define PG8_WAIT_V(n) ((void)0)
#define PG8_WAIT_L(n) ((void)0)
#else
#define PG8_WAIT_V(n) asm volatile("s_waitcnt vmcnt(" #n ")" ::: "memory")
#define PG8_WAIT_L(n) asm volatile("s_waitcnt lgkmcnt(" #n ")" ::: "memory")
#endif
template <class Epi, class Sched>
__device__ __forceinline__ void gemm_phase(LAS unsigned char* lds, const Gemm g, const Sched& S, const Epi& E, const int tid) {
    const int wid = __builtin_amdgcn_readfirstlane(tid >> 6), lane = tid & 63, wr = wid >> 2, wc = wid & 3, fr = lane & 15, fq = lane >> 4;
    const int K = g.K, nt = K / BK;
    unsigned voffA[2], voffB[2];
#pragma unroll
    for (int i = 0; i < 2; ++i) { int R, C; stage_rc(tid * 16 + i * 8192, R, C); const int Rb = Epi::PERM ? ((R & ~31) + perm32(R & 31)) : R;
        voffA[i] = (unsigned)(R * K + C) * 2u; voffB[i] = (unsigned)(Rb * K + C) * 2u; }
    const size_t kstep = (size_t)(BK * 2);
    const size_t hstep = (size_t)HALF * K * 2;
    const size_t tstep = 2 * hstep;
    const unsigned ldsw = (unsigned)wid * 1024u;
    const int aoff = lds_byte(wr * 64 + fr, fq * 8), boff = lds_byte(wc * 32 + fr, fq * 8);
#define PG8_SA(b, h) (((b) * 2 + (h)) * HTB)
#define PG8_SB(b, h) ((4 + (b) * 2 + (h)) * HTB)
#define PG8_STAGE(bufoff, gbase, voff) do { _Pragma("unroll") for (int _i = 0; _i < 2; ++_i) \
        __builtin_amdgcn_global_load_lds((const unsigned*)((const char*)(gbase) + (voff)[_i]), (LAS unsigned*)(lds + (bufoff) + ldsw + _i * 8192), 16, 0, 0); } while (0)
#define PG8_LDA(dst, b, h) do { _Pragma("unroll") for (int m = 0; m < 4; ++m) _Pragma("unroll") for (int k = 0; k < 2; ++k) dst[m][k] = *(const LAS bf16x8*)(lds + PG8_SA(b, h) + aoff + m * 2048 + k * 1024); } while (0)
#define PG8_LDB(dst, b, h) do { _Pragma("unroll") for (int n = 0; n < 2; ++n) _Pragma("unroll") for (int k = 0; k < 2; ++k) dst[n][k] = *(const LAS bf16x8*)(lds + PG8_SB(b, h) + boff + n * 2048 + k * 1024); } while (0)
#define PG8_MMA(ai, bj, At, Bt) do { __builtin_amdgcn_s_setprio(1); _Pragma("unroll") for (int m = 0; m < 4; ++m) _Pragma("unroll") for (int n = 0; n < 2; ++n) _Pragma("unroll") for (int k = 0; k < 2; ++k) \
        acc[ai][bj][m][n] = __builtin_amdgcn_mfma_f32_16x16x32_bf16(Bt[n][k], At[m][k], acc[ai][bj][m][n], 0, 0, 0); __builtin_amdgcn_s_setprio(0); } while (0)
#define PG8_BAR __builtin_amdgcn_s_barrier()
#define PG8_SCHED __builtin_amdgcn_sched_barrier(0)
    Unit cur, nxt; int ui = 0;
    if (!S.next(0, cur)) return;
    f32x4 acc[2][2][4][2];
#pragma unroll
    for (int a = 0; a < 2; ++a)
#pragma unroll
        for (int b = 0; b < 2; ++b)
#pragma unroll
            for (int m = 0; m < 4; ++m)
#pragma unroll
                for (int n = 0; n < 2; ++n) acc[a][b][m][n] = (f32x4){0.f, 0.f, 0.f, 0.f};
    bf16x8 At[4][2], B0[2][2], B1[2][2];
    const char* cA = (const char*)g.A + (size_t)cur.pm * tstep; const char* cB = (const char*)(g.Bt + (size_t)cur.e * g.bexp) + (size_t)cur.pn * tstep;
    PG8_STAGE(PG8_SB(0, 0), cB, voffB); PG8_STAGE(PG8_SB(0, 1), cB + hstep, voffB); PG8_STAGE(PG8_SA(0, 0), cA, voffA); PG8_STAGE(PG8_SA(0, 1), cA + hstep, voffA);
    if (wr == 1) PG8_BAR;
    PG8_WAIT_V(2); PG8_BAR;
    PG8_STAGE(PG8_SB(1, 0), cB + kstep, voffB); PG8_STAGE(PG8_SA(1, 0), cA + kstep, voffA); PG8_STAGE(PG8_SB(1, 1), cB + hstep + kstep, voffB);
    PG8_WAIT_V(6); PG8_BAR;
    for (;;) {
        const bool has_next = S.next(ui + 1, nxt);
        const char* nA = has_next ? (const char*)g.A + (size_t)nxt.pm * tstep : cA; const char* nB = has_next ? (const char*)(g.Bt + (size_t)nxt.e * g.bexp) + (size_t)nxt.pn * tstep : cB;
        for (int t = 0; t < nt; t += 2) {
            const bool last = (t == nt - 2);
            const char* a1 = cA + (size_t)(t + 1) * kstep;
            const char* a2 = last ? nA : cA + (size_t)(t + 2) * kstep; const char* b2 = last ? nB : cB + (size_t)(t + 2) * kstep;
            const char* a3 = a2 + kstep; const char* b3 = b2 + kstep;
            PG8_LDB(B0, 0, 0); PG8_LDB(B1, 0, 1); PG8_SCHED; PG8_LDA(At, 0, 0); PG8_STAGE(PG8_SA(1, 1), a1 + hstep, voffA);
            PG8_WAIT_V(8); PG8_WAIT_L(0); PG8_BAR; PG8_MMA(0, 0, At, B0); PG8_MMA(0, 1, At, B1); PG8_BAR; PG8_SCHED;
            PG8_LDA(At, 0, 1); PG8_STAGE(PG8_SB(0, 0), b2, voffB); PG8_STAGE(PG8_SB(0, 1), b2 + hstep, voffB); PG8_STAGE(PG8_SA(0, 0), a2, voffA);
            PG8_WAIT_V(8); PG8_WAIT_L(0); PG8_BAR; PG8_MMA(1, 0, At, B0); PG8_MMA(1, 1, At, B1); PG8_BAR; PG8_SCHED;
            PG8_LDB(B0, 1, 0); PG8_LDB(B1, 1, 1); PG8_SCHED; PG8_LDA(At, 1, 0); PG8_STAGE(PG8_SA(0, 1), a2 + hstep, voffA);
            PG8_WAIT_V(8); PG8_WAIT_L(0); PG8_BAR; PG8_MMA(0, 0, At, B0); PG8_MMA(0, 1, At, B1); PG8_BAR; PG8_SCHED;
            PG8_LDA(At, 1, 1); PG8_STAGE(PG8_SB(1, 0), b3, voffB); PG8_STAGE(PG8_SB(1, 1), b3 + hstep, voffB); PG8_STAGE(PG8_SA(1, 0), a3, voffA);
            PG8_WAIT_V(8); PG8_WAIT_L(0); PG8_BAR; PG8_MMA(1, 0, At, B0); PG8_MMA(1, 1, At, B1); PG8_BAR; PG8_SCHED;
        }
        if (wr == 0) PG8_BAR;
        {
            int t2 = threadIdx.x;
#ifndef HOST_EMU
            asm volatile("" : "+v"(t2));
#endif
            const int wid2 = __builtin_amdgcn_readfirstlane(t2 >> 6), lane2 = t2 & 63;
            E(acc, cur, wid2 >> 2, wid2 & 3, lane2 & 15, lane2 >> 4);
        }
        if (!has_next) break;
#pragma unroll
        for (int a = 0; a < 2; ++a)
#pragma unroll
            for (int b = 0; b < 2; ++b)
#pragma unroll
                for (int m = 0; m < 4; ++m)
#pragma unroll
                    for (int n = 0; n < 2; ++n) acc[a][b][m][n] = (f32x4){0.f, 0.f, 0.f, 0.f};
        cur = nxt; cA = nA; cB = nB; ++ui;
        if (wr == 1) PG8_BAR;
    }
    PG8_WAIT_V(0);
    PG8_BAR;
#undef PG8_SA
#undef PG8_SB
#undef PG8_STAGE
#undef PG8_LDA
#undef PG8_LDB
#undef PG8_MMA
#undef PG8_BAR
#undef PG8_SCHED
}
}

#define XB_TMO      128
#define XB_XCNT(j)  (256  + 64 * (j))
#define XB_XSUB(j)  (1280 + 64 * (j))
#define XB_XGEN(j)  (2304 + 64 * (j))
#define XB_TOP      3328
#define XB_TOPGEN   3392
#define XCD_BAR_WORDS 3456
#define XB_SPIN_CAP (1u << 22)
#ifdef HOST_EMU
__device__ __forceinline__ unsigned xb_ld(unsigned* p) { return *(volatile unsigned*)p; }
__device__ __forceinline__ unsigned xb_add(unsigned* p, unsigned v) { unsigned o = *p; *p = o + v; return o; }
__device__ __forceinline__ unsigned xb_xcc_id() { return blockIdx.x % 8; }
__device__ __forceinline__ unsigned atomicAdd(unsigned* p, unsigned v) { unsigned o = *p; *p = o + v; return o; }
__device__ __forceinline__ int atomicAdd(int* p, int v) { int o = *p; *p = o + v; return o; }
#else
__device__ __forceinline__ unsigned xb_ld(unsigned* p)              { return __hip_atomic_load(p, __ATOMIC_RELAXED, __HIP_MEMORY_SCOPE_AGENT); }
__device__ __forceinline__ unsigned xb_add(unsigned* p, unsigned v) { return __hip_atomic_fetch_add(p, v, __ATOMIC_RELAXED, __HIP_MEMORY_SCOPE_AGENT); }
__device__ __forceinline__ unsigned xb_xcc_id() { return (unsigned)__builtin_amdgcn_s_getreg((3 << 11) | 20) & 0xFu; }
#endif
#define XB_SPIN(cond, bar) do { unsigned _sp = 0; while (cond) { __builtin_amdgcn_s_sleep(1); \
    if ((++_sp & 255u) == 0u) { if (xb_ld(&(bar)[XB_TMO])) break; if (_sp > XB_SPIN_CAP) { atomicAdd(&(bar)[XB_TMO], 1u); break; } } } } while (0)
struct XcdBarrier { unsigned* bar; unsigned x; volatile LAS unsigned* st; };
__device__ __forceinline__ XcdBarrier xcd_barrier_post(unsigned* bar, volatile LAS unsigned* st) {
    XcdBarrier b; b.bar = bar; b.x = xb_xcc_id(); b.st = st;
    if (threadIdx.x == 0) (void)xb_add(&bar[XB_XCNT(b.x)], 1u);
    return b;
}
__device__ __forceinline__ void xcd_barrier_complete(unsigned* bar, unsigned x, unsigned& nloc, unsigned& nx) {
    const unsigned G = gridDim.x;
    unsigned sum, cnt, mine, sp = 0u;
    for (;;) {
        sum = 0u; cnt = 0u; mine = 0u;
#pragma unroll
        for (unsigned j = 0; j < 16; ++j) { const unsigned c = xb_ld(&bar[XB_XCNT(j)]); sum += c; cnt += (c > 0u) ? 1u : 0u; mine = (j == x) ? c : mine; }
        if (sum == G) break;
        __builtin_amdgcn_s_sleep(1);
        if ((++sp & 255u) == 0u) { if (xb_ld(&bar[XB_TMO])) break; if (sp > XB_SPIN_CAP) { atomicAdd(&bar[XB_TMO], 1u); break; } }
    }
    nloc = mine > 0u ? mine : 1u; nx = cnt > 0u ? cnt : 1u;
}
__device__ __forceinline__ void xcd_barrier(const XcdBarrier& b) {
    VM_WAIT();
    __syncthreads();
    if (threadIdx.x == 0) {
        unsigned* bar = b.bar;
        __builtin_amdgcn_s_waitcnt(0);
        unsigned nloc = b.st[0], nx = b.st[1];
        if (nloc == 0u) { xcd_barrier_complete(bar, b.x, nloc, nx); b.st[0] = nloc; b.st[1] = nx; }
        const unsigned old = xb_add(&bar[XB_XSUB(b.x)], 1u);
        const unsigned gen = old / nloc;
        if (old + 1u == (gen + 1u) * nloc) {
            __builtin_amdgcn_fence(__ATOMIC_RELEASE, "agent");
            VM_WAIT();
            const unsigned og = xb_add(&bar[XB_TOP], 1u);
            const unsigned tg = og / nx;
            if (og + 1u == (tg + 1u) * nx) xb_add(&bar[XB_TOPGEN], 1u);
            else XB_SPIN(xb_ld(&bar[XB_TOPGEN]) == tg, bar);
            __builtin_amdgcn_fence(__ATOMIC_ACQUIRE, "agent");
            xb_add(&bar[XB_XGEN(b.x)], 1u);
            VM_WAIT();
        } else {
            XB_SPIN(xb_ld(&bar[XB_XGEN(b.x)]) == gen, bar);
            __builtin_amdgcn_fence(__ATOMIC_ACQUIRE, "agent");
            VM_WAIT();
        }
    }
    __syncthreads();
}

struct Args {
    const float* in[34]; float* out; unsigned char* ws; int ph_lo, ph_hi;
};
enum { I_X = 0, I_C, I_CTX, I_CCTX, I_MODW, I_MODB, I_N1, I_N2, I_WIN, I_WOUT, I_HGLB, I_HGNG, I_MLGB, I_MLNG, I_HYCW, I_HYCB, I_HYW1, I_HYB1, I_HYW2, I_HYB2, I_HYFR, I_HYW3,
       I_HYBI, I_GDCW, I_GDAL, I_GDDT, I_GDNG, I_RW, I_RB, I_EW1, I_EB1, I_EW2, I_EB2, I_FG };
struct Ctx {
#ifdef HOST_EMU
    LAS unsigned char* lds; const Args* a; unsigned char* ws;
#else
    LAS unsigned char* lds; const __attribute__((address_space(4))) Args* a; unsigned char* ws;
#endif
    int tid, lane, wave, vcu, G, bid;
};
#define WSP(T, off) ((T*)(C.ws + (off)))
#define INP(i) (C.a->in[i])

__device__ __forceinline__ const float* xrow_l0(const Ctx& C, int r) { return r < NLAT ? INP(I_X) + (size_t)r * D : INP(I_CTX) + (size_t)(r - NLAT) * D; }
__device__ __forceinline__ int row_batch(int r) { return r < NLAT ? r / SEQ : NB; }

__device__ __forceinline__ void transpose_item(const float* W, int ldw, int K, bf16_t* WT, int k0, int nsrc0, int ndst0, LAS float* scr, int lane) {
#pragma unroll 8
    for (int i = 0; i < 32; ++i) { const int kk = 2 * i + (lane >> 5); scr[kk * 33 + (lane & 31)] = W[(size_t)(k0 + kk) * ldw + nsrc0 + (lane & 31)]; }
    LDS_WAIT(); asm volatile("" ::: "memory");
    const int c = lane & 7;
#pragma unroll
    for (int j = 0; j < 4; ++j) { const int n = (lane >> 3) + 8 * j; const LAS float* s = scr + (8 * c) * 33 + n;
        u32x4 o; o.x = pk2(s[0 * 33], s[1 * 33]); o.y = pk2(s[2 * 33], s[3 * 33]); o.z = pk2(s[4 * 33], s[5 * 33]); o.w = pk2(s[6 * 33], s[7 * 33]);
        *(u32x4*)(WT + (size_t)(ndst0 + n) * K + k0 + 8 * c) = o; }
    LDS_WAIT(); asm volatile("" ::: "memory");
}
__device__ __forceinline__ void p0_prologue(Ctx& C) {
    LAS float* scr = (LAS float*)(C.lds + C.wave * 16384);
    const int gw = C.vcu * 8 + C.wave, NGW = C.G * 8, lane = C.lane;
    constexpr int I_IN = 16 * (ZW / 32), I_OUT = 16 * (D / 32), I_1 = 16 * (2 * DE / 32), I_2 = (DE / 64) * (D / 32);
    constexpr int PER_L = I_IN + I_OUT + NE * (I_1 + I_2);
    for (int it = gw; it < DEPTH * PER_L; it += NGW) {
        const int l = it / PER_L; int r = it % PER_L;
        if (r < I_IN) { const int kb = r / (ZW / 32), nb = r % (ZW / 32), nd = 32 * nb, ns = nd < 2304 ? nd : nd + 16;
            transpose_item(INP(I_WIN) + (size_t)l * D * IN_W, IN_W, D, WSP(bf16_t, WS_WIN) + (size_t)l * ZW * D, 64 * kb, ns, nd, scr, lane); continue; }
        r -= I_IN;
        if (r < I_OUT) { const int kb = r / (D / 32), nb = r % (D / 32);
            transpose_item(INP(I_WOUT) + (size_t)l * D * D, D, D, WSP(bf16_t, WS_WOUT) + (size_t)l * D * D, 64 * kb, 32 * nb, 32 * nb, scr, lane); continue; }
        r -= I_OUT;
        const int e = r / (I_1 + I_2); r %= (I_1 + I_2);
        if (r < I_1) { const int kb = r / (2 * DE / 32), nb = r % (2 * DE / 32), nd = 32 * nb;
            const int ntile = nd / 256, hh = (nd % 256) / 128, j = nd % 128, ns = DE * hh + 128 * ntile + j;
            transpose_item(INP(I_EW1) + ((size_t)l * NE + e) * D * 2 * DE, 2 * DE, D, WSP(bf16_t, WS_W1) + ((size_t)l * NE + e) * 2 * DE * D, 64 * kb, ns, nd, scr, lane); continue; }
        r -= I_1;
        { const int kb = r / (D / 32), nb = r % (D / 32);
            transpose_item(INP(I_EW2) + ((size_t)l * NE + e) * DE * D, D, DE, WSP(bf16_t, WS_W2) + ((size_t)l * NE + e) * D * DE, 64 * kb, 32 * nb, 32 * nb, scr, lane); }
    }
    for (int it = gw; it < DEPTH * (NB + 1) * (6 * D / 64); it += NGW) {
        const int l = it / ((NB + 1) * (6 * D / 64)), b = (it / (6 * D / 64)) % (NB + 1), n = (it % (6 * D / 64)) * 64 + lane;
        const float* w = INP(I_MODW) + (size_t)l * D * 6 * D + n; const float* cv = b < NB ? INP(I_C) + b * D : INP(I_CCTX);
        float acc = 0.f;
#pragma unroll 16
        for (int k = 0; k < D; ++k) acc += siluf_(cv[k]) * w[(size_t)k * 6 * D];
        WSP(float, WS_MOD)[((size_t)l * (NB + 1) + b) * 6 * D + n] = acc + INP(I_MODB)[l * 6 * D + n];
    }
    const int gt = gw * 64 + lane, NGT = NGW * 64;
    for (int i = gt; i < 256; i += NGT) { const float a0 = INP(I_HGLB)[i], a1 = INP(I_HGLB)[256 + i], mx = fmaxf(a0, a1), e0 = __expf(a0 - mx), e1 = __expf(a1 - mx);
        WSP(float, WS_LB)[i] = 0.f; WSP(float, WS_LB)[256 + i] = e1 / (e0 + e1); }
    for (int i = gt; i < DEPTH * 32 * D; i += NGT) { const int l = i / (32 * D), j = (i / D) % 32, k = i % D; const int col = j < 16 ? 2304 + j : 4112 + (j - 16);
        WSP(float, WS_WG)[i] = INP(I_WIN)[((size_t)l * D + k) * IN_W + col]; }
    for (int i = gt; i < DEPTH * NE * D; i += NGT) { const int l = i / (NE * D), e = (i / D) % NE, k = i % D;
        WSP(float, WS_WR)[i] = INP(I_RW)[((size_t)l * D + k) * NE + e]; }
    for (int i = gw; i < DEPTH * (SEQ + LC); i += NGW) {
        const int l = i / (SEQ + LC), p = i % (SEQ + LC); const bool isc = p >= SEQ; const int pos = isc ? p - SEQ : p, len = isc ? LC : SEQ;
        const float *w1 = INP(I_HYW1) + l * 17 * 64, *b1 = INP(I_HYB1) + l * 64, *w2 = INP(I_HYW2) + l * 64 * 64, *b2 = INP(I_HYB2) + l * 64, *fr = INP(I_HYFR) + l * 128;
        float s = b1[lane] + ((float)pos / (float)(len - 1)) * w1[lane];
#pragma unroll
        for (int j = 0; j < 8; ++j) { const float band = 1e-4f + (7.0f - 1e-4f) * (float)j / 7.0f; const float ang = 6.283185307179586f * (float)pos * band / (float)len;
            s += cosf(ang) * w1[(1 + j) * 64 + lane] - sinf(ang) * w1[(9 + j) * 64 + lane]; }
        scr[lane] = sinf(fr[lane] * s);
        LDS_WAIT(); asm volatile("" ::: "memory");
        float s2 = b2[lane];
#pragma unroll 8
        for (int q = 0; q < 64; ++q) s2 += scr[q] * w2[q * 64 + lane];
        WSP(float, WS_HDN)[((size_t)l * (SEQ + LC) + p) * 64 + lane] = sinf(fr[64 + lane] * s2);
        LDS_WAIT(); asm volatile("" ::: "memory");
    }
}

__device__ __forceinline__ void rms_mod_row(const f32x4 (&xv)[4], const float* gain, const float* sh, const float* sc, bf16_t* orow, int lane, f32x4 (&hv)[4]) {
    float s = 0.f;
#pragma unroll
    for (int j = 0; j < 4; ++j) s += (xv[j].x * xv[j].x + xv[j].y * xv[j].y) + (xv[j].z * xv[j].z + xv[j].w * xv[j].w);
    const float rstd = 1.f / sqrtf(wave_sum(s) * (1.f / D) + EPS);
#pragma unroll
    for (int j = 0; j < 4; ++j) { const int c = 4 * lane + 256 * j; const f32x4 g = *(const f32x4*)(gain + c), a = *(const f32x4*)(sc + c), b = *(const f32x4*)(sh + c);
        hv[j] = xv[j] * rstd * g * (a + 1.0f) + b;
        u32x2 w; w.x = pk2(hv[j].x, hv[j].y); w.y = pk2(hv[j].z, hv[j].w); *(u32x2*)(orow + c) = w; }
}
__device__ __forceinline__ void load_w32(Ctx& C, const float* W, int n) {
    __syncthreads();
    for (int o = C.tid; o < n * 256; o += 512) *(LAS f32x4*)(C.lds + (size_t)o * 16) = *(const f32x4*)(W + (size_t)o * 4);
    __syncthreads();
}
__device__ __forceinline__ float row2_dots(LAS unsigned char* lds, const f32x4 (&hv)[2][4], int lane, int n) {
    float v[64];
#pragma unroll
    for (int jj = 0; jj < 32; ++jj) { float s0 = 0.f, s1 = 0.f;
        if (jj < n) {
#pragma unroll
            for (int j = 0; j < 4; ++j) { const f32x4 w = *(const LAS f32x4*)(lds + (size_t)jj * 4096 + (size_t)(4 * lane + 256 * j) * 4);
                s0 += (hv[0][j].x * w.x + hv[0][j].y * w.y) + (hv[0][j].z * w.z + hv[0][j].w * w.w); s1 += (hv[1][j].x * w.x + hv[1][j].y * w.y) + (hv[1][j].z * w.z + hv[1][j].w * w.w); } }
        v[jj] = s0; v[32 + jj] = s1; }
#pragma unroll
    for (int st = 0; st < 6; ++st) { const int m = 32 >> st, nh = 32 >> st; const bool up = (lane & m) != 0;
#pragma unroll
        for (int i = 0; i < nh; ++i) { const float a = v[i], bb = v[i + nh]; const float send = up ? a : bb, keep = up ? bb : a; v[i] = keep + __shfl_xor(send, m); } }
    return v[0];
}
__device__ __forceinline__ void phase_rows_a(Ctx& C, int l) {
    const int gw = C.vcu * 8 + C.wave, NGW = C.G * 8, lane = C.lane;
    const int nrows = (l == DEPTH) ? NLAT : NT;
    float* xcur = WSP(float, WS_X);
    if (l < DEPTH) load_w32(C, WSP(float, WS_WG) + (size_t)l * 32 * D, 32);
    for (int r0 = 2 * gw; r0 < nrows; r0 += 2 * NGW) {
        f32x4 xv[2][4];
#pragma unroll
        for (int q = 0; q < 2; ++q) { const int r = r0 + q; const int bb = row_batch(r);
            if (l == 0) { const float* xr = xrow_l0(C, r);
#pragma unroll
                for (int j = 0; j < 4; ++j) xv[q][j] = *(const f32x4*)(xr + 4 * lane + 256 * j); }
            else {
                const int lp = l - 1; const int ntok = (lp == DEPTH - 1) ? NLAT : NT;
                const float* xr = xcur + (size_t)r * D;
#pragma unroll
                for (int j = 0; j < 4; ++j) xv[q][j] = *(const f32x4*)(xr + 4 * lane + 256 * j);
                if (r < ntok) {
                    const float* g2 = WSP(float, WS_MOD) + ((size_t)lp * (NB + 1) + bb) * 6 * D + 5 * D;
                    const int* te = WSP(int, WS_TOP) + (size_t)r * 4; const int* tp = WSP(int, WS_TOP) + (size_t)NT * 4 + (size_t)r * 4; const float* tg = WSP(float, WS_TOP) + (size_t)NT * 8 + (size_t)r * 4;
                    const LAS int* tbase = (const LAS int*)(C.lds + LDSX_OFF + LX_TILE) + MAXTILES;
                    f32x4 ys[4];
#pragma unroll
                    for (int j = 0; j < 4; ++j) ys[j] = (f32x4){0.f, 0.f, 0.f, 0.f};
#pragma unroll
                    for (int k = 0; k < TOPK; ++k) { const int e = te[k]; const size_t yr = (size_t)tbase[e] * 256 + tp[k]; const float gk = tg[k]; const bf16_t* yp = WSP(bf16_t, WS_Y) + yr * D;
#pragma unroll
                        for (int j = 0; j < 4; ++j) { const u32x2 w = *(const u32x2*)(yp + 4 * lane + 256 * j);
                            ys[j].x += gk * u2f(w.x << 16); ys[j].y += gk * u2f(w.x & 0xffff0000u); ys[j].z += gk * u2f(w.y << 16); ys[j].w += gk * u2f(w.y & 0xffff0000u); } }
#pragma unroll
                    for (int j = 0; j < 4; ++j) { const f32x4 g = *(const f32x4*)(g2 + 4 * lane + 256 * j); xv[q][j] = xv[q][j] + g * ys[j]; }
                    if (l < DEPTH) {
#pragma unroll
                        for (int j = 0; j < 4; ++j) *(f32x4*)(xcur + (size_t)r * D + 4 * lane + 256 * j) = xv[q][j]; }
                }
            }
        }
        if (l == DEPTH) {
#pragma unroll
            for (int q = 0; q < 2; ++q) { float s = 0.f;
#pragma unroll
                for (int j = 0; j < 4; ++j) s += (xv[q][j].x * xv[q][j].x + xv[q][j].y * xv[q][j].y) + (xv[q][j].z * xv[q][j].z + xv[q][j].w * xv[q][j].w);
                const float rstd = 1.f / sqrtf(wave_sum(s) * (1.f / D) + EPS);
#pragma unroll
                for (int j = 0; j < 4; ++j) { const f32x4 g = *(const f32x4*)(INP(I_FG) + 4 * lane + 256 * j); *(f32x4*)(C.a->out + (size_t)(r0 + q) * D + 4 * lane + 256 * j) = xv[q][j] * rstd * g; } }
            continue;
        }
        f32x4 hv[2][4];
#pragma unroll
        for (int q = 0; q < 2; ++q) { const int r = r0 + q; const float* mod = WSP(float, WS_MOD) + ((size_t)l * (NB + 1) + row_batch(r)) * 6 * D;
            rms_mod_row(xv[q], INP(I_N1) + l * D, mod, mod + D, WSP(bf16_t, WS_H) + (size_t)r * D, lane, hv[q]); }
        const float mine = row2_dots(C.lds, hv, lane, 32);
        WSP(float, WS_ZG)[(size_t)(r0 + (lane >> 5)) * 32 + (lane & 31)] = mine;
    }
}
__device__ __forceinline__ int build_tiles(Ctx& C, int l) {
    LAS int* tile_e = (LAS int*)(C.lds + LDSX_OFF + LX_TILE); LAS int* tbase = tile_e + MAXTILES;
    const unsigned* cnt = WSP(unsigned, WS_CTL) + CW_CNT + l * NE;
    __syncthreads();
    if (C.tid == 0) { int t = 0;
        for (int e = 0; e < NE; ++e) { const int c = (int)cnt[e], n = (c + 255) / 256; tbase[e] = t; for (int i = 0; i < n; ++i) tile_e[t + i] = e; t += n; }
        tbase[NE] = t; }
    __syncthreads();
    return tbase[NE];
}
__device__ __forceinline__ void phase_rows_b(Ctx& C, int l) {
    const int gw = C.vcu * 8 + C.wave, NGW = C.G * 8, lane = C.lane;
    const int ntok = (l == DEPTH - 1) ? NLAT : NT;
    const float* xcur = WSP(float, WS_X);
    unsigned* cnt = WSP(unsigned, WS_CTL) + CW_CNT + l * NE;
    static_assert(NE <= 32, "router width");
    load_w32(C, WSP(float, WS_WR) + (size_t)l * NE * D, NE);
    for (int r0 = 2 * gw; r0 < ntok; r0 += 2 * NGW) {
        f32x4 hv[2][4];
#pragma unroll
        for (int q = 0; q < 2; ++q) { const int r = r0 + q; f32x4 xv[4];
#pragma unroll
            for (int j = 0; j < 4; ++j) xv[j] = *(const f32x4*)(xcur + (size_t)r * D + 4 * lane + 256 * j);
            const float* mod = WSP(float, WS_MOD) + ((size_t)l * (NB + 1) + row_batch(r)) * 6 * D;
            rms_mod_row(xv, INP(I_N2) + l * D, mod + 3 * D, mod + 4 * D, WSP(bf16_t, WS_H) + (size_t)r * D, lane, hv[q]); }
        const float lgm = row2_dots(C.lds, hv, lane, NE);
        const int jl = lane & 31, r = r0 + (lane >> 5);
        float v = (jl < NE) ? lgm + INP(I_RB)[l * NE + (jl < NE ? jl : 0)] : -3.0e38f;
        float tv[4]; int ti[4];
#pragma unroll
        for (int k = 0; k < 4; ++k) { float bv = v; int bi = jl;
#pragma unroll
            for (int o = 1; o < 32; o <<= 1) { const float ov = __shfl_xor(bv, o); const int oi = __shfl_xor(bi, o); const bool take = (ov > bv) || (ov == bv && oi < bi); bv = take ? ov : bv; bi = take ? oi : bi; }
            tv[k] = bv; ti[k] = bi; v = (jl == bi) ? -3.4e38f : v; }
        const float e1 = __expf(tv[1] - tv[0]), e2 = __expf(tv[2] - tv[0]), e3 = __expf(tv[3] - tv[0]), inv = 1.f / (1.f + e1 + e2 + e3);
        const float gk[4] = {inv, e1 * inv, e2 * inv, e3 * inv};
        if (jl < 4) {
            int e = ti[0]; float g = gk[0];
#pragma unroll
            for (int k = 1; k < 4; ++k) { e = (jl == k) ? ti[k] : e; g = (jl == k) ? gk[k] : g; }
            const int pos = (int)atomicAdd(cnt + e, 1u);
            WSP(int, WS_TOP)[(size_t)r * 4 + jl] = e; WSP(int, WS_TOP)[(size_t)NT * 4 + (size_t)r * 4 + jl] = pos; WSP(float, WS_TOP)[(size_t)NT * 8 + (size_t)r * 4 + jl] = g;
        }
    }
}
__device__ __forceinline__ void phase_gather(Ctx& C, int l) {
    const int gw = C.vcu * 8 + C.wave, NGW = C.G * 8, lane = C.lane;
    const int ntok = (l == DEPTH - 1) ? NLAT : NT;
    (void)build_tiles(C, l);
    const LAS int* tbase = (const LAS int*)(C.lds + LDSX_OFF + LX_TILE) + MAXTILES;
    const unsigned* cnt = WSP(unsigned, WS_CTL) + CW_CNT + l * NE;
    for (int it = gw; it < ntok * 4; it += NGW) { const int r = it >> 2, k = it & 3;
        const int e = WSP(int, WS_TOP)[(size_t)r * 4 + k], pos = WSP(int, WS_TOP)[(size_t)NT * 4 + (size_t)r * 4 + k];
        const u32x4* s = (const u32x4*)(WSP(bf16_t, WS_H) + (size_t)r * D); u32x4* d = (u32x4*)(WSP(bf16_t, WS_HS) + ((size_t)tbase[e] * 256 + pos) * D);
        d[lane] = s[lane]; d[lane + 64] = s[lane + 64]; }
    for (int it = gw; it < NE * 256; it += NGW) { const int e = it >> 8, p = it & 255; const int c = (int)cnt[e], pad0 = c, pad1 = ((c + 255) / 256) * 256;
        if (pad0 + p < pad1) { u32x4* d = (u32x4*)(WSP(bf16_t, WS_HS) + ((size_t)tbase[e] * 256 + pad0 + p) * D); d[lane] = (u32x4){0u, 0u, 0u, 0u}; d[lane + 64] = (u32x4){0u, 0u, 0u, 0u}; } }
}

template <int MIX> __device__ __forceinline__ int scan_row(int b, int dir, int s) {
    if (s < LC) { const int t = dir ? LC - 1 - s : s; return NLAT + b * LC + t; }
    const int i0 = s - LC, i = dir ? SEQ - 1 - i0 : i0;
    const int t = (MIX == 1) ? (i % GROWS) * GW + (i / GROWS) : i;
    return b * SEQ + t;
}
typedef float f32x16 __attribute__((ext_vector_type(16)));
template <int NT_, int KS>
__device__ __forceinline__ void mm_nt(const LAS bf16_t* A, int lda, const LAS bf16_t* B, int ldb, f32x16 (&acc)[NT_], int lane) {
    const int r = lane & 31, kh = (lane >> 5) * 8;
#pragma unroll
    for (int kk = 0; kk < KS; ++kk) {
        const bf16x8 a = *(const LAS bf16x8*)(A + r * lda + 16 * kk + kh);
#pragma unroll
        for (int n = 0; n < NT_; ++n) { const bf16x8 b = *(const LAS bf16x8*)(B + (32 * n + r) * ldb + 16 * kk + kh); acc[n] = __builtin_amdgcn_mfma_f32_32x32x16_bf16(a, b, acc[n], 0, 0, 0); }
    }
}
#ifdef HOST_EMU
#define ITEM_IDS() const int tid = C.tid, lane = C.lane, w = C.wave
#else
#define ITEM_IDS() int tid_ = C.tid; asm volatile("" : "+v"(tid_)); const int tid = tid_, lane = tid_ & 63, w = __builtin_amdgcn_readfirstlane(tid_ >> 6)
#endif
#define CROW(ri, lane) (((ri) & 3) + 8 * ((ri) >> 2) + 4 * ((lane) >> 5))
constexpr int LS = 72, LF = 65;
constexpr int GA_Q = 0, GA_K = 9216, GA_BVT = 18432, GA_BKGT = 27648, GA_KDT = 36864, GA_QKM = 46080, GA_TB = 55296, GA_UT = 64512, GA_WT = 73728, GA_AM = 82944, GA_AMB = 99584, GA_TT = 108800, GA_DG = 118016, GA_XT = 122368, GA_G = 124928;
__device__ __forceinline__ void gdn_a_item(Ctx& C, int l, int b, int h, int dir, int c) {
    LAS unsigned char* lds = C.lds; ITEM_IDS();
    LAS bf16_t* Qb = (LAS bf16_t*)(lds + GA_Q); LAS bf16_t* Kb = (LAS bf16_t*)(lds + GA_K); LAS bf16_t* BVT = (LAS bf16_t*)(lds + GA_BVT); LAS bf16_t* BKGT = (LAS bf16_t*)(lds + GA_BKGT);
    LAS bf16_t* KDT = (LAS bf16_t*)(lds + GA_KDT); LAS bf16_t* QKM = (LAS bf16_t*)(lds + GA_QKM); LAS bf16_t* TB = (LAS bf16_t*)(lds + GA_TB); LAS bf16_t* UT = (LAS bf16_t*)(lds + GA_UT); LAS bf16_t* WT = (LAS bf16_t*)(lds + GA_WT);
    LAS float* AM = (LAS float*)(lds + GA_AM); LAS bf16_t* AMb = (LAS bf16_t*)(lds + GA_AMB); LAS bf16_t* TT = (LAS bf16_t*)(lds + GA_TT); LAS float* Dg = (LAS float*)(lds + GA_DG); LAS bf16_t* XT = (LAS bf16_t*)(lds + GA_XT); LAS float* G = (LAS float*)(lds + GA_G);
    const bf16_t* zb = WSP(bf16_t, WS_Z); const float* zg = WSP(float, WS_ZG);
    unsigned char* blob = C.ws + WS_GD + ((size_t)((b * NH + h) * 2 + dir) * NCH + c) * GD_BLOB;
    const int i = tid >> 3, d0 = (tid & 7) * 8; const int row = scan_row<2>(b, dir, 64 * c + i);
    float qv[8], kv[8], vv[8];
    { const bf16_t* zr = zb + (size_t)row * ZW; const bool isc = row >= NLAT; const int t = isc ? (row - NLAT) % LC : row % SEQ, len = isc ? LC : SEQ;
        const bool hp = t > 0, hn = t < len - 1; const float* cw = INP(I_GDCW) + l * 3 * 768;
        float sq = 0.f, sk = 0.f;
#pragma unroll
        for (int a = 0; a < 3; ++a) { const int cc = a * 256 + h * 64 + d0; const bf16_t* zp = zr + GDB + cc;
            const u32x4 z1 = *(const u32x4*)zp, z0 = hp ? *(const u32x4*)(zp - ZW) : (u32x4){0u, 0u, 0u, 0u}, z2 = hn ? *(const u32x4*)(zp + ZW) : (u32x4){0u, 0u, 0u, 0u};
            const unsigned u0[4] = {z0.x, z0.y, z0.z, z0.w}, u1[4] = {z1.x, z1.y, z1.z, z1.w}, u2[4] = {z2.x, z2.y, z2.z, z2.w};
#pragma unroll
            for (int j = 0; j < 8; ++j) { const int jj = j >> 1; const bool hi = j & 1;
                const float x0 = hi ? u2f(u0[jj] & 0xffff0000u) : u2f(u0[jj] << 16), x1 = hi ? u2f(u1[jj] & 0xffff0000u) : u2f(u1[jj] << 16), x2 = hi ? u2f(u2[jj] & 0xffff0000u) : u2f(u2[jj] << 16);
                float sacc = cw[cc + j] * x0 + cw[768 + cc + j] * x1 + cw[1536 + cc + j] * x2;
                sacc = siluf_(sacc);
                if (a == 0) { qv[j] = sacc; sq += sacc * sacc; } else if (a == 1) { kv[j] = sacc; sk += sacc * sacc; } else vv[j] = sacc; } }
#pragma unroll
        for (int o = 1; o < 8; o <<= 1) { sq += __shfl_xor(sq, o); sk += __shfl_xor(sk, o); }
        const float rq = 0.125f / sqrtf(sq + EPS), rk = 1.f / sqrtf(sk + EPS);
#pragma unroll
        for (int j = 0; j < 8; ++j) { qv[j] *= rq; kv[j] *= rk; }
        if ((tid & 7) == 0) { const float* g = zg + (size_t)row * 32 + 16;
            G[128 + i] = -__expf(INP(I_GDAL)[l * 8 + dir * 4 + h]) * softplusf_(g[(2 * dir) * 4 + h] + INP(I_GDDT)[l * 8 + dir * 4 + h]); G[64 + i] = sigmoidf_(g[(2 * dir + 1) * 4 + h]); }
        u32x4 wq, wk; wq.x = pk2(qv[0], qv[1]); wq.y = pk2(qv[2], qv[3]); wq.z = pk2(qv[4], qv[5]); wq.w = pk2(qv[6], qv[7]); wk.x = pk2(kv[0], kv[1]); wk.y = pk2(kv[2], kv[3]); wk.z = pk2(kv[4], kv[5]); wk.w = pk2(kv[6], kv[7]);
        *(LAS u32x4*)(Qb + i * LS + d0) = wq; *(LAS u32x4*)(Kb + i * LS + d0) = wk;
        for (int o = tid; o < 64 * LS / 2; o += 512) ((LAS unsigned*)TT)[o] = 0u;
    }
    __syncthreads();
    if (w == 0) { float gsum = G[128 + lane];
#pragma unroll
        for (int o = 1; o < 64; o <<= 1) { const float t = __shfl(gsum, lane - o); if (lane >= o) gsum += t; }
        G[lane] = gsum; }
    __syncthreads();
    { const float gi = G[i], be = G[64 + i], gl = G[63]; const float eg = __expf(gi), ed = __expf(gl - gi);
#pragma unroll
        for (int j = 0; j < 8; ++j) { BVT[(d0 + j) * LS + i] = (bf16_t)f2bf(be * vv[j]); BKGT[(d0 + j) * LS + i] = (bf16_t)f2bf(be * kv[j] * eg); KDT[(d0 + j) * LS + i] = (bf16_t)f2bf(kv[j] * ed); } }
    for (int rep_ = 0; rep_ < 1 + ((REPMASK >> 18) & 1); ++rep_)
    if (w < 4) { f32x16 acc[2]; acc[0] = (f32x16)(0.f); acc[1] = (f32x16)(0.f);
        const int rh = (w & 1) * 32; mm_nt<2, 4>((w >> 1) ? Qb + rh * LS : Kb + rh * LS, LS, Kb, LS, acc, lane);
#pragma unroll
        for (int n = 0; n < 2; ++n)
#pragma unroll
            for (int ri = 0; ri < 16; ++ri) { const int ii = rh + CROW(ri, lane), jj = 32 * n + (lane & 31); const float dec = __expf(G[ii] - G[jj]);
                if (w >> 1) QKM[ii * LS + jj] = (bf16_t)f2bf(jj <= ii ? acc[n][ri] * dec : 0.f); else { const float av = (jj < ii) ? G[64 + ii] * acc[n][ri] * dec : 0.f; AM[ii * LF + jj] = av; AMb[ii * LS + jj] = (bf16_t)f2bf(av); } } }
    __syncthreads();
    for (int rep_ = 0; rep_ < 1 + ((REPMASK >> 19) & 1); ++rep_) {
    if (w == 0) { const int bb = lane >> 4, cc = lane & 15; float t[16];
#pragma unroll
        for (int r = 0; r < 16; ++r) { float x = (r == cc) ? 1.f : 0.f;
#pragma unroll
            for (int r2 = 0; r2 < r; ++r2) x -= AM[(16 * bb + r) * LF + 16 * bb + r2] * t[r2];
            t[r] = x; Dg[(bb * 16 + r) * 17 + cc] = x; asm volatile("" ::: "memory"); } }
    __syncthreads();
    if (w < 4) { const int cl = lane & 15, q4 = lane >> 4; LAS bf16_t* XTw = XT + w * 256;
#pragma unroll
        for (int bb = 0; bb < 4; ++bb) {
            f32x4 acc = (f32x4){0.f, 0.f, 0.f, 0.f};
#pragma unroll
            for (int kk = 0; kk < 2; ++kk) { const bf16x8 a = *(const LAS bf16x8*)(AMb + (16 * bb + cl) * LS + 32 * kk + 8 * q4), tb = *(const LAS bf16x8*)(TT + (16 * w + cl) * LS + 32 * kk + 8 * q4);
                acc = __builtin_amdgcn_mfma_f32_16x16x32_bf16(a, tb, acc, 0, 0, 0); }
            float x[4];
#pragma unroll
            for (int r = 0; r < 4; ++r) x[r] = ((16 * bb + 4 * q4 + r) == (16 * w + cl) ? 1.f : 0.f) - acc[r];
            *(LAS u32x2*)(XTw + cl * 16 + 4 * q4) = (u32x2){pk2(x[0], x[1]), pk2(x[2], x[3])};
            LDS_WAIT(); asm volatile("" ::: "memory");
            bf16x8 da = (bf16x8)(0), xb = (bf16x8)(0);
            if (q4 < 2) { const LAS float* dp = Dg + (bb * 16 + cl) * 17 + 8 * q4; u32x4 dv; dv.x = pk2(dp[0], dp[1]); dv.y = pk2(dp[2], dp[3]); dv.z = pk2(dp[4], dp[5]); dv.w = pk2(dp[6], dp[7]);
                __builtin_memcpy(&da, &dv, 16); xb = *(const LAS bf16x8*)(XTw + cl * 16 + 8 * q4); }
            const f32x4 z4 = (f32x4){0.f, 0.f, 0.f, 0.f}; const f32x4 tt = __builtin_amdgcn_mfma_f32_16x16x32_bf16(da, xb, z4, 0, 0, 0);
            *(LAS u32x2*)(TT + (16 * w + cl) * LS + 16 * bb + 4 * q4) = (u32x2){pk2(tt[0], tt[1]), pk2(tt[2], tt[3])};
#pragma unroll
            for (int r = 0; r < 4; ++r) TB[(16 * bb + 4 * q4 + r) * LS + 16 * w + cl] = (bf16_t)f2bf(tt[r]);
            LDS_WAIT(); asm volatile("" ::: "memory");
        } }
    }
    __syncthreads();
    for (int rep_ = 0; rep_ < 1 + ((REPMASK >> 20) & 1); ++rep_)
    if (w < 4) { f32x16 acc[2]; acc[0] = (f32x16)(0.f); acc[1] = (f32x16)(0.f);
        const int rh = (w & 1) * 32; mm_nt<2, 4>(((w >> 1) ? BKGT : BVT) + rh * LS, LS, TB, LS, acc, lane);
        LAS bf16_t* dst = (w >> 1) ? WT : UT;
#pragma unroll
        for (int n = 0; n < 2; ++n)
#pragma unroll
            for (int ri = 0; ri < 16; ++ri) dst[(rh + CROW(ri, lane)) * LS + 32 * n + (lane & 31)] = (bf16_t)f2bf(acc[n][ri]); }
    __syncthreads();
    for (int rep_ = 0; rep_ < 1 + ((REPMASK >> 21) & 1); ++rep_)
    { f32x16 acc[2]; acc[0] = (f32x16)(0.f); acc[1] = (f32x16)(0.f);
        const int pr = w >> 1, rh = (w & 1) * 32;
        const LAS bf16_t* Ap = (pr == 0 || pr == 1) ? QKM : (pr == 2 ? KDT : UT); const LAS bf16_t* Bp = (pr == 0 || pr == 2) ? WT : (pr == 1 ? UT : KDT);
        mm_nt<2, 4>(Ap + rh * LS, LS, Bp, LS, acc, lane);
        const float egl = __expf(G[63]);
#pragma unroll
        for (int n = 0; n < 2; ++n)
#pragma unroll
            for (int ri = 0; ri < 16; ++ri) { const int rr = rh + CROW(ri, lane), cc = 32 * n + (lane & 31); const float a = acc[n][ri];
                if (pr == 0) ((bf16_t*)(blob + 8192))[rr * 64 + cc] = (bf16_t)f2bf(bf2f(Qb[rr * LS + cc]) * __expf(G[rr]) - a);
                else if (pr == 1) ((float*)(blob + 32768))[rr * 64 + cc] = a;
                else if (pr == 2) ((bf16_t*)blob)[rr * 64 + cc] = (bf16_t)f2bf((rr == cc ? egl : 0.f) - a);
                else ((float*)(blob + 16384))[rr * 64 + cc] = a; } }
    __syncthreads();
}
__device__ __forceinline__ void gdn_b_scan(Ctx& C, int sidx) {
    LAS unsigned char* lds = C.lds; const int tid = C.tid, lane = C.lane, w = C.wave;
    LAS bf16_t* STb = (LAS bf16_t*)lds;
    LAS bf16_t* Pb = (LAS bf16_t*)(lds + 18432);
    for (int o = tid; o < 2 * 64 * LS; o += 512) STb[o] = 0;
    __syncthreads();
    int cur = 0;
    const int pr = tid >> 3, pc8 = (tid & 7) * 8, eh = (w & 1) * 32, dh = (w >> 1) * 32;
    u32x4 pv = *(const u32x4*)((const bf16_t*)(C.ws + WS_GD + ((size_t)sidx * NCH) * GD_BLOB) + pr * 64 + pc8);
    f32x16 qv = (f32x16)(0.f);
    if (w < 4) { const float* qt = (const float*)(C.ws + WS_GD + ((size_t)sidx * NCH) * GD_BLOB + 16384);
#pragma unroll
        for (int ri = 0; ri < 16; ++ri) qv[ri] = qt[(eh + CROW(ri, lane)) * 64 + dh + (lane & 31)]; }
    for (int c = 0; c < NCH; ++c) {
        bf16_t* gst = WSP(bf16_t, WS_GST) + ((size_t)sidx * NCH + c) * 4096;
        *(LAS u32x4*)(Pb + pr * LS + pc8) = pv;
        *(u32x4*)(gst + pr * 64 + pc8) = *(const LAS u32x4*)(STb + cur * 64 * LS + pr * LS + pc8);
        const int cn = (c + 1 < NCH) ? c + 1 : c; const unsigned char* nblob = C.ws + WS_GD + ((size_t)sidx * NCH + cn) * GD_BLOB;
        pv = *(const u32x4*)((const bf16_t*)nblob + pr * 64 + pc8);
        f32x16 nq = (f32x16)(0.f);
        if (w < 4) { const float* qt = (const float*)(nblob + 16384);
#pragma unroll
            for (int ri = 0; ri < 16; ++ri) nq[ri] = qt[(eh + CROW(ri, lane)) * 64 + dh + (lane & 31)]; }
        __syncthreads();
        if (w < 4) { f32x16 acc[1]; acc[0] = qv;
            mm_nt<1, 4>(STb + cur * 64 * LS + eh * LS, LS, Pb + dh * LS, LS, acc, lane);
#pragma unroll
            for (int ri = 0; ri < 16; ++ri) STb[(cur ^ 1) * 64 * LS + (eh + CROW(ri, lane)) * LS + dh + (lane & 31)] = (bf16_t)f2bf(acc[0][ri]); }
        __syncthreads();
        cur ^= 1; qv = nq;
    }
}
__device__ __forceinline__ void gdn_c_item(Ctx& C, int l, int b, int h, int jt) {
    LAS unsigned char* lds = C.lds; ITEM_IDS();
    LAS bf16_t* Rb = (LAS bf16_t*)lds;
    LAS bf16_t* Sb = (LAS bf16_t*)(lds + 18432);
    LAS float* OF = (LAS float*)(lds + 36864);
    const bool isc = jt < NCHC; const int jl = jt - NCHC;
    int cidx[2]; cidx[0] = jt; cidx[1] = isc ? (NCHC - 1 - jt) : NCHC + (SEQ / 64 - 1 - jl);
    const unsigned char* blob[2];
    const int dirw = w >> 2, qw = w & 3, ihw = (qw & 1) * 32, ehw = (qw >> 1) * 32;
    f32x16 acc0;
    { const float* ol = (const float*)(C.ws + WS_GD + ((size_t)((b * NH + h) * 2 + dirw) * NCH + cidx[dirw]) * GD_BLOB + 32768);
#pragma unroll
        for (int ri = 0; ri < 16; ++ri) acc0[ri] = ol[(ihw + CROW(ri, lane)) * 64 + ehw + (lane & 31)]; }
    const int tokf = tid >> 3, e0f = (tid & 7) * 8; const int rowf = isc ? NLAT + b * LC + 64 * jt + tokf : b * SEQ + 64 * jl + tokf;
    const u32x4 gzv = *(const u32x4*)(WSP(bf16_t, WS_Z) + (size_t)rowf * ZW + GDB + 768 + h * 64 + e0f);
    const f32x4 ngv0 = *(const f32x4*)(INP(I_GDNG) + l * 256 + h * 64 + e0f), ngv1 = *(const f32x4*)(INP(I_GDNG) + l * 256 + h * 64 + e0f + 4);
#pragma unroll
    for (int dir = 0; dir < 2; ++dir) { const size_t sc = (size_t)((b * NH + h) * 2 + dir) * NCH + cidx[dir]; blob[dir] = C.ws + WS_GD + sc * GD_BLOB;
        const bf16_t* gst = WSP(bf16_t, WS_GST) + sc * 4096; const int r = tid >> 3, c8 = (tid & 7) * 8;
        *(LAS u32x4*)(Rb + dir * 64 * LS + r * LS + c8) = *(const u32x4*)((const bf16_t*)(blob[dir] + 8192) + r * 64 + c8);
        *(LAS u32x4*)(Sb + dir * 64 * LS + r * LS + c8) = *(const u32x4*)(gst + r * 64 + c8); }
    __syncthreads();
    { const int dir = dirw, ih = ihw, eh = ehw; f32x16 acc[1]; acc[0] = acc0;
        mm_nt<1, 4>(Rb + dir * 64 * LS + ih * LS, LS, Sb + dir * 64 * LS + eh * LS, LS, acc, lane);
#pragma unroll
        for (int ri = 0; ri < 16; ++ri) { const int ii = ih + CROW(ri, lane), tok = dir ? 63 - ii : ii; OF[dir * 64 * LF + tok * LF + eh + (lane & 31)] = acc[0][ri]; } }
    __syncthreads();
    { const int tok = tid >> 3, e0 = (tid & 7) * 8; const int row = isc ? NLAT + b * LC + 64 * jt + tok : b * SEQ + 64 * jl + tok;
        float o[8]; float ss = 0.f;
#pragma unroll
        for (int j = 0; j < 8; ++j) { o[j] = OF[tok * LF + e0 + j] + OF[64 * LF + tok * LF + e0 + j]; ss += o[j] * o[j]; }
#pragma unroll
        for (int k = 1; k < 8; k <<= 1) ss += __shfl_xor(ss, k);
        const float rs = 1.f / sqrtf(ss * (1.f / 64.f) + EPS);
        const float ng[8] = {ngv0.x, ngv0.y, ngv0.z, ngv0.w, ngv1.x, ngv1.y, ngv1.z, ngv1.w}; const unsigned gu[4] = {gzv.x, gzv.y, gzv.z, gzv.w};
        unsigned pk[4];
#pragma unroll
        for (int j = 0; j < 4; ++j) pk[j] = pk2(o[2 * j] * rs * ng[2 * j] * siluf_(u2f(gu[j] << 16)), o[2 * j + 1] * rs * ng[2 * j + 1] * siluf_(u2f(gu[j] & 0xffff0000u)));
        *(u32x4*)(WSP(bf16_t, WS_MIX) + (size_t)row * D + 768 + h * 64 + e0) = (u32x4){pk[0], pk[1], pk[2], pk[3]}; }
    __syncthreads();
}
constexpr int MA_Q = 0, MA_K = 9216, MA_VT = 18432, MA_KWT = 27648, MA_P = 36864, MA_ONE = 46080  , MA_S = 50688  ;
__device__ __forceinline__ void mlstm_a_item(Ctx& C, int l, int b, int h, int dir, int c) {
    LAS unsigned char* lds = C.lds; ITEM_IDS();
    LAS bf16_t* Qb = (LAS bf16_t*)(lds + MA_Q); LAS bf16_t* Kb = (LAS bf16_t*)(lds + MA_K); LAS bf16_t* VT = (LAS bf16_t*)(lds + MA_VT); LAS bf16_t* KWT = (LAS bf16_t*)(lds + MA_KWT);
    LAS bf16_t* Pm = (LAS bf16_t*)(lds + MA_P); LAS bf16_t* ONE = (LAS bf16_t*)(lds + MA_ONE); LAS float* Sc = (LAS float*)(lds + MA_S);
    const bf16_t* zb = WSP(bf16_t, WS_Z); const float* zg = WSP(float, WS_ZG);
    unsigned char* blob = C.ws + WS_ML + ((size_t)((b * NH + h) * 2 + dir) * NCH + c) * ML_BLOB;
    const int i = tid >> 3, d0 = (tid & 7) * 8; const int row = scan_row<1>(b, dir, 64 * c + i);
    float kv[8];
    { const bf16_t* zr = zb + (size_t)row * ZW + MLB + h * 64 + d0;
        *(LAS u32x4*)(Qb + i * LS + d0) = *(const u32x4*)zr;
        const u32x4 kr = *(const u32x4*)(zr + 256), vr = *(const u32x4*)(zr + 512);
        const unsigned ku[4] = {kr.x, kr.y, kr.z, kr.w}, vu[4] = {vr.x, vr.y, vr.z, vr.w};
#pragma unroll
        for (int j = 0; j < 4; ++j) { kv[2 * j] = u2f(ku[j] << 16) * 0.125f; kv[2 * j + 1] = u2f(ku[j] & 0xffff0000u) * 0.125f; VT[(d0 + 2 * j) * LS + i] = (bf16_t)(vu[j] & 0xffffu); VT[(d0 + 2 * j + 1) * LS + i] = (bf16_t)(vu[j] >> 16); }
        u32x4 wk; wk.x = pk2(kv[0], kv[1]); wk.y = pk2(kv[2], kv[3]); wk.z = pk2(kv[4], kv[5]); wk.w = pk2(kv[6], kv[7]); *(LAS u32x4*)(Kb + i * LS + d0) = wk;
        if ((tid & 7) == 0) { const float* gb = INP(I_MLGB) + l * 16; const float* g = zg + (size_t)row * 32;
            Sc[i] = g[(2 * dir) * 4 + h] + gb[(2 * dir) * 4 + h]; Sc[64 + i] = logsigmoidf_(g[(2 * dir + 1) * 4 + h] + gb[(2 * dir + 1) * 4 + h]); }
        for (int o = tid; o < 32 * LS; o += 512) ONE[o] = (bf16_t)((o < LS) ? 0x3f80 : 0);
    }
    __syncthreads();
    if (w == 0) { float fc = Sc[64 + lane];
#pragma unroll
        for (int o = 1; o < 64; o <<= 1) { const float t = __shfl(fc, lane - o); if (lane >= o) fc += t; }
        const float li = Sc[lane]; float pm = li - fc;
#pragma unroll
        for (int o = 1; o < 64; o <<= 1) { const float t = __shfl(pm, lane - o); if (lane >= o) pm = fmaxf(pm, t); }
        const float fl = __shfl(fc, 63); const float gg = fl - fc + li; float gm = gg;
#pragma unroll
        for (int o = 1; o < 64; o <<= 1) gm = fmaxf(gm, __shfl_xor(gm, o));
        Sc[128 + lane] = fc; Sc[192 + lane] = gg - gm; Sc[256 + lane] = fc + pm;
        if (lane == 0) { ((float*)(blob + 33792))[0] = gm; ((float*)(blob + 33792))[1] = fl; }
        ((float*)(blob + 32768))[64 + lane] = fc + pm; ((float*)(blob + 32768))[128 + lane] = fc; }
    __syncthreads();
    { const float e = __expf(Sc[192 + i]);
#pragma unroll
        for (int j = 0; j < 8; ++j) KWT[(d0 + j) * LS + i] = (bf16_t)f2bf(kv[j] * e); }
    if (w < 2) { f32x16 acc[2]; acc[0] = (f32x16)(0.f); acc[1] = (f32x16)(0.f);
        const int rh = w * 32; mm_nt<2, 4>(Qb + rh * LS, LS, Kb, LS, acc, lane);
#pragma unroll
        for (int n = 0; n < 2; ++n)
#pragma unroll
            for (int ri = 0; ri < 16; ++ri) { const int ii = rh + CROW(ri, lane), jj = 32 * n + (lane & 31);
                Pm[ii * LS + jj] = (bf16_t)f2bf(jj <= ii ? acc[n][ri] * __expf(Sc[128 + ii] - Sc[128 + jj] + Sc[jj] - Sc[256 + ii]) : 0.f); } }
    __syncthreads();
    { const int pr = w >> 2, q = w & 3, rh = (q & 1) * 32, ch = (q >> 1) * 32; f32x16 acc[1]; acc[0] = (f32x16)(0.f);
        const LAS bf16_t* Ap = pr ? VT : Pm; const LAS bf16_t* Bp = pr ? KWT : VT;
        mm_nt<1, 4>(Ap + rh * LS, LS, Bp + ch * LS, LS, acc, lane);
        float* dst = (float*)(blob + (pr ? 16384 : 0));
#pragma unroll
        for (int ri = 0; ri < 16; ++ri) dst[(rh + CROW(ri, lane)) * 64 + ch + (lane & 31)] = acc[0][ri];
        if (q < 2) {
            f32x16 a2[1]; a2[0] = (f32x16)(0.f);
            if (pr == 0) { mm_nt<1, 4>(Pm + (q * 32) * LS, LS, ONE, LS, a2, lane);
                if ((lane & 31) == 0) {
#pragma unroll
                    for (int ri = 0; ri < 16; ++ri) ((float*)(blob + 32768))[q * 32 + CROW(ri, lane)] = a2[0][ri]; } }
            else { mm_nt<1, 4>(ONE, LS, KWT + (q * 32) * LS, LS, a2, lane);
                if (lane < 32) ((float*)(blob + 32768))[192 + q * 32 + lane] = a2[0][0]; } } }
    __syncthreads();
}
__device__ __forceinline__ void mlstm_b_scan(Ctx& C, int sidx) {
    const int tid = C.tid, e = tid >> 3, d0 = (tid & 7) * 8;
    float ct[8], nn[8]; float m = 0.f;
#pragma unroll
    for (int j = 0; j < 8; ++j) { ct[j] = 0.f; nn[j] = 0.f; }
    f32x4 u0, u1, n0, n1; float gm, fl;
    { const unsigned char* blob = C.ws + WS_ML + ((size_t)sidx * NCH) * ML_BLOB;
        u0 = *(const f32x4*)((const float*)(blob + 16384) + e * 64 + d0); u1 = *(const f32x4*)((const float*)(blob + 16384) + e * 64 + d0 + 4);
        n0 = *(const f32x4*)((const float*)(blob + 32768) + 192 + d0); n1 = *(const f32x4*)((const float*)(blob + 32768) + 192 + d0 + 4); gm = ((const float*)(blob + 33792))[0]; fl = ((const float*)(blob + 33792))[1]; }
    for (int c = 0; c < NCH; ++c) {
        unsigned char* st = C.ws + WS_MST + ((size_t)sidx * NCH + c) * ML_ST;
        const int cn = (c + 1 < NCH) ? c + 1 : c; const unsigned char* blob = C.ws + WS_ML + ((size_t)sidx * NCH + cn) * ML_BLOB;
        const f32x4 pu0 = *(const f32x4*)((const float*)(blob + 16384) + e * 64 + d0), pu1 = *(const f32x4*)((const float*)(blob + 16384) + e * 64 + d0 + 4);
        const f32x4 pn0 = *(const f32x4*)((const float*)(blob + 32768) + 192 + d0), pn1 = *(const f32x4*)((const float*)(blob + 32768) + 192 + d0 + 4);
        const float pgm = ((const float*)(blob + 33792))[0], pfl = ((const float*)(blob + 33792))[1];
        u32x4 wv; wv.x = pk2(ct[0], ct[1]); wv.y = pk2(ct[2], ct[3]); wv.z = pk2(ct[4], ct[5]); wv.w = pk2(ct[6], ct[7]);
        *(u32x4*)((bf16_t*)st + e * 64 + d0) = wv;
        if (e == 0) { *(f32x4*)((float*)(st + 8192) + d0) = (f32x4){nn[0], nn[1], nn[2], nn[3]}; *(f32x4*)((float*)(st + 8192) + d0 + 4) = (f32x4){nn[4], nn[5], nn[6], nn[7]}; if (d0 == 0) ((float*)(st + 8192))[64] = m; }
        const float mn = fmaxf(fl + m, gm), ao = __expf(fl + m - mn), an = __expf(gm - mn); m = mn;
        const float uu[8] = {u0.x, u0.y, u0.z, u0.w, u1.x, u1.y, u1.z, u1.w}, un[8] = {n0.x, n0.y, n0.z, n0.w, n1.x, n1.y, n1.z, n1.w};
#pragma unroll
        for (int j = 0; j < 8; ++j) { ct[j] = ao * ct[j] + an * uu[j]; nn[j] = ao * nn[j] + an * un[j]; }
        u0 = pu0; u1 = pu1; n0 = pn0; n1 = pn1; gm = pgm; fl = pfl;
    }
}
__device__ __forceinline__ void mlstm_c_item(Ctx& C, int l, int b, int h, int jt) {
    LAS unsigned char* lds = C.lds; ITEM_IDS();
    LAS bf16_t* Qb = (LAS bf16_t*)lds;
    LAS bf16_t* Sb = (LAS bf16_t*)(lds + 18432);
    LAS float* OF = (LAS float*)(lds + 36864);
    LAS float* Sc = (LAS float*)(lds + 70144);
    const bool isc = jt < NCHC; const int jl = jt - NCHC;
    int cidx[2]; cidx[0] = jt; cidx[1] = isc ? (NCHC - 1 - jt) : NCHC + (SEQ / 64 - 1 - jl);
    const unsigned char* blob[2]; const bf16_t* zb = WSP(bf16_t, WS_Z);
    const int i = tid >> 3, d0 = (tid & 7) * 8;
    const int dirw = w >> 2, qw = w & 3, ihw = (qw & 1) * 32, ehw = (qw >> 1) * 32;
    float nlv[16];
    { const float* nl = (const float*)(C.ws + WS_ML + ((size_t)((b * NH + h) * 2 + dirw) * NCH + cidx[dirw]) * ML_BLOB);
#pragma unroll
        for (int ri = 0; ri < 16; ++ri) nlv[ri] = nl[(ihw + CROW(ri, lane)) * 64 + ehw + (lane & 31)]; }
    const int rowf = scan_row<1>(b, 0, 64 * cidx[0] + i);
    const u32x4 gzv = *(const u32x4*)(zb + (size_t)rowf * ZW + MLB + 768 + h * 64 + d0);
    const f32x4 ngv0 = *(const f32x4*)(INP(I_MLNG) + l * 256 + h * 64 + d0), ngv1 = *(const f32x4*)(INP(I_MLNG) + l * 256 + h * 64 + d0 + 4);
#pragma unroll
    for (int dir = 0; dir < 2; ++dir) { const size_t sc = (size_t)((b * NH + h) * 2 + dir) * NCH + cidx[dir]; blob[dir] = C.ws + WS_ML + sc * ML_BLOB;
        const unsigned char* st = C.ws + WS_MST + sc * ML_ST; const int row = scan_row<1>(b, dir, 64 * cidx[dir] + i);
        const u32x4 qr = *(const u32x4*)(zb + (size_t)row * ZW + MLB + h * 64 + d0);
        *(LAS u32x4*)(Qb + dir * 64 * LS + i * LS + d0) = qr;
        *(LAS u32x4*)(Sb + dir * 64 * LS + i * LS + d0) = *(const u32x4*)((const bf16_t*)st + i * 64 + d0);
        const float* n0 = (const float*)(st + 8192) + d0; const unsigned qu[4] = {qr.x, qr.y, qr.z, qr.w}; float qn = 0.f;
#pragma unroll
        for (int j = 0; j < 4; ++j) qn += u2f(qu[j] << 16) * n0[2 * j] + u2f(qu[j] & 0xffff0000u) * n0[2 * j + 1];
#pragma unroll
        for (int k = 1; k < 8; k <<= 1) qn += __shfl_xor(qn, k);
        if ((tid & 7) == 0) { const float* sv = (const float*)(blob[dir] + 32768); const float m0 = ((const float*)(st + 8192))[64];
            const float mloc = sv[64 + i], ainit = sv[128 + i] + m0, M = fmaxf(mloc, ainit), s1 = __expf(mloc - M), s2 = __expf(ainit - M);
            LAS float* o = Sc + dir * 256; o[i] = s1; o[64 + i] = s2; o[128 + i] = s1 * sv[i] + s2 * qn; o[192 + i] = __expf(-M); } }
    __syncthreads();
    { const int dir = dirw, ih = ihw, eh = ehw; f32x16 acc[1]; acc[0] = (f32x16)(0.f);
        mm_nt<1, 4>(Qb + dir * 64 * LS + ih * LS, LS, Sb + dir * 64 * LS + eh * LS, LS, acc, lane);
        const LAS float* o = Sc + dir * 256;
#pragma unroll
        for (int ri = 0; ri < 16; ++ri) { const int ii = ih + CROW(ri, lane), tok = dir ? 63 - ii : ii, ee = eh + (lane & 31);
            const float num = o[ii] * nlv[ri] + o[64 + ii] * acc[0][ri];
            OF[dir * 64 * LF + tok * LF + ee] = num / fmaxf(fabsf(o[128 + ii]), o[192 + ii]); } }
    __syncthreads();
    { const int tok = tid >> 3, e0 = (tid & 7) * 8; const int row = scan_row<1>(b, 0, 64 * cidx[0] + tok);
        float o[8]; float ss = 0.f;
#pragma unroll
        for (int j = 0; j < 8; ++j) { o[j] = OF[tok * LF + e0 + j] + OF[64 * LF + tok * LF + e0 + j]; ss += o[j] * o[j]; }
#pragma unroll
        for (int k = 1; k < 8; k <<= 1) ss += __shfl_xor(ss, k);
        const float rs = 1.f / sqrtf(ss * (1.f / 64.f) + EPS);
        const float ng[8] = {ngv0.x, ngv0.y, ngv0.z, ngv0.w, ngv1.x, ngv1.y, ngv1.z, ngv1.w}; const unsigned gu[4] = {gzv.x, gzv.y, gzv.z, gzv.w};
        unsigned pk[4];
#pragma unroll
        for (int j = 0; j < 4; ++j) pk[j] = pk2(o[2 * j] * rs * ng[2 * j] * sigmoidf_(u2f(gu[j] << 16)), o[2 * j + 1] * rs * ng[2 * j + 1] * sigmoidf_(u2f(gu[j] & 0xffff0000u)));
        *(u32x4*)(WSP(bf16_t, WS_MIX) + (size_t)row * D + 256 + h * 64 + e0) = (u32x4){pk[0], pk[1], pk[2], pk[3]}; }
    __syncthreads();
}
constexpr int HA_Q = 0, HA_K = 16640, HA_CUM = 33280, HA_V = 49920, HA_SC = 66560  , HA_VT = 70912, HA_KDT = 80128, HA_QT = 89344, HA_KT = 98560;
__device__ __forceinline__ void hgrn_a_item(Ctx& C, int l, int b, int h, int dir, int c) {
    LAS unsigned char* lds = C.lds; ITEM_IDS();
    LAS float* Qf = (LAS float*)(lds + HA_Q); LAS float* Kf = (LAS float*)(lds + HA_K); LAS float* CUM = (LAS float*)(lds + HA_CUM); LAS float* Vf = (LAS float*)(lds + HA_V); LAS float* SC = (LAS float*)(lds + HA_SC);
    LAS bf16_t* VT = (LAS bf16_t*)(lds + HA_VT); LAS bf16_t* KDT = (LAS bf16_t*)(lds + HA_KDT); LAS bf16_t* QTb = (LAS bf16_t*)(lds + HA_QT); LAS bf16_t* KTb = (LAS bf16_t*)(lds + HA_KT);
    const bf16_t* zb = WSP(bf16_t, WS_Z);
    unsigned char* blob = C.ws + WS_HG + ((size_t)((b * NH + h) * 2 + dir) * NCH + c) * HG_BLOB;
    const int i = tid >> 3, d0 = (tid & 7) * 8; const int row = scan_row<0>(b, dir, 64 * c + i);
    { const bf16_t* zr = zb + (size_t)row * ZW + HGB + h * 64 + d0; const float* lbp = WSP(float, WS_LB) + l * 256 + h * 64 + d0;
#pragma unroll
        for (int j = 0; j < 8; ++j) { const float qz = bf2f(zr[j]), iz = bf2f(zr[256 + j]), fz = bf2f(zr[512 + dir * 256 + j]), lb = lbp[j];
            const float sg = 1.f / (1.f + __expf(-fz)), sgn = 1.f / (1.f + __expf(fz));
            Qf[i * LF + d0 + j] = siluf_(qz); Kf[i * LF + d0 + j] = (1.f - lb) * sgn; CUM[i * LF + d0 + j] = __logf(lb + (1.f - lb) * sg); Vf[i * LF + d0 + j] = iz; VT[(d0 + j) * LS + i] = (bf16_t)f2bf(iz); } }
    __syncthreads();
    if (tid < 256) { const int sub = tid >> 6, d = tid & 63; float a = 0.f;
#pragma unroll
        for (int t = 0; t < 16; ++t) { a += CUM[(16 * sub + t) * LF + d]; CUM[(16 * sub + t) * LF + d] = a; } }
    __syncthreads();
    { const int sub = i >> 4; u32x4 wq, wk; float qt[8], kt[8];
#pragma unroll
        for (int j = 0; j < 8; ++j) { const float cm = CUM[i * LF + d0 + j], last = CUM[(16 * sub + 15) * LF + d0 + j], kk = Kf[i * LF + d0 + j];
            KDT[(d0 + j) * LS + i] = (bf16_t)f2bf(kk * __expf(last - cm)); qt[j] = Qf[i * LF + d0 + j] * __expf(cm); kt[j] = kk * __expf(fminf(-cm, 80.f));
            if ((i & 15) == 15) ((float*)(blob + 32768))[sub * 64 + d0 + j] = __expf(last); }
        wq.x = pk2(qt[0], qt[1]); wq.y = pk2(qt[2], qt[3]); wq.z = pk2(qt[4], qt[5]); wq.w = pk2(qt[6], qt[7]);
        wk.x = pk2(kt[0], kt[1]); wk.y = pk2(kt[2], kt[3]); wk.z = pk2(kt[4], kt[5]); wk.w = pk2(kt[6], kt[7]);
        *(u32x4*)((bf16_t*)(blob + 33792) + i * 64 + d0) = wq; *(LAS u32x4*)(QTb + i * LS + d0) = wq; *(LAS u32x4*)(KTb + i * LS + d0) = wk; }
    __syncthreads();
    if (w < 4) { const int sub = w, cl = lane & 15, q4 = lane >> 4; f32x4 acc = (f32x4){0.f, 0.f, 0.f, 0.f};
#pragma unroll
        for (int kk = 0; kk < 2; ++kk) { const bf16x8 a = *(const LAS bf16x8*)(QTb + (16 * sub + cl) * LS + 32 * kk + 8 * q4), bb = *(const LAS bf16x8*)(KTb + (16 * sub + cl) * LS + 32 * kk + 8 * q4);
            acc = __builtin_amdgcn_mfma_f32_16x16x32_bf16(a, bb, acc, 0, 0, 0); }
#pragma unroll
        for (int r = 0; r < 4; ++r) { const int t = 4 * q4 + r; SC[(sub * 16 + t) * 17 + cl] = (cl <= t) ? acc[r] : 0.f; } }
    __syncthreads();
    { const int sub = i >> 4, t = i & 15; float o[8];
#pragma unroll
        for (int j = 0; j < 8; ++j) o[j] = 0.f;
        for (int s2 = 0; s2 <= t; ++s2) { const float sc = SC[(sub * 16 + t) * 17 + s2];
#pragma unroll
            for (int j = 0; j < 8; ++j) o[j] += sc * Vf[(16 * sub + s2) * LF + d0 + j]; }
        float* op = (float*)(blob + 41984) + i * 64 + d0; *(f32x4*)op = (f32x4){o[0], o[1], o[2], o[3]}; *(f32x4*)(op + 4) = (f32x4){o[4], o[5], o[6], o[7]}; }
    { const int sub = w >> 1, eh = (w & 1) * 32; f32x16 acc[2]; acc[0] = (f32x16)(0.f); acc[1] = (f32x16)(0.f);
        mm_nt<2, 1>(VT + eh * LS + 16 * sub, LS, KDT + 16 * sub, LS, acc, lane);
        bf16_t* ut = (bf16_t*)blob + sub * 4096;
#pragma unroll
        for (int n = 0; n < 2; ++n)
#pragma unroll
            for (int ri = 0; ri < 16; ++ri) ut[(eh + CROW(ri, lane)) * 64 + 32 * n + (lane & 31)] = (bf16_t)f2bf(acc[n][ri]); }
    __syncthreads();
}
__device__ __forceinline__ void hgrn_b_scan(Ctx& C, int sidx) {
    const int tid = C.tid, e = tid >> 3, d0 = (tid & 7) * 8;
    LAS float* LAM = (LAS float*)C.lds;
    __syncthreads();
    for (int o = tid; o < NCH * 64; o += 512) { const int c = o >> 6, q = o & 63; *(LAS f32x4*)(LAM + c * 256 + q * 4) = *(const f32x4*)((const float*)(C.ws + WS_HG + ((size_t)sidx * NCH + c) * HG_BLOB + 32768) + q * 4); }
    __syncthreads();
    float st[8];
#pragma unroll
    for (int j = 0; j < 8; ++j) st[j] = 0.f;
    u32x4 ur[3][4];
#define HGB_LOAD(slot, cc) do { const int c_ = (cc) < NCH ? (cc) : NCH - 1; const unsigned char* blob_ = C.ws + WS_HG + ((size_t)sidx * NCH + c_) * HG_BLOB; \
        _Pragma("unroll") for (int sub = 0; sub < 4; ++sub) ur[slot][sub] = *(const u32x4*)((const bf16_t*)blob_ + sub * 4096 + e * 64 + d0); } while (0)
#define HGB_APPLY(slot, cc) do { bf16_t* so_ = WSP(bf16_t, WS_HST) + ((size_t)sidx * NCH + (cc)) * 4 * 4096; \
        _Pragma("unroll") for (int sub = 0; sub < 4; ++sub) { u32x4 wv; wv.x = pk2(st[0], st[1]); wv.y = pk2(st[2], st[3]); wv.z = pk2(st[4], st[5]); wv.w = pk2(st[6], st[7]); \
            *(u32x4*)(so_ + sub * 4096 + e * 64 + d0) = wv; \
            const f32x4 la_ = *(const LAS f32x4*)(LAM + ((cc) * 4 + sub) * 64 + d0), lb_ = *(const LAS f32x4*)(LAM + ((cc) * 4 + sub) * 64 + d0 + 4); \
            const unsigned uu[4] = {ur[slot][sub].x, ur[slot][sub].y, ur[slot][sub].z, ur[slot][sub].w}; const float lam[8] = {la_.x, la_.y, la_.z, la_.w, lb_.x, lb_.y, lb_.z, lb_.w}; \
            _Pragma("unroll") for (int j = 0; j < 4; ++j) { st[2 * j] = lam[2 * j] * st[2 * j] + u2f(uu[j] << 16); st[2 * j + 1] = lam[2 * j + 1] * st[2 * j + 1] + u2f(uu[j] & 0xffff0000u); } } } while (0)
    HGB_LOAD(0, 0); HGB_LOAD(1, 1);
    int c = 0;
    for (; c + 3 <= NCH; c += 3) {
        HGB_LOAD(2, c + 2); HGB_APPLY(0, c);
        HGB_LOAD(0, c + 3); HGB_APPLY(1, c + 1);
        HGB_LOAD(1, c + 4); HGB_APPLY(2, c + 2);
    }
    if (c < NCH) { HGB_APPLY(0, c); ++c; }
    if (c < NCH) { HGB_APPLY(1, c); ++c; }
#undef HGB_LOAD
#undef HGB_APPLY
    __syncthreads();
}
__device__ __forceinline__ void hgrn_c_item(Ctx& C, int l, int b, int h, int jt) {
    LAS unsigned char* lds = C.lds; ITEM_IDS();
    LAS bf16_t* STw = (LAS bf16_t*)(lds + w * 11520);
    LAS bf16_t* QTw = STw + 64 * LS;
    LAS float* OF = (LAS float*)(lds + 92160);
    const bool isc = jt < NCHC; const int jl = jt - NCHC;
    int cidx[2]; cidx[0] = jt; cidx[1] = isc ? (NCHC - 1 - jt) : NCHC + (SEQ / 64 - 1 - jl);
    const int tokf = tid >> 3, e0f = (tid & 7) * 8; const int rowf = scan_row<0>(b, 0, 64 * cidx[0] + tokf);
    const u32x4 gzv = *(const u32x4*)(WSP(bf16_t, WS_Z) + (size_t)rowf * ZW + HGB + 1024 + h * 64 + e0f);
    const f32x4 ngv0 = *(const f32x4*)(INP(I_HGNG) + l * 256 + h * 64 + e0f), ngv1 = *(const f32x4*)(INP(I_HGNG) + l * 256 + h * 64 + e0f + 4);
    { const int dir = w >> 2, sub = w & 3; const size_t sc = (size_t)((b * NH + h) * 2 + dir) * NCH + cidx[dir]; const unsigned char* blob = C.ws + WS_HG + sc * HG_BLOB;
        const bf16_t* st = WSP(bf16_t, WS_HST) + (sc * 4 + sub) * 4096; const bf16_t* qt = (const bf16_t*)(blob + 33792) + (16 * sub) * 64;
#pragma unroll
        for (int k = 0; k < 8; ++k) { const int o = lane + 64 * k, r = o >> 3, c8 = (o & 7) * 8; *(LAS u32x4*)(STw + r * LS + c8) = *(const u32x4*)(st + r * 64 + c8); }
#pragma unroll
        for (int k = 0; k < 2; ++k) { const int o = lane + 64 * k, r = o >> 3, c8 = (o & 7) * 8; *(LAS u32x4*)(QTw + r * LS + c8) = *(const u32x4*)(qt + r * 64 + c8); }
        const float* oi = (const float*)(blob + 41984) + (16 * sub) * 64;
        float oiv[16];
#pragma unroll
        for (int nt = 0; nt < 4; ++nt)
#pragma unroll
            for (int r = 0; r < 4; ++r) oiv[4 * nt + r] = oi[(4 * (lane >> 4) + r) * 64 + 16 * nt + (lane & 15)];
        LDS_WAIT(); asm volatile("" ::: "memory");
        const int tr = lane & 15, kq = (lane >> 4) * 8;
#pragma unroll
        for (int nt = 0; nt < 4; ++nt) { f32x4 acc = (f32x4){0.f, 0.f, 0.f, 0.f};
#pragma unroll
            for (int kk = 0; kk < 2; ++kk) { const bf16x8 a = *(const LAS bf16x8*)(QTw + tr * LS + 32 * kk + kq), bb = *(const LAS bf16x8*)(STw + (16 * nt + tr) * LS + 32 * kk + kq);
                acc = __builtin_amdgcn_mfma_f32_16x16x32_bf16(a, bb, acc, 0, 0, 0); }
#pragma unroll
            for (int r = 0; r < 4; ++r) { const int t = 4 * (lane >> 4) + r, ii = 16 * sub + t, tok = dir ? 63 - ii : ii, ee = 16 * nt + (lane & 15);
                OF[dir * 64 * LF + tok * LF + ee] = acc[r] + oiv[4 * nt + r]; } } }
    __syncthreads();
    { const int tok = tid >> 3, e0 = (tid & 7) * 8; const int row = scan_row<0>(b, 0, 64 * cidx[0] + tok);
        float o[8]; float ss = 0.f;
#pragma unroll
        for (int j = 0; j < 8; ++j) { o[j] = OF[tok * LF + e0 + j] + OF[64 * LF + tok * LF + e0 + j]; ss += o[j] * o[j]; }
#pragma unroll
        for (int k = 1; k < 8; k <<= 1) ss += __shfl_xor(ss, k);
        const float rs = 1.f / sqrtf(ss * (1.f / 64.f) + EPS);
        const float ng[8] = {ngv0.x, ngv0.y, ngv0.z, ngv0.w, ngv1.x, ngv1.y, ngv1.z, ngv1.w}; const unsigned gu[4] = {gzv.x, gzv.y, gzv.z, gzv.w};
        unsigned pk[4];
#pragma unroll
        for (int j = 0; j < 4; ++j) pk[j] = pk2(o[2 * j] * rs * ng[2 * j] * siluf_(u2f(gu[j] << 16)), o[2 * j + 1] * rs * ng[2 * j + 1] * siluf_(u2f(gu[j] & 0xffff0000u)));
        *(u32x4*)(WSP(bf16_t, WS_MIX) + (size_t)row * D + h * 64 + e0) = (u32x4){pk[0], pk[1], pk[2], pk[3]}; }
    __syncthreads();
}
__device__ __forceinline__ void phase_gdn_a(Ctx& C, int l) {
    for (int rep = 0; rep < 1 + ((REPMASK >> 10) & 1); ++rep)
    for (int it = C.bid; it < NSCAN * NCH; it += C.G) { const int sidx = it / NCH, c = it % NCH; gdn_a_item(C, l, sidx / (NH * 2), (sidx / 2) % NH, sidx & 1, c); }
    for (int rep = 0; rep < 1 + ((REPMASK >> 11) & 1); ++rep)
    for (int it = C.bid; it < NSCAN * NCH; it += C.G) { const int sidx = it / NCH, c = it % NCH; mlstm_a_item(C, l, sidx / (NH * 2), (sidx / 2) % NH, sidx & 1, c); }
    for (int rep = 0; rep < 1 + ((REPMASK >> 12) & 1); ++rep)
    for (int it = C.bid; it < NSCAN * NCH; it += C.G) { const int sidx = it / NCH, c = it % NCH; hgrn_a_item(C, l, sidx / (NH * 2), (sidx / 2) % NH, sidx & 1, c); }
}
__device__ __forceinline__ void phase_hy_transpose(Ctx& C) {
    const int gw = C.vcu * 8 + C.wave, NGW = C.G * 8, lane = C.lane;
    LAS bf16_t* scr = (LAS bf16_t*)(C.lds + C.wave * 8448);
    const bf16_t* zb = WSP(bf16_t, WS_Z); bf16_t* zt = WSP(bf16_t, WS_ZT);
    for (int it = gw; it < (NT / 64) * 12; it += NGW) { const int r0 = (it / 12) * 64, cb = (it % 12) * 64;
#pragma unroll 8
        for (int rr = 0; rr < 64; rr += 2) { const int r = rr + (lane >> 5), c2 = (lane & 31) * 2; const unsigned v = *(const unsigned*)(zb + (size_t)(r0 + r) * ZW + HYB + cb + c2);
            scr[r * 66 + c2] = (bf16_t)(v & 0xffffu); scr[r * 66 + c2 + 1] = (bf16_t)(v >> 16); }
        LDS_WAIT(); asm volatile("" ::: "memory");
#pragma unroll 8
        for (int cc = 0; cc < 64; cc += 2) { const int c = cc + (lane >> 5), r2 = (lane & 31) * 2;
            *(unsigned*)(zt + (size_t)(cb + c) * NT + r0 + r2) = (unsigned)scr[r2 * 66 + c] | ((unsigned)scr[(r2 + 1) * 66 + c] << 16); }
        LDS_WAIT(); asm volatile("" ::: "memory"); }
}
__device__ __forceinline__ void phase_gdn_c(Ctx& C, int l) {
    const int j0 = (l == 0) ? 0 : NCHC, nj = NCH - j0;
    for (int it = C.bid; it < NB * NH * nj; it += C.G) { const int bh = it / nj, jt = j0 + it % nj; gdn_c_item(C, l, bh / NH, bh % NH, jt); }
    for (int it = C.bid; it < NB * NH * nj; it += C.G) { const int bh = it / nj, jt = j0 + it % nj; mlstm_c_item(C, l, bh / NH, bh % NH, jt); }
    for (int it = C.bid; it < NB * NH * nj; it += C.G) { const int bh = it / nj, jt = j0 + it % nj; hgrn_c_item(C, l, bh / NH, bh % NH, jt); }
}

__device__ __forceinline__ f32x2 cmul(f32x2 a, f32x2 w) { return (f32x2){a.x * w.x - a.y * w.y, a.x * w.y + a.y * w.x}; }
__device__ __forceinline__ f32x2 cmulc(f32x2 a, f32x2 w) { return (f32x2){a.x * w.x + a.y * w.y, a.y * w.x - a.x * w.y}; }
template <int N> __device__ __forceinline__ void fft_fwd(LAS f32x2* X, const LAS f32x2* tw, int tid) {
    constexpr int NG = (N / 4 + 511) / 512, NB2 = (N / 2 + 511) / 512;
    int h = N >> 1;
#pragma unroll 1
    for (; h >= 2; h >>= 2) { const float tf = 3.14159265358979f / (float)h; const int hh = h >> 1;
        f32x2 x0[NG], x1[NG], x2[NG], x3[NG], w1[NG]; int bs[NG];
#pragma unroll
        for (int q = 0; q < NG; ++q) { const int j = tid + 512 * q; const int jm = j & (hh - 1); bs[q] = ((j - jm) << 2) + jm;
            if (j < (N >> 2)) { x0[q] = X[bs[q]]; x1[q] = X[bs[q] + hh]; x2[q] = X[bs[q] + h]; x3[q] = X[bs[q] + h + hh]; const float ang = (float)jm * tf; w1[q] = (f32x2){__cosf(ang), -__sinf(ang)}; } }
#pragma unroll
        for (int q = 0; q < NG; ++q) { const int j = tid + 512 * q; if (j < (N >> 2)) {
            const f32x2 w2 = cmul(w1[q], w1[q]);
            const f32x2 a0 = x0[q] + x2[q], a2 = cmul(x0[q] - x2[q], w1[q]), a1 = x1[q] + x3[q]; const f32x2 d13 = cmul(x1[q] - x3[q], w1[q]); const f32x2 a3 = (f32x2){d13.y, -d13.x};
            X[bs[q]] = a0 + a1; X[bs[q] + hh] = cmul(a0 - a1, w2); X[bs[q] + h] = a2 + a3; X[bs[q] + h + hh] = cmul(a2 - a3, w2); } }
        __syncthreads(); }
    if (h == 1) {
        f32x2 a[NB2], b[NB2];
#pragma unroll
        for (int q = 0; q < NB2; ++q) { const int j = tid + 512 * q; if (j < (N >> 1)) { a[q] = X[2 * j]; b[q] = X[2 * j + 1]; } }
#pragma unroll
        for (int q = 0; q < NB2; ++q) { const int j = tid + 512 * q; if (j < (N >> 1)) { X[2 * j] = a[q] + b[q]; X[2 * j + 1] = a[q] - b[q]; } }
        __syncthreads(); }
}
template <int N> __device__ __forceinline__ void fft_inv(LAS f32x2* X, const LAS f32x2* tw, int tid) {
    constexpr int NG = (N / 4 + 511) / 512, NB2 = (N / 2 + 511) / 512;
    constexpr int LOG2N = (N == 8192) ? 13 : (N == 4096) ? 12 : (N == 2048) ? 11 : (N == 1024) ? 10 : (N == 512) ? 9 : (N == 256) ? 8 : (N == 128) ? 7 : (N == 64) ? 6 : -1;
    static_assert(LOG2N > 0, "fft size");
    int h = 2;
    if (LOG2N & 1) {
        f32x2 a[NB2], b[NB2];
#pragma unroll
        for (int q = 0; q < NB2; ++q) { const int j = tid + 512 * q; if (j < (N >> 1)) { a[q] = X[2 * j]; b[q] = X[2 * j + 1]; } }
#pragma unroll
        for (int q = 0; q < NB2; ++q) { const int j = tid + 512 * q; if (j < (N >> 1)) { X[2 * j] = a[q] + b[q]; X[2 * j + 1] = a[q] - b[q]; } }
        __syncthreads(); h = 4; }
#pragma unroll 1
    for (; h <= (N >> 1); h <<= 2) { const float tf = 3.14159265358979f / (float)h; const int hh = h >> 1;
        f32x2 x0[NG], x1[NG], x2[NG], x3[NG], w1[NG]; int bs[NG];
#pragma unroll
        for (int q = 0; q < NG; ++q) { const int j = tid + 512 * q; const int jm = j & (hh - 1); bs[q] = ((j - jm) << 2) + jm;
            if (j < (N >> 2)) { x0[q] = X[bs[q]]; x1[q] = X[bs[q] + hh]; x2[q] = X[bs[q] + h]; x3[q] = X[bs[q] + h + hh]; const float ang = (float)jm * tf; w1[q] = (f32x2){__cosf(ang), -__sinf(ang)}; } }
#pragma unroll
        for (int q = 0; q < NG; ++q) { const int j = tid + 512 * q; if (j < (N >> 2)) {
            const f32x2 w2 = cmul(w1[q], w1[q]);
            const f32x2 b1 = cmulc(x1[q], w2), b3 = cmulc(x3[q], w2); const f32x2 a0 = x0[q] + b1, a1 = x0[q] - b1, a2 = x2[q] + b3, a3 = x2[q] - b3;
            const f32x2 c2 = cmulc(a2, w1[q]); const f32x2 t3 = cmulc(a3, w1[q]); const f32x2 c3 = (f32x2){-t3.y, t3.x};
            X[bs[q]] = a0 + c2; X[bs[q] + h] = a0 - c2; X[bs[q] + hh] = a1 + c3; X[bs[q] + h + hh] = a1 - c3; } }
        __syncthreads(); }
}
__device__ __forceinline__ float block_sum(Ctx& C, float v, LAS float* red) {
    v = wave_sum(v); __syncthreads(); if (C.lane == 0) red[C.wave] = v; __syncthreads();
    float s = 0.f;
#pragma unroll
    for (int i = 0; i < 8; ++i) s += red[i];
    return s;
}
#define FFT_FWD_P(X) do { fft_fwd<N>(X, tw, tid); if ((REPMASK >> 15) & 1) { fft_inv<N>(X, tw, tid); for (int i_ = tid; i_ < N; i_ += 512) X[i_] = X[i_] * (1.0f / (float)N); __syncthreads(); fft_fwd<N>(X, tw, tid); } } while (0)
template <int LEN>
__device__ __forceinline__ void hyena_channel(Ctx& C, int l, int c, int row0, int hoff  ) {
    LAS f32x2* X = (LAS f32x2*)C.lds; LAS f32x2* Y1 = (LAS f32x2*)(C.lds + 65536); const LAS f32x2* tw = (const LAS f32x2*)(C.lds + 98304); LAS float* red = (LAS float*)(C.lds + LDSX_OFF + 128);
    constexpr int N = 2 * LEN, len = LEN, NI = (LEN + 511) / 512;
#ifdef HOST_EMU
    const int tid = C.tid;
#else
    int tid_ = C.tid; asm volatile("" : "+v"(tid_)); const int tid = tid_;
#endif
    f32x2* Ks = WSP(f32x2, WS_KS) + (size_t)C.bid * 2 * FFTN;
    const float* hd = WSP(float, WS_HDN) + ((size_t)l * (SEQ + LC) + hoff) * 64;
    const float* w3 = INP(I_HYW3) + (size_t)l * 64 * 1024;
    const float delta = (-4.605170185988091f / 1.5f + (-4.605170185988091f / 0.3f + 4.605170185988091f / 1.5f) * (float)c / 255.0f);
    const float ad = fabsf(delta);
    LAS f32x4* W3c = (LAS f32x4*)(C.lds + 98304);
    __syncthreads();
    if (tid < 256) { const int j = tid >> 2, q = tid & 3; ((LAS float*)W3c)[tid] = w3[j * 1024 + (q & 1) * 512 + (q >> 1) * 256 + c]; }
    __syncthreads();
    float ss0 = 0.f, ss1 = 0.f;
    for (int p = tid; p < len; p += 512) { const float* hr = hd + (size_t)p * 64; f32x4 acc = (f32x4){0.f, 0.f, 0.f, 0.f};
#pragma unroll 16
        for (int j = 0; j < 64; ++j) acc = acc + W3c[j] * hr[j];
        const float win = __expf(-((float)p / (float)(len - 1)) * ad); acc = acc * win;
        X[p] = (f32x2){acc.x, 0.f}; ss0 += acc.x * acc.x; ss1 += acc.z * acc.z;
        if (p >= 1) { X[N - p] = (f32x2){acc.y, 0.f}; ss0 += acc.y * acc.y; ss1 += acc.w * acc.w; }
        Y1[p] = (f32x2){acc.z, acc.w}; }
    if (tid == 0) X[len] = (f32x2){0.f, 0.f};
    const float scale0 = 1.f / sqrtf(block_sum(C, ss0, red) + EPS), scale1 = 1.f / sqrtf(block_sum(C, ss1, red) + EPS);
    __syncthreads();
    for (int n = 0; n < 2 + 2 * ((REPMASK >> 16) & 1); ++n) {
        if (n & 1) { for (int p = tid; p < len; p += 512) { const f32x2 t1 = Y1[p]; X[p] = (f32x2){t1.x, 0.f}; if (p >= 1) X[N - p] = (f32x2){t1.y, 0.f}; } if (tid == 0) X[len] = (f32x2){0.f, 0.f}; __syncthreads(); }
        FFT_FWD_P(X);
        const float scale = (n & 1) ? scale1 : scale0;
        for (int i = tid; i < N; i += 512) Ks[(size_t)(n & 1) * FFTN + i] = X[i] * scale;
        __syncthreads();
    }
    const bf16_t* zt = WSP(bf16_t, WS_ZT); const float* cw = INP(I_HYCW) + l * 3 * 768; const float* cb = INP(I_HYCB) + l * 768;
    const float bias0 = INP(I_HYBI)[l * 512 + c], bias1 = INP(I_HYBI)[l * 512 + 256 + c];
    float* hyt = WSP(float, WS_HYT) + (size_t)c * NT;
    const float inv_n = 1.0f / (float)N;
    const float cw0[3] = {cw[c], cw[768 + c], cw[1536 + c]}, cw1[3] = {cw[256 + c], cw[768 + 256 + c], cw[1536 + 256 + c]}, cw2[3] = {cw[512 + c], cw[768 + 512 + c], cw[1536 + 512 + c]};
    const float cb0 = cb[c], cb1 = cb[256 + c], cb2 = cb[512 + c];
    auto conv3 = [&](const bf16_t* zc, int row, int t, const float (&wv)[3], float bv) -> float {
        const bf16_t* zr = zc + row; float s = bv + wv[1] * bf2f(zr[0]);
        if (t > 0) s += wv[0] * bf2f(zr[-1]);
        if (t < len - 1) s += wv[2] * bf2f(zr[1]);
        return s; };
    const bf16_t* z0 = zt + (size_t)c * NT; const bf16_t* z1 = zt + (size_t)(256 + c) * NT; const bf16_t* z2 = zt + (size_t)(512 + c) * NT;
    for (int q2 = 0; q2 < NB * (1 + ((REPMASK >> 17) & 1)); q2 += 2) { const int q = q2 % NB;
        const int ra = row0 + q * len, rb = ra + len;
        float va[NI], vb[NI];
#pragma unroll
        for (int k = 0; k < NI; ++k) { const int t = tid + 512 * k; if (t < len) { va[k] = conv3(z0, ra + t, t, cw0, cb0); vb[k] = conv3(z0, rb + t, t, cw0, cb0); X[t] = (f32x2){va[k], vb[k]}; X[len + t] = (f32x2){0.f, 0.f}; } }
        __syncthreads();
        FFT_FWD_P(X);
#pragma unroll
        for (int k = 0; k < 2 * NI; ++k) { const int i = tid + 512 * k; if (i < N) { const f32x2 kk = Ks[i], x = X[i]; X[i] = (f32x2){x.x * kk.x - x.y * kk.y, x.x * kk.y + x.y * kk.x}; } }
        __syncthreads();
        fft_inv<N>(X, tw, tid);
        f32x2 y1[NI];
#pragma unroll
        for (int k = 0; k < NI; ++k) { const int t = tid + 512 * k; if (t < len) { const f32x2 cv = X[t] * inv_n; const float xa = conv3(z1, ra + t, t, cw1, cb1), xb = conv3(z1, rb + t, t, cw1, cb1);
            y1[k] = (f32x2){xa * (cv.x + bias0 * va[k]), xb * (cv.y + bias0 * vb[k])}; } }
        __syncthreads();
#pragma unroll
        for (int k = 0; k < NI; ++k) { const int t = tid + 512 * k; if (t < len) { Y1[t] = y1[k]; X[t] = y1[k]; X[len + t] = (f32x2){0.f, 0.f}; } }
        __syncthreads();
        FFT_FWD_P(X);
#pragma unroll
        for (int k = 0; k < 2 * NI; ++k) { const int i = tid + 512 * k; if (i < N) { const f32x2 kk = Ks[FFTN + i], x = X[i]; X[i] = (f32x2){x.x * kk.x - x.y * kk.y, x.x * kk.y + x.y * kk.x}; } }
        __syncthreads();
        fft_inv<N>(X, tw, tid);
#pragma unroll
        for (int k = 0; k < NI; ++k) { const int t = tid + 512 * k; if (t < len) { const f32x2 cv = X[t] * inv_n, yy = Y1[t]; const float xa = conv3(z2, ra + t, t, cw2, cb2), xb = conv3(z2, rb + t, t, cw2, cb2);
            hyt[ra + t] = xa * (cv.x + bias1 * yy.x); hyt[rb + t] = xb * (cv.y + bias1 * yy.y); } }
        __syncthreads();
    }
}
__device__ __forceinline__ void phase_mixers(Ctx& C, int l, int parts = 3) {
    const int G = C.G, me = C.bid;
    const int nscan = 3 * NSCAN, nsw = G > nscan ? nscan : G;
    if (parts & 1) for (int j = me; j < nscan; j += nsw) { if (me >= nsw) break;
        const int mix = j / NSCAN, r = j % NSCAN;
        if (mix == 0) hgrn_b_scan(C, r); else if (mix == 1) mlstm_b_scan(C, r); else gdn_b_scan(C, r); }
    if (parts & 2) {
        LAS f32x2* tw = (LAS f32x2*)(C.lds + 98304); volatile LAS int* jobw = (volatile LAS int*)(C.lds + LDSX_OFF + 192);
        __syncthreads();
        for (int k = C.tid; k < TWN; k += 512) { float s, c; sincospi_((float)k / (float)TWN, &s, &c); tw[k] = (f32x2){c, -s}; }
        __syncthreads();
        unsigned* qh = WSP(unsigned, WS_CTL) + CW_HYQ + 64 * l + ((parts == 2) ? 32 : 0);
        for (;;) {
            if (C.tid == 0) jobw[0] = (int)atomicAdd(qh, 1u);
            __syncthreads();
            const int c = jobw[0];
            __syncthreads();
            if (c >= 256) break;
            hyena_channel<SEQ>(C, l, c, 0, 0); if (l == 0) hyena_channel<LC>(C, l, c, NLAT, SEQ);
        }
    }
}
__device__ __forceinline__ void phase_finalize(Ctx& C, int l) {
    const int gw = C.vcu * 8 + C.wave, NGW = C.G * 8, lane = C.lane;
    const int nrows = (l == 0) ? NT : NLAT;
    const bf16_t* zb = WSP(bf16_t, WS_Z); bf16_t* mix = WSP(bf16_t, WS_MIX);
    LAS float* scr = (LAS float*)(C.lds + C.wave * 8448);
    const int ntr = nrows / 64;
    for (int it = gw; it < ntr * 8; it += NGW) { const int rt = it / 8, cb = (it % 8) * 32; const float* src = WSP(float, WS_HYT) + (size_t)cb * NT + rt * 64;
#pragma unroll 8
        for (int cc = 0; cc < 32; ++cc) scr[cc * 65 + lane] = src[(size_t)cc * NT + lane];
        LDS_WAIT(); asm volatile("" ::: "memory");
        for (int rr = 0; rr < 64; rr += 4) { const int r = rr + (lane >> 4), c2 = (lane & 15) * 2;
            *(unsigned*)(mix + (size_t)(rt * 64 + r) * D + 512 + cb + c2) = pk2(scr[c2 * 65 + r], scr[(c2 + 1) * 65 + r]); }
        LDS_WAIT(); asm volatile("" ::: "memory"); }
}

enum { PH_PRO = 0, PH_L0 = 1, PH_PER_LAYER = 10, PH_FINAL = PH_L0 + DEPTH * PH_PER_LAYER, PH_COUNT };
__global__ void __launch_bounds__(512, 2) fwd_kernel(Args args) {
#ifdef HOST_EMU
    unsigned char* lds = emu::cur->blk->lds;
#else
    extern __shared__ __attribute__((aligned(16))) unsigned char lds[];
#endif
#ifdef HOST_EMU
    Ctx C; C.lds = (LAS unsigned char*)lds; C.a = &args; C.ws = args.ws;
#else
    Ctx C; C.lds = (LAS unsigned char*)lds; C.a = (const __attribute__((address_space(4))) Args*)__builtin_amdgcn_kernarg_segment_ptr(); C.ws = C.a->ws;
#endif
    C.tid = threadIdx.x; C.lane = C.tid & 63; C.wave = __builtin_amdgcn_readfirstlane(C.tid >> 6);
    C.bid = blockIdx.x; C.G = gridDim.x; { const int bx = blockIdx.x; C.vcu = (C.G % 8 == 0) ? (bx % 8) * (C.G / 8) + bx / 8 : bx; }
    volatile LAS unsigned* MISC = (volatile LAS unsigned*)(C.lds + LDSX_OFF + LX_MISC);
    for (int u = C.tid; u < 64; u += 512) MISC[u] = 0u;
    __syncthreads();
    const int lo = C.a->ph_lo, hi = C.a->ph_hi;
    const bool multi = (hi - lo) > 1;
    XcdBarrier bar; bar.bar = WSP(unsigned, WS_CTL) + CW_BAR; bar.x = 0; bar.st = nullptr;
    if (multi) bar = xcd_barrier_post(WSP(unsigned, WS_CTL) + CW_BAR, MISC + 8);
#ifndef HOST_EMU
    if (multi) { cooperative_groups::this_grid().sync(); }
#endif
    const Ctx C0 = C;
#ifdef HOST_EMU
#define LAUNDER_CTX() Ctx C = C0; C.tid = threadIdx.x; C.lane = C.tid & 63; C.wave = C.tid >> 6;
#else
#define LAUNDER_CTX() Ctx C = C0; C.tid = threadIdx.x; \
        {   unsigned long long pw = (unsigned long long)C.ws, pa = (unsigned long long)C.a; unsigned w0 = (unsigned)pw, w1 = (unsigned)(pw >> 32), a0 = (unsigned)pa, a1 = (unsigned)(pa >> 32), v0 = (unsigned)C.vcu, g0 = (unsigned)C.G, b0 = (unsigned)C.bid; \
            asm volatile("" : "+v"(w0), "+v"(w1), "+v"(a0), "+v"(a1), "+v"(v0), "+v"(g0), "+v"(b0), "+v"(C.tid)); \
            w0 = __builtin_amdgcn_readfirstlane(w0); w1 = __builtin_amdgcn_readfirstlane(w1); a0 = __builtin_amdgcn_readfirstlane(a0); a1 = __builtin_amdgcn_readfirstlane(a1); \
            C.vcu = (int)__builtin_amdgcn_readfirstlane(v0); C.G = (int)__builtin_amdgcn_readfirstlane(g0); C.bid = (int)__builtin_amdgcn_readfirstlane(b0); \
            C.ws = (unsigned char*)(((unsigned long long)w1 << 32) | w0); C.a = (const __attribute__((address_space(4))) Args*)(((unsigned long long)a1 << 32) | a0); } \
        C.lane = C.tid & 63; C.wave = __builtin_amdgcn_readfirstlane(C.tid >> 6);
#endif
#define PH_BEGIN(k) if (lo <= (k) && (k) < hi) { LAUNDER_CTX()
#define PH_END(k) if ((k) + 1 < hi) { XcdBarrier b2 = bar; b2.bar = WSP(unsigned, WS_CTL) + CW_BAR; xcd_barrier(b2); if ((REPMASK >> 22) & 1) xcd_barrier(b2); } }
#define REP(b) ((REPMASK >> (b)) & 1)
    PH_BEGIN(PH_PRO) p0_prologue(C); if (REP(0)) { __syncthreads(); p0_prologue(C); } PH_END(PH_PRO)
#define LAYER_PHASES(l) { constexpr int pb = PH_L0 + (l) * PH_PER_LAYER; \
    PH_BEGIN(pb + 0) if ((l) > 0) (void)build_tiles(C, (l) > 0 ? (l) - 1 : 0); phase_rows_a(C, (l)); if (REP(13) && (l) == 0) { __syncthreads(); phase_rows_a(C, (l)); } PH_END(pb + 0) \
    PH_BEGIN(pb + 1) pg8::Gemm g{WSP(bf16_t, WS_H), WSP(bf16_t, WS_WIN) + (size_t)(l) * ZW * D, D, 0}; pg8::StaticOrder S; S.init(NT, ZW, C.G, C.bid); \
        pg8::EpiBf16 E{WSP(bf16_t, WS_Z), ZW, nullptr, 0}; pg8::gemm_phase(C.lds, g, S, E, C.tid); if (REP(1)) { __syncthreads(); pg8::gemm_phase(C.lds, g, S, E, C.tid); } PH_END(pb + 1) \
    PH_BEGIN(pb + 2) phase_hy_transpose(C); __syncthreads(); phase_gdn_a(C, (l)); if (REP(8)) { __syncthreads(); phase_gdn_a(C, (l)); } PH_END(pb + 2) \
    PH_BEGIN(pb + 3) phase_mixers(C, (l)); if (REP(2)) { __syncthreads(); phase_mixers(C, (l), 1); } if (REP(3)) { __syncthreads(); phase_mixers(C, (l), 2); } PH_END(pb + 3) \
    PH_BEGIN(pb + 4) phase_finalize(C, (l)); __syncthreads(); phase_gdn_c(C, (l)); if (REP(4)) { __syncthreads(); phase_finalize(C, (l)); } if (REP(9)) { __syncthreads(); phase_gdn_c(C, (l)); } PH_END(pb + 4) \
    PH_BEGIN(pb + 5) pg8::Gemm g{WSP(bf16_t, WS_MIX), WSP(bf16_t, WS_WOUT) + (size_t)(l) * D * D, D, 0}; pg8::StaticOrder S; S.init((l) == 0 ? NT : NLAT, D, C.G, C.bid); \
        pg8::EpiResid E{(l) == 0 ? INP(I_X) : WSP(float, WS_X), (l) == 0 ? INP(I_CTX) : WSP(float, WS_X) + (size_t)NLAT * D, WSP(float, WS_X), WSP(float, WS_MOD) + (size_t)(l) * (NB + 1) * 6 * D + 2 * D}; \
        pg8::gemm_phase(C.lds, g, S, E, C.tid); if (REP(14) && (l) == 0) { __syncthreads(); pg8::gemm_phase(C.lds, g, S, E, C.tid); } PH_END(pb + 5) \
    PH_BEGIN(pb + 6) phase_rows_b(C, (l)); PH_END(pb + 6) \
    PH_BEGIN(pb + 7) phase_gather(C, (l)); if (REP(5)) { __syncthreads(); phase_gather(C, (l)); } PH_END(pb + 7) \
    PH_BEGIN(pb + 8) const int ntiles = build_tiles(C, (l)); \
        pg8::Gemm g{WSP(bf16_t, WS_HS), WSP(bf16_t, WS_W1) + (size_t)(l) * NE * 2 * DE * D, D, (size_t)2 * DE * D}; pg8::MoeOrder S; S.init(ntiles, 2 * DE, C.G, C.bid, (const LAS int*)(C.lds + LDSX_OFF + LX_TILE)); \
        pg8::EpiSwiglu E{WSP(bf16_t, WS_A2), INP(I_EB1) + (size_t)(l) * NE * 2 * DE}; pg8::gemm_phase(C.lds, g, S, E, C.tid); if (REP(6)) { __syncthreads(); pg8::gemm_phase(C.lds, g, S, E, C.tid); } PH_END(pb + 8) \
    PH_BEGIN(pb + 9) const int ntiles = build_tiles(C, (l)); \
        pg8::Gemm g{WSP(bf16_t, WS_A2), WSP(bf16_t, WS_W2) + (size_t)(l) * NE * D * DE, DE, (size_t)D * DE}; pg8::MoeOrder S; S.init(ntiles, D, C.G, C.bid, (const LAS int*)(C.lds + LDSX_OFF + LX_TILE)); \
        pg8::EpiBf16 E{WSP(bf16_t, WS_Y), D, INP(I_EB2) + (size_t)(l) * NE * D, D}; pg8::gemm_phase(C.lds, g, S, E, C.tid); if (REP(7)) { __syncthreads(); pg8::gemm_phase(C.lds, g, S, E, C.tid); } PH_END(pb + 9) }
    LAYER_PHASES(0)
    LAYER_PHASES(1)
    static_assert(DEPTH == 2, "two layers written out");
    PH_BEGIN(PH_FINAL) (void)build_tiles(C, DEPTH - 1); phase_rows_a(C, DEPTH); PH_END(PH_FINAL)
}

#ifndef MK_PER_PHASE
#define MK_PER_PHASE 0
#endif
extern "C" void kernel_launch(void* const* d_in, const int* in_sizes, int n_in, void* d_out, int out_size, void* d_ws, size_t ws_size, hipStream_t stream) {
    static int grid = 0;
#ifndef HOST_EMU
    if (grid == 0) {
        if (n_in != 34 || ws_size < WS_END) { fprintf(stderr, "kernel_launch: unexpected n_in %d / ws %zu (need %zu)\n", n_in, ws_size, (size_t)WS_END); grid = -1; return; }
        int dev = 0, cus = 0, per_cu = 0;
        hipGetDevice(&dev); hipDeviceGetAttribute(&cus, hipDeviceAttributeMultiprocessorCount, dev);
        hipFuncSetAttribute((const void*)fwd_kernel, hipFuncAttributeMaxDynamicSharedMemorySize, LDS_BYTES);
        hipOccupancyMaxActiveBlocksPerMultiprocessor(&per_cu, (const void*)fwd_kernel, 512, LDS_BYTES);
        if (per_cu < 1) { fprintf(stderr, "kernel_launch: occupancy query says %d blocks per CU\n", per_cu); per_cu = 1; }
        grid = cus;
        (void)hipGetLastError();
    }
    if (grid < 0) return;
#else
    grid = EMU_GRID;
#endif
    hipMemsetAsync((char*)d_ws + WS_CTL, 0, CTL_BYTES, stream);
    Args a{};
    for (int i = 0; i < 34; ++i) a.in[i] = (const float*)d_in[i];
    a.out = (float*)d_out; a.ws = (unsigned char*)d_ws;
#ifdef HOST_EMU
    a.ph_lo = 0; a.ph_hi = PH_COUNT;
    if (getenv("EMU_PH_HI")) a.ph_hi = atoi(getenv("EMU_PH_HI"));
    emu::launch([&]() { fwd_kernel(a); }, dim3(grid), dim3(512), LDS_BYTES);
#else
#if MK_PER_PHASE
    for (int ph = 0; ph < PH_COUNT; ++ph) { a.ph_lo = ph; a.ph_hi = ph + 1; hipLaunchKernelGGL(fwd_kernel, dim3(grid), dim3(512), LDS_BYTES, stream, a); }
#else
    a.ph_lo = 0; a.ph_hi = PH_COUNT;
    void* kargs[] = {&a};
    hipError_t e = hipLaunchCooperativeKernel((const void*)fwd_kernel, dim3(grid), dim3(512), kargs, LDS_BYTES, stream);
    if (e != hipSuccess) fprintf(stderr, "cooperative launch failed: %s (grid %d)\n", hipGetErrorString(e), grid);
#endif
#endif
}
```

```cpp
#ifdef HOST_EMU
#include "host/emu.h"
#else
#include <hip/hip_runtime.h>
#include <hip/hip_cooperative_groups.h>
#endif
#include <cstdio>
#include <cstdint>
#include <cmath>
#ifndef REPMASK
#define REPMASK 0
#endif

#ifndef CFG_B
#define CFG_B 4
#define CFG_L 4096
#define CFG_GW 64
#define CFG_LC 256
#define CFG_NE 32
#endif
constexpr int NB = CFG_B, SEQ = CFG_L, GW = CFG_GW, GROWS = SEQ / GW, LC = CFG_LC, NE = CFG_NE, TOPK = 4, DEPTH = 2;
constexpr int D = 1024, WG_ = 256, NH = 4, DH = 64;
constexpr int NLAT = NB * SEQ, NCTX = NB * LC, NT = NLAT + NCTX;
constexpr int IN_W = 4128, ZW = 4096;
constexpr int HGB = 0, MLB = 1280, HYB = 2304, GDB = 3072;
constexpr int DE = 1024;
constexpr float EPS = 1e-6f;
constexpr int FFTN = 2 * SEQ, FFTNC = 2 * LC, TWN = FFTN / 2;
static_assert(NT % 256 == 0 && NLAT % 256 == 0, "row counts must be multiples of 256");
static_assert(SEQ % 16 == 0 && LC % 16 == 0, "chunking");
constexpr int MAXTILES = (NT * TOPK + NE * 255) / 256 + 1;

constexpr size_t al256(size_t x) { return (x + 255) & ~(size_t)255; }
constexpr size_t WS_CTL = 0, CTL_BYTES = 1 << 20;
constexpr size_t WS_WIN = WS_CTL + CTL_BYTES;
constexpr size_t WS_WOUT = WS_WIN + (size_t)DEPTH * ZW * D * 2;
constexpr size_t WS_W1 = WS_WOUT + (size_t)DEPTH * D * D * 2;
constexpr size_t WS_W2 = WS_W1 + (size_t)DEPTH * NE * 2 * DE * D * 2;
constexpr size_t WS_WG = WS_W2 + (size_t)DEPTH * NE * D * DE * 2;
constexpr size_t WS_WR = WS_WG + (size_t)DEPTH * 32 * D * 4;
constexpr size_t WS_MOD = WS_WR + (size_t)DEPTH * NE * D * 4;
constexpr size_t WS_LB = WS_MOD + al256((size_t)DEPTH * (NB + 1) * 6 * D * 4);
constexpr size_t WS_HDN = WS_LB + (size_t)DEPTH * 256 * 4;
constexpr size_t WS_X = WS_HDN + (size_t)DEPTH * (SEQ + LC) * 64 * 4;
constexpr size_t WS_H = WS_X + (size_t)NT * D * 4;
constexpr size_t WS_Z = WS_H + (size_t)NT * D * 2;
constexpr size_t WS_ZG = WS_Z + (size_t)NT * ZW * 2;
constexpr size_t WS_MIX = WS_ZG + (size_t)NT * 32 * 4;
constexpr size_t WS_OB = WS_MIX + (size_t)NT * D * 2;
constexpr size_t WS_HYT = WS_OB + (size_t)6 * NT * 256 * 4;
constexpr size_t WS_KS = WS_HYT + (size_t)256 * NT * 4;
constexpr size_t WS_TOP = WS_KS + (size_t)256 * 2 * FFTN * 8;
constexpr size_t WS_HS = WS_TOP + (size_t)NT * 4 * 12;
constexpr size_t WS_A2 = WS_HS + (size_t)MAXTILES * 256 * D * 2;
constexpr size_t WS_Y = WS_A2 + (size_t)MAXTILES * 256 * DE * 2;
constexpr int NCH = (LC + SEQ) / 64, NCHC = LC / 64, NSCAN = NB * NH * 2;
constexpr size_t GD_BLOB = 32768;
constexpr size_t WS_GD = WS_Y + (size_t)MAXTILES * 256 * D * 2;
constexpr size_t WS_GST = WS_GD + (size_t)NSCAN * NCH * GD_BLOB;
constexpr size_t ML_BLOB = 17920;
constexpr size_t WS_ML = WS_GST + (size_t)NSCAN * NCH * 8192;
constexpr size_t ML_ST = 8192 + 512;
constexpr size_t WS_MST = WS_ML + (size_t)NSCAN * NCH * ML_BLOB;
constexpr size_t HG_BLOB = 50176;
constexpr size_t WS_HG = WS_MST + (size_t)NSCAN * NCH * ML_ST;
constexpr size_t WS_HST = WS_HG + (size_t)NSCAN * NCH * HG_BLOB;
constexpr size_t WS_ZT = WS_HST + (size_t)NSCAN * NCH * 4 * 8192;
constexpr size_t WS_END = WS_ZT + (size_t)768 * NT * 2;
static_assert(SEQ % 64 == 0 && LC % 64 == 0, "64-token chunks");
constexpr int CW_CNT = 64;
constexpr int CW_HYQ = 192;
constexpr int CW_BAR = 4096;

constexpr int RING_BYTES = 131072, LDSX_OFF = RING_BYTES, LDS_BYTES = 147456;
constexpr int LX_MISC = 0, LX_TILE = 256;

#ifdef HOST_EMU
#define __expf expf
#define __logf logf
#define __sinf sinf
#define __cosf cosf
#define LAS
#define GAS
#define DEV_ASM(x) ((void)0)
#define VM_WAIT() ((void)0)
#define LDS_WAIT() do { int _s; (void)emu::wave_xchg(&_s, 4, _s); } while (0)
#else
#define LAS __attribute__((address_space(3)))
#define GAS __attribute__((address_space(1)))
#define VM_WAIT() asm volatile("s_waitcnt vmcnt(0)" ::: "memory")
#define LDS_WAIT() asm volatile("s_waitcnt lgkmcnt(0)" ::: "memory")
#endif
typedef unsigned short bf16_t;
typedef short bf16x8 __attribute__((ext_vector_type(8)));
typedef float f32x4 __attribute__((ext_vector_type(4)));
typedef float f32x2 __attribute__((ext_vector_type(2)));
typedef unsigned u32x4 __attribute__((ext_vector_type(4)));
typedef unsigned u32x2 __attribute__((ext_vector_type(2)));

__device__ __forceinline__ float u2f(unsigned u) { float f; __builtin_memcpy(&f, &u, 4); return f; }
__device__ __forceinline__ unsigned f2u(float f) { unsigned u; __builtin_memcpy(&u, &f, 4); return u; }
__device__ __forceinline__ float bf2f(bf16_t b) { return u2f((unsigned)b << 16); }
__device__ __forceinline__ unsigned f2bf(float f) { unsigned u = f2u(f); return (u + 0x7fffu + ((u >> 16) & 1u)) >> 16; }
__device__ __forceinline__ unsigned pk2(float lo, float hi) { return f2bf(lo) | (f2bf(hi) << 16); }
__device__ __forceinline__ unsigned cvt_pk_bf16(float lo, float hi) {
#ifdef HOST_EMU
    return pk2(lo, hi);
#else
    unsigned r; asm volatile("v_cvt_pk_bf16_f32 %0, %1, %2" : "=v"(r) : "v"(lo), "v"(hi)); return r;
#endif
}
__device__ __forceinline__ float wave_sum(float v) {
#pragma unroll
    for (int o = 1; o < 64; o <<= 1) v += __shfl_xor(v, o);
    return v;
}
__device__ __forceinline__ float sigmoidf_(float x) { return 1.f / (1.f + __expf(-x)); }
__device__ __forceinline__ float siluf_(float x) { return x * sigmoidf_(x); }
__device__ __forceinline__ float softplusf_(float x) { return x > 20.f ? x : log1pf(__expf(x)); }
__device__ __forceinline__ float logsigmoidf_(float x) { return x < -20.f ? x : -log1pf(__expf(-x)); }
#ifdef HOST_EMU
static inline void sincospi_(float x, float* s, float* c) { *s = (float)sin(M_PI * (double)x); *c = (float)cos(M_PI * (double)x); }
#else
__device__ __forceinline__ void sincospi_(float x, float* s, float* c) { sincospif(x, s, c); }
#endif

namespace pg8 {
constexpr int BM = 256, BK = 64, HALF = 128, HTB = HALF * BK * 2, STAGE_BYTES = 8 * HTB, NXCD = 8, WGM = 8;
__host__ __device__ __forceinline__ int lds_byte(int r, int c) { const int st = (r >> 4) * 2 + (c >> 5), rr = r & 15, cc = c & 31, ob = rr * 64 + cc * 2; return st * 1024 + (ob ^ (((ob >> 9) & 1) << 5)); }
__host__ __device__ __forceinline__ void stage_rc(int b, int& R, int& C) { const int st = b / 1024, sb = b % 1024, swz = sb ^ (((sb >> 9) & 1) << 5); R = (st >> 1) * 16 + swz / 64; C = (st & 1) * 32 + (swz % 64) / 2; }
__host__ __device__ __forceinline__ int perm32(int rho) { const int n = rho >> 4, i = rho & 15; return 8 * (i >> 2) + 4 * n + (i & 3); }

struct Unit { int pm, pn, e; };
struct Gemm { const bf16_t* A; const bf16_t* Bt; int K; size_t bexp; };

__host__ __device__ __forceinline__ int xcd_remap(int L, int nwg) { const int q = nwg / NXCD, r = nwg % NXCD, xcd = L % NXCD, off = L / NXCD; return (xcd < r ? xcd * (q + 1) : r * (q + 1) + (xcd - r) * q) + off; }
struct StaticOrder {
    int nM, nN, nwg, G, c;
    __host__ __device__ void init(int M, int N, int G_, int c_) { nM = M / BM; nN = N / BM; nwg = nM * nN; G = G_; c = c_; }
    __host__ __device__ bool next(int i, Unit& u) const {
        const long L = (long)i * G + c; if (L >= nwg) return false;
        const int wgid = xcd_remap((int)L, nwg);
        const int nig = WGM * nN, gid = wgid / nig, fm = gid * WGM, gsz = (nM - fm) < WGM ? (nM - fm) : WGM;
        u.pm = fm + ((wgid % nig) % gsz); u.pn = (wgid % nig) / gsz; u.e = 0; return true;
    }
};
struct MoeOrder {
    int ntiles, nN, nwg, G, c; const LAS int* tile_e;
    __device__ void init(int ntiles_, int N, int G_, int c_, const LAS int* te) { ntiles = ntiles_; nN = N / BM; nwg = ntiles * nN; G = G_; c = c_; tile_e = te; }
    __device__ bool next(int i, Unit& u) const {
        const long L = (long)i * G + c; if (L >= nwg) return false;
        const int wgid = xcd_remap((int)L, nwg);
        u.pm = wgid / nN; u.pn = wgid % nN; u.e = __builtin_amdgcn_readfirstlane(tile_e[u.pm]); return true;
    }
};

struct EpiBf16 {
    static constexpr bool PERM = true;
    bf16_t* O; int ldc; const float* bias; int bias_estride;
    __device__ __forceinline__ void operator()(const f32x4 (&acc)[2][2][4][2], const Unit& u, int wr, int wc, int fr, int fq) const {
        const int row0 = u.pm * BM + wr * 64 + fr, col0 = u.pn * BM + wc * 32 + 8 * fq;
        f32x4 bv[2][2];
#pragma unroll
        for (int bj = 0; bj < 2; ++bj)
#pragma unroll
            for (int n = 0; n < 2; ++n) bv[bj][n] = bias ? *(const f32x4*)(bias + (size_t)u.e * bias_estride + col0 + bj * HALF + 4 * n) : (f32x4){0.f, 0.f, 0.f, 0.f};
#pragma unroll
        for (int ai = 0; ai < 2; ++ai)
#pragma unroll
            for (int m = 0; m < 4; ++m) { bf16_t* rowp = O + (size_t)(row0 + ai * HALF + m * 16) * ldc + col0;
#pragma unroll
                for (int bj = 0; bj < 2; ++bj) { const f32x4 v0 = acc[ai][bj][m][0] + bv[bj][0], v1 = acc[ai][bj][m][1] + bv[bj][1];
                    u32x4 w; w.x = cvt_pk_bf16(v0[0], v0[1]); w.y = cvt_pk_bf16(v0[2], v0[3]); w.z = cvt_pk_bf16(v1[0], v1[1]); w.w = cvt_pk_bf16(v1[2], v1[3]);
                    *(u32x4*)(rowp + bj * HALF) = w; } }
    }
};
struct EpiSwiglu {
    static constexpr bool PERM = true;
    bf16_t* O; const float* b1;
    __device__ __forceinline__ void operator()(const f32x4 (&acc)[2][2][4][2], const Unit& u, int wr, int wc, int fr, int fq) const {
        const int row0 = u.pm * BM + wr * 64 + fr, cj = u.pn * HALF + wc * 32 + 8 * fq;
        const float* bb = b1 + (size_t)u.e * 2 * DE;
        f32x4 bg[2], bl[2];
#pragma unroll
        for (int n = 0; n < 2; ++n) { bg[n] = *(const f32x4*)(bb + cj + 4 * n); bl[n] = *(const f32x4*)(bb + DE + cj + 4 * n); }
#pragma unroll
        for (int ai = 0; ai < 2; ++ai)
#pragma unroll
            for (int m = 0; m < 4; ++m) { bf16_t* rowp = O + (size_t)(row0 + ai * HALF + m * 16) * DE + cj;
                float y[8];
#pragma unroll
                for (int n = 0; n < 2; ++n) { const f32x4 g = acc[ai][0][m][n] + bg[n], l = acc[ai][1][m][n] + bl[n];
#pragma unroll
                    for (int j = 0; j < 4; ++j) { const float gg = fminf(g[j], 7.0f), ll = fminf(fmaxf(l[j], -7.0f), 7.0f); y[4 * n + j] = (ll + 1.0f) * gg * (1.f / (1.f + __expf(-1.702f * gg))); } }
                u32x4 w; w.x = cvt_pk_bf16(y[0], y[1]); w.y = cvt_pk_bf16(y[2], y[3]); w.z = cvt_pk_bf16(y[4], y[5]); w.w = cvt_pk_bf16(y[6], y[7]);
                *(u32x4*)rowp = w; }
    }
};
struct EpiResid {
    static constexpr bool PERM = false;
    const float* base0; const float* base1; float* out; const float* g;
    __device__ __forceinline__ void operator()(const f32x4 (&acc)[2][2][4][2], const Unit& u, int wr, int wc, int fr, int fq) const {
        const int col0 = u.pn * BM + wc * 32 + 4 * fq;
#pragma unroll
        for (int ai = 0; ai < 2; ++ai)
#pragma unroll
            for (int m = 0; m < 4; ++m) { const int r = u.pm * BM + ai * HALF + wr * 64 + m * 16 + fr;
                const float* bp = (r < NLAT) ? base0 + (size_t)r * D : base1 + (size_t)(r - NLAT) * D; const int bb = (r < NLAT) ? r / SEQ : NB;
                const float* gp = g + (size_t)bb * 6 * D;
#pragma unroll
                for (int bj = 0; bj < 2; ++bj)
#pragma unroll
                    for (int n = 0; n < 2; ++n) { const int c = col0 + bj * HALF + n * 16; const f32x4 bs = *(const f32x4*)(bp + c), gv = *(const f32x4*)(gp + c);
                        *(f32x4*)(out + (size_t)r * D + c) = bs + gv * acc[ai][bj][m][n]; } }
    }
};

#ifdef HOST_EMU
#define PG8_WAIT_V(n) ((void)0)
#define PG8_WAIT_L(n) ((void)0)
#else
#define PG8_WAIT_V(n) asm volatile("s_waitcnt vmcnt(" #n ")" ::: "memory")
#define PG8_WAIT_L(n) asm volatile("s_waitcnt lgkmcnt(" #n ")" ::: "memory")
#endif
template <class Epi, class Sched>
__device__ __forceinline__ void gemm_phase(LAS unsigned char* lds, const Gemm g, const Sched& S, const Epi& E, const int tid) {
    const int wid = __builtin_amdgcn_readfirstlane(tid >> 6), lane = tid & 63, wr = wid >> 2, wc = wid & 3, fr = lane & 15, fq = lane >> 4;
    const int K = g.K, nt = K / BK;
    unsigned voffA[2], voffB[2];
#pragma unroll
    for (int i = 0; i < 2; ++i) { int R, C; stage_rc(tid * 16 + i * 8192, R, C); const int Rb = Epi::PERM ? ((R & ~31) + perm32(R & 31)) : R;
        voffA[i] = (unsigned)(R * K + C) * 2u; voffB[i] = (unsigned)(Rb * K + C) * 2u; }
    const size_t kstep = (size_t)(BK * 2);
    const size_t hstep = (size_t)HALF * K * 2;
    const size_t tstep = 2 * hstep;
    const unsigned ldsw = (unsigned)wid * 1024u;
    const int aoff = lds_byte(wr * 64 + fr, fq * 8), boff = lds_byte(wc * 32 + fr, fq * 8);
#define PG8_SA(b, h) (((b) * 2 + (h)) * HTB)
#define PG8_SB(b, h) ((4 + (b) * 2 + (h)) * HTB)
#define PG8_STAGE(bufoff, gbase, voff) do { _Pragma("unroll") for (int _i = 0; _i < 2; ++_i) \
        __builtin_amdgcn_global_load_lds((const unsigned*)((const char*)(gbase) + (voff)[_i]), (LAS unsigned*)(lds + (bufoff) + ldsw + _i * 8192), 16, 0, 0); } while (0)
#define PG8_LDA(dst, b, h) do { _Pragma("unroll") for (int m = 0; m < 4; ++m) _Pragma("unroll") for (int k = 0; k < 2; ++k) dst[m][k] = *(const LAS bf16x8*)(lds + PG8_SA(b, h) + aoff + m * 2048 + k * 1024); } while (0)
#define PG8_LDB(dst, b, h) do { _Pragma("unroll") for (int n = 0; n < 2; ++n) _Pragma("unroll") for (int k = 0; k < 2; ++k) dst[n][k] = *(const LAS bf16x8*)(lds + PG8_SB(b, h) + boff + n * 2048 + k * 1024); } while (0)
#define PG8_MMA(ai, bj, At, Bt) do { __builtin_amdgcn_s_setprio(1); _Pragma("unroll") for (int m = 0; m < 4; ++m) _Pragma("unroll") for (int n = 0; n < 2; ++n) _Pragma("unroll") for (int k = 0; k < 2; ++k) \
        acc[ai][bj][m][n] = __builtin_amdgcn_mfma_f32_16x16x32_bf16(Bt[n][k], At[m][k], acc[ai][bj][m][n], 0, 0, 0); __builtin_amdgcn_s_setprio(0); } while (0)
#define PG8_BAR __builtin_amdgcn_s_barrier()
#define PG8_SCHED __builtin_amdgcn_sched_barrier(0)
    Unit cur, nxt; int ui = 0;
    if (!S.next(0, cur)) return;
    f32x4 acc[2][2][4][2];
#pragma unroll
    for (int a = 0; a < 2; ++a)
#pragma unroll
        for (int b = 0; b < 2; ++b)
#pragma unroll
            for (int m = 0; m < 4; ++m)
#pragma unroll
                for (int n = 0; n < 2; ++n) acc[a][b][m][n] = (f32x4){0.f, 0.f, 0.f, 0.f};
    bf16x8 At[4][2], B0[2][2], B1[2][2];
    const char* cA = (const char*)g.A + (size_t)cur.pm * tstep; const char* cB = (const char*)(g.Bt + (size_t)cur.e * g.bexp) + (size_t)cur.pn * tstep;
    PG8_STAGE(PG8_SB(0, 0), cB, voffB); PG8_STAGE(PG8_SB(0, 1), cB + hstep, voffB); PG8_STAGE(PG8_SA(0, 0), cA, voffA); PG8_STAGE(PG8_SA(0, 1), cA + hstep, voffA);
    if (wr == 1) PG8_BAR;
    PG8_WAIT_V(2); PG8_BAR;
    PG8_STAGE(PG8_SB(1, 0), cB + kstep, voffB); PG8_STAGE(PG8_SA(1, 0), cA + kstep, voffA); PG8_STAGE(PG8_SB(1, 1), cB + hstep + kstep, voffB);
    PG8_WAIT_V(6); PG8_BAR;
    for (;;) {
        const bool has_next = S.next(ui + 1, nxt);
        const char* nA = has_next ? (const char*)g.A + (size_t)nxt.pm * tstep : cA; const char* nB = has_next ? (const char*)(g.Bt + (size_t)nxt.e * g.bexp) + (size_t)nxt.pn * tstep : cB;
        for (int t = 0; t < nt; t += 2) {
            const bool last = (t == nt - 2);
            const char* a1 = cA + (size_t)(t + 1) * kstep;
            const char* a2 = last ? nA : cA + (size_t)(t + 2) * kstep; const char* b2 = last ? nB : cB + (size_t)(t + 2) * kstep;
            const char* a3 = a2 + kstep; const char* b3 = b2 + kstep;
            PG8_LDB(B0, 0, 0); PG8_LDB(B1, 0, 1); PG8_SCHED; PG8_LDA(At, 0, 0); PG8_STAGE(PG8_SA(1, 1), a1 + hstep, voffA);
            PG8_WAIT_V(8); PG8_WAIT_L(0); PG8_BAR; PG8_MMA(0, 0, At, B0); PG8_MMA(0, 1, At, B1); PG8_BAR; PG8_SCHED;
            PG8_LDA(At, 0, 1); PG8_STAGE(PG8_SB(0, 0), b2, voffB); PG8_STAGE(PG8_SB(0, 1), b2 + hstep, voffB); PG8_STAGE(PG8_SA(0, 0), a2, voffA);
            PG8_WAIT_V(8); PG8_WAIT_L(0); PG8_BAR; PG8_MMA(1, 0, At, B0); PG8_MMA(1, 1, At, B1); PG8_BAR; PG8_SCHED;
            PG8_LDB(B0, 1, 0); PG8_LDB(B1, 1, 1); PG8_SCHED; PG8_LDA(At, 1, 0); PG8_STAGE(PG8_SA(0, 1), a2 + hstep, voffA);
            PG8_WAIT_V(8); PG8_WAIT_L(0); PG8_BAR; PG8_MMA(0, 0, At, B0); PG8_MMA(0, 1, At, B1); PG8_BAR; PG8_SCHED;
            PG8_LDA(At, 1, 1); PG8_STAGE(PG8_SB(1, 0), b3, voffB); PG8_STAGE(PG8_SB(1, 1), b3 + hstep, voffB); PG8_STAGE(PG8_SA(1, 0), a3, voffA);
            PG8_WAIT_V(8); PG8_WAIT_L(0); PG8_BAR; PG8_MMA(1, 0, At, B0); PG8_MMA(1, 1, At, B1); PG8_BAR; PG8_SCHED;
        }
        if (wr == 0) PG8_BAR;
        {
            int t2 = threadIdx.x;
#ifndef HOST_EMU
            asm volatile("" : "+v"(t2));
#endif
            const int wid2 = __builtin_amdgcn_readfirstlane(t2 >> 6), lane2 = t2 & 63;
            E(acc, cur, wid2 >> 2, wid2 & 3, lane2 & 15, lane2 >> 4);
        }
        if (!has_next) break;
#pragma unroll
        for (int a = 0; a < 2; ++a)
#pragma unroll
            for (int b = 0; b < 2; ++b)
#pragma unroll
                for (int m = 0; m < 4; ++m)
#pragma unroll
                    for (int n = 0; n < 2; ++n) acc[a][b][m][n] = (f32x4){0.f, 0.f, 0.f, 0.f};
        cur = nxt; cA = nA; cB = nB; ++ui;
        if (wr == 1) PG8_BAR;
    }
    PG8_WAIT_V(0);
    PG8_BAR;
#undef PG8_SA
#undef PG8_SB
#undef PG8_STAGE
#undef PG8_LDA
#undef PG8_LDB
#undef PG8_MMA
#undef PG8_BAR
#undef PG8_SCHED
}
}

#define XB_TMO      128
#define XB_XCNT(j)  (256  + 64 * (j))
#define XB_XSUB(j)  (1280 + 64 * (j))
#define XB_XGEN(j)  (2304 + 64 * (j))
#define XB_TOP      3328
#define XB_TOPGEN   3392
#define XCD_BAR_WORDS 3456
#define XB_SPIN_CAP (1u << 22)
#ifdef HOST_EMU
__device__ __forceinline__ unsigned xb_ld(unsigned* p) { return *(volatile unsigned*)p; }
__device__ __forceinline__ unsigned xb_add(unsigned* p, unsigned v) { unsigned o = *p; *p = o + v; return o; }
__device__ __forceinline__ unsigned xb_xcc_id() { return blockIdx.x % 8; }
__device__ __forceinline__ unsigned atomicAdd(unsigned* p, unsigned v) { unsigned o = *p; *p = o + v; return o; }
__device__ __forceinline__ int atomicAdd(int* p, int v) { int o = *p; *p = o + v; return o; }
#else
__device__ __forceinline__ unsigned xb_ld(unsigned* p)              { return __hip_atomic_load(p, __ATOMIC_RELAXED, __HIP_MEMORY_SCOPE_AGENT); }
__device__ __forceinline__ unsigned xb_add(unsigned* p, unsigned v) { return __hip_atomic_fetch_add(p, v, __ATOMIC_RELAXED, __HIP_MEMORY_SCOPE_AGENT); }
__device__ __forceinline__ unsigned xb_xcc_id() { return (unsigned)__builtin_amdgcn_s_getreg((3 << 11) | 20) & 0xFu; }
#endif
#define XB_SPIN(cond, bar) do { unsigned _sp = 0; while (cond) { __builtin_amdgcn_s_sleep(1); \
    if ((++_sp & 255u) == 0u) { if (xb_ld(&(bar)[XB_TMO])) break; if (_sp > XB_SPIN_CAP) { atomicAdd(&(bar)[XB_TMO], 1u); break; } } } } while (0)
struct XcdBarrier { unsigned* bar; unsigned x; volatile LAS unsigned* st; };
__device__ __forceinline__ XcdBarrier xcd_barrier_post(unsigned* bar, volatile LAS unsigned* st) {
    XcdBarrier b; b.bar = bar; b.x = xb_xcc_id(); b.st = st;
    if (threadIdx.x == 0) (void)xb_add(&bar[XB_XCNT(b.x)], 1u);
    return b;
}
__device__ __forceinline__ void xcd_barrier_complete(unsigned* bar, unsigned x, unsigned& nloc, unsigned& nx) {
    const unsigned G = gridDim.x;
    unsigned sum, cnt, mine, sp = 0u;
    for (;;) {
        sum = 0u; cnt = 0u; mine = 0u;
#pragma unroll
        for (unsigned j = 0; j < 16; ++j) { const unsigned c = xb_ld(&bar[XB_XCNT(j)]); sum += c; cnt += (c > 0u) ? 1u : 0u; mine = (j == x) ? c : mine; }
        if (sum == G) break;
        __builtin_amdgcn_s_sleep(1);
        if ((++sp & 255u) == 0u) { if (xb_ld(&bar[XB_TMO])) break; if (sp > XB_SPIN_CAP) { atomicAdd(&bar[XB_TMO], 1u); break; } }
    }
    nloc = mine > 0u ? mine : 1u; nx = cnt > 0u ? cnt : 1u;
}
__device__ __forceinline__ void xcd_barrier(const XcdBarrier& b) {
    VM_WAIT();
    __syncthreads();
    if (threadIdx.x == 0) {
        unsigned* bar = b.bar;
        __builtin_amdgcn_s_waitcnt(0);
        unsigned nloc = b.st[0], nx = b.st[1];
        if (nloc == 0u) { xcd_barrier_complete(bar, b.x, nloc, nx); b.st[0] = nloc; b.st[1] = nx; }
        const unsigned old = xb_add(&bar[XB_XSUB(b.x)], 1u);
        const unsigned gen = old / nloc;
        if (old + 1u == (gen + 1u) * nloc) {
            __builtin_amdgcn_fence(__ATOMIC_RELEASE, "agent");
            VM_WAIT();
            const unsigned og = xb_add(&bar[XB_TOP], 1u);
            const unsigned tg = og / nx;
            if (og + 1u == (tg + 1u) * nx) xb_add(&bar[XB_TOPGEN], 1u);
            else XB_SPIN(xb_ld(&bar[XB_TOPGEN]) == tg, bar);
            __builtin_amdgcn_fence(__ATOMIC_ACQUIRE, "agent");
            xb_add(&bar[XB_XGEN(b.x)], 1u);
            VM_WAIT();
        } else {
            XB_SPIN(xb_ld(&bar[XB_XGEN(b.x)]) == gen, bar);
            __builtin_amdgcn_fence(__ATOMIC_ACQUIRE, "agent");
            VM_WAIT();
        }
    }
    __syncthreads();
}

struct Args {
    const float* in[34]; float* out; unsigned char* ws; int ph_lo, ph_hi;
};
enum { I_X = 0, I_C, I_CTX, I_CCTX, I_MODW, I_MODB, I_N1, I_N2, I_WIN, I_WOUT, I_HGLB, I_HGNG, I_MLGB, I_MLNG, I_HYCW, I_HYCB, I_HYW1, I_HYB1, I_HYW2, I_HYB2, I_HYFR, I_HYW3,
       I_HYBI, I_GDCW, I_GDAL, I_GDDT, I_GDNG, I_RW, I_RB, I_EW1, I_EB1, I_EW2, I_EB2, I_FG };
struct Ctx {
#ifdef HOST_EMU
    LAS unsigned char* lds; const Args* a; unsigned char* ws;
#else
    LAS unsigned char* lds; const __attribute__((address_space(4))) Args* a; unsigned char* ws;
#endif
    int tid, lane, wave, vcu, G, bid;
};
#define WSP(T, off) ((T*)(C.ws + (off)))
#define INP(i) (C.a->in[i])

__device__ __forceinline__ const float* xrow_l0(const Ctx& C, int r) { return r < NLAT ? INP(I_X) + (size_t)r * D : INP(I_CTX) + (size_t)(r - NLAT) * D; }
__device__ __forceinline__ int row_batch(int r) { return r < NLAT ? r / SEQ : NB; }

__device__ __forceinline__ void transpose_item(const float* W, int ldw, int K, bf16_t* WT, int k0, int nsrc0, int ndst0, LAS float* scr, int lane) {
#pragma unroll 8
    for (int i = 0; i < 32; ++i) { const int kk = 2 * i + (lane >> 5); scr[kk * 33 + (lane & 31)] = W[(size_t)(k0 + kk) * ldw + nsrc0 + (lane & 31)]; }
    LDS_WAIT(); asm volatile("" ::: "memory");
    const int c = lane & 7;
#pragma unroll
    for (int j = 0; j < 4; ++j) { const int n = (lane >> 3) + 8 * j; const LAS float* s = scr + (8 * c) * 33 + n;
        u32x4 o; o.x = pk2(s[0 * 33], s[1 * 33]); o.y = pk2(s[2 * 33], s[3 * 33]); o.z = pk2(s[4 * 33], s[5 * 33]); o.w = pk2(s[6 * 33], s[7 * 33]);
        *(u32x4*)(WT + (size_t)(ndst0 + n) * K + k0 + 8 * c) = o; }
    LDS_WAIT(); asm volatile("" ::: "memory");
}
__device__ __forceinline__ void p0_prologue(Ctx& C) {
    LAS float* scr = (LAS float*)(C.lds + C.wave * 16384);
    const int gw = C.vcu * 8 + C.wave, NGW = C.G * 8, lane = C.lane;
    constexpr int I_IN = 16 * (ZW / 32), I_OUT = 16 * (D / 32), I_1 = 16 * (2 * DE / 32), I_2 = (DE / 64) * (D / 32);
    constexpr int PER_L = I_IN + I_OUT + NE * (I_1 + I_2);
    for (int it = gw; it < DEPTH * PER_L; it += NGW) {
        const int l = it / PER_L; int r = it % PER_L;
        if (r < I_IN) { const int kb = r / (ZW / 32), nb = r % (ZW / 32), nd = 32 * nb, ns = nd < 2304 ? nd : nd + 16;
            transpose_item(INP(I_WIN) + (size_t)l * D * IN_W, IN_W, D, WSP(bf16_t, WS_WIN) + (size_t)l * ZW * D, 64 * kb, ns, nd, scr, lane); continue; }
        r -= I_IN;
        if (r < I_OUT) { const int kb = r / (D / 32), nb = r % (D / 32);
            transpose_item(INP(I_WOUT) + (size_t)l * D * D, D, D, WSP(bf16_t, WS_WOUT) + (size_t)l * D * D, 64 * kb, 32 * nb, 32 * nb, scr, lane); continue; }
        r -= I_OUT;
        const int e = r / (I_1 + I_2); r %= (I_1 + I_2);
        if (r < I_1) { const int kb = r / (2 * DE / 32), nb = r % (2 * DE / 32), nd = 32 * nb;
            const int ntile = nd / 256, hh = (nd % 256) / 128, j = nd % 128, ns = DE * hh + 128 * ntile + j;
            transpose_item(INP(I_EW1) + ((size_t)l * NE + e) * D * 2 * DE, 2 * DE, D, WSP(bf16_t, WS_W1) + ((size_t)l * NE + e) * 2 * DE * D, 64 * kb, ns, nd, scr, lane); continue; }
        r -= I_1;
        { const int kb = r / (D / 32), nb = r % (D / 32);
            transpose_item(INP(I_EW2) + ((size_t)l * NE + e) * DE * D, D, DE, WSP(bf16_t, WS_W2) + ((size_t)l * NE + e) * D * DE, 64 * kb, 32 * nb, 32 * nb, scr, lane); }
    }
    for (int it = gw; it < DEPTH * (NB + 1) * (6 * D / 64); it += NGW) {
        const int l = it / ((NB + 1) * (6 * D / 64)), b = (it / (6 * D / 64)) % (NB + 1), n = (it % (6 * D / 64)) * 64 + lane;
        const float* w = INP(I_MODW) + (size_t)l * D * 6 * D + n; const float* cv = b < NB ? INP(I_C) + b * D : INP(I_CCTX);
        float acc = 0.f;
#pragma unroll 16
        for (int k = 0; k < D; ++k) acc += siluf_(cv[k]) * w[(size_t)k * 6 * D];
        WSP(float, WS_MOD)[((size_t)l * (NB + 1) + b) * 6 * D + n] = acc + INP(I_MODB)[l * 6 * D + n];
    }
    const int gt = gw * 64 + lane, NGT = NGW * 64;
    for (int i = gt; i < 256; i += NGT) { const float a0 = INP(I_HGLB)[i], a1 = INP(I_HGLB)[256 + i], mx = fmaxf(a0, a1), e0 = __expf(a0 - mx), e1 = __expf(a1 - mx);
        WSP(float, WS_LB)[i] = 0.f; WSP(float, WS_LB)[256 + i] = e1 / (e0 + e1); }
    for (int i = gt; i < DEPTH * 32 * D; i += NGT) { const int l = i / (32 * D), j = (i / D) % 32, k = i % D; const int col = j < 16 ? 2304 + j : 4112 + (j - 16);
        WSP(float, WS_WG)[i] = INP(I_WIN)[((size_t)l * D + k) * IN_W + col]; }
    for (int i = gt; i < DEPTH * NE * D; i += NGT) { const int l = i / (NE * D), e = (i / D) % NE, k = i % D;
        WSP(float, WS_WR)[i] = INP(I_RW)[((size_t)l * D + k) * NE + e]; }
    for (int i = gw; i < DEPTH * (SEQ + LC); i += NGW) {
        const int l = i / (SEQ + LC), p = i % (SEQ + LC); const bool isc = p >= SEQ; const int pos = isc ? p - SEQ : p, len = isc ? LC : SEQ;
        const float *w1 = INP(I_HYW1) + l * 17 * 64, *b1 = INP(I_HYB1) + l * 64, *w2 = INP(I_HYW2) + l * 64 * 64, *b2 = INP(I_HYB2) + l * 64, *fr = INP(I_HYFR) + l * 128;
        float s = b1[lane] + ((float)pos / (float)(len - 1)) * w1[lane];
#pragma unroll
        for (int j = 0; j < 8; ++j) { const float band = 1e-4f + (7.0f - 1e-4f) * (float)j / 7.0f; const float ang = 6.283185307179586f * (float)pos * band / (float)len;
            s += cosf(ang) * w1[(1 + j) * 64 + lane] - sinf(ang) * w1[(9 + j) * 64 + lane]; }
        scr[lane] = sinf(fr[lane] * s);
        LDS_WAIT(); asm volatile("" ::: "memory");
        float s2 = b2[lane];
#pragma unroll 8
        for (int q = 0; q < 64; ++q) s2 += scr[q] * w2[q * 64 + lane];
        WSP(float, WS_HDN)[((size_t)l * (SEQ + LC) + p) * 64 + lane] = sinf(fr[64 + lane] * s2);
        LDS_WAIT(); asm volatile("" ::: "memory");
    }
}

__device__ __forceinline__ void rms_mod_row(const f32x4 (&xv)[4], const float* gain, const float* sh, const float* sc, bf16_t* orow, int lane, f32x4 (&hv)[4]) {
    float s = 0.f;
#pragma unroll
    for (int j = 0; j < 4; ++j) s += (xv[j].x * xv[j].x + xv[j].y * xv[j].y) + (xv[j].z * xv[j].z + xv[j].w * xv[j].w);
    const float rstd = 1.f / sqrtf(wave_sum(s) * (1.f / D) + EPS);
#pragma unroll
    for (int j = 0; j < 4; ++j) { const int c = 4 * lane + 256 * j; const f32x4 g = *(const f32x4*)(gain + c), a = *(const f32x4*)(sc + c), b = *(const f32x4*)(sh + c);
        hv[j] = xv[j] * rstd * g * (a + 1.0f) + b;
        u32x2 w; w.x = pk2(hv[j].x, hv[j].y); w.y = pk2(hv[j].z, hv[j].w); *(u32x2*)(orow + c) = w; }
}
__device__ __forceinline__ void load_w32(Ctx& C, const float* W, int n) {
    __syncthreads();
    for (int o = C.tid; o < n * 256; o += 512) *(LAS f32x4*)(C.lds + (size_t)o * 16) = *(const f32x4*)(W + (size_t)o * 4);
    __syncthreads();
}
__device__ __forceinline__ float row2_dots(LAS unsigned char* lds, const f32x4 (&hv)[2][4], int lane, int n) {
    float v[64];
#pragma unroll
    for (int jj = 0; jj < 32; ++jj) { float s0 = 0.f, s1 = 0.f;
        if (jj < n) {
#pragma unroll
            for (int j = 0; j < 4; ++j) { const f32x4 w = *(const LAS f32x4*)(lds + (size_t)jj * 4096 + (size_t)(4 * lane + 256 * j) * 4);
                s0 += (hv[0][j].x * w.x + hv[0][j].y * w.y) + (hv[0][j].z * w.z + hv[0][j].w * w.w); s1 += (hv[1][j].x * w.x + hv[1][j].y * w.y) + (hv[1][j].z * w.z + hv[1][j].w * w.w); } }
        v[jj] = s0; v[32 + jj] = s1; }
#pragma unroll
    for (int st = 0; st < 6; ++st) { const int m = 32 >> st, nh = 32 >> st; const bool up = (lane & m) != 0;
#pragma unroll
        for (int i = 0; i < nh; ++i) { const float a = v[i], bb = v[i + nh]; const float send = up ? a : bb, keep = up ? bb : a; v[i] = keep + __shfl_xor(send, m); } }
    return v[0];
}
__device__ __forceinline__ void phase_rows_a(Ctx& C, int l) {
    const int gw = C.vcu * 8 + C.wave, NGW = C.G * 8, lane = C.lane;
    const int nrows = (l == DEPTH) ? NLAT : NT;
    float* xcur = WSP(float, WS_X);
    if (l < DEPTH) load_w32(C, WSP(float, WS_WG) + (size_t)l * 32 * D, 32);
    for (int r0 = 2 * gw; r0 < nrows; r0 += 2 * NGW) {
        f32x4 xv[2][4];
#pragma unroll
        for (int q = 0; q < 2; ++q) { const int r = r0 + q; const int bb = row_batch(r);
            if (l == 0) { const float* xr = xrow_l0(C, r);
#pragma unroll
                for (int j = 0; j < 4; ++j) xv[q][j] = *(const f32x4*)(xr + 4 * lane + 256 * j); }
            else {
                const int lp = l - 1; const int ntok = (lp == DEPTH - 1) ? NLAT : NT;
                const float* xr = xcur + (size_t)r * D;
#pragma unroll
                for (int j = 0; j < 4; ++j) xv[q][j] = *(const f32x4*)(xr + 4 * lane + 256 * j);
                if (r < ntok) {
                    const float* g2 = WSP(float, WS_MOD) + ((size_t)lp * (NB + 1) + bb) * 6 * D + 5 * D;
                    const int* te = WSP(int, WS_TOP) + (size_t)r * 4; const int* tp = WSP(int, WS_TOP) + (size_t)NT * 4 + (size_t)r * 4; const float* tg = WSP(float, WS_TOP) + (size_t)NT * 8 + (size_t)r * 4;
                    const LAS int* tbase = (const LAS int*)(C.lds + LDSX_OFF + LX_TILE) + MAXTILES;
                    f32x4 ys[4];
#pragma unroll
                    for (int j = 0; j < 4; ++j) ys[j] = (f32x4){0.f, 0.f, 0.f, 0.f};
#pragma unroll
                    for (int k = 0; k < TOPK; ++k) { const int e = te[k]; const size_t yr = (size_t)tbase[e] * 256 + tp[k]; const float gk = tg[k]; const bf16_t* yp = WSP(bf16_t, WS_Y) + yr * D;
#pragma unroll
                        for (int j = 0; j < 4; ++j) { const u32x2 w = *(const u32x2*)(yp + 4 * lane + 256 * j);
                            ys[j].x += gk * u2f(w.x << 16); ys[j].y += gk * u2f(w.x & 0xffff0000u); ys[j].z += gk * u2f(w.y << 16); ys[j].w += gk * u2f(w.y & 0xffff0000u); } }
#pragma unroll
                    for (int j = 0; j < 4; ++j) { const f32x4 g = *(const f32x4*)(g2 + 4 * lane + 256 * j); xv[q][j] = xv[q][j] + g * ys[j]; }
                    if (l < DEPTH) {
#pragma unroll
                        for (int j = 0; j < 4; ++j) *(f32x4*)(xcur + (size_t)r * D + 4 * lane + 256 * j) = xv[q][j]; }
                }
            }
        }
        if (l == DEPTH) {
#pragma unroll
            for (int q = 0; q < 2; ++q) { float s = 0.f;
#pragma unroll
                for (int j = 0; j < 4; ++j) s += (xv[q][j].x * xv[q][j].x + xv[q][j].y * xv[q][j].y) + (xv[q][j].z * xv[q][j].z + xv[q][j].w * xv[q][j].w);
                const float rstd = 1.f / sqrtf(wave_sum(s) * (1.f / D) + EPS);
#pragma unroll
                for (int j = 0; j < 4; ++j) { const f32x4 g = *(const f32x4*)(INP(I_FG) + 4 * lane + 256 * j); *(f32x4*)(C.a->out + (size_t)(r0 + q) * D + 4 * lane + 256 * j) = xv[q][j] * rstd * g; } }
            continue;
        }
        f32x4 hv[2][4];
#pragma unroll
        for (int q = 0; q < 2; ++q) { const int r = r0 + q; const float* mod = WSP(float, WS_MOD) + ((size_t)l * (NB + 1) + row_batch(r)) * 6 * D;
            rms_mod_row(xv[q], INP(I_N1) + l * D, mod, mod + D, WSP(bf16_t, WS_H) + (size_t)r * D, lane, hv[q]); }
        const float mine = row2_dots(C.lds, hv, lane, 32);
        WSP(float, WS_ZG)[(size_t)(r0 + (lane >> 5)) * 32 + (lane & 31)] = mine;
    }
}
__device__ __forceinline__ int build_tiles(Ctx& C, int l) {
    LAS int* tile_e = (LAS int*)(C.lds + LDSX_OFF + LX_TILE); LAS int* tbase = tile_e + MAXTILES;
    const unsigned* cnt = WSP(unsigned, WS_CTL) + CW_CNT + l * NE;
    __syncthreads();
    if (C.tid == 0) { int t = 0;
        for (int e = 0; e < NE; ++e) { const int c = (int)cnt[e], n = (c + 255) / 256; tbase[e] = t; for (int i = 0; i < n; ++i) tile_e[t + i] = e; t += n; }
        tbase[NE] = t; }
    __syncthreads();
    return tbase[NE];
}
__device__ __forceinline__ void phase_rows_b(Ctx& C, int l) {
    const int gw = C.vcu * 8 + C.wave, NGW = C.G * 8, lane = C.lane;
    const int ntok = (l == DEPTH - 1) ? NLAT : NT;
    const float* xcur = WSP(float, WS_X);
    unsigned* cnt = WSP(unsigned, WS_CTL) + CW_CNT + l * NE;
    static_assert(NE <= 32, "router width");
    load_w32(C, WSP(float, WS_WR) + (size_t)l * NE * D, NE);
    for (int r0 = 2 * gw; r0 < ntok; r0 += 2 * NGW) {
        f32x4 hv[2][4];
#pragma unroll
        for (int q = 0; q < 2; ++q) { const int r = r0 + q; f32x4 xv[4];
#pragma unroll
            for (int j = 0; j < 4; ++j) xv[j] = *(const f32x4*)(xcur + (size_t)r * D + 4 * lane + 256 * j);
            const float* mod = WSP(float, WS_MOD) + ((size_t)l * (NB + 1) + row_batch(r)) * 6 * D;
            rms_mod_row(xv, INP(I_N2) + l * D, mod + 3 * D, mod + 4 * D, WSP(bf16_t, WS_H) + (size_t)r * D, lane, hv[q]); }
        const float lgm = row2_dots(C.lds, hv, lane, NE);
        const int jl = lane & 31, r = r0 + (lane >> 5);
        float v = (jl < NE) ? lgm + INP(I_RB)[l * NE + (jl < NE ? jl : 0)] : -3.0e38f;
        float tv[4]; int ti[4];
#pragma unroll
        for (int k = 0; k < 4; ++k) { float bv = v; int bi = jl;
#pragma unroll
            for (int o = 1; o < 32; o <<= 1) { const float ov = __shfl_xor(bv, o); const int oi = __shfl_xor(bi, o); const bool take = (ov > bv) || (ov == bv && oi < bi); bv = take ? ov : bv; bi = take ? oi : bi; }
            tv[k] = bv; ti[k] = bi; v = (jl == bi) ? -3.4e38f : v; }
        const float e1 = __expf(tv[1] - tv[0]), e2 = __expf(tv[2] - tv[0]), e3 = __expf(tv[3] - tv[0]), inv = 1.f / (1.f + e1 + e2 + e3);
        const float gk[4] = {inv, e1 * inv, e2 * inv, e3 * inv};
        if (jl < 4) {
            int e = ti[0]; float g = gk[0];
#pragma unroll
            for (int k = 1; k < 4; ++k) { e = (jl == k) ? ti[k] : e; g = (jl == k) ? gk[k] : g; }
            const int pos = (int)atomicAdd(cnt + e, 1u);
            WSP(int, WS_TOP)[(size_t)r * 4 + jl] = e; WSP(int, WS_TOP)[(size_t)NT * 4 + (size_t)r * 4 + jl] = pos; WSP(float, WS_TOP)[(size_t)NT * 8 + (size_t)r * 4 + jl] = g;
        }
    }
}
__device__ __forceinline__ void phase_gather(Ctx& C, int l) {
    const int gw = C.vcu * 8 + C.wave, NGW = C.G * 8, lane = C.lane;
    const int ntok = (l == DEPTH - 1) ? NLAT : NT;
    (void)build_tiles(C, l);
    const LAS int* tbase = (const LAS int*)(C.lds + LDSX_OFF + LX_TILE) + MAXTILES;
    const unsigned* cnt = WSP(unsigned, WS_CTL) + CW_CNT + l * NE;
    for (int it = gw; it < ntok * 4; it += NGW) { const int r = it >> 2, k = it & 3;
        const int e = WSP(int, WS_TOP)[(size_t)r * 4 + k], pos = WSP(int, WS_TOP)[(size_t)NT * 4 + (size_t)r * 4 + k];
        const u32x4* s = (const u32x4*)(WSP(bf16_t, WS_H) + (size_t)r * D); u32x4* d = (u32x4*)(WSP(bf16_t, WS_HS) + ((size_t)tbase[e] * 256 + pos) * D);
        d[lane] = s[lane]; d[lane + 64] = s[lane + 64]; }
    for (int it = gw; it < NE * 256; it += NGW) { const int e = it >> 8, p = it & 255; const int c = (int)cnt[e], pad0 = c, pad1 = ((c + 255) / 256) * 256;
        if (pad0 + p < pad1) { u32x4* d = (u32x4*)(WSP(bf16_t, WS_HS) + ((size_t)tbase[e] * 256 + pad0 + p) * D); d[lane] = (u32x4){0u, 0u, 0u, 0u}; d[lane + 64] = (u32x4){0u, 0u, 0u, 0u}; } }
}

template <int MIX> __device__ __forceinline__ int scan_row(int b, int dir, int s) {
    if (s < LC) { const int t = dir ? LC - 1 - s : s; return NLAT + b * LC + t; }
    const int i0 = s - LC, i = dir ? SEQ - 1 - i0 : i0;
    const int t = (MIX == 1) ? (i % GROWS) * GW + (i / GROWS) : i;
    return b * SEQ + t;
}
typedef float f32x16 __attribute__((ext_vector_type(16)));
template <int NT_, int KS>
__device__ __forceinline__ void mm_nt(const LAS bf16_t* A, int lda, const LAS bf16_t* B, int ldb, f32x16 (&acc)[NT_], int lane) {
    const int r = lane & 31, kh = (lane >> 5) * 8;
#pragma unroll
    for (int kk = 0; kk < KS; ++kk) {
        const bf16x8 a = *(const LAS bf16x8*)(A + r * lda + 16 * kk + kh);
#pragma unroll
        for (int n = 0; n < NT_; ++n) { const bf16x8 b = *(const LAS bf16x8*)(B + (32 * n + r) * ldb + 16 * kk + kh); acc[n] = __builtin_amdgcn_mfma_f32_32x32x16_bf16(a, b, acc[n], 0, 0, 0); }
    }
}
#ifdef HOST_EMU
#define ITEM_IDS() const int tid = C.tid, lane = C.lane, w = C.wave
#else
#define ITEM_IDS() int tid_ = C.tid; asm volatile("" : "+v"(tid_)); const int tid = tid_, lane = tid_ & 63, w = __builtin_amdgcn_readfirstlane(tid_ >> 6)
#endif
#define CROW(ri, lane) (((ri) & 3) + 8 * ((ri) >> 2) + 4 * ((lane) >> 5))
constexpr int LS = 72, LF = 65;
constexpr int GA_Q = 0, GA_K = 9216, GA_BVT = 18432, GA_BKGT = 27648, GA_KDT = 36864, GA_QKM = 46080, GA_TB = 55296, GA_UT = 64512, GA_WT = 73728, GA_AM = 82944, GA_AMB = 99584, GA_TT = 108800, GA_DG = 118016, GA_XT = 122368, GA_G = 124928;
__device__ __forceinline__ void gdn_a_item(Ctx& C, int l, int b, int h, int dir, int c) {
    LAS unsigned char* lds = C.lds; ITEM_IDS();
    LAS bf16_t* Qb = (LAS bf16_t*)(lds + GA_Q); LAS bf16_t* Kb = (LAS bf16_t*)(lds + GA_K); LAS bf16_t* BVT = (LAS bf16_t*)(lds + GA_BVT); LAS bf16_t* BKGT = (LAS bf16_t*)(lds + GA_BKGT);
    LAS bf16_t* KDT = (LAS bf16_t*)(lds + GA_KDT); LAS bf16_t* QKM = (LAS bf16_t*)(lds + GA_QKM); LAS bf16_t* TB = (LAS bf16_t*)(lds + GA_TB); LAS bf16_t* UT = (LAS bf16_t*)(lds + GA_UT); LAS bf16_t* WT = (LAS bf16_t*)(lds + GA_WT);
    LAS float* AM = (LAS float*)(lds + GA_AM); LAS bf16_t* AMb = (LAS bf16_t*)(lds + GA_AMB); LAS bf16_t* TT = (LAS bf16_t*)(lds + GA_TT); LAS float* Dg = (LAS float*)(lds + GA_DG); LAS bf16_t* XT = (LAS bf16_t*)(lds + GA_XT); LAS float* G = (LAS float*)(lds + GA_G);
    const bf16_t* zb = WSP(bf16_t, WS_Z); const float* zg = WSP(float, WS_ZG);
    unsigned char* blob = C.ws + WS_GD + ((size_t)((b * NH + h) * 2 + dir) * NCH + c) * GD_BLOB;
    const int i = tid >> 3, d0 = (tid & 7) * 8; const int row = scan_row<2>(b, dir, 64 * c + i);
    float qv[8], kv[8], vv[8];
    { const bf16_t* zr = zb + (size_t)row * ZW; const bool isc = row >= NLAT; const int t = isc ? (row - NLAT) % LC : row % SEQ, len = isc ? LC : SEQ;
        const bool hp = t > 0, hn = t < len - 1; const float* cw = INP(I_GDCW) + l * 3 * 768;
        float sq = 0.f, sk = 0.f;
#pragma unroll
        for (int a = 0; a < 3; ++a) { const int cc = a * 256 + h * 64 + d0; const bf16_t* zp = zr + GDB + cc;
            const u32x4 z1 = *(const u32x4*)zp, z0 = *(const u32x4*)(zp - (hp ? ZW : 0)), z2 = *(const u32x4*)(zp + (hn ? ZW : 0));
            const unsigned u0[4] = {z0.x, z0.y, z0.z, z0.w}, u1[4] = {z1.x, z1.y, z1.z, z1.w}, u2[4] = {z2.x, z2.y, z2.z, z2.w};
#pragma unroll
            for (int j = 0; j < 8; ++j) { const int jj = j >> 1; const bool hi = j & 1;
                const float x0 = hi ? u2f(u0[jj] & 0xffff0000u) : u2f(u0[jj] << 16), x1 = hi ? u2f(u1[jj] & 0xffff0000u) : u2f(u1[jj] << 16), x2 = hi ? u2f(u2[jj] & 0xffff0000u) : u2f(u2[jj] << 16);
                float sacc = (hp ? cw[cc + j] : 0.f) * x0 + cw[768 + cc + j] * x1 + (hn ? cw[1536 + cc + j] : 0.f) * x2;
                sacc = siluf_(sacc);
                if (a == 0) { qv[j] = sacc; sq += sacc * sacc; } else if (a == 1) { kv[j] = sacc; sk += sacc * sacc; } else vv[j] = sacc; } }
#pragma unroll
        for (int o = 1; o < 8; o <<= 1) { sq += __shfl_xor(sq, o); sk += __shfl_xor(sk, o); }
        const float rq = 0.125f / sqrtf(sq + EPS), rk = 1.f / sqrtf(sk + EPS);
#pragma unroll
        for (int j = 0; j < 8; ++j) { qv[j] *= rq; kv[j] *= rk; }
        if ((tid & 7) == 0) { const float* g = zg + (size_t)row * 32 + 16;
            G[128 + i] = -__expf(INP(I_GDAL)[l * 8 + dir * 4 + h]) * softplusf_(g[(2 * dir) * 4 + h] + INP(I_GDDT)[l * 8 + dir * 4 + h]); G[64 + i] = sigmoidf_(g[(2 * dir + 1) * 4 + h]); }
        u32x4 wq, wk; wq.x = pk2(qv[0], qv[1]); wq.y = pk2(qv[2], qv[3]); wq.z = pk2(qv[4], qv[5]); wq.w = pk2(qv[6], qv[7]); wk.x = pk2(kv[0], kv[1]); wk.y = pk2(kv[2], kv[3]); wk.z = pk2(kv[4], kv[5]); wk.w = pk2(kv[6], kv[7]);
        *(LAS u32x4*)(Qb + i * LS + d0) = wq; *(LAS u32x4*)(Kb + i * LS + d0) = wk;
        for (int o = tid; o < 64 * LS / 2; o += 512) ((LAS unsigned*)TT)[o] = 0u;
    }
    __syncthreads();
    if (w == 0) { float gsum = G[128 + lane];
#pragma unroll
        for (int o = 1; o < 64; o <<= 1) { const float t = __shfl(gsum, lane - o); if (lane >= o) gsum += t; }
        G[lane] = gsum; }
    __syncthreads();
    { const float gi = G[i], be = G[64 + i], gl = G[63]; const float eg = __expf(gi), ed = __expf(gl - gi);
#pragma unroll
        for (int j = 0; j < 8; ++j) { BVT[(d0 + j) * LS + i] = (bf16_t)f2bf(be * vv[j]); BKGT[(d0 + j) * LS + i] = (bf16_t)f2bf(be * kv[j] * eg); KDT[(d0 + j) * LS + i] = (bf16_t)f2bf(kv[j] * ed); } }
    for (int rep_ = 0; rep_ < 1 + ((REPMASK >> 18) & 1); ++rep_)
    if (w < 4) { f32x16 acc[2]; acc[0] = (f32x16)(0.f); acc[1] = (f32x16)(0.f);
        const int rh = (w & 1) * 32; mm_nt<2, 4>((w >> 1) ? Qb + rh * LS : Kb + rh * LS, LS, Kb, LS, acc, lane);
        float gi[16], bi[16], gj[2];
#pragma unroll
        for (int ri = 0; ri < 16; ++ri) { gi[ri] = G[rh + CROW(ri, lane)]; bi[ri] = G[64 + rh + CROW(ri, lane)]; }
        gj[0] = G[lane & 31]; gj[1] = G[32 + (lane & 31)];
        if (w >> 1) {
#pragma unroll
            for (int n = 0; n < 2; ++n)
#pragma unroll
                for (int ri = 0; ri < 16; ++ri) { const int ii = rh + CROW(ri, lane), jj = 32 * n + (lane & 31); QKM[ii * LS + jj] = (bf16_t)f2bf(jj <= ii ? acc[n][ri] * __expf(gi[ri] - gj[n]) : 0.f); }
        } else {
#pragma unroll
            for (int n = 0; n < 2; ++n)
#pragma unroll
                for (int ri = 0; ri < 16; ++ri) { const int ii = rh + CROW(ri, lane), jj = 32 * n + (lane & 31); const float av = (jj < ii) ? bi[ri] * acc[n][ri] * __expf(gi[ri] - gj[n]) : 0.f; AM[ii * LF + jj] = av; AMb[ii * LS + jj] = (bf16_t)f2bf(av); }
        } }
    __syncthreads();
    for (int rep_ = 0; rep_ < 1 + ((REPMASK >> 19) & 1); ++rep_) {
    if (w == 0) { const int bb = lane >> 4, cc = lane & 15; float t[16];
#pragma unroll
        for (int r = 0; r < 16; ++r) { float x = (r == cc) ? 1.f : 0.f;
#pragma unroll
            for (int r2 = 0; r2 < r; ++r2) x -= AM[(16 * bb + r) * LF + 16 * bb + r2] * t[r2];
            t[r] = x; Dg[(bb * 16 + r) * 17 + cc] = x; asm volatile("" ::: "memory"); } }
    __syncthreads();
    if (w < 4) { const int cl = lane & 15, q4 = lane >> 4; LAS bf16_t* XTw = XT + w * 256;
#pragma unroll
        for (int bb = 0; bb < 4; ++bb) {
            f32x4 acc = (f32x4){0.f, 0.f, 0.f, 0.f};
#pragma unroll
            for (int kk = 0; kk < 2; ++kk) { const bf16x8 a = *(const LAS bf16x8*)(AMb + (16 * bb + cl) * LS + 32 * kk + 8 * q4), tb = *(const LAS bf16x8*)(TT + (16 * w + cl) * LS + 32 * kk + 8 * q4);
                acc = __builtin_amdgcn_mfma_f32_16x16x32_bf16(a, tb, acc, 0, 0, 0); }
            float x[4];
#pragma unroll
            for (int r = 0; r < 4; ++r) x[r] = ((16 * bb + 4 * q4 + r) == (16 * w + cl) ? 1.f : 0.f) - acc[r];
            *(LAS u32x2*)(XTw + cl * 16 + 4 * q4) = (u32x2){pk2(x[0], x[1]), pk2(x[2], x[3])};
            LDS_WAIT(); asm volatile("" ::: "memory");
            bf16x8 da = (bf16x8)(0), xb = (bf16x8)(0);
            if (q4 < 2) { const LAS float* dp = Dg + (bb * 16 + cl) * 17 + 8 * q4; u32x4 dv; dv.x = pk2(dp[0], dp[1]); dv.y = pk2(dp[2], dp[3]); dv.z = pk2(dp[4], dp[5]); dv.w = pk2(dp[6], dp[7]);
                __builtin_memcpy(&da, &dv, 16); xb = *(const LAS bf16x8*)(XTw + cl * 16 + 8 * q4); }
            const f32x4 z4 = (f32x4){0.f, 0.f, 0.f, 0.f}; const f32x4 tt = __builtin_amdgcn_mfma_f32_16x16x32_bf16(da, xb, z4, 0, 0, 0);
            *(LAS u32x2*)(TT + (16 * w + cl) * LS + 16 * bb + 4 * q4) = (u32x2){pk2(tt[0], tt[1]), pk2(tt[2], tt[3])};
#pragma unroll
            for (int r = 0; r < 4; ++r) TB[(16 * bb + 4 * q4 + r) * LS + 16 * w + cl] = (bf16_t)f2bf(tt[r]);
            LDS_WAIT(); asm volatile("" ::: "memory");
        } }
    }
    __syncthreads();
    for (int rep_ = 0; rep_ < 1 + ((REPMASK >> 20) & 1); ++rep_)
    if (w < 4) { f32x16 acc[2]; acc[0] = (f32x16)(0.f); acc[1] = (f32x16)(0.f);
        const int rh = (w & 1) * 32; mm_nt<2, 4>(((w >> 1) ? BKGT : BVT) + rh * LS, LS, TB, LS, acc, lane);
        LAS bf16_t* dst = (w >> 1) ? WT : UT;
#pragma unroll
        for (int n = 0; n < 2; ++n)
#pragma unroll
            for (int ri = 0; ri < 16; ++ri) dst[(rh + CROW(ri, lane)) * LS + 32 * n + (lane & 31)] = (bf16_t)f2bf(acc[n][ri]); }
    __syncthreads();
    for (int rep_ = 0; rep_ < 1 + ((REPMASK >> 21) & 1); ++rep_)
    { f32x16 acc[2]; acc[0] = (f32x16)(0.f); acc[1] = (f32x16)(0.f);
        const int pr = w >> 1, rh = (w & 1) * 32;
        const LAS bf16_t* Ap = (pr == 0 || pr == 1) ? QKM : (pr == 2 ? KDT : UT); const LAS bf16_t* Bp = (pr == 0 || pr == 2) ? WT : (pr == 1 ? UT : KDT);
        mm_nt<2, 4>(Ap + rh * LS, LS, Bp, LS, acc, lane);
        const float egl = __expf(G[63]);
        LAS bf16_t* OUT = (LAS bf16_t*)(lds + GA_AM) + ((pr == 2) ? 0 : (pr == 0) ? 4096 : (pr == 3) ? 8192 : 12288);
        float qe[2][16];
        if (pr == 0) {
#pragma unroll
            for (int ri = 0; ri < 16; ++ri) { const int rr = rh + CROW(ri, lane); const float eg = __expf(G[rr]); qe[0][ri] = bf2f(Qb[rr * LS + (lane & 31)]) * eg; qe[1][ri] = bf2f(Qb[rr * LS + 32 + (lane & 31)]) * eg; } }
#pragma unroll
        for (int n = 0; n < 2; ++n)
#pragma unroll
            for (int ri = 0; ri < 16; ++ri) { const int rr = rh + CROW(ri, lane), cc = 32 * n + (lane & 31); const float a = acc[n][ri];
                const float v = (pr == 0) ? qe[n][ri] - a : (pr == 2) ? ((rr == cc ? egl : 0.f) - a) : a;
                OUT[rr * 64 + cc] = (bf16_t)f2bf(v); } }
    __syncthreads();
#pragma unroll
    for (int k = 0; k < 4; ++k) { const int o = tid + 512 * k; *(u32x4*)(blob + (size_t)o * 16) = *(const LAS u32x4*)(lds + GA_AM + o * 16); }
    __syncthreads();
}
__device__ __forceinline__ void gdn_b_scan(Ctx& C, int sidx) {
    LAS unsigned char* lds = C.lds; const int tid = C.tid, lane = C.lane, w = C.wave;
    LAS bf16_t* STb = (LAS bf16_t*)lds;
    LAS bf16_t* Pb = (LAS bf16_t*)(lds + 18432);
    for (int o = tid; o < 2 * 64 * LS; o += 512) STb[o] = 0;
    __syncthreads();
    int cur = 0;
    const int pr = tid >> 3, pc8 = (tid & 7) * 8, eh = (w & 1) * 32, dh = (w >> 1) * 32;
    u32x4 pv = *(const u32x4*)((const bf16_t*)(C.ws + WS_GD + ((size_t)sidx * NCH) * GD_BLOB) + pr * 64 + pc8);
    f32x16 qv = (f32x16)(0.f);
    if (w < 4) { const bf16_t* qt = (const bf16_t*)(C.ws + WS_GD + ((size_t)sidx * NCH) * GD_BLOB + 16384);
#pragma unroll
        for (int ri = 0; ri < 16; ++ri) qv[ri] = bf2f(qt[(eh + CROW(ri, lane)) * 64 + dh + (lane & 31)]); }
    for (int c = 0; c < NCH; ++c) {
        bf16_t* gst = WSP(bf16_t, WS_GST) + ((size_t)sidx * NCH + c) * 4096;
        *(LAS u32x4*)(Pb + pr * LS + pc8) = pv;
        *(u32x4*)(gst + pr * 64 + pc8) = *(const LAS u32x4*)(STb + cur * 64 * LS + pr * LS + pc8);
        const int cn = (c + 1 < NCH) ? c + 1 : c; const unsigned char* nblob = C.ws + WS_GD + ((size_t)sidx * NCH + cn) * GD_BLOB;
        pv = *(const u32x4*)((const bf16_t*)nblob + pr * 64 + pc8);
        f32x16 nq = (f32x16)(0.f);
        if (w < 4) { const bf16_t* qt = (const bf16_t*)(nblob + 16384);
#pragma unroll
            for (int ri = 0; ri < 16; ++ri) nq[ri] = bf2f(qt[(eh + CROW(ri, lane)) * 64 + dh + (lane & 31)]); }
        __syncthreads();
        if (w < 4) { f32x16 acc[1]; acc[0] = qv;
            mm_nt<1, 4>(STb + cur * 64 * LS + eh * LS, LS, Pb + dh * LS, LS, acc, lane);
#pragma unroll
            for (int ri = 0; ri < 16; ++ri) STb[(cur ^ 1) * 64 * LS + (eh + CROW(ri, lane)) * LS + dh + (lane & 31)] = (bf16_t)f2bf(acc[0][ri]); }
        __syncthreads();
        cur ^= 1; qv = nq;
    }
}
__device__ __forceinline__ void gdn_c_item(Ctx& C, int l, int b, int h, int jt) {
    LAS unsigned char* lds = C.lds; ITEM_IDS();
    LAS bf16_t* Rb = (LAS bf16_t*)lds;
    LAS bf16_t* Sb = (LAS bf16_t*)(lds + 18432);
    LAS float* OF = (LAS float*)(lds + 36864);
    const bool isc = jt < NCHC; const int jl = jt - NCHC;
    int cidx[2]; cidx[0] = jt; cidx[1] = isc ? (NCHC - 1 - jt) : NCHC + (SEQ / 64 - 1 - jl);
    const unsigned char* blob[2];
    const int dirw = w >> 2, qw = w & 3, ihw = (qw & 1) * 32, ehw = (qw >> 1) * 32;
    f32x16 acc0;
    { const bf16_t* ol = (const bf16_t*)(C.ws + WS_GD + ((size_t)((b * NH + h) * 2 + dirw) * NCH + cidx[dirw]) * GD_BLOB + 24576);
#pragma unroll
        for (int ri = 0; ri < 16; ++ri) acc0[ri] = bf2f(ol[(ihw + CROW(ri, lane)) * 64 + ehw + (lane & 31)]); }
    const int tokf = tid >> 3, e0f = (tid & 7) * 8; const int rowf = isc ? NLAT + b * LC + 64 * jt + tokf : b * SEQ + 64 * jl + tokf;
    const u32x4 gzv = *(const u32x4*)(WSP(bf16_t, WS_Z) + (size_t)rowf * ZW + GDB + 768 + h * 64 + e0f);
    const f32x4 ngv0 = *(const f32x4*)(INP(I_GDNG) + l * 256 + h * 64 + e0f), ngv1 = *(const f32x4*)(INP(I_GDNG) + l * 256 + h * 64 + e0f + 4);
#pragma unroll
    for (int dir = 0; dir < 2; ++dir) { const size_t sc = (size_t)((b * NH + h) * 2 + dir) * NCH + cidx[dir]; blob[dir] = C.ws + WS_GD + sc * GD_BLOB;
        const bf16_t* gst = WSP(bf16_t, WS_GST) + sc * 4096; const int r = tid >> 3, c8 = (tid & 7) * 8;
        *(LAS u32x4*)(Rb + dir * 64 * LS + r * LS + c8) = *(const u32x4*)((const bf16_t*)(blob[dir] + 8192) + r * 64 + c8);
        *(LAS u32x4*)(Sb + dir * 64 * LS + r * LS + c8) = *(const u32x4*)(gst + r * 64 + c8); }
    __syncthreads();
    { const int dir = dirw, ih = ihw, eh = ehw; f32x16 acc[1]; acc[0] = acc0;
        mm_nt<1, 4>(Rb + dir * 64 * LS + ih * LS, LS, Sb + dir * 64 * LS + eh * LS, LS, acc, lane);
#pragma unroll
        for (int ri = 0; ri < 16; ++ri) { const int ii = ih + CROW(ri, lane), tok = dir ? 63 - ii : ii; OF[dir * 64 * LF + tok * LF + eh + (lane & 31)] = acc[0][ri]; } }
    __syncthreads();
    { const int tok = tid >> 3, e0 = (tid & 7) * 8; const int row = isc ? NLAT + b * LC + 64 * jt + tok : b * SEQ + 64 * jl + tok;
        float o[8]; float ss = 0.f;
#pragma unroll
        for (int j = 0; j < 8; ++j) { o[j] = OF[tok * LF + e0 + j] + OF[64 * LF + tok * LF + e0 + j]; ss += o[j] * o[j]; }
#pragma unroll
        for (int k = 1; k < 8; k <<= 1) ss += __shfl_xor(ss, k);
        const float rs = 1.f / sqrtf(ss * (1.f / 64.f) + EPS);
        const float ng[8] = {ngv0.x, ngv0.y, ngv0.z, ngv0.w, ngv1.x, ngv1.y, ngv1.z, ngv1.w}; const unsigned gu[4] = {gzv.x, gzv.y, gzv.z, gzv.w};
        unsigned pk[4];
#pragma unroll
        for (int j = 0; j < 4; ++j) pk[j] = pk2(o[2 * j] * rs * ng[2 * j] * siluf_(u2f(gu[j] << 16)), o[2 * j + 1] * rs * ng[2 * j + 1] * siluf_(u2f(gu[j] & 0xffff0000u)));
        *(u32x4*)(WSP(bf16_t, WS_MIX) + (size_t)row * D + 768 + h * 64 + e0) = (u32x4){pk[0], pk[1], pk[2], pk[3]}; }
    __syncthreads();
}
constexpr int MA_Q = 0, MA_K = 9216, MA_VT = 18432, MA_KWT = 27648, MA_P = 36864, MA_ONE = 46080  , MA_S = 50688  ;
__device__ __forceinline__ void mlstm_a_item(Ctx& C, int l, int b, int h, int dir, int c) {
    LAS unsigned char* lds = C.lds; ITEM_IDS();
    LAS bf16_t* Qb = (LAS bf16_t*)(lds + MA_Q); LAS bf16_t* Kb = (LAS bf16_t*)(lds + MA_K); LAS bf16_t* VT = (LAS bf16_t*)(lds + MA_VT); LAS bf16_t* KWT = (LAS bf16_t*)(lds + MA_KWT);
    LAS bf16_t* Pm = (LAS bf16_t*)(lds + MA_P); LAS bf16_t* ONE = (LAS bf16_t*)(lds + MA_ONE); LAS float* Sc = (LAS float*)(lds + MA_S);
    const bf16_t* zb = WSP(bf16_t, WS_Z); const float* zg = WSP(float, WS_ZG);
    unsigned char* blob = C.ws + WS_ML + ((size_t)((b * NH + h) * 2 + dir) * NCH + c) * ML_BLOB;
    const int i = tid >> 3, d0 = (tid & 7) * 8; const int row = scan_row<1>(b, dir, 64 * c + i);
    float kv[8];
    { const bf16_t* zr = zb + (size_t)row * ZW + MLB + h * 64 + d0;
        *(LAS u32x4*)(Qb + i * LS + d0) = *(const u32x4*)zr;
        const u32x4 kr = *(const u32x4*)(zr + 256), vr = *(const u32x4*)(zr + 512);
        const unsigned ku[4] = {kr.x, kr.y, kr.z, kr.w}, vu[4] = {vr.x, vr.y, vr.z, vr.w};
#pragma unroll
        for (int j = 0; j < 4; ++j) { kv[2 * j] = u2f(ku[j] << 16) * 0.125f; kv[2 * j + 1] = u2f(ku[j] & 0xffff0000u) * 0.125f; VT[(d0 + 2 * j) * LS + i] = (bf16_t)(vu[j] & 0xffffu); VT[(d0 + 2 * j + 1) * LS + i] = (bf16_t)(vu[j] >> 16); }
        u32x4 wk; wk.x = pk2(kv[0], kv[1]); wk.y = pk2(kv[2], kv[3]); wk.z = pk2(kv[4], kv[5]); wk.w = pk2(kv[6], kv[7]); *(LAS u32x4*)(Kb + i * LS + d0) = wk;
        if ((tid & 7) == 0) { const float* gb = INP(I_MLGB) + l * 16; const float* g = zg + (size_t)row * 32;
            Sc[i] = g[(2 * dir) * 4 + h] + gb[(2 * dir) * 4 + h]; Sc[64 + i] = logsigmoidf_(g[(2 * dir + 1) * 4 + h] + gb[(2 * dir + 1) * 4 + h]); }
        for (int o = tid; o < 32 * LS; o += 512) ONE[o] = (bf16_t)((o < LS) ? 0x3f80 : 0);
    }
    __syncthreads();
    if (w == 0) { float fc = Sc[64 + lane];
#pragma unroll
        for (int o = 1; o < 64; o <<= 1) { const float t = __shfl(fc, lane - o); if (lane >= o) fc += t; }
        const float li = Sc[lane]; float pm = li - fc;
#pragma unroll
        for (int o = 1; o < 64; o <<= 1) { const float t = __shfl(pm, lane - o); if (lane >= o) pm = fmaxf(pm, t); }
        const float fl = __shfl(fc, 63); const float gg = fl - fc + li; float gm = gg;
#pragma unroll
        for (int o = 1; o < 64; o <<= 1) gm = fmaxf(gm, __shfl_xor(gm, o));
        Sc[128 + lane] = fc; Sc[192 + lane] = gg - gm; Sc[256 + lane] = fc + pm;
        if (lane == 0) { ((float*)(blob + 17408))[0] = gm; ((float*)(blob + 17408))[1] = fl; }
        ((float*)(blob + 16384))[64 + lane] = fc + pm; ((float*)(blob + 16384))[128 + lane] = fc; }
    __syncthreads();
    { const float e = __expf(Sc[192 + i]);
#pragma unroll
        for (int j = 0; j < 8; ++j) KWT[(d0 + j) * LS + i] = (bf16_t)f2bf(kv[j] * e); }
    if (w < 2) { f32x16 acc[2]; acc[0] = (f32x16)(0.f); acc[1] = (f32x16)(0.f);
        const int rh = w * 32; mm_nt<2, 4>(Qb + rh * LS, LS, Kb, LS, acc, lane);
        float fi[16], cj[2];
#pragma unroll
        for (int ri = 0; ri < 16; ++ri) { const int ii = rh + CROW(ri, lane); fi[ri] = Sc[128 + ii] - Sc[256 + ii]; }
        cj[0] = Sc[lane & 31] - Sc[128 + (lane & 31)]; cj[1] = Sc[32 + (lane & 31)] - Sc[128 + 32 + (lane & 31)];
#pragma unroll
        for (int n = 0; n < 2; ++n)
#pragma unroll
            for (int ri = 0; ri < 16; ++ri) { const int ii = rh + CROW(ri, lane), jj = 32 * n + (lane & 31);
                Pm[ii * LS + jj] = (bf16_t)f2bf(jj <= ii ? acc[n][ri] * __expf(fi[ri] + cj[n]) : 0.f); } }
    __syncthreads();
    { const int pr = w >> 2, q = w & 3, rh = (q & 1) * 32, ch = (q >> 1) * 32; f32x16 acc[1]; acc[0] = (f32x16)(0.f);
        const LAS bf16_t* Ap = pr ? VT : Pm; const LAS bf16_t* Bp = pr ? KWT : VT;
        mm_nt<1, 4>(Ap + rh * LS, LS, Bp + ch * LS, LS, acc, lane);
        LAS bf16_t* OUT = (LAS bf16_t*)(lds + MA_Q) + (pr ? 4096 : 0);
#pragma unroll
        for (int ri = 0; ri < 16; ++ri) OUT[(rh + CROW(ri, lane)) * 64 + ch + (lane & 31)] = (bf16_t)f2bf(acc[0][ri]);
        if (q < 2) {
            f32x16 a2[1]; a2[0] = (f32x16)(0.f);
            if (pr == 0) { mm_nt<1, 4>(Pm + (q * 32) * LS, LS, ONE, LS, a2, lane);
                if ((lane & 31) == 0) {
#pragma unroll
                    for (int ri = 0; ri < 16; ++ri) ((float*)(blob + 16384))[q * 32 + CROW(ri, lane)] = a2[0][ri]; } }
            else { mm_nt<1, 4>(ONE, LS, KWT + (q * 32) * LS, LS, a2, lane);
                if (lane < 32) ((float*)(blob + 16384))[192 + q * 32 + lane] = a2[0][0]; } } }
    __syncthreads();
#pragma unroll
    for (int k = 0; k < 2; ++k) { const int o = tid + 512 * k; *(u32x4*)(blob + (size_t)o * 16) = *(const LAS u32x4*)(lds + MA_Q + o * 16); }
    __syncthreads();
}
__device__ __forceinline__ void mlstm_b_scan(Ctx& C, int sidx) {
    const int tid = C.tid, e = tid >> 3, d0 = (tid & 7) * 8;
    float ct[8], nn[8]; float m = 0.f;
#pragma unroll
    for (int j = 0; j < 8; ++j) { ct[j] = 0.f; nn[j] = 0.f; }
    u32x4 uq; f32x4 n0, n1; float gm, fl;
    { const unsigned char* blob = C.ws + WS_ML + ((size_t)sidx * NCH) * ML_BLOB;
        uq = *(const u32x4*)((const bf16_t*)(blob + 8192) + e * 64 + d0);
        n0 = *(const f32x4*)((const float*)(blob + 16384) + 192 + d0); n1 = *(const f32x4*)((const float*)(blob + 16384) + 192 + d0 + 4); gm = ((const float*)(blob + 17408))[0]; fl = ((const float*)(blob + 17408))[1]; }
    for (int c = 0; c < NCH; ++c) {
        unsigned char* st = C.ws + WS_MST + ((size_t)sidx * NCH + c) * ML_ST;
        const int cn = (c + 1 < NCH) ? c + 1 : c; const unsigned char* blob = C.ws + WS_ML + ((size_t)sidx * NCH + cn) * ML_BLOB;
        const u32x4 puq = *(const u32x4*)((const bf16_t*)(blob + 8192) + e * 64 + d0);
        const f32x4 pn0 = *(const f32x4*)((const float*)(blob + 16384) + 192 + d0), pn1 = *(const f32x4*)((const float*)(blob + 16384) + 192 + d0 + 4);
        const float pgm = ((const float*)(blob + 17408))[0], pfl = ((const float*)(blob + 17408))[1];
        u32x4 wv; wv.x = pk2(ct[0], ct[1]); wv.y = pk2(ct[2], ct[3]); wv.z = pk2(ct[4], ct[5]); wv.w = pk2(ct[6], ct[7]);
        *(u32x4*)((bf16_t*)st + e * 64 + d0) = wv;
        if (e == 0) { *(f32x4*)((float*)(st + 8192) + d0) = (f32x4){nn[0], nn[1], nn[2], nn[3]}; *(f32x4*)((float*)(st + 8192) + d0 + 4) = (f32x4){nn[4], nn[5], nn[6], nn[7]}; if (d0 == 0) ((float*)(st + 8192))[64] = m; }
        const float mn = fmaxf(fl + m, gm), ao = __expf(fl + m - mn), an = __expf(gm - mn); m = mn;
        const unsigned uw[4] = {uq.x, uq.y, uq.z, uq.w}; const float un[8] = {n0.x, n0.y, n0.z, n0.w, n1.x, n1.y, n1.z, n1.w};
#pragma unroll
        for (int j = 0; j < 4; ++j) { ct[2 * j] = ao * ct[2 * j] + an * u2f(uw[j] << 16); ct[2 * j + 1] = ao * ct[2 * j + 1] + an * u2f(uw[j] & 0xffff0000u); }
#pragma unroll
        for (int j = 0; j < 8; ++j) nn[j] = ao * nn[j] + an * un[j];
        uq = puq; n0 = pn0; n1 = pn1; gm = pgm; fl = pfl;
    }
}
__device__ __forceinline__ void mlstm_c_item(Ctx& C, int l, int b, int h, int jt) {
    LAS unsigned char* lds = C.lds; ITEM_IDS();
    LAS bf16_t* Qb = (LAS bf16_t*)lds;
    LAS bf16_t* Sb = (LAS bf16_t*)(lds + 18432);
    LAS float* OF = (LAS float*)(lds + 36864);
    LAS float* Sc = (LAS float*)(lds + 70144);
    const bool isc = jt < NCHC; const int jl = jt - NCHC;
    int cidx[2]; cidx[0] = jt; cidx[1] = isc ? (NCHC - 1 - jt) : NCHC + (SEQ / 64 - 1 - jl);
    const unsigned char* blob[2]; const bf16_t* zb = WSP(bf16_t, WS_Z);
    const int i = tid >> 3, d0 = (tid & 7) * 8;
    const int dirw = w >> 2, qw = w & 3, ihw = (qw & 1) * 32, ehw = (qw >> 1) * 32;
    float nlv[16];
    { const bf16_t* nl = (const bf16_t*)(C.ws + WS_ML + ((size_t)((b * NH + h) * 2 + dirw) * NCH + cidx[dirw]) * ML_BLOB);
#pragma unroll
        for (int ri = 0; ri < 16; ++ri) nlv[ri] = bf2f(nl[(ihw + CROW(ri, lane)) * 64 + ehw + (lane & 31)]); }
    const int rowf = scan_row<1>(b, 0, 64 * cidx[0] + i);
    const u32x4 gzv = *(const u32x4*)(zb + (size_t)rowf * ZW + MLB + 768 + h * 64 + d0);
    const f32x4 ngv0 = *(const f32x4*)(INP(I_MLNG) + l * 256 + h * 64 + d0), ngv1 = *(const f32x4*)(INP(I_MLNG) + l * 256 + h * 64 + d0 + 4);
#pragma unroll
    for (int dir = 0; dir < 2; ++dir) { const size_t sc = (size_t)((b * NH + h) * 2 + dir) * NCH + cidx[dir]; blob[dir] = C.ws + WS_ML + sc * ML_BLOB;
        const unsigned char* st = C.ws + WS_MST + sc * ML_ST; const int row = scan_row<1>(b, dir, 64 * cidx[dir] + i);
        const u32x4 qr = *(const u32x4*)(zb + (size_t)row * ZW + MLB + h * 64 + d0);
        *(LAS u32x4*)(Qb + dir * 64 * LS + i * LS + d0) = qr;
        *(LAS u32x4*)(Sb + dir * 64 * LS + i * LS + d0) = *(const u32x4*)((const bf16_t*)st + i * 64 + d0);
        const float* n0 = (const float*)(st + 8192) + d0; const unsigned qu[4] = {qr.x, qr.y, qr.z, qr.w}; float qn = 0.f;
#pragma unroll
        for (int j = 0; j < 4; ++j) qn += u2f(qu[j] << 16) * n0[2 * j] + u2f(qu[j] & 0xffff0000u) * n0[2 * j + 1];
#pragma unroll
        for (int k = 1; k < 8; k <<= 1) qn += __shfl_xor(qn, k);
        if ((tid & 7) == 0) { const float* sv = (const float*)(blob[dir] + 16384); const float m0 = ((const float*)(st + 8192))[64];
            const float mloc = sv[64 + i], ainit = sv[128 + i] + m0, M = fmaxf(mloc, ainit), s1 = __expf(mloc - M), s2 = __expf(ainit - M);
            LAS float* o = Sc + dir * 256; o[i] = s1; o[64 + i] = s2; o[128 + i] = s1 * sv[i] + s2 * qn; o[192 + i] = __expf(-M); } }
    __syncthreads();
    { const int dir = dirw, ih = ihw, eh = ehw; f32x16 acc[1]; acc[0] = (f32x16)(0.f);
        mm_nt<1, 4>(Qb + dir * 64 * LS + ih * LS, LS, Sb + dir * 64 * LS + eh * LS, LS, acc, lane);
        const LAS float* o = Sc + dir * 256; float s1[16], s2[16], dn[16];
#pragma unroll
        for (int ri = 0; ri < 16; ++ri) { const int ii = ih + CROW(ri, lane); s1[ri] = o[ii]; s2[ri] = o[64 + ii]; dn[ri] = 1.f / fmaxf(fabsf(o[128 + ii]), o[192 + ii]); }
#pragma unroll
        for (int ri = 0; ri < 16; ++ri) { const int ii = ih + CROW(ri, lane), tok = dir ? 63 - ii : ii, ee = eh + (lane & 31);
            OF[dir * 64 * LF + tok * LF + ee] = (s1[ri] * nlv[ri] + s2[ri] * acc[0][ri]) * dn[ri]; } }
    __syncthreads();
    { const int tok = tid >> 3, e0 = (tid & 7) * 8; const int row = scan_row<1>(b, 0, 64 * cidx[0] + tok);
        float o[8]; float ss = 0.f;
#pragma unroll
        for (int j = 0; j < 8; ++j) { o[j] = OF[tok * LF + e0 + j] + OF[64 * LF + tok * LF + e0 + j]; ss += o[j] * o[j]; }
#pragma unroll
        for (int k = 1; k < 8; k <<= 1) ss += __shfl_xor(ss, k);
        const float rs = 1.f / sqrtf(ss * (1.f / 64.f) + EPS);
        const float ng[8] = {ngv0.x, ngv0.y, ngv0.z, ngv0.w, ngv1.x, ngv1.y, ngv1.z, ngv1.w}; const unsigned gu[4] = {gzv.x, gzv.y, gzv.z, gzv.w};
        unsigned pk[4];
#pragma unroll
        for (int j = 0; j < 4; ++j) pk[j] = pk2(o[2 * j] * rs * ng[2 * j] * sigmoidf_(u2f(gu[j] << 16)), o[2 * j + 1] * rs * ng[2 * j + 1] * sigmoidf_(u2f(gu[j] & 0xffff0000u)));
        *(u32x4*)(WSP(bf16_t, WS_MIX) + (size_t)row * D + 256 + h * 64 + e0) = (u32x4){pk[0], pk[1], pk[2], pk[3]}; }
    __syncthreads();
}
constexpr int HA_Q = 0, HA_K = 16640, HA_CUM = 33280, HA_V = 49920, HA_SC = 66560  , HA_VT = 70912, HA_KDT = 80128, HA_QT = 89344, HA_KT = 98560;
__device__ __forceinline__ void hgrn_a_item(Ctx& C, int l, int b, int h, int dir, int c) {
    LAS unsigned char* lds = C.lds; ITEM_IDS();
    LAS float* Qf = (LAS float*)(lds + HA_Q); LAS float* Kf = (LAS float*)(lds + HA_K); LAS float* CUM = (LAS float*)(lds + HA_CUM); LAS float* Vf = (LAS float*)(lds + HA_V); LAS float* SC = (LAS float*)(lds + HA_SC);
    LAS bf16_t* VT = (LAS bf16_t*)(lds + HA_VT); LAS bf16_t* KDT = (LAS bf16_t*)(lds + HA_KDT); LAS bf16_t* QTb = (LAS bf16_t*)(lds + HA_QT); LAS bf16_t* KTb = (LAS bf16_t*)(lds + HA_KT);
    const bf16_t* zb = WSP(bf16_t, WS_Z);
    unsigned char* blob = C.ws + WS_HG + ((size_t)((b * NH + h) * 2 + dir) * NCH + c) * HG_BLOB;
    const int i = tid >> 3, d0 = (tid & 7) * 8; const int row = scan_row<0>(b, dir, 64 * c + i);
    { const bf16_t* zr = zb + (size_t)row * ZW + HGB + h * 64 + d0; const float* lbp = WSP(float, WS_LB) + l * 256 + h * 64 + d0;
#pragma unroll
        for (int j = 0; j < 8; ++j) { const float qz = bf2f(zr[j]), iz = bf2f(zr[256 + j]), fz = bf2f(zr[512 + dir * 256 + j]), lb = lbp[j];
            const float sg = 1.f / (1.f + __expf(-fz)), sgn = 1.f / (1.f + __expf(fz));
            Qf[i * LF + d0 + j] = siluf_(qz); Kf[i * LF + d0 + j] = (1.f - lb) * sgn; CUM[i * LF + d0 + j] = __logf(lb + (1.f - lb) * sg); Vf[i * LF + d0 + j] = iz; VT[(d0 + j) * LS + i] = (bf16_t)f2bf(iz); } }
    __syncthreads();
    if (tid < 256) { const int sub = tid >> 6, d = tid & 63; float cv[16];
#pragma unroll
        for (int t = 0; t < 16; ++t) cv[t] = CUM[(16 * sub + t) * LF + d];
#pragma unroll
        for (int t = 1; t < 16; ++t) cv[t] += cv[t - 1];
#pragma unroll
        for (int t = 0; t < 16; ++t) CUM[(16 * sub + t) * LF + d] = cv[t]; }
    __syncthreads();
    { const int sub = i >> 4; u32x4 wq, wk; float qt[8], kt[8], cmv[8], lsv[8], kkv[8], qqv[8];
#pragma unroll
        for (int j = 0; j < 8; ++j) { cmv[j] = CUM[i * LF + d0 + j]; lsv[j] = CUM[(16 * sub + 15) * LF + d0 + j]; kkv[j] = Kf[i * LF + d0 + j]; qqv[j] = Qf[i * LF + d0 + j]; }
#pragma unroll
        for (int j = 0; j < 8; ++j) { const float cm = cmv[j], last = lsv[j], kk = kkv[j];
            KDT[(d0 + j) * LS + i] = (bf16_t)f2bf(kk * __expf(last - cm)); qt[j] = qqv[j] * __expf(cm); kt[j] = kk * __expf(fminf(-cm, 80.f));
            if ((i & 15) == 15) ((float*)(blob + 32768))[sub * 64 + d0 + j] = __expf(last); }
        wq.x = pk2(qt[0], qt[1]); wq.y = pk2(qt[2], qt[3]); wq.z = pk2(qt[4], qt[5]); wq.w = pk2(qt[6], qt[7]);
        wk.x = pk2(kt[0], kt[1]); wk.y = pk2(kt[2], kt[3]); wk.z = pk2(kt[4], kt[5]); wk.w = pk2(kt[6], kt[7]);
        *(u32x4*)((bf16_t*)(blob + 33792) + i * 64 + d0) = wq; *(LAS u32x4*)(QTb + i * LS + d0) = wq; *(LAS u32x4*)(KTb + i * LS + d0) = wk; }
    __syncthreads();
    if (w < 4) { const int sub = w, cl = lane & 15, q4 = lane >> 4; f32x4 acc = (f32x4){0.f, 0.f, 0.f, 0.f};
#pragma unroll
        for (int kk = 0; kk < 2; ++kk) { const bf16x8 a = *(const LAS bf16x8*)(QTb + (16 * sub + cl) * LS + 32 * kk + 8 * q4), bb = *(const LAS bf16x8*)(KTb + (16 * sub + cl) * LS + 32 * kk + 8 * q4);
            acc = __builtin_amdgcn_mfma_f32_16x16x32_bf16(a, bb, acc, 0, 0, 0); }
#pragma unroll
        for (int r = 0; r < 4; ++r) { const int t = 4 * q4 + r; SC[(sub * 16 + t) * 17 + cl] = (cl <= t) ? acc[r] : 0.f; } }
    __syncthreads();
    { const int sub = i >> 4, t = i & 15; float o[8];
#pragma unroll
        for (int j = 0; j < 8; ++j) o[j] = 0.f;
#pragma unroll
        for (int s2 = 0; s2 < 16; ++s2) { const float sc = SC[(sub * 16 + t) * 17 + s2];
#pragma unroll
            for (int j = 0; j < 8; ++j) o[j] += sc * Vf[(16 * sub + s2) * LF + d0 + j]; }
        u32x4 ow; ow.x = pk2(o[0], o[1]); ow.y = pk2(o[2], o[3]); ow.z = pk2(o[4], o[5]); ow.w = pk2(o[6], o[7]); *(u32x4*)((bf16_t*)(blob + 41984) + i * 64 + d0) = ow; }
    { const int sub = w >> 1, eh = (w & 1) * 32; f32x16 acc[2]; acc[0] = (f32x16)(0.f); acc[1] = (f32x16)(0.f);
        mm_nt<2, 1>(VT + eh * LS + 16 * sub, LS, KDT + 16 * sub, LS, acc, lane);
        LAS bf16_t* ut = (LAS bf16_t*)(lds + HA_Q) + sub * 4096;
#pragma unroll
        for (int n = 0; n < 2; ++n)
#pragma unroll
            for (int ri = 0; ri < 16; ++ri) ut[(eh + CROW(ri, lane)) * 64 + 32 * n + (lane & 31)] = (bf16_t)f2bf(acc[n][ri]); }
    __syncthreads();
#pragma unroll
    for (int k = 0; k < 4; ++k) { const int o = tid + 512 * k; *(u32x4*)(blob + (size_t)o * 16) = *(const LAS u32x4*)(lds + HA_Q + o * 16); }
    __syncthreads();
}
__device__ __forceinline__ void hgrn_b_scan(Ctx& C, int sidx) {
    const int tid = C.tid, e = tid >> 3, d0 = (tid & 7) * 8;
    LAS float* LAM = (LAS float*)C.lds;
    __syncthreads();
    for (int o = tid; o < NCH * 64; o += 512) { const int c = o >> 6, q = o & 63; *(LAS f32x4*)(LAM + c * 256 + q * 4) = *(const f32x4*)((const float*)(C.ws + WS_HG + ((size_t)sidx * NCH + c) * HG_BLOB + 32768) + q * 4); }
    __syncthreads();
    float st[8];
#pragma unroll
    for (int j = 0; j < 8; ++j) st[j] = 0.f;
    u32x4 ur[3][4];
#define HGB_LOAD(slot, cc) do { const int c_ = (cc) < NCH ? (cc) : NCH - 1; const unsigned char* blob_ = C.ws + WS_HG + ((size_t)sidx * NCH + c_) * HG_BLOB; \
        _Pragma("unroll") for (int sub = 0; sub < 4; ++sub) ur[slot][sub] = *(const u32x4*)((const bf16_t*)blob_ + sub * 4096 + e * 64 + d0); } while (0)
#define HGB_APPLY(slot, cc) do { bf16_t* so_ = WSP(bf16_t, WS_HST) + ((size_t)sidx * NCH + (cc)) * 4 * 4096; \
        _Pragma("unroll") for (int sub = 0; sub < 4; ++sub) { u32x4 wv; wv.x = pk2(st[0], st[1]); wv.y = pk2(st[2], st[3]); wv.z = pk2(st[4], st[5]); wv.w = pk2(st[6], st[7]); \
            *(u32x4*)(so_ + sub * 4096 + e * 64 + d0) = wv; \
            const f32x4 la_ = *(const LAS f32x4*)(LAM + ((cc) * 4 + sub) * 64 + d0), lb_ = *(const LAS f32x4*)(LAM + ((cc) * 4 + sub) * 64 + d0 + 4); \
            const unsigned uu[4] = {ur[slot][sub].x, ur[slot][sub].y, ur[slot][sub].z, ur[slot][sub].w}; const float lam[8] = {la_.x, la_.y, la_.z, la_.w, lb_.x, lb_.y, lb_.z, lb_.w}; \
            _Pragma("unroll") for (int j = 0; j < 4; ++j) { st[2 * j] = lam[2 * j] * st[2 * j] + u2f(uu[j] << 16); st[2 * j + 1] = lam[2 * j + 1] * st[2 * j + 1] + u2f(uu[j] & 0xffff0000u); } } } while (0)
    HGB_LOAD(0, 0); HGB_LOAD(1, 1);
    int c = 0;
    for (; c + 3 <= NCH; c += 3) {
        HGB_LOAD(2, c + 2); HGB_APPLY(0, c);
        HGB_LOAD(0, c + 3); HGB_APPLY(1, c + 1);
        HGB_LOAD(1, c + 4); HGB_APPLY(2, c + 2);
    }
    if (c < NCH) { HGB_APPLY(0, c); ++c; }
    if (c < NCH) { HGB_APPLY(1, c); ++c; }
#undef HGB_LOAD
#undef HGB_APPLY
    __syncthreads();
}
__device__ __forceinline__ void hgrn_c_item(Ctx& C, int l, int b, int h, int jt) {
    LAS unsigned char* lds = C.lds; ITEM_IDS();
    LAS bf16_t* STw = (LAS bf16_t*)(lds + w * 11520);
    LAS bf16_t* QTw = STw + 64 * LS;
    LAS float* OF = (LAS float*)(lds + 92160);
    const bool isc = jt < NCHC; const int jl = jt - NCHC;
    int cidx[2]; cidx[0] = jt; cidx[1] = isc ? (NCHC - 1 - jt) : NCHC + (SEQ / 64 - 1 - jl);
    const int tokf = tid >> 3, e0f = (tid & 7) * 8; const int rowf = scan_row<0>(b, 0, 64 * cidx[0] + tokf);
    const u32x4 gzv = *(const u32x4*)(WSP(bf16_t, WS_Z) + (size_t)rowf * ZW + HGB + 1024 + h * 64 + e0f);
    const f32x4 ngv0 = *(const f32x4*)(INP(I_HGNG) + l * 256 + h * 64 + e0f), ngv1 = *(const f32x4*)(INP(I_HGNG) + l * 256 + h * 64 + e0f + 4);
    { const int dir = w >> 2, sub = w & 3; const size_t sc = (size_t)((b * NH + h) * 2 + dir) * NCH + cidx[dir]; const unsigned char* blob = C.ws + WS_HG + sc * HG_BLOB;
        const bf16_t* st = WSP(bf16_t, WS_HST) + (sc * 4 + sub) * 4096; const bf16_t* qt = (const bf16_t*)(blob + 33792) + (16 * sub) * 64;
#pragma unroll
        for (int k = 0; k < 8; ++k) { const int o = lane + 64 * k, r = o >> 3, c8 = (o & 7) * 8; *(LAS u32x4*)(STw + r * LS + c8) = *(const u32x4*)(st + r * 64 + c8); }
#pragma unroll
        for (int k = 0; k < 2; ++k) { const int o = lane + 64 * k, r = o >> 3, c8 = (o & 7) * 8; *(LAS u32x4*)(QTw + r * LS + c8) = *(const u32x4*)(qt + r * 64 + c8); }
        const bf16_t* oi = (const bf16_t*)(blob + 41984) + (16 * sub) * 64;
        float oiv[16];
#pragma unroll
        for (int nt = 0; nt < 4; ++nt)
#pragma unroll
            for (int r = 0; r < 4; ++r) oiv[4 * nt + r] = bf2f(oi[(4 * (lane >> 4) + r) * 64 + 16 * nt + (lane & 15)]);
        LDS_WAIT(); asm volatile("" ::: "memory");
        const int tr = lane & 15, kq = (lane >> 4) * 8;
#pragma unroll
        for (int nt = 0; nt < 4; ++nt) { f32x4 acc = (f32x4){0.f, 0.f, 0.f, 0.f};
#pragma unroll
            for (int kk = 0; kk < 2; ++kk) { const bf16x8 a = *(const LAS bf16x8*)(QTw + tr * LS + 32 * kk + kq), bb = *(const LAS bf16x8*)(STw + (16 * nt + tr) * LS + 32 * kk + kq);
                acc = __builtin_amdgcn_mfma_f32_16x16x32_bf16(a, bb, acc, 0, 0, 0); }
#pragma unroll
            for (int r = 0; r < 4; ++r) { const int t = 4 * (lane >> 4) + r, ii = 16 * sub + t, tok = dir ? 63 - ii : ii, ee = 16 * nt + (lane & 15);
                OF[dir * 64 * LF + tok * LF + ee] = acc[r] + oiv[4 * nt + r]; } } }
    __syncthreads();
    { const int tok = tid >> 3, e0 = (tid & 7) * 8; const int row = scan_row<0>(b, 0, 64 * cidx[0] + tok);
        float o[8]; float ss = 0.f;
#pragma unroll
        for (int j = 0; j < 8; ++j) { o[j] = OF[tok * LF + e0 + j] + OF[64 * LF + tok * LF + e0 + j]; ss += o[j] * o[j]; }
#pragma unroll
        for (int k = 1; k < 8; k <<= 1) ss += __shfl_xor(ss, k);
        const float rs = 1.f / sqrtf(ss * (1.f / 64.f) + EPS);
        const float ng[8] = {ngv0.x, ngv0.y, ngv0.z, ngv0.w, ngv1.x, ngv1.y, ngv1.z, ngv1.w}; const unsigned gu[4] = {gzv.x, gzv.y, gzv.z, gzv.w};
        unsigned pk[4];
#pragma unroll
        for (int j = 0; j < 4; ++j) pk[j] = pk2(o[2 * j] * rs * ng[2 * j] * siluf_(u2f(gu[j] << 16)), o[2 * j + 1] * rs * ng[2 * j + 1] * siluf_(u2f(gu[j] & 0xffff0000u)));
        *(u32x4*)(WSP(bf16_t, WS_MIX) + (size_t)row * D + h * 64 + e0) = (u32x4){pk[0], pk[1], pk[2], pk[3]}; }
    __syncthreads();
}
__device__ __forceinline__ void phase_gdn_a(Ctx& C, int l) {
    for (int rep = 0; rep < 1 + ((REPMASK >> 10) & 1); ++rep)
    for (int it = C.bid; it < NSCAN * NCH; it += C.G) { const int sidx = it / NCH, c = it % NCH; gdn_a_item(C, l, sidx / (NH * 2), (sidx / 2) % NH, sidx & 1, c); }
    for (int rep = 0; rep < 1 + ((REPMASK >> 11) & 1); ++rep)
    for (int it = (C.bid + C.G / 3) % C.G; it < NSCAN * NCH; it += C.G) { const int sidx = it / NCH, c = it % NCH; mlstm_a_item(C, l, sidx / (NH * 2), (sidx / 2) % NH, sidx & 1, c); }
    for (int rep = 0; rep < 1 + ((REPMASK >> 12) & 1); ++rep)
    for (int it = (C.bid + 2 * (C.G / 3)) % C.G; it < NSCAN * NCH; it += C.G) { const int sidx = it / NCH, c = it % NCH; hgrn_a_item(C, l, sidx / (NH * 2), (sidx / 2) % NH, sidx & 1, c); }
}
__device__ __forceinline__ void phase_hy_transpose(Ctx& C) {
    const int gw = C.vcu * 8 + C.wave, NGW = C.G * 8, lane = C.lane;
    LAS bf16_t* scr = (LAS bf16_t*)(C.lds + C.wave * 8448);
    const bf16_t* zb = WSP(bf16_t, WS_Z); bf16_t* zt = WSP(bf16_t, WS_ZT);
    for (int it = gw; it < (NT / 64) * 12; it += NGW) { const int r0 = (it / 12) * 64, cb = (it % 12) * 64;
#pragma unroll 8
        for (int rr = 0; rr < 64; rr += 2) { const int r = rr + (lane >> 5), c2 = (lane & 31) * 2; const unsigned v = *(const unsigned*)(zb + (size_t)(r0 + r) * ZW + HYB + cb + c2);
            scr[r * 66 + c2] = (bf16_t)(v & 0xffffu); scr[r * 66 + c2 + 1] = (bf16_t)(v >> 16); }
        LDS_WAIT(); asm volatile("" ::: "memory");
#pragma unroll 8
        for (int cc = 0; cc < 64; cc += 2) { const int c = cc + (lane >> 5), r2 = (lane & 31) * 2;
            *(unsigned*)(zt + (size_t)(cb + c) * NT + r0 + r2) = (unsigned)scr[r2 * 66 + c] | ((unsigned)scr[(r2 + 1) * 66 + c] << 16); }
        LDS_WAIT(); asm volatile("" ::: "memory"); }
}
__device__ __forceinline__ void phase_gdn_c(Ctx& C, int l) {
    const int j0 = (l == 0) ? 0 : NCHC, nj = NCH - j0;
    for (int it = C.bid; it < NB * NH * nj; it += C.G) { const int bh = it / nj, jt = j0 + it % nj; gdn_c_item(C, l, bh / NH, bh % NH, jt); }
    for (int it = (C.bid + C.G / 3) % C.G; it < NB * NH * nj; it += C.G) { const int bh = it / nj, jt = j0 + it % nj; mlstm_c_item(C, l, bh / NH, bh % NH, jt); }
    for (int it = (C.bid + 2 * (C.G / 3)) % C.G; it < NB * NH * nj; it += C.G) { const int bh = it / nj, jt = j0 + it % nj; hgrn_c_item(C, l, bh / NH, bh % NH, jt); }
}

__device__ __forceinline__ f32x2 cmul(f32x2 a, f32x2 w) { return (f32x2){a.x * w.x - a.y * w.y, a.x * w.y + a.y * w.x}; }
__device__ __forceinline__ f32x2 cmulc(f32x2 a, f32x2 w) { return (f32x2){a.x * w.x + a.y * w.y, a.y * w.x - a.x * w.y}; }
template <int N> __device__ __forceinline__ void fft_fwd(LAS f32x2* X, const LAS f32x2* tw, int tid) {
    constexpr int NG = (N / 4 + 511) / 512, NB2 = (N / 2 + 511) / 512;
    int h = N >> 1;
#pragma unroll 1
    for (; h >= 2; h >>= 2) { const float tf = 3.14159265358979f / (float)h; const int hh = h >> 1;
        f32x2 x0[NG], x1[NG], x2[NG], x3[NG], w1[NG]; int bs[NG];
#pragma unroll
        for (int q = 0; q < NG; ++q) { const int j = tid + 512 * q; const int jm = j & (hh - 1); bs[q] = ((j - jm) << 2) + jm;
            if (j < (N >> 2)) { x0[q] = X[bs[q]]; x1[q] = X[bs[q] + hh]; x2[q] = X[bs[q] + h]; x3[q] = X[bs[q] + h + hh]; const float ang = (float)jm * tf; w1[q] = (f32x2){__cosf(ang), -__sinf(ang)}; } }
#pragma unroll
        for (int q = 0; q < NG; ++q) { const int j = tid + 512 * q; if (j < (N >> 2)) {
            const f32x2 w2 = cmul(w1[q], w1[q]);
            const f32x2 a0 = x0[q] + x2[q], a2 = cmul(x0[q] - x2[q], w1[q]), a1 = x1[q] + x3[q]; const f32x2 d13 = cmul(x1[q] - x3[q], w1[q]); const f32x2 a3 = (f32x2){d13.y, -d13.x};
            X[bs[q]] = a0 + a1; X[bs[q] + hh] = cmul(a0 - a1, w2); X[bs[q] + h] = a2 + a3; X[bs[q] + h + hh] = cmul(a2 - a3, w2); } }
        __syncthreads(); }
    if (h == 1) {
        f32x2 a[NB2], b[NB2];
#pragma unroll
        for (int q = 0; q < NB2; ++q) { const int j = tid + 512 * q; if (j < (N >> 1)) { a[q] = X[2 * j]; b[q] = X[2 * j + 1]; } }
#pragma unroll
        for (int q = 0; q < NB2; ++q) { const int j = tid + 512 * q; if (j < (N >> 1)) { X[2 * j] = a[q] + b[q]; X[2 * j + 1] = a[q] - b[q]; } }
        __syncthreads(); }
}
template <int N> __device__ __forceinline__ void fft_inv(LAS f32x2* X, const LAS f32x2* tw, int tid) {
    constexpr int NG = (N / 4 + 511) / 512, NB2 = (N / 2 + 511) / 512;
    constexpr int LOG2N = (N == 8192) ? 13 : (N == 4096) ? 12 : (N == 2048) ? 11 : (N == 1024) ? 10 : (N == 512) ? 9 : (N == 256) ? 8 : (N == 128) ? 7 : (N == 64) ? 6 : -1;
    static_assert(LOG2N > 0, "fft size");
    int h = 2;
    if (LOG2N & 1) {
        f32x2 a[NB2], b[NB2];
#pragma unroll
        for (int q = 0; q < NB2; ++q) { const int j = tid + 512 * q; if (j < (N >> 1)) { a[q] = X[2 * j]; b[q] = X[2 * j + 1]; } }
#pragma unroll
        for (int q = 0; q < NB2; ++q) { const int j = tid + 512 * q; if (j < (N >> 1)) { X[2 * j] = a[q] + b[q]; X[2 * j + 1] = a[q] - b[q]; } }
        __syncthreads(); h = 4; }
#pragma unroll 1
    for (; h <= (N >> 1); h <<= 2) { const float tf = 3.14159265358979f / (float)h; const int hh = h >> 1;
        f32x2 x0[NG], x1[NG], x2[NG], x3[NG], w1[NG]; int bs[NG];
#pragma unroll
        for (int q = 0; q < NG; ++q) { const int j = tid + 512 * q; const int jm = j & (hh - 1); bs[q] = ((j - jm) << 2) + jm;
            if (j < (N >> 2)) { x0[q] = X[bs[q]]; x1[q] = X[bs[q] + hh]; x2[q] = X[bs[q] + h]; x3[q] = X[bs[q] + h + hh]; const float ang = (float)jm * tf; w1[q] = (f32x2){__cosf(ang), -__sinf(ang)}; } }
#pragma unroll
        for (int q = 0; q < NG; ++q) { const int j = tid + 512 * q; if (j < (N >> 2)) {
            const f32x2 w2 = cmul(w1[q], w1[q]);
            const f32x2 b1 = cmulc(x1[q], w2), b3 = cmulc(x3[q], w2); const f32x2 a0 = x0[q] + b1, a1 = x0[q] - b1, a2 = x2[q] + b3, a3 = x2[q] - b3;
            const f32x2 c2 = cmulc(a2, w1[q]); const f32x2 t3 = cmulc(a3, w1[q]); const f32x2 c3 = (f32x2){-t3.y, t3.x};
            X[bs[q]] = a0 + c2; X[bs[q] + h] = a0 - c2; X[bs[q] + hh] = a1 + c3; X[bs[q] + h + hh] = a1 - c3; } }
        __syncthreads(); }
}
__device__ __forceinline__ float block_sum(Ctx& C, float v, LAS float* red) {
    v = wave_sum(v); __syncthreads(); if (C.lane == 0) red[C.wave] = v; __syncthreads();
    float s = 0.f;
#pragma unroll
    for (int i = 0; i < 8; ++i) s += red[i];
    return s;
}
#define FFT_FWD_P(X) do { fft_fwd<N>(X, tw, tid); if ((REPMASK >> 15) & 1) { fft_inv<N>(X, tw, tid); for (int i_ = tid; i_ < N; i_ += 512) X[i_] = X[i_] * (1.0f / (float)N); __syncthreads(); fft_fwd<N>(X, tw, tid); } } while (0)
template <int LEN>
__device__ __forceinline__ void hyena_channel(Ctx& C, int l, int c, int row0, int hoff  ) {
    LAS f32x2* X = (LAS f32x2*)C.lds; LAS f32x2* Y1 = (LAS f32x2*)(C.lds + 65536); const LAS f32x2* tw = (const LAS f32x2*)(C.lds + 98304); LAS float* red = (LAS float*)(C.lds + LDSX_OFF + 128);
    constexpr int N = 2 * LEN, len = LEN, NI = (LEN + 511) / 512;
#ifdef HOST_EMU
    const int tid = C.tid;
#else
    int tid_ = C.tid; asm volatile("" : "+v"(tid_)); const int tid = tid_;
#endif
    f32x2* Ks = WSP(f32x2, WS_KS) + (size_t)C.bid * 2 * FFTN;
    const float* hd = WSP(float, WS_HDN) + ((size_t)l * (SEQ + LC) + hoff) * 64;
    const float* w3 = INP(I_HYW3) + (size_t)l * 64 * 1024;
    const float delta = (-4.605170185988091f / 1.5f + (-4.605170185988091f / 0.3f + 4.605170185988091f / 1.5f) * (float)c / 255.0f);
    const float ad = fabsf(delta);
    LAS f32x4* W3c = (LAS f32x4*)(C.lds + 98304);
    __syncthreads();
    if (tid < 256) { const int j = tid >> 2, q = tid & 3; ((LAS float*)W3c)[tid] = w3[j * 1024 + (q & 1) * 512 + (q >> 1) * 256 + c]; }
    __syncthreads();
    float ss0 = 0.f, ss1 = 0.f;
    for (int p = tid; p < len; p += 512) { const float* hr = hd + (size_t)p * 64; f32x4 acc = (f32x4){0.f, 0.f, 0.f, 0.f};
#pragma unroll 16
        for (int j = 0; j < 64; ++j) acc = acc + W3c[j] * hr[j];
        const float win = __expf(-((float)p / (float)(len - 1)) * ad); acc = acc * win;
        X[p] = (f32x2){acc.x, 0.f}; ss0 += acc.x * acc.x; ss1 += acc.z * acc.z;
        if (p >= 1) { X[N - p] = (f32x2){acc.y, 0.f}; ss0 += acc.y * acc.y; ss1 += acc.w * acc.w; }
        Y1[p] = (f32x2){acc.z, acc.w}; }
    if (tid == 0) X[len] = (f32x2){0.f, 0.f};
    const float scale0 = 1.f / sqrtf(block_sum(C, ss0, red) + EPS), scale1 = 1.f / sqrtf(block_sum(C, ss1, red) + EPS);
    __syncthreads();
    for (int n = 0; n < 2 + 2 * ((REPMASK >> 16) & 1); ++n) {
        if (n & 1) { for (int p = tid; p < len; p += 512) { const f32x2 t1 = Y1[p]; X[p] = (f32x2){t1.x, 0.f}; if (p >= 1) X[N - p] = (f32x2){t1.y, 0.f}; } if (tid == 0) X[len] = (f32x2){0.f, 0.f}; __syncthreads(); }
        FFT_FWD_P(X);
        const float scale = (n & 1) ? scale1 : scale0;
        for (int i = tid; i < N; i += 512) Ks[(size_t)(n & 1) * FFTN + i] = X[i] * scale;
        __syncthreads();
    }
    const bf16_t* zt = WSP(bf16_t, WS_ZT); const float* cw = INP(I_HYCW) + l * 3 * 768; const float* cb = INP(I_HYCB) + l * 768;
    const float bias0 = INP(I_HYBI)[l * 512 + c], bias1 = INP(I_HYBI)[l * 512 + 256 + c];
    float* hyt = WSP(float, WS_HYT) + (size_t)c * NT;
    const float inv_n = 1.0f / (float)N;
    const float cw0[3] = {cw[c], cw[768 + c], cw[1536 + c]}, cw1[3] = {cw[256 + c], cw[768 + 256 + c], cw[1536 + 256 + c]}, cw2[3] = {cw[512 + c], cw[768 + 512 + c], cw[1536 + 512 + c]};
    const float cb0 = cb[c], cb1 = cb[256 + c], cb2 = cb[512 + c];
    const bf16_t* z0 = zt + (size_t)c * NT; const bf16_t* z1 = zt + (size_t)(256 + c) * NT; const bf16_t* z2 = zt + (size_t)(512 + c) * NT;
    LAS f32x2* X1 = Y1;
    LAS f32x2* X2 = (LAS f32x2*)(C.lds + 98304);
    LAS bf16_t* RAW = (LAS bf16_t*)(X + len);
    constexpr int RS = LEN + 16;
    for (int q2 = 0; q2 < NB * (1 + ((REPMASK >> 17) & 1)); q2 += 2) { const int q = q2 % NB;
        const int ra = row0 + q * len, rb = ra + len;
        float va[NI], vb[NI];
#pragma unroll
        for (int col = 0; col < 3; ++col) { const bf16_t* zc = col == 0 ? z0 : (col == 1 ? z1 : z2); const float* wv = col == 0 ? cw0 : (col == 1 ? cw1 : cw2); const float bv = col == 0 ? cb0 : (col == 1 ? cb1 : cb2);
            if (8 * tid < len) { *(LAS u32x4*)(RAW + 8 + 8 * tid) = *(const u32x4*)(zc + ra + 8 * tid); *(LAS u32x4*)(RAW + RS + 8 + 8 * tid) = *(const u32x4*)(zc + rb + 8 * tid); }
            if (tid == 0) { RAW[7] = 0; RAW[8 + len] = 0; RAW[RS + 7] = 0; RAW[RS + 8 + len] = 0; }
            __syncthreads();
#pragma unroll
            for (int k = 0; k < NI; ++k) { const int t = tid + 512 * k; if (t < len) {
                const float ca = bv + wv[0] * bf2f(RAW[7 + t]) + wv[1] * bf2f(RAW[8 + t]) + wv[2] * bf2f(RAW[9 + t]);
                const float cbv = bv + wv[0] * bf2f(RAW[RS + 7 + t]) + wv[1] * bf2f(RAW[RS + 8 + t]) + wv[2] * bf2f(RAW[RS + 9 + t]);
                if (col == 0) { va[k] = ca; vb[k] = cbv; X[t] = (f32x2){ca, cbv}; } else if (col == 1) X1[t] = (f32x2){ca, cbv}; else X2[t] = (f32x2){ca, cbv}; } }
            __syncthreads(); }
#pragma unroll
        for (int k = 0; k < NI; ++k) { const int t = tid + 512 * k; if (t < len) X[len + t] = (f32x2){0.f, 0.f}; }
        __syncthreads();
        FFT_FWD_P(X);
#pragma unroll 1
        for (int k0 = 0; k0 < 2 * NI; k0 += 8) { f32x2 kv_[8], xv_[8];
#pragma unroll
        for (int k = 0; k < 8; ++k) { const int i = tid + 512 * (k0 + k); if (i < N) { kv_[k] = Ks[i]; xv_[k] = X[i]; } }
#pragma unroll
        for (int k = 0; k < 8; ++k) { const int i = tid + 512 * (k0 + k); if (i < N) X[i] = cmul(xv_[k], kv_[k]); } }
        __syncthreads();
        fft_inv<N>(X, tw, tid);
        f32x2 y1[NI];
#pragma unroll
        for (int k = 0; k < NI; ++k) { const int t = tid + 512 * k; if (t < len) { const f32x2 cv = X[t] * inv_n, x1 = X1[t];
            y1[k] = (f32x2){x1.x * (cv.x + bias0 * va[k]), x1.y * (cv.y + bias0 * vb[k])}; } }
        __syncthreads();
#pragma unroll
        for (int k = 0; k < NI; ++k) { const int t = tid + 512 * k; if (t < len) { X[t] = y1[k]; X[len + t] = (f32x2){0.f, 0.f}; } }
        __syncthreads();
        FFT_FWD_P(X);
#pragma unroll 1
        for (int k0 = 0; k0 < 2 * NI; k0 += 8) { f32x2 kv_[8], xv_[8];
#pragma unroll
        for (int k = 0; k < 8; ++k) { const int i = tid + 512 * (k0 + k); if (i < N) { kv_[k] = Ks[FFTN + i]; xv_[k] = X[i]; } }
#pragma unroll
        for (int k = 0; k < 8; ++k) { const int i = tid + 512 * (k0 + k); if (i < N) X[i] = cmul(xv_[k], kv_[k]); } }
        __syncthreads();
        fft_inv<N>(X, tw, tid);
#pragma unroll
        for (int k = 0; k < NI; ++k) { const int t = tid + 512 * k; if (t < len) { const f32x2 cv = X[t] * inv_n, yy = y1[k], x2 = X2[t];
            hyt[ra + t] = x2.x * (cv.x + bias1 * yy.x); hyt[rb + t] = x2.y * (cv.y + bias1 * yy.y); } }
        __syncthreads();
    }
}
__device__ __forceinline__ void phase_mixers(Ctx& C, int l, int parts = 3) {
    const int G = C.G, me = C.bid;
    const int nscan = 3 * NSCAN, nsw = G > nscan ? nscan : G;
    if (parts & 1) for (int j = me; j < nscan; j += nsw) { if (me >= nsw) break;
        const int mix = j / NSCAN, r = j % NSCAN;
        if (mix == 0) { if (!(parts & 32) || (parts & 4)) hgrn_b_scan(C, r); } else if (mix == 1) { if (!(parts & 32) || (parts & 8)) mlstm_b_scan(C, r); } else { if (!(parts & 32) || (parts & 16)) gdn_b_scan(C, r); } }
    if (parts & 2) {
        LAS f32x2* tw = (LAS f32x2*)(C.lds + 98304); volatile LAS int* jobw = (volatile LAS int*)(C.lds + LDSX_OFF + 192);
        __syncthreads();
        for (int k = C.tid; k < TWN; k += 512) { float s, c; sincospi_((float)k / (float)TWN, &s, &c); tw[k] = (f32x2){c, -s}; }
        __syncthreads();
        unsigned* qh = WSP(unsigned, WS_CTL) + CW_HYQ + 64 * l + ((parts == 2) ? 32 : 0) + ((parts & 64) ? 16 : 0);
        for (;;) {
            if (C.tid == 0) jobw[0] = (int)atomicAdd(qh, 1u);
            __syncthreads();
            const int c = jobw[0];
            __syncthreads();
            if (c >= 256) break;
            hyena_channel<SEQ>(C, l, c, 0, 0); if (l == 0) hyena_channel<LC>(C, l, c, NLAT, SEQ);
        }
    }
}
__device__ __forceinline__ void phase_finalize(Ctx& C, int l) {
    const int gw = C.vcu * 8 + C.wave, NGW = C.G * 8, lane = C.lane;
    const int nrows = (l == 0) ? NT : NLAT;
    const bf16_t* zb = WSP(bf16_t, WS_Z); bf16_t* mix = WSP(bf16_t, WS_MIX);
    LAS float* scr = (LAS float*)(C.lds + C.wave * 8448);
    const int ntr = nrows / 64;
    for (int it = gw; it < ntr * 8; it += NGW) { const int rt = it / 8, cb = (it % 8) * 32; const float* src = WSP(float, WS_HYT) + (size_t)cb * NT + rt * 64;
#pragma unroll 8
        for (int cc = 0; cc < 32; ++cc) scr[cc * 65 + lane] = src[(size_t)cc * NT + lane];
        LDS_WAIT(); asm volatile("" ::: "memory");
        for (int rr = 0; rr < 64; rr += 4) { const int r = rr + (lane >> 4), c2 = (lane & 15) * 2;
            *(unsigned*)(mix + (size_t)(rt * 64 + r) * D + 512 + cb + c2) = pk2(scr[c2 * 65 + r], scr[(c2 + 1) * 65 + r]); }
        LDS_WAIT(); asm volatile("" ::: "memory"); }
}

enum { PH_PRO = 0, PH_L0 = 1, PH_PER_LAYER = 10, PH_FINAL = PH_L0 + DEPTH * PH_PER_LAYER, PH_COUNT };
__global__ void __launch_bounds__(512, 2) fwd_kernel(Args args) {
#ifdef HOST_EMU
    unsigned char* lds = emu::cur->blk->lds;
#else
    extern __shared__ __attribute__((aligned(16))) unsigned char lds[];
#endif
#ifdef HOST_EMU
    Ctx C; C.lds = (LAS unsigned char*)lds; C.a = &args; C.ws = args.ws;
#else
    Ctx C; C.lds = (LAS unsigned char*)lds; C.a = (const __attribute__((address_space(4))) Args*)__builtin_amdgcn_kernarg_segment_ptr(); C.ws = C.a->ws;
#endif
    C.tid = threadIdx.x; C.lane = C.tid & 63; C.wave = __builtin_amdgcn_readfirstlane(C.tid >> 6);
    C.bid = blockIdx.x; C.G = gridDim.x; { const int bx = blockIdx.x; C.vcu = (C.G % 8 == 0) ? (bx % 8) * (C.G / 8) + bx / 8 : bx; }
    volatile LAS unsigned* MISC = (volatile LAS unsigned*)(C.lds + LDSX_OFF + LX_MISC);
    for (int u = C.tid; u < 64; u += 512) MISC[u] = 0u;
    __syncthreads();
    const int lo = C.a->ph_lo, hi = C.a->ph_hi;
    const bool multi = (hi - lo) > 1;
    XcdBarrier bar; bar.bar = WSP(unsigned, WS_CTL) + CW_BAR; bar.x = 0; bar.st = nullptr;
    if (multi) bar = xcd_barrier_post(WSP(unsigned, WS_CTL) + CW_BAR, MISC + 8);
#ifndef HOST_EMU
    if (multi) { cooperative_groups::this_grid().sync(); }
#endif
    const Ctx C0 = C;
#ifdef HOST_EMU
#define LAUNDER_CTX() Ctx C = C0; C.tid = threadIdx.x; C.lane = C.tid & 63; C.wave = C.tid >> 6;
#else
#define LAUNDER_CTX() Ctx C = C0; C.tid = threadIdx.x; \
        {   unsigned long long pw = (unsigned long long)C.ws, pa = (unsigned long long)C.a; unsigned w0 = (unsigned)pw, w1 = (unsigned)(pw >> 32), a0 = (unsigned)pa, a1 = (unsigned)(pa >> 32), v0 = (unsigned)C.vcu, g0 = (unsigned)C.G, b0 = (unsigned)C.bid; \
            asm volatile("" : "+v"(w0), "+v"(w1), "+v"(a0), "+v"(a1), "+v"(v0), "+v"(g0), "+v"(b0), "+v"(C.tid)); \
            w0 = __builtin_amdgcn_readfirstlane(w0); w1 = __builtin_amdgcn_readfirstlane(w1); a0 = __builtin_amdgcn_readfirstlane(a0); a1 = __builtin_amdgcn_readfirstlane(a1); \
            C.vcu = (int)__builtin_amdgcn_readfirstlane(v0); C.G = (int)__builtin_amdgcn_readfirstlane(g0); C.bid = (int)__builtin_amdgcn_readfirstlane(b0); \
            C.ws = (unsigned char*)(((unsigned long long)w1 << 32) | w0); C.a = (const __attribute__((address_space(4))) Args*)(((unsigned long long)a1 << 32) | a0); } \
        C.lane = C.tid & 63; C.wave = __builtin_amdgcn_readfirstlane(C.tid >> 6);
#endif
#define PH_BEGIN(k) if (lo <= (k) && (k) < hi) { LAUNDER_CTX()
#define PH_END(k) if ((k) + 1 < hi) { XcdBarrier b2 = bar; b2.bar = WSP(unsigned, WS_CTL) + CW_BAR; xcd_barrier(b2); if ((REPMASK >> 22) & 1) xcd_barrier(b2); } }
#define REP(b) ((REPMASK >> (b)) & 1)
    PH_BEGIN(PH_PRO) p0_prologue(C); if (REP(0)) { __syncthreads(); p0_prologue(C); } PH_END(PH_PRO)
#define LAYER_PHASES(l) { constexpr int pb = PH_L0 + (l) * PH_PER_LAYER; \
    PH_BEGIN(pb + 0) if ((l) > 0) (void)build_tiles(C, (l) > 0 ? (l) - 1 : 0); phase_rows_a(C, (l)); if (REP(13) && (l) == 0) { __syncthreads(); phase_rows_a(C, (l)); } PH_END(pb + 0) \
    PH_BEGIN(pb + 1) pg8::Gemm g{WSP(bf16_t, WS_H), WSP(bf16_t, WS_WIN) + (size_t)(l) * ZW * D, D, 0}; pg8::StaticOrder S; S.init(NT, ZW, C.G, C.bid); \
        pg8::EpiBf16 E{WSP(bf16_t, WS_Z), ZW, nullptr, 0}; pg8::gemm_phase(C.lds, g, S, E, C.tid); if (REP(1)) { __syncthreads(); pg8::gemm_phase(C.lds, g, S, E, C.tid); } PH_END(pb + 1) \
    PH_BEGIN(pb + 2) phase_hy_transpose(C); __syncthreads(); phase_gdn_a(C, (l)); if (REP(8)) { __syncthreads(); phase_gdn_a(C, (l)); } PH_END(pb + 2) \
    PH_BEGIN(pb + 3) phase_mixers(C, (l)); if (REP(2)) { __syncthreads(); phase_mixers(C, (l), 1); } if (REP(26)) { __syncthreads(); phase_mixers(C, (l), 3 | 64); } if (REP(23)) { __syncthreads(); phase_mixers(C, (l), 1 | 32 | 4); } if (REP(24)) { __syncthreads(); phase_mixers(C, (l), 1 | 32 | 8); } if (REP(25)) { __syncthreads(); phase_mixers(C, (l), 1 | 32 | 16); } if (REP(3)) { __syncthreads(); phase_mixers(C, (l), 2); } PH_END(pb + 3) \
    PH_BEGIN(pb + 4) phase_finalize(C, (l)); __syncthreads(); phase_gdn_c(C, (l)); if (REP(4)) { __syncthreads(); phase_finalize(C, (l)); } if (REP(9)) { __syncthreads(); phase_gdn_c(C, (l)); } PH_END(pb + 4) \
    PH_BEGIN(pb + 5) pg8::Gemm g{WSP(bf16_t, WS_MIX), WSP(bf16_t, WS_WOUT) + (size_t)(l) * D * D, D, 0}; pg8::StaticOrder S; S.init((l) == 0 ? NT : NLAT, D, C.G, C.bid); \
        pg8::EpiResid E{(l) == 0 ? INP(I_X) : WSP(float, WS_X), (l) == 0 ? INP(I_CTX) : WSP(float, WS_X) + (size_t)NLAT * D, WSP(float, WS_X), WSP(float, WS_MOD) + (size_t)(l) * (NB + 1) * 6 * D + 2 * D}; \
        pg8::gemm_phase(C.lds, g, S, E, C.tid); if (REP(14) && (l) == 0) { __syncthreads(); pg8::gemm_phase(C.lds, g, S, E, C.tid); } PH_END(pb + 5) \
    PH_BEGIN(pb + 6) phase_rows_b(C, (l)); PH_END(pb + 6) \
    PH_BEGIN(pb + 7) phase_gather(C, (l)); if (REP(5)) { __syncthreads(); phase_gather(C, (l)); } PH_END(pb + 7) \
    PH_BEGIN(pb + 8) const int ntiles = build_tiles(C, (l)); \
        pg8::Gemm g{WSP(bf16_t, WS_HS), WSP(bf16_t, WS_W1) + (size_t)(l) * NE * 2 * DE * D, D, (size_t)2 * DE * D}; pg8::MoeOrder S; S.init(ntiles, 2 * DE, C.G, C.bid, (const LAS int*)(C.lds + LDSX_OFF + LX_TILE)); \
        pg8::EpiSwiglu E{WSP(bf16_t, WS_A2), INP(I_EB1) + (size_t)(l) * NE * 2 * DE}; pg8::gemm_phase(C.lds, g, S, E, C.tid); if (REP(6)) { __syncthreads(); pg8::gemm_phase(C.lds, g, S, E, C.tid); } PH_END(pb + 8) \
    PH_BEGIN(pb + 9) const int ntiles = build_tiles(C, (l)); \
        pg8::Gemm g{WSP(bf16_t, WS_A2), WSP(bf16_t, WS_W2) + (size_t)(l) * NE * D * DE, DE, (size_t)D * DE}; pg8::MoeOrder S; S.init(ntiles, D, C.G, C.bid, (const LAS int*)(C.lds + LDSX_OFF + LX_TILE)); \
        pg8::EpiBf16 E{WSP(bf16_t, WS_Y), D, INP(I_EB2) + (size_t)(l) * NE * D, D}; pg8::gemm_phase(C.lds, g, S, E, C.tid); if (REP(7)) { __syncthreads(); pg8::gemm_phase(C.lds, g, S, E, C.tid); } PH_END(pb + 9) }
    LAYER_PHASES(0)
    LAYER_PHASES(1)
    static_assert(DEPTH == 2, "two layers written out");
    PH_BEGIN(PH_FINAL) (void)build_tiles(C, DEPTH - 1); phase_rows_a(C, DEPTH); PH_END(PH_FINAL)
}

#ifndef MK_PER_PHASE
#define MK_PER_PHASE 0
#endif
extern "C" void kernel_launch(void* const* d_in, const int* in_sizes, int n_in, void* d_out, int out_size, void* d_ws, size_t ws_size, hipStream_t stream) {
    static int grid = 0;
#ifndef HOST_EMU
    if (grid == 0) {
        if (n_in != 34 || ws_size < WS_END) { fprintf(stderr, "kernel_launch: unexpected n_in %d / ws %zu (need %zu)\n", n_in, ws_size, (size_t)WS_END); grid = -1; return; }
        int dev = 0, cus = 0, per_cu = 0;
        hipGetDevice(&dev); hipDeviceGetAttribute(&cus, hipDeviceAttributeMultiprocessorCount, dev);
        hipFuncSetAttribute((const void*)fwd_kernel, hipFuncAttributeMaxDynamicSharedMemorySize, LDS_BYTES);
        hipOccupancyMaxActiveBlocksPerMultiprocessor(&per_cu, (const void*)fwd_kernel, 512, LDS_BYTES);
        if (per_cu < 1) { fprintf(stderr, "kernel_launch: occupancy query says %d blocks per CU\n", per_cu); per_cu = 1; }
        grid = cus;
        (void)hipGetLastError();
    }
    if (grid < 0) return;
#else
    grid = EMU_GRID;
#endif
    hipMemsetAsync((char*)d_ws + WS_CTL, 0, CTL_BYTES, stream);
    Args a{};
    for (int i = 0; i < 34; ++i) a.in[i] = (const float*)d_in[i];
    a.out = (float*)d_out; a.ws = (unsigned char*)d_ws;
#ifdef HOST_EMU
    a.ph_lo = 0; a.ph_hi = PH_COUNT;
    if (getenv("EMU_PH_HI")) a.ph_hi = atoi(getenv("EMU_PH_HI"));
    emu::launch([&]() { fwd_kernel(a); }, dim3(grid), dim3(512), LDS_BYTES);
#else
#if MK_PER_PHASE
    for (int ph = 0; ph < PH_COUNT; ++ph) { a.ph_lo = ph; a.ph_hi = ph + 1; hipLaunchKernelGGL(fwd_kernel, dim3(grid), dim3(512), LDS_BYTES, stream, a); }
#else
    a.ph_lo = 0; a.ph_hi = PH_COUNT;
    void* kargs[] = {&a};
    hipError_t e = hipLaunchCooperativeKernel((const void*)fwd_kernel, dim3(grid), dim3(512), kargs, LDS_BYTES, stream);
    if (e != hipSuccess) fprintf(stderr, "cooperative launch failed: %s (grid %d)\n", hipGetErrorString(e), grid);
#endif
#endif
}
```

```cpp
#ifdef HOST_EMU
#include "host/emu.h"
#else
#include <hip/hip_runtime.h>
#include <hip/hip_cooperative_groups.h>
#endif
#include <cstdio>
#include <cstdint>
#include <cmath>
#ifndef REPMASK
#define REPMASK 0
#endif

#ifndef CFG_B
#define CFG_B 4
#define CFG_L 4096
#define CFG_GW 64
#define CFG_LC 256
#define CFG_NE 32
#endif
constexpr int NB = CFG_B, SEQ = CFG_L, GW = CFG_GW, GROWS = SEQ / GW, LC = CFG_LC, NE = CFG_NE, TOPK = 4, DEPTH = 2;
constexpr int D = 1024, WG_ = 256, NH = 4, DH = 64;
constexpr int NLAT = NB * SEQ, NCTX = NB * LC, NT = NLAT + NCTX;
constexpr int IN_W = 4128, ZW = 4096;
constexpr int HGB = 0, MLB = 1280, HYB = 2304, GDB = 3072;
constexpr int DE = 1024;
constexpr float EPS = 1e-6f;
constexpr int FFTN = 2 * SEQ, FFTNC = 2 * LC, TWN = FFTN / 2;
static_assert(NT % 256 == 0 && NLAT % 256 == 0, "row counts must be multiples of 256");
static_assert(SEQ % 16 == 0 && LC % 16 == 0, "chunking");
constexpr int MAXTILES = (NT * TOPK + NE * 255) / 256 + 1;

constexpr size_t al256(size_t x) { return (x + 255) & ~(size_t)255; }
constexpr size_t WS_CTL = 0, CTL_BYTES = 1 << 20;
constexpr size_t WS_WIN = WS_CTL + CTL_BYTES;
constexpr size_t WS_WOUT = WS_WIN + (size_t)DEPTH * ZW * D * 2;
constexpr size_t WS_W1 = WS_WOUT + (size_t)DEPTH * D * D * 2;
constexpr size_t WS_W2 = WS_W1 + (size_t)DEPTH * NE * 2 * DE * D * 2;
constexpr size_t WS_WG = WS_W2 + (size_t)DEPTH * NE * D * DE * 2;
constexpr size_t WS_WR = WS_WG + (size_t)DEPTH * 32 * D * 4;
constexpr size_t WS_MOD = WS_WR + (size_t)DEPTH * NE * D * 4;
constexpr size_t WS_LB = WS_MOD + al256((size_t)DEPTH * (NB + 1) * 6 * D * 4);
constexpr size_t WS_HDN = WS_LB + (size_t)DEPTH * 256 * 4;
constexpr size_t WS_X = WS_HDN + (size_t)DEPTH * (SEQ + LC) * 64 * 4;
constexpr size_t WS_H = WS_X + (size_t)NT * D * 4;
constexpr size_t WS_Z = WS_H + (size_t)NT * D * 2;
constexpr size_t WS_ZG = WS_Z + (size_t)NT * ZW * 2;
constexpr size_t WS_MIX = WS_ZG + (size_t)NT * 32 * 4;
constexpr size_t WS_OB = WS_MIX + (size_t)NT * D * 2;
constexpr size_t WS_HYT = WS_OB + (size_t)6 * NT * 256 * 4;
constexpr size_t WS_KS = WS_HYT + (size_t)256 * NT * 4;
constexpr size_t WS_TOP = WS_KS + (size_t)256 * 2 * FFTN * 8;
constexpr size_t WS_HS = WS_TOP + (size_t)NT * 4 * 12;
constexpr size_t WS_A2 = WS_HS + (size_t)MAXTILES * 256 * D * 2;
constexpr size_t WS_Y = WS_A2 + (size_t)MAXTILES * 256 * DE * 2;
constexpr int NCH = (LC + SEQ) / 64, NCHC = LC / 64, NSCAN = NB * NH * 2;
constexpr size_t GD_BLOB = 32768;
constexpr size_t WS_GD = WS_Y + (size_t)MAXTILES * 256 * D * 2;
constexpr size_t WS_GST = WS_GD + (size_t)NSCAN * NCH * GD_BLOB;
constexpr size_t ML_BLOB = 17920;
constexpr size_t WS_ML = WS_GST + (size_t)NSCAN * NCH * 8192;
constexpr size_t ML_ST = 8192 + 512;
constexpr size_t WS_MST = WS_ML + (size_t)NSCAN * NCH * ML_BLOB;
constexpr size_t HG_BLOB = 50176;
constexpr size_t WS_HG = WS_MST + (size_t)NSCAN * NCH * ML_ST;
constexpr size_t WS_HST = WS_HG + (size_t)NSCAN * NCH * HG_BLOB;
constexpr size_t WS_ZT = WS_HST + (size_t)NSCAN * NCH * 4 * 8192;
constexpr size_t WS_END = WS_ZT + (size_t)768 * NT * 2;
static_assert(SEQ % 64 == 0 && LC % 64 == 0, "64-token chunks");
constexpr int CW_CNT = 64;
constexpr int CW_HYQ = 192;
constexpr int CW_BAR = 4096;

constexpr int RING_BYTES = 131072, LDSX_OFF = RING_BYTES, LDS_BYTES = 147456;
constexpr int LX_MISC = 0, LX_TILE = 256;

#ifdef HOST_EMU
#define __expf expf
#define __logf logf
#define __sinf sinf
#define __cosf cosf
#define LAS
#define GAS
#define DEV_ASM(x) ((void)0)
#define VM_WAIT() ((void)0)
#define LDS_WAIT() do { int _s; (void)emu::wave_xchg(&_s, 4, _s); } while (0)
#else
#define LAS __attribute__((address_space(3)))
#define GAS __attribute__((address_space(1)))
#define VM_WAIT() asm volatile("s_waitcnt vmcnt(0)" ::: "memory")
#define LDS_WAIT() asm volatile("s_waitcnt lgkmcnt(0)" ::: "memory")
#endif
typedef unsigned short bf16_t;
typedef short bf16x8 __attribute__((ext_vector_type(8)));
typedef float f32x4 __attribute__((ext_vector_type(4)));
typedef float f32x2 __attribute__((ext_vector_type(2)));
typedef unsigned u32x4 __attribute__((ext_vector_type(4)));
typedef unsigned u32x2 __attribute__((ext_vector_type(2)));

__device__ __forceinline__ float u2f(unsigned u) { float f; __builtin_memcpy(&f, &u, 4); return f; }
__device__ __forceinline__ unsigned f2u(float f) { unsigned u; __builtin_memcpy(&u, &f, 4); return u; }
__device__ __forceinline__ float bf2f(bf16_t b) { return u2f((unsigned)b << 16); }
__device__ __forceinline__ unsigned f2bf(float f) { unsigned u = f2u(f); return (u + 0x7fffu + ((u >> 16) & 1u)) >> 16; }
__device__ __forceinline__ unsigned pk2(float lo, float hi) { return f2bf(lo) | (f2bf(hi) << 16); }
__device__ __forceinline__ unsigned cvt_pk_bf16(float lo, float hi) {
#ifdef HOST_EMU
    return pk2(lo, hi);
#else
    unsigned r; asm volatile("v_cvt_pk_bf16_f32 %0, %1, %2" : "=v"(r) : "v"(lo), "v"(hi)); return r;
#endif
}
__device__ __forceinline__ float wave_sum(float v) {
#pragma unroll
    for (int o = 1; o < 64; o <<= 1) v += __shfl_xor(v, o);
    return v;
}
__device__ __forceinline__ float sigmoidf_(float x) { return 1.f / (1.f + __expf(-x)); }
__device__ __forceinline__ float siluf_(float x) { return x * sigmoidf_(x); }
__device__ __forceinline__ float softplusf_(float x) { return x > 20.f ? x : log1pf(__expf(x)); }
__device__ __forceinline__ float logsigmoidf_(float x) { return x < -20.f ? x : -log1pf(__expf(-x)); }
#ifdef HOST_EMU
static inline void sincospi_(float x, float* s, float* c) { *s = (float)sin(M_PI * (double)x); *c = (float)cos(M_PI * (double)x); }
#else
__device__ __forceinline__ void sincospi_(float x, float* s, float* c) { sincospif(x, s, c); }
#endif

namespace pg8 {
constexpr int BM = 256, BK = 64, HALF = 128, HTB = HALF * BK * 2, STAGE_BYTES = 8 * HTB, NXCD = 8, WGM = 8;
__host__ __device__ __forceinline__ int lds_byte(int r, int c) { const int st = (r >> 4) * 2 + (c >> 5), rr = r & 15, cc = c & 31, ob = rr * 64 + cc * 2; return st * 1024 + (ob ^ (((ob >> 9) & 1) << 5)); }
__host__ __device__ __forceinline__ void stage_rc(int b, int& R, int& C) { const int st = b / 1024, sb = b % 1024, swz = sb ^ (((sb >> 9) & 1) << 5); R = (st >> 1) * 16 + swz / 64; C = (st & 1) * 32 + (swz % 64) / 2; }
__host__ __device__ __forceinline__ int perm32(int rho) { const int n = rho >> 4, i = rho & 15; return 8 * (i >> 2) + 4 * n + (i & 3); }

struct Unit { int pm, pn, e; };
struct Gemm { const bf16_t* A; const bf16_t* Bt; int K; size_t bexp; };

__host__ __device__ __forceinline__ int xcd_remap(int L, int nwg) { const int q = nwg / NXCD, r = nwg % NXCD, xcd = L % NXCD, off = L / NXCD; return (xcd < r ? xcd * (q + 1) : r * (q + 1) + (xcd - r) * q) + off; }
struct StaticOrder {
    int nM, nN, nwg, G, c;
    __host__ __device__ void init(int M, int N, int G_, int c_) { nM = M / BM; nN = N / BM; nwg = nM * nN; G = G_; c = c_; }
    __host__ __device__ bool next(int i, Unit& u) const {
        const long L = (long)i * G + c; if (L >= nwg) return false;
        const int wgid = xcd_remap((int)L, nwg);
        const int nig = WGM * nN, gid = wgid / nig, fm = gid * WGM, gsz = (nM - fm) < WGM ? (nM - fm) : WGM;
        u.pm = fm + ((wgid % nig) % gsz); u.pn = (wgid % nig) / gsz; u.e = 0; return true;
    }
};
struct MoeOrder {
    int ntiles, nN, nwg, G, c; const LAS int* tile_e;
    __device__ void init(int ntiles_, int N, int G_, int c_, const LAS int* te) { ntiles = ntiles_; nN = N / BM; nwg = ntiles * nN; G = G_; c = c_; tile_e = te; }
    __device__ bool next(int i, Unit& u) const {
        const long L = (long)i * G + c; if (L >= nwg) return false;
        const int wgid = xcd_remap((int)L, nwg);
        u.pm = wgid / nN; u.pn = wgid % nN; u.e = __builtin_amdgcn_readfirstlane(tile_e[u.pm]); return true;
    }
};

struct EpiBf16 {
    static constexpr bool PERM = true;
    bf16_t* O; int ldc; const float* bias; int bias_estride;
    __device__ __forceinline__ void operator()(const f32x4 (&acc)[2][2][4][2], const Unit& u, int wr, int wc, int fr, int fq) const {
        const int row0 = u.pm * BM + wr * 64 + fr, col0 = u.pn * BM + wc * 32 + 8 * fq;
        f32x4 bv[2][2];
#pragma unroll
        for (int bj = 0; bj < 2; ++bj)
#pragma unroll
            for (int n = 0; n < 2; ++n) bv[bj][n] = bias ? *(const f32x4*)(bias + (size_t)u.e * bias_estride + col0 + bj * HALF + 4 * n) : (f32x4){0.f, 0.f, 0.f, 0.f};
#pragma unroll
        for (int ai = 0; ai < 2; ++ai)
#pragma unroll
            for (int m = 0; m < 4; ++m) { bf16_t* rowp = O + (size_t)(row0 + ai * HALF + m * 16) * ldc + col0;
#pragma unroll
                for (int bj = 0; bj < 2; ++bj) { const f32x4 v0 = acc[ai][bj][m][0] + bv[bj][0], v1 = acc[ai][bj][m][1] + bv[bj][1];
                    u32x4 w; w.x = cvt_pk_bf16(v0[0], v0[1]); w.y = cvt_pk_bf16(v0[2], v0[3]); w.z = cvt_pk_bf16(v1[0], v1[1]); w.w = cvt_pk_bf16(v1[2], v1[3]);
                    *(u32x4*)(rowp + bj * HALF) = w; } }
    }
};
struct EpiSwiglu {
    static constexpr bool PERM = true;
    bf16_t* O; const float* b1;
    __device__ __forceinline__ void operator()(const f32x4 (&acc)[2][2][4][2], const Unit& u, int wr, int wc, int fr, int fq) const {
        const int row0 = u.pm * BM + wr * 64 + fr, cj = u.pn * HALF + wc * 32 + 8 * fq;
        const float* bb = b1 + (size_t)u.e * 2 * DE;
        f32x4 bg[2], bl[2];
#pragma unroll
        for (int n = 0; n < 2; ++n) { bg[n] = *(const f32x4*)(bb + cj + 4 * n); bl[n] = *(const f32x4*)(bb + DE + cj + 4 * n); }
#pragma unroll
        for (int ai = 0; ai < 2; ++ai)
#pragma unroll
            for (int m = 0; m < 4; ++m) { bf16_t* rowp = O + (size_t)(row0 + ai * HALF + m * 16) * DE + cj;
                float y[8];
#pragma unroll
                for (int n = 0; n < 2; ++n) { const f32x4 g = acc[ai][0][m][n] + bg[n], l = acc[ai][1][m][n] + bl[n];
#pragma unroll
                    for (int j = 0; j < 4; ++j) { const float gg = fminf(g[j], 7.0f), ll = fminf(fmaxf(l[j], -7.0f), 7.0f); y[4 * n + j] = (ll + 1.0f) * gg * (1.f / (1.f + __expf(-1.702f * gg))); } }
                u32x4 w; w.x = cvt_pk_bf16(y[0], y[1]); w.y = cvt_pk_bf16(y[2], y[3]); w.z = cvt_pk_bf16(y[4], y[5]); w.w = cvt_pk_bf16(y[6], y[7]);
                *(u32x4*)rowp = w; }
    }
};
struct EpiResid {
    static constexpr bool PERM = false;
    const float* base0; const float* base1; float* out; const float* g;
    __device__ __forceinline__ void operator()(const f32x4 (&acc)[2][2][4][2], const Unit& u, int wr, int wc, int fr, int fq) const {
        const int col0 = u.pn * BM + wc * 32 + 4 * fq;
#pragma unroll
        for (int ai = 0; ai < 2; ++ai)
#pragma unroll
            for (int m = 0; m < 4; ++m) { const int r = u.pm * BM + ai * HALF + wr * 64 + m * 16 + fr;
                const float* bp = (r < NLAT) ? base0 + (size_t)r * D : base1 + (size_t)(r - NLAT) * D; const int bb = (r < NLAT) ? r / SEQ : NB;
                const float* gp = g + (size_t)bb * 6 * D;
#pragma unroll
                for (int bj = 0; bj < 2; ++bj)
#pragma unroll
                    for (int n = 0; n < 2; ++n) { const int c = col0 + bj * HALF + n * 16; const f32x4 bs = *(const f32x4*)(bp + c), gv = *(const f32x4*)(gp + c);
                        *(f32x4*)(out + (size_t)r * D + c) = bs + gv * acc[ai][bj][m][n]; } }
    }
};

#ifdef HOST_EMU
#define PG8_WAIT_V(n) ((void)0)
#define PG8_WAIT_L(n) ((void)0)
#else
#define PG8_WAIT_V(n) asm volatile("s_waitcnt vmcnt(" #n ")" ::: "memory")
#define PG8_WAIT_L(n) asm volatile("s_waitcnt lgkmcnt(" #n ")" ::: "memory")
#endif
template <class Epi, class Sched>
__device__ __forceinline__ void gemm_phase(LAS unsigned char* lds, const Gemm g, const Sched& S, const Epi& E, const int tid) {
    const int wid = __builtin_amdgcn_readfirstlane(tid >> 6), lane = tid & 63, wr = wid >> 2, wc = wid & 3, fr = lane & 15, fq = lane >> 4;
    const int K = g.K, nt = K / BK;
    unsigned voffA[2], voffB[2];
#pragma unroll
    for (int i = 0; i < 2; ++i) { int R, C; stage_rc(tid * 16 + i * 8192, R, C); const int Rb = Epi::PERM ? ((R & ~31) + perm32(R & 31)) : R;
        voffA[i] = (unsigned)(R * K + C) * 2u; voffB[i] = (unsigned)(Rb * K + C) * 2u; }
    const size_t kstep = (size_t)(BK * 2);
    const size_t hstep = (size_t)HALF * K * 2;
    const size_t tstep = 2 * hstep;
    const unsigned ldsw = (unsigned)wid * 1024u;
    const int aoff = lds_byte(wr * 64 + fr, fq * 8), boff = lds_byte(wc * 32 + fr, fq * 8);
#define PG8_SA(b, h) (((b) * 2 + (h)) * HTB)
#define PG8_SB(b, h) ((4 + (b) * 2 + (h)) * HTB)
#define PG8_STAGE(bufoff, gbase, voff) do { _Pragma("unroll") for (int _i = 0; _i < 2; ++_i) \
        __builtin_amdgcn_global_load_lds((const unsigned*)((const char*)(gbase) + (voff)[_i]), (LAS unsigned*)(lds + (bufoff) + ldsw + _i * 8192), 16, 0, 0); } while (0)
#define PG8_LDA(dst, b, h) do { _Pragma("unroll") for (int m = 0; m < 4; ++m) _Pragma("unroll") for (int k = 0; k < 2; ++k) dst[m][k] = *(const LAS bf16x8*)(lds + PG8_SA(b, h) + aoff + m * 2048 + k * 1024); } while (0)
#define PG8_LDB(dst, b, h) do { _Pragma("unroll") for (int n = 0; n < 2; ++n) _Pragma("unroll") for (int k = 0; k < 2; ++k) dst[n][k] = *(const LAS bf16x8*)(lds + PG8_SB(b, h) + boff + n * 2048 + k * 1024); } while (0)
#define PG8_MMA(ai, bj, At, Bt) do { __builtin_amdgcn_s_setprio(1); _Pragma("unroll") for (int m = 0; m < 4; ++m) _Pragma("unroll") for (int n = 0; n < 2; ++n) _Pragma("unroll") for (int k = 0; k < 2; ++k) \
        acc[ai][bj][m][n] = __builtin_amdgcn_mfma_f32_16x16x32_bf16(Bt[n][k], At[m][k], acc[ai][bj][m][n], 0, 0, 0); __builtin_amdgcn_s_setprio(0); } while (0)
#define PG8_BAR __builtin_amdgcn_s_barrier()
#define PG8_SCHED __builtin_amdgcn_sched_barrier(0)
    Unit cur, nxt; int ui = 0;
    if (!S.next(0, cur)) return;
    f32x4 acc[2][2][4][2];
#pragma unroll
    for (int a = 0; a < 2; ++a)
#pragma unroll
        for (int b = 0; b < 2; ++b)
#pragma unroll
            for (int m = 0; m < 4; ++m)
#pragma unroll
                for (int n = 0; n < 2; ++n) acc[a][b][m][n] = (f32x4){0.f, 0.f, 0.f, 0.f};
    bf16x8 At[4][2], B0[2][2], B1[2][2];
    const char* cA = (const char*)g.A + (size_t)cur.pm * tstep; const char* cB = (const char*)(g.Bt + (size_t)cur.e * g.bexp) + (size_t)cur.pn * tstep;
    PG8_STAGE(PG8_SB(0, 0), cB, voffB); PG8_STAGE(PG8_SB(0, 1), cB + hstep, voffB); PG8_STAGE(PG8_SA(0, 0), cA, voffA); PG8_STAGE(PG8_SA(0, 1), cA + hstep, voffA);
    if (wr == 1) PG8_BAR;
    PG8_WAIT_V(2); PG8_BAR;
    PG8_STAGE(PG8_SB(1, 0), cB + kstep, voffB); PG8_STAGE(PG8_SA(1, 0), cA + kstep, voffA); PG8_STAGE(PG8_SB(1, 1), cB + hstep + kstep, voffB);
    PG8_WAIT_V(6); PG8_BAR;
    for (;;) {
        const bool has_next = S.next(ui + 1, nxt);
        const char* nA = has_next ? (const char*)g.A + (size_t)nxt.pm * tstep : cA; const char* nB = has_next ? (const char*)(g.Bt + (size_t)nxt.e * g.bexp) + (size_t)nxt.pn * tstep : cB;
        for (int t = 0; t < nt; t += 2) {
            const bool last = (t == nt - 2);
            const char* a1 = cA + (size_t)(t + 1) * kstep;
            const char* a2 = last ? nA : cA + (size_t)(t + 2) * kstep; const char* b2 = last ? nB : cB + (size_t)(t + 2) * kstep;
            const char* a3 = a2 + kstep; const char* b3 = b2 + kstep;
            PG8_LDB(B0, 0, 0); PG8_LDB(B1, 0, 1); PG8_SCHED; PG8_LDA(At, 0, 0); PG8_STAGE(PG8_SA(1, 1), a1 + hstep, voffA);
            PG8_WAIT_V(8); PG8_WAIT_L(0); PG8_BAR; PG8_MMA(0, 0, At, B0); PG8_MMA(0, 1, At, B1); PG8_BAR; PG8_SCHED;
            PG8_LDA(At, 0, 1); PG8_STAGE(PG8_SB(0, 0), b2, voffB); PG8_STAGE(PG8_SB(0, 1), b2 + hstep, voffB); PG8_STAGE(PG8_SA(0, 0), a2, voffA);
            PG8_WAIT_V(8); PG8_WAIT_L(0); PG8_BAR; PG8_MMA(1, 0, At, B0); PG8_MMA(1, 1, At, B1); PG8_BAR; PG8_SCHED;
            PG8_LDB(B0, 1, 0); PG8_LDB(B1, 1, 1); PG8_SCHED; PG8_LDA(At, 1, 0); PG8_STAGE(PG8_SA(0, 1), a2 + hstep, voffA);
            PG8_WAIT_V(8); PG8_WAIT_L(0); PG8_BAR; PG8_MMA(0, 0, At, B0); PG8_MMA(0, 1, At, B1); PG8_BAR; PG8_SCHED;
            PG8_LDA(At, 1, 1); PG8_STAGE(PG8_SB(1, 0), b3, voffB); PG8_STAGE(PG8_SB(1, 1), b3 + hstep, voffB); PG8_STAGE(PG8_SA(1, 0), a3, voffA);
            PG8_WAIT_V(8); PG8_WAIT_L(0); PG8_BAR; PG8_MMA(1, 0, At, B0); PG8_MMA(1, 1, At, B1); PG8_BAR; PG8_SCHED;
        }
        if (wr == 0) PG8_BAR;
        {
            int t2 = threadIdx.x;
#ifndef HOST_EMU
            asm volatile("" : "+v"(t2));
#endif
            const int wid2 = __builtin_amdgcn_readfirstlane(t2 >> 6), lane2 = t2 & 63;
            E(acc, cur, wid2 >> 2, wid2 & 3, lane2 & 15, lane2 >> 4);
        }
        if (!has_next) break;
#pragma unroll
        for (int a = 0; a < 2; ++a)
#pragma unroll
            for (int b = 0; b < 2; ++b)
#pragma unroll
                for (int m = 0; m < 4; ++m)
#pragma unroll
                    for (int n = 0; n < 2; ++n) acc[a][b][m][n] = (f32x4){0.f, 0.f, 0.f, 0.f};
        cur = nxt; cA = nA; cB = nB; ++ui;
        if (wr == 1) PG8_BAR;
    }
    PG8_WAIT_V(0);
    PG8_BAR;
#undef PG8_SA
#undef PG8_SB
#undef PG8_STAGE
#undef PG8_LDA
#undef PG8_LDB
#undef PG8_MMA
#undef PG8_BAR
#undef PG8_SCHED
}
}

#define XB_TMO      128
#define XB_XCNT(j)  (256  + 64 * (j))
#define XB_XSUB(j)  (1280 + 64 * (j))
#define XB_XGEN(j)  (2304 + 64 * (j))
#define XB_TOP      3328
#define XB_TOPGEN   3392
#define XCD_BAR_WORDS 3456
#define XB_SPIN_CAP (1u << 22)
#ifdef HOST_EMU
__device__ __forceinline__ unsigned xb_ld(unsigned* p) { return *(volatile unsigned*)p; }
__device__ __forceinline__ unsigned xb_add(unsigned* p, unsigned v) { unsigned o = *p; *p = o + v; return o; }
__device__ __forceinline__ unsigned xb_xcc_id() { return blockIdx.x % 8; }
__device__ __forceinline__ unsigned atomicAdd(unsigned* p, unsigned v) { unsigned o = *p; *p = o + v; return o; }
__device__ __forceinline__ int atomicAdd(int* p, int v) { int o = *p; *p = o + v; return o; }
#else
__device__ __forceinline__ unsigned xb_ld(unsigned* p)              { return __hip_atomic_load(p, __ATOMIC_RELAXED, __HIP_MEMORY_SCOPE_AGENT); }
__device__ __forceinline__ unsigned xb_add(unsigned* p, unsigned v) { return __hip_atomic_fetch_add(p, v, __ATOMIC_RELAXED, __HIP_MEMORY_SCOPE_AGENT); }
__device__ __forceinline__ unsigned xb_xcc_id() { return (unsigned)__builtin_amdgcn_s_getreg((3 << 11) | 20) & 0xFu; }
#endif
#define XB_SPIN(cond, bar) do { unsigned _sp = 0; while (cond) { __builtin_amdgcn_s_sleep(1); \
    if ((++_sp & 255u) == 0u) { if (xb_ld(&(bar)[XB_TMO])) break; if (_sp > XB_SPIN_CAP) { atomicAdd(&(bar)[XB_TMO], 1u); break; } } } } while (0)
struct XcdBarrier { unsigned* bar; unsigned x; volatile LAS unsigned* st; };
__device__ __forceinline__ XcdBarrier xcd_barrier_post(unsigned* bar, volatile LAS unsigned* st) {
    XcdBarrier b; b.bar = bar; b.x = xb_xcc_id(); b.st = st;
    if (threadIdx.x == 0) (void)xb_add(&bar[XB_XCNT(b.x)], 1u);
    return b;
}
__device__ __forceinline__ void xcd_barrier_complete(unsigned* bar, unsigned x, unsigned& nloc, unsigned& nx) {
    const unsigned G = gridDim.x;
    unsigned sum, cnt, mine, sp = 0u;
    for (;;) {
        sum = 0u; cnt = 0u; mine = 0u;
#pragma unroll
        for (unsigned j = 0; j < 16; ++j) { const unsigned c = xb_ld(&bar[XB_XCNT(j)]); sum += c; cnt += (c > 0u) ? 1u : 0u; mine = (j == x) ? c : mine; }
        if (sum == G) break;
        __builtin_amdgcn_s_sleep(1);
        if ((++sp & 255u) == 0u) { if (xb_ld(&bar[XB_TMO])) break; if (sp > XB_SPIN_CAP) { atomicAdd(&bar[XB_TMO], 1u); break; } }
    }
    nloc = mine > 0u ? mine : 1u; nx = cnt > 0u ? cnt : 1u;
}
__device__ __forceinline__ void xcd_barrier(const XcdBarrier& b) {
    VM_WAIT();
    __syncthreads();
    if (threadIdx.x == 0) {
        unsigned* bar = b.bar;
        __builtin_amdgcn_s_waitcnt(0);
        unsigned nloc = b.st[0], nx = b.st[1];
        if (nloc == 0u) { xcd_barrier_complete(bar, b.x, nloc, nx); b.st[0] = nloc; b.st[1] = nx; }
        const unsigned old = xb_add(&bar[XB_XSUB(b.x)], 1u);
        const unsigned gen = old / nloc;
        if (old + 1u == (gen + 1u) * nloc) {
            __builtin_amdgcn_fence(__ATOMIC_RELEASE, "agent");
            VM_WAIT();
            const unsigned og = xb_add(&bar[XB_TOP], 1u);
            const unsigned tg = og / nx;
            if (og + 1u == (tg + 1u) * nx) xb_add(&bar[XB_TOPGEN], 1u);
            else XB_SPIN(xb_ld(&bar[XB_TOPGEN]) == tg, bar);
            __builtin_amdgcn_fence(__ATOMIC_ACQUIRE, "agent");
            xb_add(&bar[XB_XGEN(b.x)], 1u);
            VM_WAIT();
        } else {
            XB_SPIN(xb_ld(&bar[XB_XGEN(b.x)]) == gen, bar);
            __builtin_amdgcn_fence(__ATOMIC_ACQUIRE, "agent");
            VM_WAIT();
        }
    }
    __syncthreads();
}

struct Args {
    const float* in[34]; float* out; unsigned char* ws; int ph_lo, ph_hi;
};
enum { I_X = 0, I_C, I_CTX, I_CCTX, I_MODW, I_MODB, I_N1, I_N2, I_WIN, I_WOUT, I_HGLB, I_HGNG, I_MLGB, I_MLNG, I_HYCW, I_HYCB, I_HYW1, I_HYB1, I_HYW2, I_HYB2, I_HYFR, I_HYW3,
       I_HYBI, I_GDCW, I_GDAL, I_GDDT, I_GDNG, I_RW, I_RB, I_EW1, I_EB1, I_EW2, I_EB2, I_FG };
struct Ctx {
#ifdef HOST_EMU
    LAS unsigned char* lds; const Args* a; unsigned char* ws;
#else
    LAS unsigned char* lds; const __attribute__((address_space(4))) Args* a; unsigned char* ws;
#endif
    int tid, lane, wave, vcu, G, bid;
};
#define WSP(T, off) ((T*)(C.ws + (off)))
#define INP(i) (C.a->in[i])

__device__ __forceinline__ const float* xrow_l0(const Ctx& C, int r) { return r < NLAT ? INP(I_X) + (size_t)r * D : INP(I_CTX) + (size_t)(r - NLAT) * D; }
__device__ __forceinline__ int row_batch(int r) { return r < NLAT ? r / SEQ : NB; }

__device__ __forceinline__ void transpose_item(const float* W, int ldw, int K, bf16_t* WT, int k0, int nsrc0, int ndst0, LAS float* scr, int lane) {
#pragma unroll 8
    for (int i = 0; i < 32; ++i) { const int kk = 2 * i + (lane >> 5); scr[kk * 33 + (lane & 31)] = W[(size_t)(k0 + kk) * ldw + nsrc0 + (lane & 31)]; }
    LDS_WAIT(); asm volatile("" ::: "memory");
    const int c = lane & 7;
#pragma unroll
    for (int j = 0; j < 4; ++j) { const int n = (lane >> 3) + 8 * j; const LAS float* s = scr + (8 * c) * 33 + n;
        u32x4 o; o.x = pk2(s[0 * 33], s[1 * 33]); o.y = pk2(s[2 * 33], s[3 * 33]); o.z = pk2(s[4 * 33], s[5 * 33]); o.w = pk2(s[6 * 33], s[7 * 33]);
        *(u32x4*)(WT + (size_t)(ndst0 + n) * K + k0 + 8 * c) = o; }
    LDS_WAIT(); asm volatile("" ::: "memory");
}
__device__ __forceinline__ void p0_prologue(Ctx& C) {
    LAS float* scr = (LAS float*)(C.lds + C.wave * 16384);
    const int gw = C.vcu * 8 + C.wave, NGW = C.G * 8, lane = C.lane;
    constexpr int I_IN = 16 * (ZW / 32), I_OUT = 16 * (D / 32), I_1 = 16 * (2 * DE / 32), I_2 = (DE / 64) * (D / 32);
    constexpr int PER_L = I_IN + I_OUT + NE * (I_1 + I_2);
    for (int it = gw; it < DEPTH * PER_L; it += NGW) {
        const int l = it / PER_L; int r = it % PER_L;
        if (r < I_IN) { const int kb = r / (ZW / 32), nb = r % (ZW / 32), nd = 32 * nb, ns = nd < 2304 ? nd : nd + 16;
            transpose_item(INP(I_WIN) + (size_t)l * D * IN_W, IN_W, D, WSP(bf16_t, WS_WIN) + (size_t)l * ZW * D, 64 * kb, ns, nd, scr, lane); continue; }
        r -= I_IN;
        if (r < I_OUT) { const int kb = r / (D / 32), nb = r % (D / 32);
            transpose_item(INP(I_WOUT) + (size_t)l * D * D, D, D, WSP(bf16_t, WS_WOUT) + (size_t)l * D * D, 64 * kb, 32 * nb, 32 * nb, scr, lane); continue; }
        r -= I_OUT;
        const int e = r / (I_1 + I_2); r %= (I_1 + I_2);
        if (r < I_1) { const int kb = r / (2 * DE / 32), nb = r % (2 * DE / 32), nd = 32 * nb;
            const int ntile = nd / 256, hh = (nd % 256) / 128, j = nd % 128, ns = DE * hh + 128 * ntile + j;
            transpose_item(INP(I_EW1) + ((size_t)l * NE + e) * D * 2 * DE, 2 * DE, D, WSP(bf16_t, WS_W1) + ((size_t)l * NE + e) * 2 * DE * D, 64 * kb, ns, nd, scr, lane); continue; }
        r -= I_1;
        { const int kb = r / (D / 32), nb = r % (D / 32);
            transpose_item(INP(I_EW2) + ((size_t)l * NE + e) * DE * D, D, DE, WSP(bf16_t, WS_W2) + ((size_t)l * NE + e) * D * DE, 64 * kb, 32 * nb, 32 * nb, scr, lane); }
    }
    for (int it = gw; it < DEPTH * (NB + 1) * (6 * D / 64); it += NGW) {
        const int l = it / ((NB + 1) * (6 * D / 64)), b = (it / (6 * D / 64)) % (NB + 1), n = (it % (6 * D / 64)) * 64 + lane;
        const float* w = INP(I_MODW) + (size_t)l * D * 6 * D + n; const float* cv = b < NB ? INP(I_C) + b * D : INP(I_CCTX);
        float acc = 0.f;
#pragma unroll 16
        for (int k = 0; k < D; ++k) acc += siluf_(cv[k]) * w[(size_t)k * 6 * D];
        WSP(float, WS_MOD)[((size_t)l * (NB + 1) + b) * 6 * D + n] = acc + INP(I_MODB)[l * 6 * D + n];
    }
    const int gt = gw * 64 + lane, NGT = NGW * 64;
    for (int i = gt; i < 256; i += NGT) { const float a0 = INP(I_HGLB)[i], a1 = INP(I_HGLB)[256 + i], mx = fmaxf(a0, a1), e0 = __expf(a0 - mx), e1 = __expf(a1 - mx);
        WSP(float, WS_LB)[i] = 0.f; WSP(float, WS_LB)[256 + i] = e1 / (e0 + e1); }
    for (int i = gt; i < DEPTH * 32 * D; i += NGT) { const int l = i / (32 * D), j = (i / D) % 32, k = i % D; const int col = j < 16 ? 2304 + j : 4112 + (j - 16);
        WSP(float, WS_WG)[i] = INP(I_WIN)[((size_t)l * D + k) * IN_W + col]; }
    for (int i = gt; i < DEPTH * NE * D; i += NGT) { const int l = i / (NE * D), e = (i / D) % NE, k = i % D;
        WSP(float, WS_WR)[i] = INP(I_RW)[((size_t)l * D + k) * NE + e]; }
    for (int i = gw; i < DEPTH * (SEQ + LC); i += NGW) {
        const int l = i / (SEQ + LC), p = i % (SEQ + LC); const bool isc = p >= SEQ; const int pos = isc ? p - SEQ : p, len = isc ? LC : SEQ;
        const float *w1 = INP(I_HYW1) + l * 17 * 64, *b1 = INP(I_HYB1) + l * 64, *w2 = INP(I_HYW2) + l * 64 * 64, *b2 = INP(I_HYB2) + l * 64, *fr = INP(I_HYFR) + l * 128;
        float s = b1[lane] + ((float)pos / (float)(len - 1)) * w1[lane];
#pragma unroll
        for (int j = 0; j < 8; ++j) { const float band = 1e-4f + (7.0f - 1e-4f) * (float)j / 7.0f; const float ang = 6.283185307179586f * (float)pos * band / (float)len;
            s += cosf(ang) * w1[(1 + j) * 64 + lane] - sinf(ang) * w1[(9 + j) * 64 + lane]; }
        scr[lane] = sinf(fr[lane] * s);
        LDS_WAIT(); asm volatile("" ::: "memory");
        float s2 = b2[lane];
#pragma unroll 8
        for (int q = 0; q < 64; ++q) s2 += scr[q] * w2[q * 64 + lane];
        WSP(float, WS_HDN)[((size_t)l * (SEQ + LC) + p) * 64 + lane] = sinf(fr[64 + lane] * s2);
        LDS_WAIT(); asm volatile("" ::: "memory");
    }
}

__device__ __forceinline__ void rms_mod_row(const f32x4 (&xv)[4], const float* gain, const float* sh, const float* sc, bf16_t* orow, int lane, f32x4 (&hv)[4]) {
    float s = 0.f;
#pragma unroll
    for (int j = 0; j < 4; ++j) s += (xv[j].x * xv[j].x + xv[j].y * xv[j].y) + (xv[j].z * xv[j].z + xv[j].w * xv[j].w);
    const float rstd = 1.f / sqrtf(wave_sum(s) * (1.f / D) + EPS);
#pragma unroll
    for (int j = 0; j < 4; ++j) { const int c = 4 * lane + 256 * j; const f32x4 g = *(const f32x4*)(gain + c), a = *(const f32x4*)(sc + c), b = *(const f32x4*)(sh + c);
        hv[j] = xv[j] * rstd * g * (a + 1.0f) + b;
        u32x2 w; w.x = pk2(hv[j].x, hv[j].y); w.y = pk2(hv[j].z, hv[j].w); *(u32x2*)(orow + c) = w; }
}
__device__ __forceinline__ void load_w32(Ctx& C, const float* W, int n) {
    __syncthreads();
    for (int o = C.tid; o < n * 256; o += 512) *(LAS f32x4*)(C.lds + (size_t)o * 16) = *(const f32x4*)(W + (size_t)o * 4);
    __syncthreads();
}
__device__ __forceinline__ float row2_dots(LAS unsigned char* lds, const f32x4 (&hv)[2][4], int lane, int n) {
    float v[64];
#pragma unroll
    for (int jj = 0; jj < 32; ++jj) { float s0 = 0.f, s1 = 0.f;
        if (jj < n) {
#pragma unroll
            for (int j = 0; j < 4; ++j) { const f32x4 w = *(const LAS f32x4*)(lds + (size_t)jj * 4096 + (size_t)(4 * lane + 256 * j) * 4);
                s0 += (hv[0][j].x * w.x + hv[0][j].y * w.y) + (hv[0][j].z * w.z + hv[0][j].w * w.w); s1 += (hv[1][j].x * w.x + hv[1][j].y * w.y) + (hv[1][j].z * w.z + hv[1][j].w * w.w); } }
        v[jj] = s0; v[32 + jj] = s1; }
#pragma unroll
    for (int st = 0; st < 6; ++st) { const int m = 32 >> st, nh = 32 >> st; const bool up = (lane & m) != 0;
#pragma unroll
        for (int i = 0; i < nh; ++i) { const float a = v[i], bb = v[i + nh]; const float send = up ? a : bb, keep = up ? bb : a; v[i] = keep + __shfl_xor(send, m); } }
    return v[0];
}
__device__ __forceinline__ void phase_rows_a(Ctx& C, int l) {
    const int gw = C.vcu * 8 + C.wave, NGW = C.G * 8, lane = C.lane;
    const int nrows = (l == DEPTH) ? NLAT : NT;
    float* xcur = WSP(float, WS_X);
    if (l < DEPTH) load_w32(C, WSP(float, WS_WG) + (size_t)l * 32 * D, 32);
    for (int r0 = 2 * gw; r0 < nrows; r0 += 2 * NGW) {
        f32x4 xv[2][4];
#pragma unroll
        for (int q = 0; q < 2; ++q) { const int r = r0 + q; const int bb = row_batch(r);
            if (l == 0) { const float* xr = xrow_l0(C, r);
#pragma unroll
                for (int j = 0; j < 4; ++j) xv[q][j] = *(const f32x4*)(xr + 4 * lane + 256 * j); }
            else {
                const int lp = l - 1; const int ntok = (lp == DEPTH - 1) ? NLAT : NT;
                const float* xr = xcur + (size_t)r * D;
#pragma unroll
                for (int j = 0; j < 4; ++j) xv[q][j] = *(const f32x4*)(xr + 4 * lane + 256 * j);
                if (r < ntok) {
                    const float* g2 = WSP(float, WS_MOD) + ((size_t)lp * (NB + 1) + bb) * 6 * D + 5 * D;
                    const int* te = WSP(int, WS_TOP) + (size_t)r * 4; const int* tp = WSP(int, WS_TOP) + (size_t)NT * 4 + (size_t)r * 4; const float* tg = WSP(float, WS_TOP) + (size_t)NT * 8 + (size_t)r * 4;
                    const LAS int* tbase = (const LAS int*)(C.lds + LDSX_OFF + LX_TILE) + MAXTILES;
                    f32x4 ys[4];
#pragma unroll
                    for (int j = 0; j < 4; ++j) ys[j] = (f32x4){0.f, 0.f, 0.f, 0.f};
#pragma unroll
                    for (int k = 0; k < TOPK; ++k) { const int e = te[k]; const size_t yr = (size_t)tbase[e] * 256 + tp[k]; const float gk = tg[k]; const bf16_t* yp = WSP(bf16_t, WS_Y) + yr * D;
#pragma unroll
                        for (int j = 0; j < 4; ++j) { const u32x2 w = *(const u32x2*)(yp + 4 * lane + 256 * j);
                            ys[j].x += gk * u2f(w.x << 16); ys[j].y += gk * u2f(w.x & 0xffff0000u); ys[j].z += gk * u2f(w.y << 16); ys[j].w += gk * u2f(w.y & 0xffff0000u); } }
#pragma unroll
                    for (int j = 0; j < 4; ++j) { const f32x4 g = *(const f32x4*)(g2 + 4 * lane + 256 * j); xv[q][j] = xv[q][j] + g * ys[j]; }
                    if (l < DEPTH) {
#pragma unroll
                        for (int j = 0; j < 4; ++j) *(f32x4*)(xcur + (size_t)r * D + 4 * lane + 256 * j) = xv[q][j]; }
                }
            }
        }
        if (l == DEPTH) {
#pragma unroll
            for (int q = 0; q < 2; ++q) { float s = 0.f;
#pragma unroll
                for (int j = 0; j < 4; ++j) s += (xv[q][j].x * xv[q][j].x + xv[q][j].y * xv[q][j].y) + (xv[q][j].z * xv[q][j].z + xv[q][j].w * xv[q][j].w);
                const float rstd = 1.f / sqrtf(wave_sum(s) * (1.f / D) + EPS);
#pragma unroll
                for (int j = 0; j < 4; ++j) { const f32x4 g = *(const f32x4*)(INP(I_FG) + 4 * lane + 256 * j); *(f32x4*)(C.a->out + (size_t)(r0 + q) * D + 4 * lane + 256 * j) = xv[q][j] * rstd * g; } }
            continue;
        }
        f32x4 hv[2][4];
#pragma unroll
        for (int q = 0; q < 2; ++q) { const int r = r0 + q; const float* mod = WSP(float, WS_MOD) + ((size_t)l * (NB + 1) + row_batch(r)) * 6 * D;
            rms_mod_row(xv[q], INP(I_N1) + l * D, mod, mod + D, WSP(bf16_t, WS_H) + (size_t)r * D, lane, hv[q]); }
        const float mine = row2_dots(C.lds, hv, lane, 32);
        WSP(float, WS_ZG)[(size_t)(r0 + (lane >> 5)) * 32 + (lane & 31)] = mine;
    }
}
__device__ __forceinline__ int build_tiles(Ctx& C, int l) {
    LAS int* tile_e = (LAS int*)(C.lds + LDSX_OFF + LX_TILE); LAS int* tbase = tile_e + MAXTILES;
    const unsigned* cnt = WSP(unsigned, WS_CTL) + CW_CNT + l * NE;
    __syncthreads();
    if (C.tid == 0) { int t = 0;
        for (int e = 0; e < NE; ++e) { const int c = (int)cnt[e], n = (c + 255) / 256; tbase[e] = t; for (int i = 0; i < n; ++i) tile_e[t + i] = e; t += n; }
        tbase[NE] = t; }
    __syncthreads();
    return tbase[NE];
}
__device__ __forceinline__ void phase_rows_b(Ctx& C, int l) {
    const int gw = C.vcu * 8 + C.wave, NGW = C.G * 8, lane = C.lane;
    const int ntok = (l == DEPTH - 1) ? NLAT : NT;
    const float* xcur = WSP(float, WS_X);
    unsigned* cnt = WSP(unsigned, WS_CTL) + CW_CNT + l * NE;
    static_assert(NE <= 32, "router width");
    load_w32(C, WSP(float, WS_WR) + (size_t)l * NE * D, NE);
    for (int r0 = 2 * gw; r0 < ntok; r0 += 2 * NGW) {
        f32x4 hv[2][4];
#pragma unroll
        for (int q = 0; q < 2; ++q) { const int r = r0 + q; f32x4 xv[4];
#pragma unroll
            for (int j = 0; j < 4; ++j) xv[j] = *(const f32x4*)(xcur + (size_t)r * D + 4 * lane + 256 * j);
            const float* mod = WSP(float, WS_MOD) + ((size_t)l * (NB + 1) + row_batch(r)) * 6 * D;
            rms_mod_row(xv, INP(I_N2) + l * D, mod + 3 * D, mod + 4 * D, WSP(bf16_t, WS_H) + (size_t)r * D, lane, hv[q]); }
        const float lgm = row2_dots(C.lds, hv, lane, NE);
        const int jl = lane & 31, r = r0 + (lane >> 5);
        float v = (jl < NE) ? lgm + INP(I_RB)[l * NE + (jl < NE ? jl : 0)] : -3.0e38f;
        float tv[4]; int ti[4];
#pragma unroll
        for (int k = 0; k < 4; ++k) { float bv = v; int bi = jl;
#pragma unroll
            for (int o = 1; o < 32; o <<= 1) { const float ov = __shfl_xor(bv, o); const int oi = __shfl_xor(bi, o); const bool take = (ov > bv) || (ov == bv && oi < bi); bv = take ? ov : bv; bi = take ? oi : bi; }
            tv[k] = bv; ti[k] = bi; v = (jl == bi) ? -3.4e38f : v; }
        const float e1 = __expf(tv[1] - tv[0]), e2 = __expf(tv[2] - tv[0]), e3 = __expf(tv[3] - tv[0]), inv = 1.f / (1.f + e1 + e2 + e3);
        const float gk[4] = {inv, e1 * inv, e2 * inv, e3 * inv};
        if (jl < 4) {
            int e = ti[0]; float g = gk[0];
#pragma unroll
            for (int k = 1; k < 4; ++k) { e = (jl == k) ? ti[k] : e; g = (jl == k) ? gk[k] : g; }
            const int pos = (int)atomicAdd(cnt + e, 1u);
            WSP(int, WS_TOP)[(size_t)r * 4 + jl] = e; WSP(int, WS_TOP)[(size_t)NT * 4 + (size_t)r * 4 + jl] = pos; WSP(float, WS_TOP)[(size_t)NT * 8 + (size_t)r * 4 + jl] = g;
        }
    }
}
__device__ __forceinline__ void phase_gather(Ctx& C, int l) {
    const int gw = C.vcu * 8 + C.wave, NGW = C.G * 8, lane = C.lane;
    const int ntok = (l == DEPTH - 1) ? NLAT : NT;
    (void)build_tiles(C, l);
    const LAS int* tbase = (const LAS int*)(C.lds + LDSX_OFF + LX_TILE) + MAXTILES;
    const unsigned* cnt = WSP(unsigned, WS_CTL) + CW_CNT + l * NE;
    for (int it = gw; it < ntok * 4; it += NGW) { const int r = it >> 2, k = it & 3;
        const int e = WSP(int, WS_TOP)[(size_t)r * 4 + k], pos = WSP(int, WS_TOP)[(size_t)NT * 4 + (size_t)r * 4 + k];
        const u32x4* s = (const u32x4*)(WSP(bf16_t, WS_H) + (size_t)r * D); u32x4* d = (u32x4*)(WSP(bf16_t, WS_HS) + ((size_t)tbase[e] * 256 + pos) * D);
        d[lane] = s[lane]; d[lane + 64] = s[lane + 64]; }
    for (int it = gw; it < NE * 256; it += NGW) { const int e = it >> 8, p = it & 255; const int c = (int)cnt[e], pad0 = c, pad1 = ((c + 255) / 256) * 256;
        if (pad0 + p < pad1) { u32x4* d = (u32x4*)(WSP(bf16_t, WS_HS) + ((size_t)tbase[e] * 256 + pad0 + p) * D); d[lane] = (u32x4){0u, 0u, 0u, 0u}; d[lane + 64] = (u32x4){0u, 0u, 0u, 0u}; } }
}

template <int MIX> __device__ __forceinline__ int scan_row(int b, int dir, int s) {
    if (s < LC) { const int t = dir ? LC - 1 - s : s; return NLAT + b * LC + t; }
    const int i0 = s - LC, i = dir ? SEQ - 1 - i0 : i0;
    const int t = (MIX == 1) ? (i % GROWS) * GW + (i / GROWS) : i;
    return b * SEQ + t;
}
typedef float f32x16 __attribute__((ext_vector_type(16)));
template <int NT_, int KS>
__device__ __forceinline__ void mm_nt(const LAS bf16_t* A, int lda, const LAS bf16_t* B, int ldb, f32x16 (&acc)[NT_], int lane) {
    const int r = lane & 31, kh = (lane >> 5) * 8;
#pragma unroll
    for (int kk = 0; kk < KS; ++kk) {
        const bf16x8 a = *(const LAS bf16x8*)(A + r * lda + 16 * kk + kh);
#pragma unroll
        for (int n = 0; n < NT_; ++n) { const bf16x8 b = *(const LAS bf16x8*)(B + (32 * n + r) * ldb + 16 * kk + kh); acc[n] = __builtin_amdgcn_mfma_f32_32x32x16_bf16(a, b, acc[n], 0, 0, 0); }
    }
}
#ifdef HOST_EMU
#define ITEM_IDS() const int tid = C.tid, lane = C.lane, w = C.wave
#else
#define ITEM_IDS() int tid_ = C.tid; asm volatile("" : "+v"(tid_)); const int tid = tid_, lane = tid_ & 63, w = __builtin_amdgcn_readfirstlane(tid_ >> 6)
#endif
#define CROW(ri, lane) (((ri) & 3) + 8 * ((ri) >> 2) + 4 * ((lane) >> 5))
constexpr int LS = 72, LF = 65;
constexpr int GA_Q = 0, GA_K = 9216, GA_BVT = 18432, GA_BKGT = 27648, GA_KDT = 36864, GA_QKM = 46080, GA_TB = 55296, GA_UT = 64512, GA_WT = 73728, GA_AM = 82944, GA_AMB = 99584, GA_TT = 108800, GA_DG = 118016, GA_XT = 122368, GA_G = 124928;
__device__ __forceinline__ void gdn_a_item(Ctx& C, int l, int b, int h, int dir, int c) {
    LAS unsigned char* lds = C.lds; ITEM_IDS();
    LAS bf16_t* Qb = (LAS bf16_t*)(lds + GA_Q); LAS bf16_t* Kb = (LAS bf16_t*)(lds + GA_K); LAS bf16_t* BVT = (LAS bf16_t*)(lds + GA_BVT); LAS bf16_t* BKGT = (LAS bf16_t*)(lds + GA_BKGT);
    LAS bf16_t* KDT = (LAS bf16_t*)(lds + GA_KDT); LAS bf16_t* QKM = (LAS bf16_t*)(lds + GA_QKM); LAS bf16_t* TB = (LAS bf16_t*)(lds + GA_TB); LAS bf16_t* UT = (LAS bf16_t*)(lds + GA_UT); LAS bf16_t* WT = (LAS bf16_t*)(lds + GA_WT);
    LAS float* AM = (LAS float*)(lds + GA_AM); LAS bf16_t* AMb = (LAS bf16_t*)(lds + GA_AMB); LAS bf16_t* TT = (LAS bf16_t*)(lds + GA_TT); LAS float* Dg = (LAS float*)(lds + GA_DG); LAS bf16_t* XT = (LAS bf16_t*)(lds + GA_XT); LAS float* G = (LAS float*)(lds + GA_G);
    const bf16_t* zb = WSP(bf16_t, WS_Z); const float* zg = WSP(float, WS_ZG);
    unsigned char* blob = C.ws + WS_GD + ((size_t)((b * NH + h) * 2 + dir) * NCH + c) * GD_BLOB;
    const int i = tid >> 3, d0 = (tid & 7) * 8; const int row = scan_row<2>(b, dir, 64 * c + i);
    float qv[8], kv[8], vv[8];
    { const bf16_t* zr = zb + (size_t)row * ZW; const bool isc = row >= NLAT; const int t = isc ? (row - NLAT) % LC : row % SEQ, len = isc ? LC : SEQ;
        const bool hp = t > 0, hn = t < len - 1; const float* cw = INP(I_GDCW) + l * 3 * 768;
        float sq = 0.f, sk = 0.f;
#pragma unroll
        for (int a = 0; a < 3; ++a) { const int cc = a * 256 + h * 64 + d0; const bf16_t* zp = zr + GDB + cc;
            const u32x4 z1 = *(const u32x4*)zp, z0 = *(const u32x4*)(zp - (hp ? ZW : 0)), z2 = *(const u32x4*)(zp + (hn ? ZW : 0));
            const unsigned u0[4] = {z0.x, z0.y, z0.z, z0.w}, u1[4] = {z1.x, z1.y, z1.z, z1.w}, u2[4] = {z2.x, z2.y, z2.z, z2.w};
#pragma unroll
            for (int j = 0; j < 8; ++j) { const int jj = j >> 1; const bool hi = j & 1;
                const float x0 = hi ? u2f(u0[jj] & 0xffff0000u) : u2f(u0[jj] << 16), x1 = hi ? u2f(u1[jj] & 0xffff0000u) : u2f(u1[jj] << 16), x2 = hi ? u2f(u2[jj] & 0xffff0000u) : u2f(u2[jj] << 16);
                float sacc = (hp ? cw[cc + j] : 0.f) * x0 + cw[768 + cc + j] * x1 + (hn ? cw[1536 + cc + j] : 0.f) * x2;
                sacc = siluf_(sacc);
                if (a == 0) { qv[j] = sacc; sq += sacc * sacc; } else if (a == 1) { kv[j] = sacc; sk += sacc * sacc; } else vv[j] = sacc; } }
#pragma unroll
        for (int o = 1; o < 8; o <<= 1) { sq += __shfl_xor(sq, o); sk += __shfl_xor(sk, o); }
        const float rq = 0.125f / sqrtf(sq + EPS), rk = 1.f / sqrtf(sk + EPS);
#pragma unroll
        for (int j = 0; j < 8; ++j) { qv[j] *= rq; kv[j] *= rk; }
        if ((tid & 7) == 0) { const float* g = zg + (size_t)row * 32 + 16;
            G[128 + i] = -__expf(INP(I_GDAL)[l * 8 + dir * 4 + h]) * softplusf_(g[(2 * dir) * 4 + h] + INP(I_GDDT)[l * 8 + dir * 4 + h]); G[64 + i] = sigmoidf_(g[(2 * dir + 1) * 4 + h]); }
        u32x4 wq, wk; wq.x = pk2(qv[0], qv[1]); wq.y = pk2(qv[2], qv[3]); wq.z = pk2(qv[4], qv[5]); wq.w = pk2(qv[6], qv[7]); wk.x = pk2(kv[0], kv[1]); wk.y = pk2(kv[2], kv[3]); wk.z = pk2(kv[4], kv[5]); wk.w = pk2(kv[6], kv[7]);
        *(LAS u32x4*)(Qb + i * LS + d0) = wq; *(LAS u32x4*)(Kb + i * LS + d0) = wk;
        for (int o = tid; o < 64 * LS / 2; o += 512) ((LAS unsigned*)TT)[o] = 0u;
    }
    __syncthreads();
    if (w == 0) { float gsum = G[128 + lane];
#pragma unroll
        for (int o = 1; o < 64; o <<= 1) { const float t = __shfl(gsum, lane - o); if (lane >= o) gsum += t; }
        G[lane] = gsum; }
    __syncthreads();
    { const float gi = G[i], be = G[64 + i], gl = G[63]; const float eg = __expf(gi), ed = __expf(gl - gi);
#pragma unroll
        for (int j = 0; j < 8; ++j) { BVT[(d0 + j) * LS + i] = (bf16_t)f2bf(be * vv[j]); BKGT[(d0 + j) * LS + i] = (bf16_t)f2bf(be * kv[j] * eg); KDT[(d0 + j) * LS + i] = (bf16_t)f2bf(kv[j] * ed); } }
    for (int rep_ = 0; rep_ < 1 + ((REPMASK >> 18) & 1); ++rep_)
    if (w < 4) { f32x16 acc[2]; acc[0] = (f32x16)(0.f); acc[1] = (f32x16)(0.f);
        const int rh = (w & 1) * 32; mm_nt<2, 4>((w >> 1) ? Qb + rh * LS : Kb + rh * LS, LS, Kb, LS, acc, lane);
        float gi[16], bi[16], gj[2];
#pragma unroll
        for (int ri = 0; ri < 16; ++ri) { gi[ri] = G[rh + CROW(ri, lane)]; bi[ri] = G[64 + rh + CROW(ri, lane)]; }
        gj[0] = G[lane & 31]; gj[1] = G[32 + (lane & 31)];
        if (w >> 1) {
#pragma unroll
            for (int n = 0; n < 2; ++n)
#pragma unroll
                for (int ri = 0; ri < 16; ++ri) { const int ii = rh + CROW(ri, lane), jj = 32 * n + (lane & 31); QKM[ii * LS + jj] = (bf16_t)f2bf(jj <= ii ? acc[n][ri] * __expf(gi[ri] - gj[n]) : 0.f); }
        } else {
#pragma unroll
            for (int n = 0; n < 2; ++n)
#pragma unroll
                for (int ri = 0; ri < 16; ++ri) { const int ii = rh + CROW(ri, lane), jj = 32 * n + (lane & 31); const float av = (jj < ii) ? bi[ri] * acc[n][ri] * __expf(gi[ri] - gj[n]) : 0.f; AM[ii * LF + jj] = av; AMb[ii * LS + jj] = (bf16_t)f2bf(av); }
        } }
    __syncthreads();
    for (int rep_ = 0; rep_ < 1 + ((REPMASK >> 19) & 1); ++rep_) {
    if (w == 0) { const int bb = lane >> 4, cc = lane & 15; float t[16];
#pragma unroll
        for (int r = 0; r < 16; ++r) { float x = (r == cc) ? 1.f : 0.f;
#pragma unroll
            for (int r2 = 0; r2 < r; ++r2) x -= AM[(16 * bb + r) * LF + 16 * bb + r2] * t[r2];
            t[r] = x; Dg[(bb * 16 + r) * 17 + cc] = x; asm volatile("" ::: "memory"); } }
    __syncthreads();
    if (w < 4) { const int cl = lane & 15, q4 = lane >> 4; LAS bf16_t* XTw = XT + w * 256;
#pragma unroll
        for (int bb = 0; bb < 4; ++bb) {
            f32x4 acc = (f32x4){0.f, 0.f, 0.f, 0.f};
#pragma unroll
            for (int kk = 0; kk < 2; ++kk) { const bf16x8 a = *(const LAS bf16x8*)(AMb + (16 * bb + cl) * LS + 32 * kk + 8 * q4), tb = *(const LAS bf16x8*)(TT + (16 * w + cl) * LS + 32 * kk + 8 * q4);
                acc = __builtin_amdgcn_mfma_f32_16x16x32_bf16(a, tb, acc, 0, 0, 0); }
            float x[4];
#pragma unroll
            for (int r = 0; r < 4; ++r) x[r] = ((16 * bb + 4 * q4 + r) == (16 * w + cl) ? 1.f : 0.f) - acc[r];
            *(LAS u32x2*)(XTw + cl * 16 + 4 * q4) = (u32x2){pk2(x[0], x[1]), pk2(x[2], x[3])};
            LDS_WAIT(); asm volatile("" ::: "memory");
            bf16x8 da = (bf16x8)(0), xb = (bf16x8)(0);
            if (q4 < 2) { const LAS float* dp = Dg + (bb * 16 + cl) * 17 + 8 * q4; u32x4 dv; dv.x = pk2(dp[0], dp[1]); dv.y = pk2(dp[2], dp[3]); dv.z = pk2(dp[4], dp[5]); dv.w = pk2(dp[6], dp[7]);
                __builtin_memcpy(&da, &dv, 16); xb = *(const LAS bf16x8*)(XTw + cl * 16 + 8 * q4); }
            const f32x4 z4 = (f32x4){0.f, 0.f, 0.f, 0.f}; const f32x4 tt = __builtin_amdgcn_mfma_f32_16x16x32_bf16(da, xb, z4, 0, 0, 0);
            *(LAS u32x2*)(TT + (16 * w + cl) * LS + 16 * bb + 4 * q4) = (u32x2){pk2(tt[0], tt[1]), pk2(tt[2], tt[3])};
#pragma unroll
            for (int r = 0; r < 4; ++r) TB[(16 * bb + 4 * q4 + r) * LS + 16 * w + cl] = (bf16_t)f2bf(tt[r]);
            LDS_WAIT(); asm volatile("" ::: "memory");
        } }
    }
    __syncthreads();
    for (int rep_ = 0; rep_ < 1 + ((REPMASK >> 20) & 1); ++rep_)
    if (w < 4) { f32x16 acc[2]; acc[0] = (f32x16)(0.f); acc[1] = (f32x16)(0.f);
        const int rh = (w & 1) * 32; mm_nt<2, 4>(((w >> 1) ? BKGT : BVT) + rh * LS, LS, TB, LS, acc, lane);
        LAS bf16_t* dst = (w >> 1) ? WT : UT;
#pragma unroll
        for (int n = 0; n < 2; ++n)
#pragma unroll
            for (int ri = 0; ri < 16; ++ri) dst[(rh + CROW(ri, lane)) * LS + 32 * n + (lane & 31)] = (bf16_t)f2bf(acc[n][ri]); }
    __syncthreads();
    for (int rep_ = 0; rep_ < 1 + ((REPMASK >> 21) & 1); ++rep_)
    { f32x16 acc[2]; acc[0] = (f32x16)(0.f); acc[1] = (f32x16)(0.f);
        const int pr = w >> 1, rh = (w & 1) * 32;
        const LAS bf16_t* Ap = (pr == 0 || pr == 1) ? QKM : (pr == 2 ? KDT : UT); const LAS bf16_t* Bp = (pr == 0 || pr == 2) ? WT : (pr == 1 ? UT : KDT);
        mm_nt<2, 4>(Ap + rh * LS, LS, Bp, LS, acc, lane);
        const float egl = __expf(G[63]);
        LAS bf16_t* OUT = (LAS bf16_t*)(lds + GA_AM) + ((pr == 2) ? 0 : (pr == 0) ? 4096 : (pr == 3) ? 8192 : 12288);
        float qe[2][16];
        if (pr == 0) {
#pragma unroll
            for (int ri = 0; ri < 16; ++ri) { const int rr = rh + CROW(ri, lane); const float eg = __expf(G[rr]); qe[0][ri] = bf2f(Qb[rr * LS + (lane & 31)]) * eg; qe[1][ri] = bf2f(Qb[rr * LS + 32 + (lane & 31)]) * eg; } }
#pragma unroll
        for (int n = 0; n < 2; ++n)
#pragma unroll
            for (int ri = 0; ri < 16; ++ri) { const int rr = rh + CROW(ri, lane), cc = 32 * n + (lane & 31); const float a = acc[n][ri];
                const float v = (pr == 0) ? qe[n][ri] - a : (pr == 2) ? ((rr == cc ? egl : 0.f) - a) : a;
                OUT[rr * 64 + cc] = (bf16_t)f2bf(v); } }
    __syncthreads();
#pragma unroll
    for (int k = 0; k < 4; ++k) { const int o = tid + 512 * k; *(u32x4*)(blob + (size_t)o * 16) = *(const LAS u32x4*)(lds + GA_AM + o * 16); }
    __syncthreads();
}
__device__ __forceinline__ void gdn_b_scan(Ctx& C, int sidx) {
    LAS unsigned char* lds = C.lds; const int tid = C.tid, lane = C.lane, w = C.wave;
    LAS bf16_t* STb = (LAS bf16_t*)lds;
    LAS bf16_t* Pb = (LAS bf16_t*)(lds + 18432);
    for (int o = tid; o < 2 * 64 * LS; o += 512) STb[o] = 0;
    __syncthreads();
    int cur = 0;
    const int pr = tid >> 3, pc8 = (tid & 7) * 8, eh = (w & 1) * 32, dh = (w >> 1) * 32;
    u32x4 pv = *(const u32x4*)((const bf16_t*)(C.ws + WS_GD + ((size_t)sidx * NCH) * GD_BLOB) + pr * 64 + pc8);
    f32x16 qv = (f32x16)(0.f);
    if (w < 4) { const bf16_t* qt = (const bf16_t*)(C.ws + WS_GD + ((size_t)sidx * NCH) * GD_BLOB + 16384);
#pragma unroll
        for (int ri = 0; ri < 16; ++ri) qv[ri] = bf2f(qt[(eh + CROW(ri, lane)) * 64 + dh + (lane & 31)]); }
    for (int c = 0; c < NCH; ++c) {
        bf16_t* gst = WSP(bf16_t, WS_GST) + ((size_t)sidx * NCH + c) * 4096;
        *(LAS u32x4*)(Pb + pr * LS + pc8) = pv;
        *(u32x4*)(gst + pr * 64 + pc8) = *(const LAS u32x4*)(STb + cur * 64 * LS + pr * LS + pc8);
        const int cn = (c + 1 < NCH) ? c + 1 : c; const unsigned char* nblob = C.ws + WS_GD + ((size_t)sidx * NCH + cn) * GD_BLOB;
        pv = *(const u32x4*)((const bf16_t*)nblob + pr * 64 + pc8);
        f32x16 nq = (f32x16)(0.f);
        if (w < 4) { const bf16_t* qt = (const bf16_t*)(nblob + 16384);
#pragma unroll
            for (int ri = 0; ri < 16; ++ri) nq[ri] = bf2f(qt[(eh + CROW(ri, lane)) * 64 + dh + (lane & 31)]); }
        __syncthreads();
        if (w < 4) { f32x16 acc[1]; acc[0] = qv;
            mm_nt<1, 4>(STb + cur * 64 * LS + eh * LS, LS, Pb + dh * LS, LS, acc, lane);
#pragma unroll
            for (int ri = 0; ri < 16; ++ri) STb[(cur ^ 1) * 64 * LS + (eh + CROW(ri, lane)) * LS + dh + (lane & 31)] = (bf16_t)f2bf(acc[0][ri]); }
        __syncthreads();
        cur ^= 1; qv = nq;
    }
}
__device__ __forceinline__ void gdn_c_item(Ctx& C, int l, int b, int h, int jt) {
    LAS unsigned char* lds = C.lds; ITEM_IDS();
    LAS bf16_t* Rb = (LAS bf16_t*)lds;
    LAS bf16_t* Sb = (LAS bf16_t*)(lds + 18432);
    LAS float* OF = (LAS float*)(lds + 36864);
    const bool isc = jt < NCHC; const int jl = jt - NCHC;
    int cidx[2]; cidx[0] = jt; cidx[1] = isc ? (NCHC - 1 - jt) : NCHC + (SEQ / 64 - 1 - jl);
    const unsigned char* blob[2];
    const int dirw = w >> 2, qw = w & 3, ihw = (qw & 1) * 32, ehw = (qw >> 1) * 32;
    f32x16 acc0;
    { const bf16_t* ol = (const bf16_t*)(C.ws + WS_GD + ((size_t)((b * NH + h) * 2 + dirw) * NCH + cidx[dirw]) * GD_BLOB + 24576);
#pragma unroll
        for (int ri = 0; ri < 16; ++ri) acc0[ri] = bf2f(ol[(ihw + CROW(ri, lane)) * 64 + ehw + (lane & 31)]); }
    const int tokf = tid >> 3, e0f = (tid & 7) * 8; const int rowf = isc ? NLAT + b * LC + 64 * jt + tokf : b * SEQ + 64 * jl + tokf;
    const u32x4 gzv = *(const u32x4*)(WSP(bf16_t, WS_Z) + (size_t)rowf * ZW + GDB + 768 + h * 64 + e0f);
    const f32x4 ngv0 = *(const f32x4*)(INP(I_GDNG) + l * 256 + h * 64 + e0f), ngv1 = *(const f32x4*)(INP(I_GDNG) + l * 256 + h * 64 + e0f + 4);
#pragma unroll
    for (int dir = 0; dir < 2; ++dir) { const size_t sc = (size_t)((b * NH + h) * 2 + dir) * NCH + cidx[dir]; blob[dir] = C.ws + WS_GD + sc * GD_BLOB;
        const bf16_t* gst = WSP(bf16_t, WS_GST) + sc * 4096; const int r = tid >> 3, c8 = (tid & 7) * 8;
        *(LAS u32x4*)(Rb + dir * 64 * LS + r * LS + c8) = *(const u32x4*)((const bf16_t*)(blob[dir] + 8192) + r * 64 + c8);
        *(LAS u32x4*)(Sb + dir * 64 * LS + r * LS + c8) = *(const u32x4*)(gst + r * 64 + c8); }
    __syncthreads();
    { const int dir = dirw, ih = ihw, eh = ehw; f32x16 acc[1]; acc[0] = acc0;
        mm_nt<1, 4>(Rb + dir * 64 * LS + ih * LS, LS, Sb + dir * 64 * LS + eh * LS, LS, acc, lane);
#pragma unroll
        for (int ri = 0; ri < 16; ++ri) { const int ii = ih + CROW(ri, lane), tok = dir ? 63 - ii : ii; OF[dir * 64 * LF + tok * LF + eh + (lane & 31)] = acc[0][ri]; } }
    __syncthreads();
    { const int tok = tid >> 3, e0 = (tid & 7) * 8; const int row = isc ? NLAT + b * LC + 64 * jt + tok : b * SEQ + 64 * jl + tok;
        float o[8]; float ss = 0.f;
#pragma unroll
        for (int j = 0; j < 8; ++j) { o[j] = OF[tok * LF + e0 + j] + OF[64 * LF + tok * LF + e0 + j]; ss += o[j] * o[j]; }
#pragma unroll
        for (int k = 1; k < 8; k <<= 1) ss += __shfl_xor(ss, k);
        const float rs = 1.f / sqrtf(ss * (1.f / 64.f) + EPS);
        const float ng[8] = {ngv0.x, ngv0.y, ngv0.z, ngv0.w, ngv1.x, ngv1.y, ngv1.z, ngv1.w}; const unsigned gu[4] = {gzv.x, gzv.y, gzv.z, gzv.w};
        unsigned pk[4];
#pragma unroll
        for (int j = 0; j < 4; ++j) pk[j] = pk2(o[2 * j] * rs * ng[2 * j] * siluf_(u2f(gu[j] << 16)), o[2 * j + 1] * rs * ng[2 * j + 1] * siluf_(u2f(gu[j] & 0xffff0000u)));
        *(u32x4*)(WSP(bf16_t, WS_MIX) + (size_t)row * D + 768 + h * 64 + e0) = (u32x4){pk[0], pk[1], pk[2], pk[3]}; }
    __syncthreads();
}
constexpr int MA_Q = 0, MA_K = 9216, MA_VT = 18432, MA_KWT = 27648, MA_P = 36864, MA_ONE = 46080  , MA_S = 50688  ;
struct MlIn { u32x4 q, k, v; float g0, g1; };
__device__ __forceinline__ void mlstm_a_load(Ctx& C, int l, int b, int h, int dir, int c, MlIn& in) {
    const int tid = C.tid, i = tid >> 3, d0 = (tid & 7) * 8; const int row = scan_row<1>(b, dir, 64 * c + i);
    const bf16_t* zr = WSP(bf16_t, WS_Z) + (size_t)row * ZW + MLB + h * 64 + d0; const float* g = WSP(float, WS_ZG) + (size_t)row * 32;
    in.q = *(const u32x4*)zr; in.k = *(const u32x4*)(zr + 256); in.v = *(const u32x4*)(zr + 512);
    in.g0 = g[(2 * dir) * 4 + h]; in.g1 = g[(2 * dir + 1) * 4 + h];
}
__device__ __forceinline__ void mlstm_a_item(Ctx& C, int l, int b, int h, int dir, int c, const MlIn& in) {
    LAS unsigned char* lds = C.lds; ITEM_IDS();
    LAS bf16_t* Qb = (LAS bf16_t*)(lds + MA_Q); LAS bf16_t* Kb = (LAS bf16_t*)(lds + MA_K); LAS bf16_t* VT = (LAS bf16_t*)(lds + MA_VT); LAS bf16_t* KWT = (LAS bf16_t*)(lds + MA_KWT);
    LAS bf16_t* Pm = (LAS bf16_t*)(lds + MA_P); LAS bf16_t* ONE = (LAS bf16_t*)(lds + MA_ONE); LAS float* Sc = (LAS float*)(lds + MA_S);
    const bf16_t* zb = WSP(bf16_t, WS_Z); const float* zg = WSP(float, WS_ZG);
    unsigned char* blob = C.ws + WS_ML + ((size_t)((b * NH + h) * 2 + dir) * NCH + c) * ML_BLOB;
    const int i = tid >> 3, d0 = (tid & 7) * 8; const int row = scan_row<1>(b, dir, 64 * c + i);
    float kv[8];
    { (void)zb; (void)zg; (void)row;
        *(LAS u32x4*)(Qb + i * LS + d0) = in.q;
        const u32x4 kr = in.k, vr = in.v;
        const unsigned ku[4] = {kr.x, kr.y, kr.z, kr.w}, vu[4] = {vr.x, vr.y, vr.z, vr.w};
#pragma unroll
        for (int j = 0; j < 4; ++j) { kv[2 * j] = u2f(ku[j] << 16) * 0.125f; kv[2 * j + 1] = u2f(ku[j] & 0xffff0000u) * 0.125f; VT[(d0 + 2 * j) * LS + i] = (bf16_t)(vu[j] & 0xffffu); VT[(d0 + 2 * j + 1) * LS + i] = (bf16_t)(vu[j] >> 16); }
        u32x4 wk; wk.x = pk2(kv[0], kv[1]); wk.y = pk2(kv[2], kv[3]); wk.z = pk2(kv[4], kv[5]); wk.w = pk2(kv[6], kv[7]); *(LAS u32x4*)(Kb + i * LS + d0) = wk;
        if ((tid & 7) == 0) { const float* gb = INP(I_MLGB) + l * 16;
            Sc[i] = in.g0 + gb[(2 * dir) * 4 + h]; Sc[64 + i] = logsigmoidf_(in.g1 + gb[(2 * dir + 1) * 4 + h]); }
        for (int o = tid; o < 32 * LS; o += 512) ONE[o] = (bf16_t)((o < LS) ? 0x3f80 : 0);
    }
    __syncthreads();
    if (w == 0) { float fc = Sc[64 + lane];
#pragma unroll
        for (int o = 1; o < 64; o <<= 1) { const float t = __shfl(fc, lane - o); if (lane >= o) fc += t; }
        const float li = Sc[lane]; float pm = li - fc;
#pragma unroll
        for (int o = 1; o < 64; o <<= 1) { const float t = __shfl(pm, lane - o); if (lane >= o) pm = fmaxf(pm, t); }
        const float fl = __shfl(fc, 63); const float gg = fl - fc + li; float gm = gg;
#pragma unroll
        for (int o = 1; o < 64; o <<= 1) gm = fmaxf(gm, __shfl_xor(gm, o));
        Sc[128 + lane] = fc; Sc[192 + lane] = gg - gm; Sc[256 + lane] = fc + pm;
        if (lane == 0) { ((float*)(blob + 17408))[0] = gm; ((float*)(blob + 17408))[1] = fl; }
        ((float*)(blob + 16384))[64 + lane] = fc + pm; ((float*)(blob + 16384))[128 + lane] = fc; }
    __syncthreads();
    { const float e = __expf(Sc[192 + i]);
#pragma unroll
        for (int j = 0; j < 8; ++j) KWT[(d0 + j) * LS + i] = (bf16_t)f2bf(kv[j] * e); }
    if (w < 2) { f32x16 acc[2]; acc[0] = (f32x16)(0.f); acc[1] = (f32x16)(0.f);
        const int rh = w * 32; mm_nt<2, 4>(Qb + rh * LS, LS, Kb, LS, acc, lane);
        float fi[16], cj[2];
#pragma unroll
        for (int ri = 0; ri < 16; ++ri) { const int ii = rh + CROW(ri, lane); fi[ri] = Sc[128 + ii] - Sc[256 + ii]; }
        cj[0] = Sc[lane & 31] - Sc[128 + (lane & 31)]; cj[1] = Sc[32 + (lane & 31)] - Sc[128 + 32 + (lane & 31)];
#pragma unroll
        for (int n = 0; n < 2; ++n)
#pragma unroll
            for (int ri = 0; ri < 16; ++ri) { const int ii = rh + CROW(ri, lane), jj = 32 * n + (lane & 31);
                Pm[ii * LS + jj] = (bf16_t)f2bf(jj <= ii ? acc[n][ri] * __expf(fi[ri] + cj[n]) : 0.f); } }
    __syncthreads();
    { const int pr = w >> 2, q = w & 3, rh = (q & 1) * 32, ch = (q >> 1) * 32; f32x16 acc[1]; acc[0] = (f32x16)(0.f);
        const LAS bf16_t* Ap = pr ? VT : Pm; const LAS bf16_t* Bp = pr ? KWT : VT;
        mm_nt<1, 4>(Ap + rh * LS, LS, Bp + ch * LS, LS, acc, lane);
        LAS bf16_t* OUT = (LAS bf16_t*)(lds + MA_Q) + (pr ? 4096 : 0);
#pragma unroll
        for (int ri = 0; ri < 16; ++ri) OUT[(rh + CROW(ri, lane)) * 64 + ch + (lane & 31)] = (bf16_t)f2bf(acc[0][ri]);
        if (q < 2) {
            f32x16 a2[1]; a2[0] = (f32x16)(0.f);
            if (pr == 0) { mm_nt<1, 4>(Pm + (q * 32) * LS, LS, ONE, LS, a2, lane);
                if ((lane & 31) == 0) {
#pragma unroll
                    for (int ri = 0; ri < 16; ++ri) ((float*)(blob + 16384))[q * 32 + CROW(ri, lane)] = a2[0][ri]; } }
            else { mm_nt<1, 4>(ONE, LS, KWT + (q * 32) * LS, LS, a2, lane);
                if (lane < 32) ((float*)(blob + 16384))[192 + q * 32 + lane] = a2[0][0]; } } }
    __syncthreads();
#pragma unroll
    for (int k = 0; k < 2; ++k) { const int o = tid + 512 * k; *(u32x4*)(blob + (size_t)o * 16) = *(const LAS u32x4*)(lds + MA_Q + o * 16); }
    __syncthreads();
}
__device__ __forceinline__ void mlstm_b_scan(Ctx& C, int sidx) {
    const int tid = C.tid, e = tid >> 3, d0 = (tid & 7) * 8;
    float ct[8], nn[8]; float m = 0.f;
#pragma unroll
    for (int j = 0; j < 8; ++j) { ct[j] = 0.f; nn[j] = 0.f; }
    u32x4 uq; f32x4 n0, n1; float gm, fl;
    { const unsigned char* blob = C.ws + WS_ML + ((size_t)sidx * NCH) * ML_BLOB;
        uq = *(const u32x4*)((const bf16_t*)(blob + 8192) + e * 64 + d0);
        n0 = *(const f32x4*)((const float*)(blob + 16384) + 192 + d0); n1 = *(const f32x4*)((const float*)(blob + 16384) + 192 + d0 + 4); gm = ((const float*)(blob + 17408))[0]; fl = ((const float*)(blob + 17408))[1]; }
    for (int c = 0; c < NCH; ++c) {
        unsigned char* st = C.ws + WS_MST + ((size_t)sidx * NCH + c) * ML_ST;
        const int cn = (c + 1 < NCH) ? c + 1 : c; const unsigned char* blob = C.ws + WS_ML + ((size_t)sidx * NCH + cn) * ML_BLOB;
        const u32x4 puq = *(const u32x4*)((const bf16_t*)(blob + 8192) + e * 64 + d0);
        const f32x4 pn0 = *(const f32x4*)((const float*)(blob + 16384) + 192 + d0), pn1 = *(const f32x4*)((const float*)(blob + 16384) + 192 + d0 + 4);
        const float pgm = ((const float*)(blob + 17408))[0], pfl = ((const float*)(blob + 17408))[1];
        u32x4 wv; wv.x = pk2(ct[0], ct[1]); wv.y = pk2(ct[2], ct[3]); wv.z = pk2(ct[4], ct[5]); wv.w = pk2(ct[6], ct[7]);
        *(u32x4*)((bf16_t*)st + e * 64 + d0) = wv;
        if (e == 0) { *(f32x4*)((float*)(st + 8192) + d0) = (f32x4){nn[0], nn[1], nn[2], nn[3]}; *(f32x4*)((float*)(st + 8192) + d0 + 4) = (f32x4){nn[4], nn[5], nn[6], nn[7]}; if (d0 == 0) ((float*)(st + 8192))[64] = m; }
        const float mn = fmaxf(fl + m, gm), ao = __expf(fl + m - mn), an = __expf(gm - mn); m = mn;
        const unsigned uw[4] = {uq.x, uq.y, uq.z, uq.w}; const float un[8] = {n0.x, n0.y, n0.z, n0.w, n1.x, n1.y, n1.z, n1.w};
#pragma unroll
        for (int j = 0; j < 4; ++j) { ct[2 * j] = ao * ct[2 * j] + an * u2f(uw[j] << 16); ct[2 * j + 1] = ao * ct[2 * j + 1] + an * u2f(uw[j] & 0xffff0000u); }
#pragma unroll
        for (int j = 0; j < 8; ++j) nn[j] = ao * nn[j] + an * un[j];
        uq = puq; n0 = pn0; n1 = pn1; gm = pgm; fl = pfl;
    }
}
__device__ __forceinline__ void mlstm_c_item(Ctx& C, int l, int b, int h, int jt) {
    LAS unsigned char* lds = C.lds; ITEM_IDS();
    LAS bf16_t* Qb = (LAS bf16_t*)lds;
    LAS bf16_t* Sb = (LAS bf16_t*)(lds + 18432);
    LAS float* OF = (LAS float*)(lds + 36864);
    LAS float* Sc = (LAS float*)(lds + 70144);
    const bool isc = jt < NCHC; const int jl = jt - NCHC;
    int cidx[2]; cidx[0] = jt; cidx[1] = isc ? (NCHC - 1 - jt) : NCHC + (SEQ / 64 - 1 - jl);
    const unsigned char* blob[2]; const bf16_t* zb = WSP(bf16_t, WS_Z);
    const int i = tid >> 3, d0 = (tid & 7) * 8;
    const int dirw = w >> 2, qw = w & 3, ihw = (qw & 1) * 32, ehw = (qw >> 1) * 32;
    float nlv[16];
    { const bf16_t* nl = (const bf16_t*)(C.ws + WS_ML + ((size_t)((b * NH + h) * 2 + dirw) * NCH + cidx[dirw]) * ML_BLOB);
#pragma unroll
        for (int ri = 0; ri < 16; ++ri) nlv[ri] = bf2f(nl[(ihw + CROW(ri, lane)) * 64 + ehw + (lane & 31)]); }
    const int rowf = scan_row<1>(b, 0, 64 * cidx[0] + i);
    const u32x4 gzv = *(const u32x4*)(zb + (size_t)rowf * ZW + MLB + 768 + h * 64 + d0);
    const f32x4 ngv0 = *(const f32x4*)(INP(I_MLNG) + l * 256 + h * 64 + d0), ngv1 = *(const f32x4*)(INP(I_MLNG) + l * 256 + h * 64 + d0 + 4);
#pragma unroll
    for (int dir = 0; dir < 2; ++dir) { const size_t sc = (size_t)((b * NH + h) * 2 + dir) * NCH + cidx[dir]; blob[dir] = C.ws + WS_ML + sc * ML_BLOB;
        const unsigned char* st = C.ws + WS_MST + sc * ML_ST; const int row = scan_row<1>(b, dir, 64 * cidx[dir] + i);
        const u32x4 qr = *(const u32x4*)(zb + (size_t)row * ZW + MLB + h * 64 + d0);
        *(LAS u32x4*)(Qb + dir * 64 * LS + i * LS + d0) = qr;
        *(LAS u32x4*)(Sb + dir * 64 * LS + i * LS + d0) = *(const u32x4*)((const bf16_t*)st + i * 64 + d0);
        const float* n0 = (const float*)(st + 8192) + d0; const unsigned qu[4] = {qr.x, qr.y, qr.z, qr.w}; float qn = 0.f;
#pragma unroll
        for (int j = 0; j < 4; ++j) qn += u2f(qu[j] << 16) * n0[2 * j] + u2f(qu[j] & 0xffff0000u) * n0[2 * j + 1];
#pragma unroll
        for (int k = 1; k < 8; k <<= 1) qn += __shfl_xor(qn, k);
        if ((tid & 7) == 0) { const float* sv = (const float*)(blob[dir] + 16384); const float m0 = ((const float*)(st + 8192))[64];
            const float mloc = sv[64 + i], ainit = sv[128 + i] + m0, M = fmaxf(mloc, ainit), s1 = __expf(mloc - M), s2 = __expf(ainit - M);
            LAS float* o = Sc + dir * 256; o[i] = s1; o[64 + i] = s2; o[128 + i] = s1 * sv[i] + s2 * qn; o[192 + i] = __expf(-M); } }
    __syncthreads();
    { const int dir = dirw, ih = ihw, eh = ehw; f32x16 acc[1]; acc[0] = (f32x16)(0.f);
        mm_nt<1, 4>(Qb + dir * 64 * LS + ih * LS, LS, Sb + dir * 64 * LS + eh * LS, LS, acc, lane);
        const LAS float* o = Sc + dir * 256; float s1[16], s2[16], dn[16];
#pragma unroll
        for (int ri = 0; ri < 16; ++ri) { const int ii = ih + CROW(ri, lane); s1[ri] = o[ii]; s2[ri] = o[64 + ii]; dn[ri] = 1.f / fmaxf(fabsf(o[128 + ii]), o[192 + ii]); }
#pragma unroll
        for (int ri = 0; ri < 16; ++ri) { const int ii = ih + CROW(ri, lane), tok = dir ? 63 - ii : ii, ee = eh + (lane & 31);
            OF[dir * 64 * LF + tok * LF + ee] = (s1[ri] * nlv[ri] + s2[ri] * acc[0][ri]) * dn[ri]; } }
    __syncthreads();
    { const int tok = tid >> 3, e0 = (tid & 7) * 8; const int row = scan_row<1>(b, 0, 64 * cidx[0] + tok);
        float o[8]; float ss = 0.f;
#pragma unroll
        for (int j = 0; j < 8; ++j) { o[j] = OF[tok * LF + e0 + j] + OF[64 * LF + tok * LF + e0 + j]; ss += o[j] * o[j]; }
#pragma unroll
        for (int k = 1; k < 8; k <<= 1) ss += __shfl_xor(ss, k);
        const float rs = 1.f / sqrtf(ss * (1.f / 64.f) + EPS);
        const float ng[8] = {ngv0.x, ngv0.y, ngv0.z, ngv0.w, ngv1.x, ngv1.y, ngv1.z, ngv1.w}; const unsigned gu[4] = {gzv.x, gzv.y, gzv.z, gzv.w};
        unsigned pk[4];
#pragma unroll
        for (int j = 0; j < 4; ++j) pk[j] = pk2(o[2 * j] * rs * ng[2 * j] * sigmoidf_(u2f(gu[j] << 16)), o[2 * j + 1] * rs * ng[2 * j + 1] * sigmoidf_(u2f(gu[j] & 0xffff0000u)));
        *(u32x4*)(WSP(bf16_t, WS_MIX) + (size_t)row * D + 256 + h * 64 + e0) = (u32x4){pk[0], pk[1], pk[2], pk[3]}; }
    __syncthreads();
}
constexpr int HA_Q = 0, HA_K = 16640, HA_CUM = 33280, HA_V = 49920, HA_SC = 66560  , HA_VT = 70912, HA_KDT = 80128, HA_QT = 89344, HA_KT = 98560;
__device__ __forceinline__ void hgrn_a_item(Ctx& C, int l, int b, int h, int dir, int c) {
    LAS unsigned char* lds = C.lds; ITEM_IDS();
    LAS float* Qf = (LAS float*)(lds + HA_Q); LAS float* Kf = (LAS float*)(lds + HA_K); LAS float* CUM = (LAS float*)(lds + HA_CUM); LAS float* Vf = (LAS float*)(lds + HA_V); LAS float* SC = (LAS float*)(lds + HA_SC);
    LAS bf16_t* VT = (LAS bf16_t*)(lds + HA_VT); LAS bf16_t* KDT = (LAS bf16_t*)(lds + HA_KDT); LAS bf16_t* QTb = (LAS bf16_t*)(lds + HA_QT); LAS bf16_t* KTb = (LAS bf16_t*)(lds + HA_KT);
    const bf16_t* zb = WSP(bf16_t, WS_Z);
    unsigned char* blob = C.ws + WS_HG + ((size_t)((b * NH + h) * 2 + dir) * NCH + c) * HG_BLOB;
    const int i = tid >> 3, d0 = (tid & 7) * 8; const int row = scan_row<0>(b, dir, 64 * c + i);
    { const bf16_t* zr = zb + (size_t)row * ZW + HGB + h * 64 + d0; const float* lbp = WSP(float, WS_LB) + l * 256 + h * 64 + d0;
#pragma unroll
        for (int j = 0; j < 8; ++j) { const float qz = bf2f(zr[j]), iz = bf2f(zr[256 + j]), fz = bf2f(zr[512 + dir * 256 + j]), lb = lbp[j];
            const float sg = 1.f / (1.f + __expf(-fz)), sgn = 1.f / (1.f + __expf(fz));
            Qf[i * LF + d0 + j] = siluf_(qz); Kf[i * LF + d0 + j] = (1.f - lb) * sgn; CUM[i * LF + d0 + j] = __logf(lb + (1.f - lb) * sg); Vf[i * LF + d0 + j] = iz; VT[(d0 + j) * LS + i] = (bf16_t)f2bf(iz); } }
    __syncthreads();
    if (tid < 256) { const int sub = tid >> 6, d = tid & 63; float cv[16];
#pragma unroll
        for (int t = 0; t < 16; ++t) cv[t] = CUM[(16 * sub + t) * LF + d];
#pragma unroll
        for (int t = 1; t < 16; ++t) cv[t] += cv[t - 1];
#pragma unroll
        for (int t = 0; t < 16; ++t) CUM[(16 * sub + t) * LF + d] = cv[t]; }
    __syncthreads();
    { const int sub = i >> 4; u32x4 wq, wk; float qt[8], kt[8], cmv[8], lsv[8], kkv[8], qqv[8];
#pragma unroll
        for (int j = 0; j < 8; ++j) { cmv[j] = CUM[i * LF + d0 + j]; lsv[j] = CUM[(16 * sub + 15) * LF + d0 + j]; kkv[j] = Kf[i * LF + d0 + j]; qqv[j] = Qf[i * LF + d0 + j]; }
#pragma unroll
        for (int j = 0; j < 8; ++j) { const float cm = cmv[j], last = lsv[j], kk = kkv[j];
            KDT[(d0 + j) * LS + i] = (bf16_t)f2bf(kk * __expf(last - cm)); qt[j] = qqv[j] * __expf(cm); kt[j] = kk * __expf(fminf(-cm, 80.f));
            if ((i & 15) == 15) ((float*)(blob + 32768))[sub * 64 + d0 + j] = __expf(last); }
        wq.x = pk2(qt[0], qt[1]); wq.y = pk2(qt[2], qt[3]); wq.z = pk2(qt[4], qt[5]); wq.w = pk2(qt[6], qt[7]);
        wk.x = pk2(kt[0], kt[1]); wk.y = pk2(kt[2], kt[3]); wk.z = pk2(kt[4], kt[5]); wk.w = pk2(kt[6], kt[7]);
        *(u32x4*)((bf16_t*)(blob + 33792) + i * 64 + d0) = wq; *(LAS u32x4*)(QTb + i * LS + d0) = wq; *(LAS u32x4*)(KTb + i * LS + d0) = wk; }
    __syncthreads();
    if (w < 4) { const int sub = w, cl = lane & 15, q4 = lane >> 4; f32x4 acc = (f32x4){0.f, 0.f, 0.f, 0.f};
#pragma unroll
        for (int kk = 0; kk < 2; ++kk) { const bf16x8 a = *(const LAS bf16x8*)(QTb + (16 * sub + cl) * LS + 32 * kk + 8 * q4), bb = *(const LAS bf16x8*)(KTb + (16 * sub + cl) * LS + 32 * kk + 8 * q4);
            acc = __builtin_amdgcn_mfma_f32_16x16x32_bf16(a, bb, acc, 0, 0, 0); }
#pragma unroll
        for (int r = 0; r < 4; ++r) { const int t = 4 * q4 + r; SC[(sub * 16 + t) * 17 + cl] = (cl <= t) ? acc[r] : 0.f; } }
    __syncthreads();
    { const int sub = i >> 4, t = i & 15; float o[8];
#pragma unroll
        for (int j = 0; j < 8; ++j) o[j] = 0.f;
#pragma unroll
        for (int s2 = 0; s2 < 16; ++s2) { const float sc = SC[(sub * 16 + t) * 17 + s2];
#pragma unroll
            for (int j = 0; j < 8; ++j) o[j] += sc * Vf[(16 * sub + s2) * LF + d0 + j]; }
        u32x4 ow; ow.x = pk2(o[0], o[1]); ow.y = pk2(o[2], o[3]); ow.z = pk2(o[4], o[5]); ow.w = pk2(o[6], o[7]); *(u32x4*)((bf16_t*)(blob + 41984) + i * 64 + d0) = ow; }
    { const int sub = w >> 1, eh = (w & 1) * 32; f32x16 acc[2]; acc[0] = (f32x16)(0.f); acc[1] = (f32x16)(0.f);
        mm_nt<2, 1>(VT + eh * LS + 16 * sub, LS, KDT + 16 * sub, LS, acc, lane);
        LAS bf16_t* ut = (LAS bf16_t*)(lds + HA_Q) + sub * 4096;
#pragma unroll
        for (int n = 0; n < 2; ++n)
#pragma unroll
            for (int ri = 0; ri < 16; ++ri) ut[(eh + CROW(ri, lane)) * 64 + 32 * n + (lane & 31)] = (bf16_t)f2bf(acc[n][ri]); }
    __syncthreads();
#pragma unroll
    for (int k = 0; k < 4; ++k) { const int o = tid + 512 * k; *(u32x4*)(blob + (size_t)o * 16) = *(const LAS u32x4*)(lds + HA_Q + o * 16); }
    __syncthreads();
}
__device__ __forceinline__ void hgrn_b_scan(Ctx& C, int sidx) {
    const int tid = C.tid, e = tid >> 3, d0 = (tid & 7) * 8;
    LAS float* LAM = (LAS float*)C.lds;
    __syncthreads();
    for (int o = tid; o < NCH * 64; o += 512) { const int c = o >> 6, q = o & 63; *(LAS f32x4*)(LAM + c * 256 + q * 4) = *(const f32x4*)((const float*)(C.ws + WS_HG + ((size_t)sidx * NCH + c) * HG_BLOB + 32768) + q * 4); }
    __syncthreads();
    float st[8];
#pragma unroll
    for (int j = 0; j < 8; ++j) st[j] = 0.f;
    u32x4 ur[3][4];
#define HGB_LOAD(slot, cc) do { const int c_ = (cc) < NCH ? (cc) : NCH - 1; const unsigned char* blob_ = C.ws + WS_HG + ((size_t)sidx * NCH + c_) * HG_BLOB; \
        _Pragma("unroll") for (int sub = 0; sub < 4; ++sub) ur[slot][sub] = *(const u32x4*)((const bf16_t*)blob_ + sub * 4096 + e * 64 + d0); } while (0)
#define HGB_APPLY(slot, cc) do { bf16_t* so_ = WSP(bf16_t, WS_HST) + ((size_t)sidx * NCH + (cc)) * 4 * 4096; \
        _Pragma("unroll") for (int sub = 0; sub < 4; ++sub) { u32x4 wv; wv.x = pk2(st[0], st[1]); wv.y = pk2(st[2], st[3]); wv.z = pk2(st[4], st[5]); wv.w = pk2(st[6], st[7]); \
            *(u32x4*)(so_ + sub * 4096 + e * 64 + d0) = wv; \
            const f32x4 la_ = *(const LAS f32x4*)(LAM + ((cc) * 4 + sub) * 64 + d0), lb_ = *(const LAS f32x4*)(LAM + ((cc) * 4 + sub) * 64 + d0 + 4); \
            const unsigned uu[4] = {ur[slot][sub].x, ur[slot][sub].y, ur[slot][sub].z, ur[slot][sub].w}; const float lam[8] = {la_.x, la_.y, la_.z, la_.w, lb_.x, lb_.y, lb_.z, lb_.w}; \
            _Pragma("unroll") for (int j = 0; j < 4; ++j) { st[2 * j] = lam[2 * j] * st[2 * j] + u2f(uu[j] << 16); st[2 * j + 1] = lam[2 * j + 1] * st[2 * j + 1] + u2f(uu[j] & 0xffff0000u); } } } while (0)
    HGB_LOAD(0, 0); HGB_LOAD(1, 1);
    int c = 0;
    for (; c + 3 <= NCH; c += 3) {
        HGB_LOAD(2, c + 2); HGB_APPLY(0, c);
        HGB_LOAD(0, c + 3); HGB_APPLY(1, c + 1);
        HGB_LOAD(1, c + 4); HGB_APPLY(2, c + 2);
    }
    if (c < NCH) { HGB_APPLY(0, c); ++c; }
    if (c < NCH) { HGB_APPLY(1, c); ++c; }
#undef HGB_LOAD
#undef HGB_APPLY
    __syncthreads();
}
__device__ __forceinline__ void hgrn_c_item(Ctx& C, int l, int b, int h, int jt) {
    LAS unsigned char* lds = C.lds; ITEM_IDS();
    LAS bf16_t* STw = (LAS bf16_t*)(lds + w * 11520);
    LAS bf16_t* QTw = STw + 64 * LS;
    LAS float* OF = (LAS float*)(lds + 92160);
    const bool isc = jt < NCHC; const int jl = jt - NCHC;
    int cidx[2]; cidx[0] = jt; cidx[1] = isc ? (NCHC - 1 - jt) : NCHC + (SEQ / 64 - 1 - jl);
    const int tokf = tid >> 3, e0f = (tid & 7) * 8; const int rowf = scan_row<0>(b, 0, 64 * cidx[0] + tokf);
    const u32x4 gzv = *(const u32x4*)(WSP(bf16_t, WS_Z) + (size_t)rowf * ZW + HGB + 1024 + h * 64 + e0f);
    const f32x4 ngv0 = *(const f32x4*)(INP(I_HGNG) + l * 256 + h * 64 + e0f), ngv1 = *(const f32x4*)(INP(I_HGNG) + l * 256 + h * 64 + e0f + 4);
    { const int dir = w >> 2, sub = w & 3; const size_t sc = (size_t)((b * NH + h) * 2 + dir) * NCH + cidx[dir]; const unsigned char* blob = C.ws + WS_HG + sc * HG_BLOB;
        const bf16_t* st = WSP(bf16_t, WS_HST) + (sc * 4 + sub) * 4096; const bf16_t* qt = (const bf16_t*)(blob + 33792) + (16 * sub) * 64;
#pragma unroll
        for (int k = 0; k < 8; ++k) { const int o = lane + 64 * k, r = o >> 3, c8 = (o & 7) * 8; *(LAS u32x4*)(STw + r * LS + c8) = *(const u32x4*)(st + r * 64 + c8); }
#pragma unroll
        for (int k = 0; k < 2; ++k) { const int o = lane + 64 * k, r = o >> 3, c8 = (o & 7) * 8; *(LAS u32x4*)(QTw + r * LS + c8) = *(const u32x4*)(qt + r * 64 + c8); }
        const bf16_t* oi = (const bf16_t*)(blob + 41984) + (16 * sub) * 64;
        float oiv[16];
#pragma unroll
        for (int nt = 0; nt < 4; ++nt)
#pragma unroll
            for (int r = 0; r < 4; ++r) oiv[4 * nt + r] = bf2f(oi[(4 * (lane >> 4) + r) * 64 + 16 * nt + (lane & 15)]);
        LDS_WAIT(); asm volatile("" ::: "memory");
        const int tr = lane & 15, kq = (lane >> 4) * 8;
#pragma unroll
        for (int nt = 0; nt < 4; ++nt) { f32x4 acc = (f32x4){0.f, 0.f, 0.f, 0.f};
#pragma unroll
            for (int kk = 0; kk < 2; ++kk) { const bf16x8 a = *(const LAS bf16x8*)(QTw + tr * LS + 32 * kk + kq), bb = *(const LAS bf16x8*)(STw + (16 * nt + tr) * LS + 32 * kk + kq);
                acc = __builtin_amdgcn_mfma_f32_16x16x32_bf16(a, bb, acc, 0, 0, 0); }
#pragma unroll
            for (int r = 0; r < 4; ++r) { const int t = 4 * (lane >> 4) + r, ii = 16 * sub + t, tok = dir ? 63 - ii : ii, ee = 16 * nt + (lane & 15);
                OF[dir * 64 * LF + tok * LF + ee] = acc[r] + oiv[4 * nt + r]; } } }
    __syncthreads();
    { const int tok = tid >> 3, e0 = (tid & 7) * 8; const int row = scan_row<0>(b, 0, 64 * cidx[0] + tok);
        float o[8]; float ss = 0.f;
#pragma unroll
        for (int j = 0; j < 8; ++j) { o[j] = OF[tok * LF + e0 + j] + OF[64 * LF + tok * LF + e0 + j]; ss += o[j] * o[j]; }
#pragma unroll
        for (int k = 1; k < 8; k <<= 1) ss += __shfl_xor(ss, k);
        const float rs = 1.f / sqrtf(ss * (1.f / 64.f) + EPS);
        const float ng[8] = {ngv0.x, ngv0.y, ngv0.z, ngv0.w, ngv1.x, ngv1.y, ngv1.z, ngv1.w}; const unsigned gu[4] = {gzv.x, gzv.y, gzv.z, gzv.w};
        unsigned pk[4];
#pragma unroll
        for (int j = 0; j < 4; ++j) pk[j] = pk2(o[2 * j] * rs * ng[2 * j] * siluf_(u2f(gu[j] << 16)), o[2 * j + 1] * rs * ng[2 * j + 1] * siluf_(u2f(gu[j] & 0xffff0000u)));
        *(u32x4*)(WSP(bf16_t, WS_MIX) + (size_t)row * D + h * 64 + e0) = (u32x4){pk[0], pk[1], pk[2], pk[3]}; }
    __syncthreads();
}
__device__ __forceinline__ void phase_gdn_a(Ctx& C, int l) {
    for (int rep = 0; rep < 1 + ((REPMASK >> 10) & 1); ++rep)
    for (int it = C.bid; it < NSCAN * NCH; it += C.G) { const int sidx = it / NCH, c = it % NCH; gdn_a_item(C, l, sidx / (NH * 2), (sidx / 2) % NH, sidx & 1, c); }
    for (int rep = 0; rep < 1 + ((REPMASK >> 11) & 1); ++rep)
    { MlIn cur, nxt; int it = (C.bid + C.G / 3) % C.G;
        if (it < NSCAN * NCH) { const int sidx = it / NCH; mlstm_a_load(C, l, sidx / (NH * 2), (sidx / 2) % NH, sidx & 1, it % NCH, cur); }
        for (; it < NSCAN * NCH; it += C.G) { const int sidx = it / NCH, c = it % NCH; const int itn = (it + C.G < NSCAN * NCH) ? it + C.G : it, sn = itn / NCH;
            mlstm_a_load(C, l, sn / (NH * 2), (sn / 2) % NH, sn & 1, itn % NCH, nxt);
            mlstm_a_item(C, l, sidx / (NH * 2), (sidx / 2) % NH, sidx & 1, c, cur); cur = nxt; } }
    for (int rep = 0; rep < 1 + ((REPMASK >> 12) & 1); ++rep)
    for (int it = (C.bid + 2 * (C.G / 3)) % C.G; it < NSCAN * NCH; it += C.G) { const int sidx = it / NCH, c = it % NCH; hgrn_a_item(C, l, sidx / (NH * 2), (sidx / 2) % NH, sidx & 1, c); }
}
__device__ __forceinline__ void phase_hy_transpose(Ctx& C) {
    const int gw = C.vcu * 8 + C.wave, NGW = C.G * 8, lane = C.lane;
    LAS bf16_t* scr = (LAS bf16_t*)(C.lds + C.wave * 8448);
    const bf16_t* zb = WSP(bf16_t, WS_Z); bf16_t* zt = WSP(bf16_t, WS_ZT);
    for (int it = gw; it < (NT / 64) * 12; it += NGW) { const int r0 = (it / 12) * 64, cb = (it % 12) * 64;
#pragma unroll 8
        for (int rr = 0; rr < 64; rr += 2) { const int r = rr + (lane >> 5), c2 = (lane & 31) * 2; const unsigned v = *(const unsigned*)(zb + (size_t)(r0 + r) * ZW + HYB + cb + c2);
            scr[r * 66 + c2] = (bf16_t)(v & 0xffffu); scr[r * 66 + c2 + 1] = (bf16_t)(v >> 16); }
        LDS_WAIT(); asm volatile("" ::: "memory");
#pragma unroll 8
        for (int cc = 0; cc < 64; cc += 2) { const int c = cc + (lane >> 5), r2 = (lane & 31) * 2;
            *(unsigned*)(zt + (size_t)(cb + c) * NT + r0 + r2) = (unsigned)scr[r2 * 66 + c] | ((unsigned)scr[(r2 + 1) * 66 + c] << 16); }
        LDS_WAIT(); asm volatile("" ::: "memory"); }
}
__device__ __forceinline__ void phase_gdn_c(Ctx& C, int l) {
    const int j0 = (l == 0) ? 0 : NCHC, nj = NCH - j0;
    for (int it = C.bid; it < NB * NH * nj; it += C.G) { const int bh = it / nj, jt = j0 + it % nj; gdn_c_item(C, l, bh / NH, bh % NH, jt); }
    for (int it = (C.bid + C.G / 3) % C.G; it < NB * NH * nj; it += C.G) { const int bh = it / nj, jt = j0 + it % nj; mlstm_c_item(C, l, bh / NH, bh % NH, jt); }
    for (int it = (C.bid + 2 * (C.G / 3)) % C.G; it < NB * NH * nj; it += C.G) { const int bh = it / nj, jt = j0 + it % nj; hgrn_c_item(C, l, bh / NH, bh % NH, jt); }
}

__device__ __forceinline__ f32x2 cmul(f32x2 a, f32x2 w) { return (f32x2){a.x * w.x - a.y * w.y, a.x * w.y + a.y * w.x}; }
__device__ __forceinline__ f32x2 cmulc(f32x2 a, f32x2 w) { return (f32x2){a.x * w.x + a.y * w.y, a.y * w.x - a.x * w.y}; }
template <int N> __device__ __forceinline__ void fft_fwd(LAS f32x2* X, const LAS f32x2* tw, int tid) {
    constexpr int NG = (N / 4 + 511) / 512, NB2 = (N / 2 + 511) / 512;
    int h = N >> 1;
#pragma unroll 1
    for (; h >= 2; h >>= 2) { const float tf = 3.14159265358979f / (float)h; const int hh = h >> 1;
        f32x2 x0[NG], x1[NG], x2[NG], x3[NG], w1[NG]; int bs[NG];
#pragma unroll
        for (int q = 0; q < NG; ++q) { const int j = tid + 512 * q; const int jm = j & (hh - 1); bs[q] = ((j - jm) << 2) + jm;
            if (j < (N >> 2)) { x0[q] = X[bs[q]]; x1[q] = X[bs[q] + hh]; x2[q] = X[bs[q] + h]; x3[q] = X[bs[q] + h + hh]; const float ang = (float)jm * tf; w1[q] = (f32x2){__cosf(ang), -__sinf(ang)}; } }
#pragma unroll
        for (int q = 0; q < NG; ++q) { const int j = tid + 512 * q; if (j < (N >> 2)) {
            const f32x2 w2 = cmul(w1[q], w1[q]);
            const f32x2 a0 = x0[q] + x2[q], a2 = cmul(x0[q] - x2[q], w1[q]), a1 = x1[q] + x3[q]; const f32x2 d13 = cmul(x1[q] - x3[q], w1[q]); const f32x2 a3 = (f32x2){d13.y, -d13.x};
            X[bs[q]] = a0 + a1; X[bs[q] + hh] = cmul(a0 - a1, w2); X[bs[q] + h] = a2 + a3; X[bs[q] + h + hh] = cmul(a2 - a3, w2); } }
        __syncthreads(); }
    if (h == 1) {
        f32x2 a[NB2], b[NB2];
#pragma unroll
        for (int q = 0; q < NB2; ++q) { const int j = tid + 512 * q; if (j < (N >> 1)) { a[q] = X[2 * j]; b[q] = X[2 * j + 1]; } }
#pragma unroll
        for (int q = 0; q < NB2; ++q) { const int j = tid + 512 * q; if (j < (N >> 1)) { X[2 * j] = a[q] + b[q]; X[2 * j + 1] = a[q] - b[q]; } }
        __syncthreads(); }
}
template <int N> __device__ __forceinline__ void fft_inv(LAS f32x2* X, const LAS f32x2* tw, int tid) {
    constexpr int NG = (N / 4 + 511) / 512, NB2 = (N / 2 + 511) / 512;
    constexpr int LOG2N = (N == 8192) ? 13 : (N == 4096) ? 12 : (N == 2048) ? 11 : (N == 1024) ? 10 : (N == 512) ? 9 : (N == 256) ? 8 : (N == 128) ? 7 : (N == 64) ? 6 : -1;
    static_assert(LOG2N > 0, "fft size");
    int h = 2;
    if (LOG2N & 1) {
        f32x2 a[NB2], b[NB2];
#pragma unroll
        for (int q = 0; q < NB2; ++q) { const int j = tid + 512 * q; if (j < (N >> 1)) { a[q] = X[2 * j]; b[q] = X[2 * j + 1]; } }
#pragma unroll
        for (int q = 0; q < NB2; ++q) { const int j = tid + 512 * q; if (j < (N >> 1)) { X[2 * j] = a[q] + b[q]; X[2 * j + 1] = a[q] - b[q]; } }
        __syncthreads(); h = 4; }
#pragma unroll 1
    for (; h <= (N >> 1); h <<= 2) { const float tf = 3.14159265358979f / (float)h; const int hh = h >> 1;
        f32x2 x0[NG], x1[NG], x2[NG], x3[NG], w1[NG]; int bs[NG];
#pragma unroll
        for (int q = 0; q < NG; ++q) { const int j = tid + 512 * q; const int jm = j & (hh - 1); bs[q] = ((j - jm) << 2) + jm;
            if (j < (N >> 2)) { x0[q] = X[bs[q]]; x1[q] = X[bs[q] + hh]; x2[q] = X[bs[q] + h]; x3[q] = X[bs[q] + h + hh]; const float ang = (float)jm * tf; w1[q] = (f32x2){__cosf(ang), -__sinf(ang)}; } }
#pragma unroll
        for (int q = 0; q < NG; ++q) { const int j = tid + 512 * q; if (j < (N >> 2)) {
            const f32x2 w2 = cmul(w1[q], w1[q]);
            const f32x2 b1 = cmulc(x1[q], w2), b3 = cmulc(x3[q], w2); const f32x2 a0 = x0[q] + b1, a1 = x0[q] - b1, a2 = x2[q] + b3, a3 = x2[q] - b3;
            const f32x2 c2 = cmulc(a2, w1[q]); const f32x2 t3 = cmulc(a3, w1[q]); const f32x2 c3 = (f32x2){-t3.y, t3.x};
            X[bs[q]] = a0 + c2; X[bs[q] + h] = a0 - c2; X[bs[q] + hh] = a1 + c3; X[bs[q] + h + hh] = a1 - c3; } }
        __syncthreads(); }
}
__device__ __forceinline__ float block_sum(Ctx& C, float v, LAS float* red) {
    v = wave_sum(v); __syncthreads(); if (C.lane == 0) red[C.wave] = v; __syncthreads();
    float s = 0.f;
#pragma unroll
    for (int i = 0; i < 8; ++i) s += red[i];
    return s;
}
#define FFT_FWD_P(X) do { fft_fwd<N>(X, tw, tid); if ((REPMASK >> 15) & 1) { fft_inv<N>(X, tw, tid); for (int i_ = tid; i_ < N; i_ += 512) X[i_] = X[i_] * (1.0f / (float)N); __syncthreads(); fft_fwd<N>(X, tw, tid); } } while (0)
template <int LEN>
__device__ __forceinline__ void hyena_channel(Ctx& C, int l, int c, int row0, int hoff  ) {
    LAS f32x2* X = (LAS f32x2*)C.lds; LAS f32x2* Y1 = (LAS f32x2*)(C.lds + 65536); const LAS f32x2* tw = (const LAS f32x2*)(C.lds + 98304); LAS float* red = (LAS float*)(C.lds + LDSX_OFF + 128);
    constexpr int N = 2 * LEN, len = LEN, NI = (LEN + 511) / 512;
#ifdef HOST_EMU
    const int tid = C.tid;
#else
    int tid_ = C.tid; asm volatile("" : "+v"(tid_)); const int tid = tid_;
#endif
    f32x2* Ks = WSP(f32x2, WS_KS) + (size_t)C.bid * 2 * FFTN;
    const float* hd = WSP(float, WS_HDN) + ((size_t)l * (SEQ + LC) + hoff) * 64;
    const float* w3 = INP(I_HYW3) + (size_t)l * 64 * 1024;
    const float delta = (-4.605170185988091f / 1.5f + (-4.605170185988091f / 0.3f + 4.605170185988091f / 1.5f) * (float)c / 255.0f);
    const float ad = fabsf(delta);
    LAS f32x4* W3c = (LAS f32x4*)(C.lds + 98304);
    __syncthreads();
    if (tid < 256) { const int j = tid >> 2, q = tid & 3; ((LAS float*)W3c)[tid] = w3[j * 1024 + (q & 1) * 512 + (q >> 1) * 256 + c]; }
    __syncthreads();
    float ss0 = 0.f, ss1 = 0.f;
    for (int p = tid; p < len; p += 512) { const float* hr = hd + (size_t)p * 64; f32x4 acc = (f32x4){0.f, 0.f, 0.f, 0.f};
#pragma unroll 16
        for (int j = 0; j < 64; ++j) acc = acc + W3c[j] * hr[j];
        const float win = __expf(-((float)p / (float)(len - 1)) * ad); acc = acc * win;
        X[p] = (f32x2){acc.x, 0.f}; ss0 += acc.x * acc.x; ss1 += acc.z * acc.z;
        if (p >= 1) { X[N - p] = (f32x2){acc.y, 0.f}; ss0 += acc.y * acc.y; ss1 += acc.w * acc.w; }
        Y1[p] = (f32x2){acc.z, acc.w}; }
    if (tid == 0) X[len] = (f32x2){0.f, 0.f};
    const float scale0 = 1.f / sqrtf(block_sum(C, ss0, red) + EPS), scale1 = 1.f / sqrtf(block_sum(C, ss1, red) + EPS);
    __syncthreads();
    for (int n = 0; n < 2 + 2 * ((REPMASK >> 16) & 1); ++n) {
        if (n & 1) { for (int p = tid; p < len; p += 512) { const f32x2 t1 = Y1[p]; X[p] = (f32x2){t1.x, 0.f}; if (p >= 1) X[N - p] = (f32x2){t1.y, 0.f}; } if (tid == 0) X[len] = (f32x2){0.f, 0.f}; __syncthreads(); }
        FFT_FWD_P(X);
        const float scale = (n & 1) ? scale1 : scale0;
        for (int i = tid; i < N; i += 512) Ks[(size_t)(n & 1) * FFTN + i] = X[i] * scale;
        __syncthreads();
    }
    const bf16_t* zt = WSP(bf16_t, WS_ZT); const float* cw = INP(I_HYCW) + l * 3 * 768; const float* cb = INP(I_HYCB) + l * 768;
    const float bias0 = INP(I_HYBI)[l * 512 + c], bias1 = INP(I_HYBI)[l * 512 + 256 + c];
    float* hyt = WSP(float, WS_HYT) + (size_t)c * NT;
    const float inv_n = 1.0f / (float)N;
    const float cw0[3] = {cw[c], cw[768 + c], cw[1536 + c]}, cw1[3] = {cw[256 + c], cw[768 + 256 + c], cw[1536 + 256 + c]}, cw2[3] = {cw[512 + c], cw[768 + 512 + c], cw[1536 + 512 + c]};
    const float cb0 = cb[c], cb1 = cb[256 + c], cb2 = cb[512 + c];
    const bf16_t* z0 = zt + (size_t)c * NT; const bf16_t* z1 = zt + (size_t)(256 + c) * NT; const bf16_t* z2 = zt + (size_t)(512 + c) * NT;
    LAS f32x2* X1 = Y1;
    LAS f32x2* X2 = (LAS f32x2*)(C.lds + 98304);
    LAS bf16_t* RAW = (LAS bf16_t*)(X + len);
    constexpr int RS = LEN + 16;
    for (int q2 = 0; q2 < NB * (1 + ((REPMASK >> 17) & 1)); q2 += 2) { const int q = q2 % NB;
        const int ra = row0 + q * len, rb = ra + len;
        float va[NI], vb[NI];
#pragma unroll
        for (int col = 0; col < 3; ++col) { const bf16_t* zc = col == 0 ? z0 : (col == 1 ? z1 : z2); const float* wv = col == 0 ? cw0 : (col == 1 ? cw1 : cw2); const float bv = col == 0 ? cb0 : (col == 1 ? cb1 : cb2);
            if (8 * tid < len) { *(LAS u32x4*)(RAW + 8 + 8 * tid) = *(const u32x4*)(zc + ra + 8 * tid); *(LAS u32x4*)(RAW + RS + 8 + 8 * tid) = *(const u32x4*)(zc + rb + 8 * tid); }
            if (tid == 0) { RAW[7] = 0; RAW[8 + len] = 0; RAW[RS + 7] = 0; RAW[RS + 8 + len] = 0; }
            __syncthreads();
#pragma unroll
            for (int k = 0; k < NI; ++k) { const int t = tid + 512 * k; if (t < len) {
                const float ca = bv + wv[0] * bf2f(RAW[7 + t]) + wv[1] * bf2f(RAW[8 + t]) + wv[2] * bf2f(RAW[9 + t]);
                const float cbv = bv + wv[0] * bf2f(RAW[RS + 7 + t]) + wv[1] * bf2f(RAW[RS + 8 + t]) + wv[2] * bf2f(RAW[RS + 9 + t]);
                if (col == 0) { va[k] = ca; vb[k] = cbv; X[t] = (f32x2){ca, cbv}; } else if (col == 1) X1[t] = (f32x2){ca, cbv}; else X2[t] = (f32x2){ca, cbv}; } }
            __syncthreads(); }
#pragma unroll
        for (int k = 0; k < NI; ++k) { const int t = tid + 512 * k; if (t < len) X[len + t] = (f32x2){0.f, 0.f}; }
        __syncthreads();
        FFT_FWD_P(X);
#pragma unroll 1
        for (int k0 = 0; k0 < 2 * NI; k0 += 8) { f32x2 kv_[8], xv_[8];
#pragma unroll
        for (int k = 0; k < 8; ++k) { const int i = tid + 512 * (k0 + k); if (i < N) { kv_[k] = Ks[i]; xv_[k] = X[i]; } }
#pragma unroll
        for (int k = 0; k < 8; ++k) { const int i = tid + 512 * (k0 + k); if (i < N) X[i] = cmul(xv_[k], kv_[k]); } }
        __syncthreads();
        fft_inv<N>(X, tw, tid);
        f32x2 y1[NI];
#pragma unroll
        for (int k = 0; k < NI; ++k) { const int t = tid + 512 * k; if (t < len) { const f32x2 cv = X[t] * inv_n, x1 = X1[t];
            y1[k] = (f32x2){x1.x * (cv.x + bias0 * va[k]), x1.y * (cv.y + bias0 * vb[k])}; } }
        __syncthreads();
#pragma unroll
        for (int k = 0; k < NI; ++k) { const int t = tid + 512 * k; if (t < len) { X[t] = y1[k]; X[len + t] = (f32x2){0.f, 0.f}; } }
        __syncthreads();
        FFT_FWD_P(X);
#pragma unroll 1
        for (int k0 = 0; k0 < 2 * NI; k0 += 8) { f32x2 kv_[8], xv_[8];
#pragma unroll
        for (int k = 0; k < 8; ++k) { const int i = tid + 512 * (k0 + k); if (i < N) { kv_[k] = Ks[FFTN + i]; xv_[k] = X[i]; } }
#pragma unroll
        for (int k = 0; k < 8; ++k) { const int i = tid + 512 * (k0 + k); if (i < N) X[i] = cmul(xv_[k], kv_[k]); } }
        __syncthreads();
        fft_inv<N>(X, tw, tid);
#pragma unroll
        for (int k = 0; k < NI; ++k) { const int t = tid + 512 * k; if (t < len) { const f32x2 cv = X[t] * inv_n, yy = y1[k], x2 = X2[t];
            hyt[ra + t] = x2.x * (cv.x + bias1 * yy.x); hyt[rb + t] = x2.y * (cv.y + bias1 * yy.y); } }
        __syncthreads();
    }
}
__device__ __forceinline__ void phase_mixers(Ctx& C, int l, int parts = 3) {
    const int G = C.G, me = C.bid;
    const int nscan = 3 * NSCAN, nsw = G > nscan ? nscan : G;
    if (parts & 1) for (int j = me; j < nscan; j += nsw) { if (me >= nsw) break;
        const int mix = j / NSCAN, r = j % NSCAN;
        if (mix == 0) { if (!(parts & 32) || (parts & 4)) hgrn_b_scan(C, r); } else if (mix == 1) { if (!(parts & 32) || (parts & 8)) mlstm_b_scan(C, r); } else { if (!(parts & 32) || (parts & 16)) gdn_b_scan(C, r); } }
    if (parts & 2) {
        LAS f32x2* tw = (LAS f32x2*)(C.lds + 98304); volatile LAS int* jobw = (volatile LAS int*)(C.lds + LDSX_OFF + 192);
        __syncthreads();
        for (int k = C.tid; k < TWN; k += 512) { float s, c; sincospi_((float)k / (float)TWN, &s, &c); tw[k] = (f32x2){c, -s}; }
        __syncthreads();
        unsigned* qh = WSP(unsigned, WS_CTL) + CW_HYQ + 64 * l + ((parts == 2) ? 32 : 0) + ((parts & 64) ? 16 : 0);
        for (;;) {
            if (C.tid == 0) jobw[0] = (int)atomicAdd(qh, 1u);
            __syncthreads();
            const int c = jobw[0];
            __syncthreads();
            if (c >= 256) break;
            hyena_channel<SEQ>(C, l, c, 0, 0); if (l == 0) hyena_channel<LC>(C, l, c, NLAT, SEQ);
        }
    }
}
__device__ __forceinline__ void phase_finalize(Ctx& C, int l) {
    const int gw = C.vcu * 8 + C.wave, NGW = C.G * 8, lane = C.lane;
    const int nrows = (l == 0) ? NT : NLAT;
    const bf16_t* zb = WSP(bf16_t, WS_Z); bf16_t* mix = WSP(bf16_t, WS_MIX);
    LAS float* scr = (LAS float*)(C.lds + C.wave * 8448);
    const int ntr = nrows / 64;
    for (int it = gw; it < ntr * 8; it += NGW) { const int rt = it / 8, cb = (it % 8) * 32; const float* src = WSP(float, WS_HYT) + (size_t)cb * NT + rt * 64;
#pragma unroll 8
        for (int cc = 0; cc < 32; ++cc) scr[cc * 65 + lane] = src[(size_t)cc * NT + lane];
        LDS_WAIT(); asm volatile("" ::: "memory");
        for (int rr = 0; rr < 64; rr += 4) { const int r = rr + (lane >> 4), c2 = (lane & 15) * 2;
            *(unsigned*)(mix + (size_t)(rt * 64 + r) * D + 512 + cb + c2) = pk2(scr[c2 * 65 + r], scr[(c2 + 1) * 65 + r]); }
        LDS_WAIT(); asm volatile("" ::: "memory"); }
}

enum { PH_PRO = 0, PH_L0 = 1, PH_PER_LAYER = 10, PH_FINAL = PH_L0 + DEPTH * PH_PER_LAYER, PH_COUNT };
__global__ void __launch_bounds__(512, 2) fwd_kernel(Args args) {
#ifdef HOST_EMU
    unsigned char* lds = emu::cur->blk->lds;
#else
    extern __shared__ __attribute__((aligned(16))) unsigned char lds[];
#endif
#ifdef HOST_EMU
    Ctx C; C.lds = (LAS unsigned char*)lds; C.a = &args; C.ws = args.ws;
#else
    Ctx C; C.lds = (LAS unsigned char*)lds; C.a = (const __attribute__((address_space(4))) Args*)__builtin_amdgcn_kernarg_segment_ptr(); C.ws = C.a->ws;
#endif
    C.tid = threadIdx.x; C.lane = C.tid & 63; C.wave = __builtin_amdgcn_readfirstlane(C.tid >> 6);
    C.bid = blockIdx.x; C.G = gridDim.x; { const int bx = blockIdx.x; C.vcu = (C.G % 8 == 0) ? (bx % 8) * (C.G / 8) + bx / 8 : bx; }
    volatile LAS unsigned* MISC = (volatile LAS unsigned*)(C.lds + LDSX_OFF + LX_MISC);
    for (int u = C.tid; u < 64; u += 512) MISC[u] = 0u;
    __syncthreads();
    const int lo = C.a->ph_lo, hi = C.a->ph_hi;
    const bool multi = (hi - lo) > 1;
    XcdBarrier bar; bar.bar = WSP(unsigned, WS_CTL) + CW_BAR; bar.x = 0; bar.st = nullptr;
    if (multi) bar = xcd_barrier_post(WSP(unsigned, WS_CTL) + CW_BAR, MISC + 8);
#ifndef HOST_EMU
    if (multi) { cooperative_groups::this_grid().sync(); }
#endif
    const Ctx C0 = C;
#ifdef HOST_EMU
#define LAUNDER_CTX() Ctx C = C0; C.tid = threadIdx.x; C.lane = C.tid & 63; C.wave = C.tid >> 6;
#else
#define LAUNDER_CTX() Ctx C = C0; C.tid = threadIdx.x; \
        {   unsigned long long pw = (unsigned long long)C.ws, pa = (unsigned long long)C.a; unsigned w0 = (unsigned)pw, w1 = (unsigned)(pw >> 32), a0 = (unsigned)pa, a1 = (unsigned)(pa >> 32), v0 = (unsigned)C.vcu, g0 = (unsigned)C.G, b0 = (unsigned)C.bid; \
            asm volatile("" : "+v"(w0), "+v"(w1), "+v"(a0), "+v"(a1), "+v"(v0), "+v"(g0), "+v"(b0), "+v"(C.tid)); \
            w0 = __builtin_amdgcn_readfirstlane(w0); w1 = __builtin_amdgcn_readfirstlane(w1); a0 = __builtin_amdgcn_readfirstlane(a0); a1 = __builtin_amdgcn_readfirstlane(a1); \
            C.vcu = (int)__builtin_amdgcn_readfirstlane(v0); C.G = (int)__builtin_amdgcn_readfirstlane(g0); C.bid = (int)__builtin_amdgcn_readfirstlane(b0); \
            C.ws = (unsigned char*)(((unsigned long long)w1 << 32) | w0); C.a = (const __attribute__((address_space(4))) Args*)(((unsigned long long)a1 << 32) | a0); } \
        C.lane = C.tid & 63; C.wave = __builtin_amdgcn_readfirstlane(C.tid >> 6);
#endif
#define PH_BEGIN(k) if (lo <= (k) && (k) < hi) { LAUNDER_CTX()
#define PH_END(k) if ((k) + 1 < hi) { XcdBarrier b2 = bar; b2.bar = WSP(unsigned, WS_CTL) + CW_BAR; xcd_barrier(b2); if ((REPMASK >> 22) & 1) xcd_barrier(b2); } }
#define REP(b) ((REPMASK >> (b)) & 1)
    PH_BEGIN(PH_PRO) p0_prologue(C); if (REP(0)) { __syncthreads(); p0_prologue(C); } PH_END(PH_PRO)
#define LAYER_PHASES(l) { constexpr int pb = PH_L0 + (l) * PH_PER_LAYER; \
    PH_BEGIN(pb + 0) if ((l) > 0) (void)build_tiles(C, (l) > 0 ? (l) - 1 : 0); phase_rows_a(C, (l)); if (REP(13) && (l) == 0) { __syncthreads(); phase_rows_a(C, (l)); } PH_END(pb + 0) \
    PH_BEGIN(pb + 1) pg8::Gemm g{WSP(bf16_t, WS_H), WSP(bf16_t, WS_WIN) + (size_t)(l) * ZW * D, D, 0}; pg8::StaticOrder S; S.init(NT, ZW, C.G, C.bid); \
        pg8::EpiBf16 E{WSP(bf16_t, WS_Z), ZW, nullptr, 0}; pg8::gemm_phase(C.lds, g, S, E, C.tid); if (REP(1)) { __syncthreads(); pg8::gemm_phase(C.lds, g, S, E, C.tid); } PH_END(pb + 1) \
    PH_BEGIN(pb + 2) phase_hy_transpose(C); __syncthreads(); phase_gdn_a(C, (l)); if (REP(8)) { __syncthreads(); phase_gdn_a(C, (l)); } PH_END(pb + 2) \
    PH_BEGIN(pb + 3) phase_mixers(C, (l)); if (REP(2)) { __syncthreads(); phase_mixers(C, (l), 1); } if (REP(26)) { __syncthreads(); phase_mixers(C, (l), 3 | 64); } if (REP(23)) { __syncthreads(); phase_mixers(C, (l), 1 | 32 | 4); } if (REP(24)) { __syncthreads(); phase_mixers(C, (l), 1 | 32 | 8); } if (REP(25)) { __syncthreads(); phase_mixers(C, (l), 1 | 32 | 16); } if (REP(3)) { __syncthreads(); phase_mixers(C, (l), 2); } PH_END(pb + 3) \
    PH_BEGIN(pb + 4) phase_finalize(C, (l)); __syncthreads(); phase_gdn_c(C, (l)); if (REP(4)) { __syncthreads(); phase_finalize(C, (l)); } if (REP(9)) { __syncthreads(); phase_gdn_c(C, (l)); } PH_END(pb + 4) \
    PH_BEGIN(pb + 5) pg8::Gemm g{WSP(bf16_t, WS_MIX), WSP(bf16_t, WS_WOUT) + (size_t)(l) * D * D, D, 0}; pg8::StaticOrder S; S.init((l) == 0 ? NT : NLAT, D, C.G, C.bid); \
        pg8::EpiResid E{(l) == 0 ? INP(I_X) : WSP(float, WS_X), (l) == 0 ? INP(I_CTX) : WSP(float, WS_X) + (size_t)NLAT * D, WSP(float, WS_X), WSP(float, WS_MOD) + (size_t)(l) * (NB + 1) * 6 * D + 2 * D}; \
        pg8::gemm_phase(C.lds, g, S, E, C.tid); if (REP(14) && (l) == 0) { __syncthreads(); pg8::gemm_phase(C.lds, g, S, E, C.tid); } PH_END(pb + 5) \
    PH_BEGIN(pb + 6) phase_rows_b(C, (l)); PH_END(pb + 6) \
    PH_BEGIN(pb + 7) phase_gather(C, (l)); if (REP(5)) { __syncthreads(); phase_gather(C, (l)); } PH_END(pb + 7) \
    PH_BEGIN(pb + 8) const int ntiles = build_tiles(C, (l)); \
        pg8::Gemm g{WSP(bf16_t, WS_HS), WSP(bf16_t, WS_W1) + (size_t)(l) * NE * 2 * DE * D, D, (size_t)2 * DE * D}; pg8::MoeOrder S; S.init(ntiles, 2 * DE, C.G, C.bid, (const LAS int*)(C.lds + LDSX_OFF + LX_TILE)); \
        pg8::EpiSwiglu E{WSP(bf16_t, WS_A2), INP(I_EB1) + (size_t)(l) * NE * 2 * DE}; pg8::gemm_phase(C.lds, g, S, E, C.tid); if (REP(6)) { __syncthreads(); pg8::gemm_phase(C.lds, g, S, E, C.tid); } PH_END(pb + 8) \
    PH_BEGIN(pb + 9) const int ntiles = build_tiles(C, (l)); \
        pg8::Gemm g{WSP(bf16_t, WS_A2), WSP(bf16_t, WS_W2) + (size_t)(l) * NE * D * DE, DE, (size_t)D * DE}; pg8::MoeOrder S; S.init(ntiles, D, C.G, C.bid, (const LAS int*)(C.lds + LDSX_OFF + LX_TILE)); \
        pg8::EpiBf16 E{WSP(bf16_t, WS_Y), D, INP(I_EB2) + (size_t)(l) * NE * D, D}; pg8::gemm_phase(C.lds, g, S, E, C.tid); if (REP(7)) { __syncthreads(); pg8::gemm_phase(C.lds, g, S, E, C.tid); } PH_END(pb + 9) }
    LAYER_PHASES(0)
    LAYER_PHASES(1)
    static_assert(DEPTH == 2, "two layers written out");
    PH_BEGIN(PH_FINAL) (void)build_tiles(C, DEPTH - 1); phase_rows_a(C, DEPTH); PH_END(PH_FINAL)
}

#ifndef MK_PER_PHASE
#define MK_PER_PHASE 0
#endif
extern "C" void kernel_launch(void* const* d_in, const int* in_sizes, int n_in, void* d_out, int out_size, void* d_ws, size_t ws_size, hipStream_t stream) {
    static int grid = 0;
#ifndef HOST_EMU
    if (grid == 0) {
        if (n_in != 34 || ws_size < WS_END) { fprintf(stderr, "kernel_launch: unexpected n_in %d / ws %zu (need %zu)\n", n_in, ws_size, (size_t)WS_END); grid = -1; return; }
        int dev = 0, cus = 0, per_cu = 0;
        hipGetDevice(&dev); hipDeviceGetAttribute(&cus, hipDeviceAttributeMultiprocessorCount, dev);
        hipFuncSetAttribute((const void*)fwd_kernel, hipFuncAttributeMaxDynamicSharedMemorySize, LDS_BYTES);
        hipOccupancyMaxActiveBlocksPerMultiprocessor(&per_cu, (const void*)fwd_kernel, 512, LDS_BYTES);
        if (per_cu < 1) { fprintf(stderr, "kernel_launch: occupancy query says %d blocks per CU\n", per_cu); per_cu = 1; }
        grid = cus;
        (void)hipGetLastError();
    }
    if (grid < 0) return;
#else
    grid = EMU_GRID;
#endif
    hipMemsetAsync((char*)d_ws + WS_CTL, 0, CTL_BYTES, stream);
    Args a{};
    for (int i = 0; i < 34; ++i) a.in[i] = (const float*)d_in[i];
    a.out = (float*)d_out; a.ws = (unsigned char*)d_ws;
#ifdef HOST_EMU
    a.ph_lo = 0; a.ph_hi = PH_COUNT;
    if (getenv("EMU_PH_HI")) a.ph_hi = atoi(getenv("EMU_PH_HI"));
    emu::launch([&]() { fwd_kernel(a); }, dim3(grid), dim3(512), LDS_BYTES);
#else
#if MK_PER_PHASE
    for (int ph = 0; ph < PH_COUNT; ++ph) { a.ph_lo = ph; a.ph_hi = ph + 1; hipLaunchKernelGGL(fwd_kernel, dim3(grid), dim3(512), LDS_BYTES, stream, a); }
#else
    a.ph_lo = 0; a.ph_hi = PH_COUNT;
    void* kargs[] = {&a};
    hipError_t e = hipLaunchCooperativeKernel((const void*)fwd_kernel, dim3(grid), dim3(512), kargs, LDS_BYTES, stream);
    if (e != hipSuccess) fprintf(stderr, "cooperative launch failed: %s (grid %d)\n", hipGetErrorString(e), grid);
#endif
#endif
}
```

```cpp
#ifdef HOST_EMU
#include "host/emu.h"
#else
#include <hip/hip_runtime.h>
#include <hip/hip_cooperative_groups.h>
#endif
#include <cstdio>
#include <cstdint>
#include <cmath>
#ifndef REPMASK
#define REPMASK 0
#endif
#ifndef TMASK
#define TMASK 0
#endif

#ifndef CFG_B
#define CFG_B 4
#define CFG_L 4096
#define CFG_GW 64
#define CFG_LC 256
#define CFG_NE 32
#endif
constexpr int NB = CFG_B, SEQ = CFG_L, GW = CFG_GW, GROWS = SEQ / GW, LC = CFG_LC, NE = CFG_NE, TOPK = 4, DEPTH = 2;
constexpr int D = 1024, WG_ = 256, NH = 4, DH = 64;
constexpr int NLAT = NB * SEQ, NCTX = NB * LC, NT = NLAT + NCTX;
constexpr int IN_W = 4128, ZW = 4096;
constexpr int HGB = 0, MLB = 1280, HYB = 2304, GDB = 3072;
constexpr int DE = 1024;
constexpr float EPS = 1e-6f;
constexpr int FFTN = 2 * SEQ, FFTNC = 2 * LC, TWN = FFTN / 2;
static_assert(NT % 256 == 0 && NLAT % 256 == 0, "row counts must be multiples of 256");
static_assert(SEQ % 16 == 0 && LC % 16 == 0, "chunking");
constexpr int MAXTILES = (NT * TOPK + NE * 255) / 256 + 1;

constexpr size_t al256(size_t x) { return (x + 255) & ~(size_t)255; }
constexpr size_t WS_CTL = 0, CTL_BYTES = 1 << 20;
constexpr size_t WS_WIN = WS_CTL + CTL_BYTES;
constexpr size_t WS_WOUT = WS_WIN + (size_t)DEPTH * ZW * D * 2;
constexpr size_t WS_W1 = WS_WOUT + (size_t)DEPTH * D * D * 2;
constexpr size_t WS_W2 = WS_W1 + (size_t)DEPTH * NE * 2 * DE * D * 2;
constexpr size_t WS_WG = WS_W2 + (size_t)DEPTH * NE * D * DE * 2;
constexpr size_t WS_WR = WS_WG + (size_t)DEPTH * 32 * D * 4;
constexpr size_t WS_MOD = WS_WR + (size_t)DEPTH * NE * D * 4;
constexpr size_t WS_LB = WS_MOD + al256((size_t)DEPTH * (NB + 1) * 6 * D * 4);
constexpr size_t WS_HDN = WS_LB + (size_t)DEPTH * 256 * 4;
constexpr size_t WS_X = WS_HDN + (size_t)DEPTH * (SEQ + LC) * 64 * 4;
constexpr size_t WS_H = WS_X + (size_t)NT * D * 4;
constexpr size_t WS_Z = WS_H + (size_t)NT * D * 2;
constexpr size_t WS_ZG = WS_Z + (size_t)NT * ZW * 2;
constexpr size_t WS_MIX = WS_ZG + (size_t)NT * 32 * 4;
constexpr size_t WS_OB = WS_MIX + (size_t)NT * D * 2;
constexpr size_t WS_HYT = WS_OB + (size_t)6 * NT * 256 * 4;
constexpr size_t WS_KS = WS_HYT + (size_t)256 * NT * 4;
constexpr size_t WS_TOP = WS_KS + (size_t)256 * 2 * FFTN * 8;
constexpr size_t WS_HS = WS_TOP + (size_t)NT * 4 * 12;
constexpr size_t WS_A2 = WS_HS + (size_t)MAXTILES * 256 * D * 2;
constexpr size_t WS_Y = WS_A2 + (size_t)MAXTILES * 256 * DE * 2;
constexpr int NCH = (LC + SEQ) / 64, NCHC = LC / 64, NSCAN = NB * NH * 2;
constexpr size_t GD_BLOB = 32768;
constexpr size_t WS_GD = WS_Y + (size_t)MAXTILES * 256 * D * 2;
constexpr size_t WS_GST = WS_GD + (size_t)NSCAN * NCH * GD_BLOB;
constexpr size_t ML_BLOB = 17920;
constexpr size_t WS_ML = WS_GST + (size_t)NSCAN * NCH * 8192;
constexpr size_t ML_ST = 8192 + 512;
constexpr size_t WS_MST = WS_ML + (size_t)NSCAN * NCH * ML_BLOB;
constexpr size_t HG_BLOB = 50176;
constexpr size_t WS_HG = WS_MST + (size_t)NSCAN * NCH * ML_ST;
constexpr size_t WS_HST = WS_HG + (size_t)NSCAN * NCH * HG_BLOB;
constexpr size_t WS_ZT = WS_HST + (size_t)NSCAN * NCH * 4 * 8192;
constexpr size_t WS_END = WS_ZT + (size_t)768 * NT * 2;
static_assert(SEQ % 64 == 0 && LC % 64 == 0, "64-token chunks");
constexpr int CW_CNT = 64;
constexpr int CW_HYQ = 192;
constexpr int CW_BAR = 4096;

constexpr int RING_BYTES = 131072, LDSX_OFF = RING_BYTES, LDS_BYTES = 147456;
constexpr int LX_MISC = 0, LX_TILE = 256;

#ifdef HOST_EMU
#define __expf expf
#define __logf logf
#define __sinf sinf
#define __cosf cosf
#define LAS
#define GAS
#define DEV_ASM(x) ((void)0)
#define VM_WAIT() ((void)0)
#define LDS_WAIT() do { int _s; (void)emu::wave_xchg(&_s, 4, _s); } while (0)
#else
#define LAS __attribute__((address_space(3)))
#define GAS __attribute__((address_space(1)))
#define VM_WAIT() asm volatile("s_waitcnt vmcnt(0)" ::: "memory")
#define LDS_WAIT() asm volatile("s_waitcnt lgkmcnt(0)" ::: "memory")
#endif
typedef unsigned short bf16_t;
typedef short bf16x8 __attribute__((ext_vector_type(8)));
typedef float f32x4 __attribute__((ext_vector_type(4)));
typedef float f32x2 __attribute__((ext_vector_type(2)));
typedef unsigned u32x4 __attribute__((ext_vector_type(4)));
typedef unsigned u32x2 __attribute__((ext_vector_type(2)));

__device__ __forceinline__ float u2f(unsigned u) { float f; __builtin_memcpy(&f, &u, 4); return f; }
__device__ __forceinline__ unsigned f2u(float f) { unsigned u; __builtin_memcpy(&u, &f, 4); return u; }
__device__ __forceinline__ float bf2f(bf16_t b) { return u2f((unsigned)b << 16); }
__device__ __forceinline__ unsigned f2bf(float f) { unsigned u = f2u(f); return (u + 0x7fffu + ((u >> 16) & 1u)) >> 16; }
__device__ __forceinline__ unsigned pk2(float lo, float hi) { return f2bf(lo) | (f2bf(hi) << 16); }
__device__ __forceinline__ unsigned cvt_pk_bf16(float lo, float hi) {
#ifdef HOST_EMU
    return pk2(lo, hi);
#else
    unsigned r; asm volatile("v_cvt_pk_bf16_f32 %0, %1, %2" : "=v"(r) : "v"(lo), "v"(hi)); return r;
#endif
}
__device__ __forceinline__ float wave_sum(float v) {
#pragma unroll
    for (int o = 1; o < 64; o <<= 1) v += __shfl_xor(v, o);
    return v;
}
__device__ __forceinline__ float sigmoidf_(float x) { return 1.f / (1.f + __expf(-x)); }
__device__ __forceinline__ float siluf_(float x) { return x * sigmoidf_(x); }
__device__ __forceinline__ float softplusf_(float x) { return x > 20.f ? x : log1pf(__expf(x)); }
__device__ __forceinline__ float logsigmoidf_(float x) { return x < -20.f ? x : -log1pf(__expf(-x)); }
#ifdef HOST_EMU
static inline void sincospi_(float x, float* s, float* c) { *s = (float)sin(M_PI * (double)x); *c = (float)cos(M_PI * (double)x); }
#else
__device__ __forceinline__ void sincospi_(float x, float* s, float* c) { sincospif(x, s, c); }
#endif

namespace pg8 {
constexpr int BM = 256, BK = 64, HALF = 128, HTB = HALF * BK * 2, STAGE_BYTES = 8 * HTB, NXCD = 8, WGM = 8;
__host__ __device__ __forceinline__ int lds_byte(int r, int c) { const int st = (r >> 4) * 2 + (c >> 5), rr = r & 15, cc = c & 31, ob = rr * 64 + cc * 2; return st * 1024 + (ob ^ (((ob >> 9) & 1) << 5)); }
__host__ __device__ __forceinline__ void stage_rc(int b, int& R, int& C) { const int st = b / 1024, sb = b % 1024, swz = sb ^ (((sb >> 9) & 1) << 5); R = (st >> 1) * 16 + swz / 64; C = (st & 1) * 32 + (swz % 64) / 2; }
__host__ __device__ __forceinline__ int perm32(int rho) { const int n = rho >> 4, i = rho & 15; return 8 * (i >> 2) + 4 * n + (i & 3); }

struct Unit { int pm, pn, e; };
struct Gemm { const bf16_t* A; const bf16_t* Bt; int K; size_t bexp; };

__host__ __device__ __forceinline__ int xcd_remap(int L, int nwg) { const int q = nwg / NXCD, r = nwg % NXCD, xcd = L % NXCD, off = L / NXCD; return (xcd < r ? xcd * (q + 1) : r * (q + 1) + (xcd - r) * q) + off; }
struct StaticOrder {
    int nM, nN, nwg, G, c;
    __host__ __device__ void init(int M, int N, int G_, int c_) { nM = M / BM; nN = N / BM; nwg = nM * nN; G = G_; c = c_; }
    __host__ __device__ bool next(int i, Unit& u) const {
        const long L = (long)i * G + c; if (L >= nwg) return false;
        const int wgid = xcd_remap((int)L, nwg);
        const int nig = WGM * nN, gid = wgid / nig, fm = gid * WGM, gsz = (nM - fm) < WGM ? (nM - fm) : WGM;
        u.pm = fm + ((wgid % nig) % gsz); u.pn = (wgid % nig) / gsz; u.e = 0; return true;
    }
};
struct MoeOrder {
    int ntiles, nN, nwg, G, c; const LAS int* tile_e;
    __device__ void init(int ntiles_, int N, int G_, int c_, const LAS int* te) { ntiles = ntiles_; nN = N / BM; nwg = ntiles * nN; G = G_; c = c_; tile_e = te; }
    __device__ bool next(int i, Unit& u) const {
        const long L = (long)i * G + c; if (L >= nwg) return false;
        const int wgid = xcd_remap((int)L, nwg);
        u.pm = wgid / nN; u.pn = wgid % nN; u.e = __builtin_amdgcn_readfirstlane(tile_e[u.pm]); return true;
    }
};

struct EpiBf16 {
    static constexpr bool PERM = true;
    bf16_t* O; int ldc; const float* bias; int bias_estride;
    __device__ __forceinline__ void operator()(const f32x4 (&acc)[2][2][4][2], const Unit& u, int wr, int wc, int fr, int fq) const {
        const int row0 = u.pm * BM + wr * 64 + fr, col0 = u.pn * BM + wc * 32 + 8 * fq;
        f32x4 bv[2][2];
#pragma unroll
        for (int bj = 0; bj < 2; ++bj)
#pragma unroll
            for (int n = 0; n < 2; ++n) bv[bj][n] = bias ? *(const f32x4*)(bias + (size_t)u.e * bias_estride + col0 + bj * HALF + 4 * n) : (f32x4){0.f, 0.f, 0.f, 0.f};
#pragma unroll
        for (int ai = 0; ai < 2; ++ai)
#pragma unroll
            for (int m = 0; m < 4; ++m) { bf16_t* rowp = O + (size_t)(row0 + ai * HALF + m * 16) * ldc + col0;
#pragma unroll
                for (int bj = 0; bj < 2; ++bj) { const f32x4 v0 = acc[ai][bj][m][0] + bv[bj][0], v1 = acc[ai][bj][m][1] + bv[bj][1];
                    u32x4 w; w.x = cvt_pk_bf16(v0[0], v0[1]); w.y = cvt_pk_bf16(v0[2], v0[3]); w.z = cvt_pk_bf16(v1[0], v1[1]); w.w = cvt_pk_bf16(v1[2], v1[3]);
                    *(u32x4*)(rowp + bj * HALF) = w; } }
    }
};
struct EpiSwiglu {
    static constexpr bool PERM = true;
    bf16_t* O; const float* b1;
    __device__ __forceinline__ void operator()(const f32x4 (&acc)[2][2][4][2], const Unit& u, int wr, int wc, int fr, int fq) const {
        const int row0 = u.pm * BM + wr * 64 + fr, cj = u.pn * HALF + wc * 32 + 8 * fq;
        const float* bb = b1 + (size_t)u.e * 2 * DE;
        f32x4 bg[2], bl[2];
#pragma unroll
        for (int n = 0; n < 2; ++n) { bg[n] = *(const f32x4*)(bb + cj + 4 * n); bl[n] = *(const f32x4*)(bb + DE + cj + 4 * n); }
#pragma unroll
        for (int ai = 0; ai < 2; ++ai)
#pragma unroll
            for (int m = 0; m < 4; ++m) { bf16_t* rowp = O + (size_t)(row0 + ai * HALF + m * 16) * DE + cj;
                float y[8];
#pragma unroll
                for (int n = 0; n < 2; ++n) { const f32x4 g = acc[ai][0][m][n] + bg[n], l = acc[ai][1][m][n] + bl[n];
#pragma unroll
                    for (int j = 0; j < 4; ++j) { const float gg = fminf(g[j], 7.0f), ll = fminf(fmaxf(l[j], -7.0f), 7.0f); y[4 * n + j] = (ll + 1.0f) * gg * (1.f / (1.f + __expf(-1.702f * gg))); } }
                u32x4 w; w.x = cvt_pk_bf16(y[0], y[1]); w.y = cvt_pk_bf16(y[2], y[3]); w.z = cvt_pk_bf16(y[4], y[5]); w.w = cvt_pk_bf16(y[6], y[7]);
                *(u32x4*)rowp = w; }
    }
};
struct EpiResid {
    static constexpr bool PERM = false;
    const float* base0; const float* base1; float* out; const float* g;
    __device__ __forceinline__ void operator()(const f32x4 (&acc)[2][2][4][2], const Unit& u, int wr, int wc, int fr, int fq) const {
        const int col0 = u.pn * BM + wc * 32 + 4 * fq;
#pragma unroll
        for (int ai = 0; ai < 2; ++ai)
#pragma unroll
            for (int m = 0; m < 4; ++m) { const int r = u.pm * BM + ai * HALF + wr * 64 + m * 16 + fr;
                const float* bp = (r < NLAT) ? base0 + (size_t)r * D : base1 + (size_t)(r - NLAT) * D; const int bb = (r < NLAT) ? r / SEQ : NB;
                const float* gp = g + (size_t)bb * 6 * D;
#pragma unroll
                for (int bj = 0; bj < 2; ++bj)
#pragma unroll
                    for (int n = 0; n < 2; ++n) { const int c = col0 + bj * HALF + n * 16; const f32x4 bs = *(const f32x4*)(bp + c), gv = *(const f32x4*)(gp + c);
                        *(f32x4*)(out + (size_t)r * D + c) = bs + gv * acc[ai][bj][m][n]; } }
    }
};

#ifdef HOST_EMU
#define PG8_WAIT_V(n) ((void)0)
#define PG8_WAIT_L(n) ((void)0)
#else
#define PG8_WAIT_V(n) asm volatile("s_waitcnt vmcnt(" #n ")" ::: "memory")
#define PG8_WAIT_L(n) asm volatile("s_waitcnt lgkmcnt(" #n ")" ::: "memory")
#endif
template <class Epi, class Sched>
__device__ __forceinline__ void gemm_phase(LAS unsigned char* lds, const Gemm g, const Sched& S, const Epi& E, const int tid) {
    const int wid = __builtin_amdgcn_readfirstlane(tid >> 6), lane = tid & 63, wr = wid >> 2, wc = wid & 3, fr = lane & 15, fq = lane >> 4;
    const int K = g.K, nt = K / BK;
    unsigned voffA[2], voffB[2];
#pragma unroll
    for (int i = 0; i < 2; ++i) { int R, C; stage_rc(tid * 16 + i * 8192, R, C); const int Rb = Epi::PERM ? ((R & ~31) + perm32(R & 31)) : R;
        voffA[i] = (unsigned)(R * K + C) * 2u; voffB[i] = (unsigned)(Rb * K + C) * 2u; }
    const size_t kstep = (size_t)(BK * 2);
    const size_t hstep = (size_t)HALF * K * 2;
    const size_t tstep = 2 * hstep;
    const unsigned ldsw = (unsigned)wid * 1024u;
    const int aoff = lds_byte(wr * 64 + fr, fq * 8), boff = lds_byte(wc * 32 + fr, fq * 8);
#define PG8_SA(b, h) (((b) * 2 + (h)) * HTB)
#define PG8_SB(b, h) ((4 + (b) * 2 + (h)) * HTB)
#define PG8_STAGE(bufoff, gbase, voff) do { _Pragma("unroll") for (int _i = 0; _i < 2; ++_i) \
        __builtin_amdgcn_global_load_lds((const unsigned*)((const char*)(gbase) + (voff)[_i]), (LAS unsigned*)(lds + (bufoff) + ldsw + _i * 8192), 16, 0, 0); } while (0)
#define PG8_LDA(dst, b, h) do { _Pragma("unroll") for (int m = 0; m < 4; ++m) _Pragma("unroll") for (int k = 0; k < 2; ++k) dst[m][k] = *(const LAS bf16x8*)(lds + PG8_SA(b, h) + aoff + m * 2048 + k * 1024); } while (0)
#define PG8_LDB(dst, b, h) do { _Pragma("unroll") for (int n = 0; n < 2; ++n) _Pragma("unroll") for (int k = 0; k < 2; ++k) dst[n][k] = *(const LAS bf16x8*)(lds + PG8_SB(b, h) + boff + n * 2048 + k * 1024); } while (0)
#define PG8_MMA(ai, bj, At, Bt) do { __builtin_amdgcn_s_setprio(1); _Pragma("unroll") for (int m = 0; m < 4; ++m) _Pragma("unroll") for (int n = 0; n < 2; ++n) _Pragma("unroll") for (int k = 0; k < 2; ++k) \
        acc[ai][bj][m][n] = __builtin_amdgcn_mfma_f32_16x16x32_bf16(Bt[n][k], At[m][k], acc[ai][bj][m][n], 0, 0, 0); __builtin_amdgcn_s_setprio(0); } while (0)
#define PG8_BAR __builtin_amdgcn_s_barrier()
#define PG8_SCHED __builtin_amdgcn_sched_barrier(0)
    Unit cur, nxt; int ui = 0;
    if (!S.next(0, cur)) return;
    f32x4 acc[2][2][4][2];
#pragma unroll
    for (int a = 0; a < 2; ++a)
#pragma unroll
        for (int b = 0; b < 2; ++b)
#pragma unroll
            for (int m = 0; m < 4; ++m)
#pragma unroll
                for (int n = 0; n < 2; ++n) acc[a][b][m][n] = (f32x4){0.f, 0.f, 0.f, 0.f};
    bf16x8 At[4][2], B0[2][2], B1[2][2];
    const char* cA = (const char*)g.A + (size_t)cur.pm * tstep; const char* cB = (const char*)(g.Bt + (size_t)cur.e * g.bexp) + (size_t)cur.pn * tstep;
    PG8_STAGE(PG8_SB(0, 0), cB, voffB); PG8_STAGE(PG8_SB(0, 1), cB + hstep, voffB); PG8_STAGE(PG8_SA(0, 0), cA, voffA); PG8_STAGE(PG8_SA(0, 1), cA + hstep, voffA);
    if (wr == 1) PG8_BAR;
    PG8_WAIT_V(2); PG8_BAR;
    PG8_STAGE(PG8_SB(1, 0), cB + kstep, voffB); PG8_STAGE(PG8_SA(1, 0), cA + kstep, voffA); PG8_STAGE(PG8_SB(1, 1), cB + hstep + kstep, voffB);
    PG8_WAIT_V(6); PG8_BAR;
    for (;;) {
        const bool has_next = S.next(ui + 1, nxt);
        const char* nA = has_next ? (const char*)g.A + (size_t)nxt.pm * tstep : cA; const char* nB = has_next ? (const char*)(g.Bt + (size_t)nxt.e * g.bexp) + (size_t)nxt.pn * tstep : cB;
        for (int t = 0; t < nt; t += 2) {
            const bool last = (t == nt - 2);
            const char* a1 = cA + (size_t)(t + 1) * kstep;
            const char* a2 = last ? nA : cA + (size_t)(t + 2) * kstep; const char* b2 = last ? nB : cB + (size_t)(t + 2) * kstep;
            const char* a3 = a2 + kstep; const char* b3 = b2 + kstep;
            PG8_LDB(B0, 0, 0); PG8_LDB(B1, 0, 1); PG8_SCHED; PG8_LDA(At, 0, 0); PG8_STAGE(PG8_SA(1, 1), a1 + hstep, voffA);
            PG8_WAIT_V(8); PG8_WAIT_L(0); PG8_BAR; PG8_MMA(0, 0, At, B0); PG8_MMA(0, 1, At, B1); PG8_BAR; PG8_SCHED;
            PG8_LDA(At, 0, 1); PG8_STAGE(PG8_SB(0, 0), b2, voffB); PG8_STAGE(PG8_SB(0, 1), b2 + hstep, voffB); PG8_STAGE(PG8_SA(0, 0), a2, voffA);
            PG8_WAIT_V(8); PG8_WAIT_L(0); PG8_BAR; PG8_MMA(1, 0, At, B0); PG8_MMA(1, 1, At, B1); PG8_BAR; PG8_SCHED;
            PG8_LDB(B0, 1, 0); PG8_LDB(B1, 1, 1); PG8_SCHED; PG8_LDA(At, 1, 0); PG8_STAGE(PG8_SA(0, 1), a2 + hstep, voffA);
            PG8_WAIT_V(8); PG8_WAIT_L(0); PG8_BAR; PG8_MMA(0, 0, At, B0); PG8_MMA(0, 1, At, B1); PG8_BAR; PG8_SCHED;
            PG8_LDA(At, 1, 1); PG8_STAGE(PG8_SB(1, 0), b3, voffB); PG8_STAGE(PG8_SB(1, 1), b3 + hstep, voffB); PG8_STAGE(PG8_SA(1, 0), a3, voffA);
            PG8_WAIT_V(8); PG8_WAIT_L(0); PG8_BAR; PG8_MMA(1, 0, At, B0); PG8_MMA(1, 1, At, B1); PG8_BAR; PG8_SCHED;
        }
        if (wr == 0) PG8_BAR;
        {
            int t2 = threadIdx.x;
#ifndef HOST_EMU
            asm volatile("" : "+v"(t2));
#endif
            const int wid2 = __builtin_amdgcn_readfirstlane(t2 >> 6), lane2 = t2 & 63;
            E(acc, cur, wid2 >> 2, wid2 & 3, lane2 & 15, lane2 >> 4);
        }
        if (!has_next) break;
#pragma unroll
        for (int a = 0; a < 2; ++a)
#pragma unroll
            for (int b = 0; b < 2; ++b)
#pragma unroll
                for (int m = 0; m < 4; ++m)
#pragma unroll
                    for (int n = 0; n < 2; ++n) acc[a][b][m][n] = (f32x4){0.f, 0.f, 0.f, 0.f};
        cur = nxt; cA = nA; cB = nB; ++ui;
        if (wr == 1) PG8_BAR;
    }
    PG8_WAIT_V(0);
    PG8_BAR;
#undef PG8_SA
#undef PG8_SB
#undef PG8_STAGE
#undef PG8_LDA
#undef PG8_LDB
#undef PG8_MMA
#undef PG8_BAR
#undef PG8_SCHED
}
}

#define XB_TMO      128
#define XB_XCNT(j)  (256  + 64 * (j))
#define XB_XSUB(j)  (1280 + 64 * (j))
#define XB_XGEN(j)  (2304 + 64 * (j))
#define XB_TOP      3328
#define XB_TOPGEN   3392
#define XCD_BAR_WORDS 3456
#define XB_SPIN_CAP (1u << 22)
#ifdef HOST_EMU
__device__ __forceinline__ unsigned xb_ld(unsigned* p) { return *(volatile unsigned*)p; }
__device__ __forceinline__ unsigned xb_add(unsigned* p, unsigned v) { unsigned o = *p; *p = o + v; return o; }
__device__ __forceinline__ unsigned xb_xcc_id() { return blockIdx.x % 8; }
__device__ __forceinline__ unsigned atomicAdd(unsigned* p, unsigned v) { unsigned o = *p; *p = o + v; return o; }
__device__ __forceinline__ int atomicAdd(int* p, int v) { int o = *p; *p = o + v; return o; }
#else
__device__ __forceinline__ unsigned xb_ld(unsigned* p)              { return __hip_atomic_load(p, __ATOMIC_RELAXED, __HIP_MEMORY_SCOPE_AGENT); }
__device__ __forceinline__ unsigned xb_add(unsigned* p, unsigned v) { return __hip_atomic_fetch_add(p, v, __ATOMIC_RELAXED, __HIP_MEMORY_SCOPE_AGENT); }
__device__ __forceinline__ unsigned xb_xcc_id() { return (unsigned)__builtin_amdgcn_s_getreg((3 << 11) | 20) & 0xFu; }
#endif
#define XB_SPIN(cond, bar) do { unsigned _sp = 0; while (cond) { __builtin_amdgcn_s_sleep(1); \
    if ((++_sp & 255u) == 0u) { if (xb_ld(&(bar)[XB_TMO])) break; if (_sp > XB_SPIN_CAP) { atomicAdd(&(bar)[XB_TMO], 1u); break; } } } } while (0)
struct XcdBarrier { unsigned* bar; unsigned x; volatile LAS unsigned* st; };
__device__ __forceinline__ XcdBarrier xcd_barrier_post(unsigned* bar, volatile LAS unsigned* st) {
    XcdBarrier b; b.bar = bar; b.x = xb_xcc_id(); b.st = st;
    if (threadIdx.x == 0) (void)xb_add(&bar[XB_XCNT(b.x)], 1u);
    return b;
}
__device__ __forceinline__ void xcd_barrier_complete(unsigned* bar, unsigned x, unsigned& nloc, unsigned& nx) {
    const unsigned G = gridDim.x;
    unsigned sum, cnt, mine, sp = 0u;
    for (;;) {
        sum = 0u; cnt = 0u; mine = 0u;
#pragma unroll
        for (unsigned j = 0; j < 16; ++j) { const unsigned c = xb_ld(&bar[XB_XCNT(j)]); sum += c; cnt += (c > 0u) ? 1u : 0u; mine = (j == x) ? c : mine; }
        if (sum == G) break;
        __builtin_amdgcn_s_sleep(1);
        if ((++sp & 255u) == 0u) { if (xb_ld(&bar[XB_TMO])) break; if (sp > XB_SPIN_CAP) { atomicAdd(&bar[XB_TMO], 1u); break; } }
    }
    nloc = mine > 0u ? mine : 1u; nx = cnt > 0u ? cnt : 1u;
}
__device__ __forceinline__ void xcd_barrier(const XcdBarrier& b) {
    VM_WAIT();
    __syncthreads();
    if (threadIdx.x == 0) {
        unsigned* bar = b.bar;
        __builtin_amdgcn_s_waitcnt(0);
        unsigned nloc = b.st[0], nx = b.st[1];
        if (nloc == 0u) { xcd_barrier_complete(bar, b.x, nloc, nx); b.st[0] = nloc; b.st[1] = nx; }
        const unsigned old = xb_add(&bar[XB_XSUB(b.x)], 1u);
        const unsigned gen = old / nloc;
        if (old + 1u == (gen + 1u) * nloc) {
            __builtin_amdgcn_fence(__ATOMIC_RELEASE, "agent");
            VM_WAIT();
            const unsigned og = xb_add(&bar[XB_TOP], 1u);
            const unsigned tg = og / nx;
            if (og + 1u == (tg + 1u) * nx) xb_add(&bar[XB_TOPGEN], 1u);
            else XB_SPIN(xb_ld(&bar[XB_TOPGEN]) == tg, bar);
            __builtin_amdgcn_fence(__ATOMIC_ACQUIRE, "agent");
            xb_add(&bar[XB_XGEN(b.x)], 1u);
            VM_WAIT();
        } else {
            XB_SPIN(xb_ld(&bar[XB_XGEN(b.x)]) == gen, bar);
            __builtin_amdgcn_fence(__ATOMIC_ACQUIRE, "agent");
            VM_WAIT();
        }
    }
    __syncthreads();
}

struct Args {
    const float* in[34]; float* out; unsigned char* ws; int ph_lo, ph_hi;
};
enum { I_X = 0, I_C, I_CTX, I_CCTX, I_MODW, I_MODB, I_N1, I_N2, I_WIN, I_WOUT, I_HGLB, I_HGNG, I_MLGB, I_MLNG, I_HYCW, I_HYCB, I_HYW1, I_HYB1, I_HYW2, I_HYB2, I_HYFR, I_HYW3,
       I_HYBI, I_GDCW, I_GDAL, I_GDDT, I_GDNG, I_RW, I_RB, I_EW1, I_EB1, I_EW2, I_EB2, I_FG };
struct Ctx {
#ifdef HOST_EMU
    LAS unsigned char* lds; const Args* a; unsigned char* ws;
#else
    LAS unsigned char* lds; const __attribute__((address_space(4))) Args* a; unsigned char* ws;
#endif
    int tid, lane, wave, vcu, G, bid;
};
#define WSP(T, off) ((T*)(C.ws + (off)))
#define INP(i) (C.a->in[i])

__device__ __forceinline__ const float* xrow_l0(const Ctx& C, int r) { return r < NLAT ? INP(I_X) + (size_t)r * D : INP(I_CTX) + (size_t)(r - NLAT) * D; }
__device__ __forceinline__ int row_batch(int r) { return r < NLAT ? r / SEQ : NB; }

__device__ __forceinline__ void transpose_item(const float* W, int ldw, int K, bf16_t* WT, int k0, int nsrc0, int ndst0, LAS float* scr, int lane) {
#pragma unroll 8
    for (int i = 0; i < 32; ++i) { const int kk = 2 * i + (lane >> 5); scr[kk * 33 + (lane & 31)] = W[(size_t)(k0 + kk) * ldw + nsrc0 + (lane & 31)]; }
    LDS_WAIT(); asm volatile("" ::: "memory");
    const int c = lane & 7;
#pragma unroll
    for (int j = 0; j < 4; ++j) { const int n = (lane >> 3) + 8 * j; const LAS float* s = scr + (8 * c) * 33 + n;
        u32x4 o; o.x = pk2(s[0 * 33], s[1 * 33]); o.y = pk2(s[2 * 33], s[3 * 33]); o.z = pk2(s[4 * 33], s[5 * 33]); o.w = pk2(s[6 * 33], s[7 * 33]);
        *(u32x4*)(WT + (size_t)(ndst0 + n) * K + k0 + 8 * c) = o; }
    LDS_WAIT(); asm volatile("" ::: "memory");
}
__device__ __forceinline__ void p0_prologue(Ctx& C) {
    LAS float* scr = (LAS float*)(C.lds + C.wave * 16384);
    const int gw = C.vcu * 8 + C.wave, NGW = C.G * 8, lane = C.lane;
    constexpr int I_IN = 16 * (ZW / 32), I_OUT = 16 * (D / 32), I_1 = 16 * (2 * DE / 32), I_2 = (DE / 64) * (D / 32);
    constexpr int PER_L = I_IN + I_OUT + NE * (I_1 + I_2);
    for (int it = gw; it < DEPTH * PER_L; it += NGW) {
        const int l = it / PER_L; int r = it % PER_L;
        if (r < I_IN) { const int kb = r / (ZW / 32), nb = r % (ZW / 32), nd = 32 * nb, ns = nd < 2304 ? nd : nd + 16;
            transpose_item(INP(I_WIN) + (size_t)l * D * IN_W, IN_W, D, WSP(bf16_t, WS_WIN) + (size_t)l * ZW * D, 64 * kb, ns, nd, scr, lane); continue; }
        r -= I_IN;
        if (r < I_OUT) { const int kb = r / (D / 32), nb = r % (D / 32);
            transpose_item(INP(I_WOUT) + (size_t)l * D * D, D, D, WSP(bf16_t, WS_WOUT) + (size_t)l * D * D, 64 * kb, 32 * nb, 32 * nb, scr, lane); continue; }
        r -= I_OUT;
        const int e = r / (I_1 + I_2); r %= (I_1 + I_2);
        if (r < I_1) { const int kb = r / (2 * DE / 32), nb = r % (2 * DE / 32), nd = 32 * nb;
            const int ntile = nd / 256, hh = (nd % 256) / 128, j = nd % 128, ns = DE * hh + 128 * ntile + j;
            transpose_item(INP(I_EW1) + ((size_t)l * NE + e) * D * 2 * DE, 2 * DE, D, WSP(bf16_t, WS_W1) + ((size_t)l * NE + e) * 2 * DE * D, 64 * kb, ns, nd, scr, lane); continue; }
        r -= I_1;
        { const int kb = r / (D / 32), nb = r % (D / 32);
            transpose_item(INP(I_EW2) + ((size_t)l * NE + e) * DE * D, D, DE, WSP(bf16_t, WS_W2) + ((size_t)l * NE + e) * D * DE, 64 * kb, 32 * nb, 32 * nb, scr, lane); }
    }
    for (int it = gw; it < DEPTH * (NB + 1) * (6 * D / 64); it += NGW) {
        const int l = it / ((NB + 1) * (6 * D / 64)), b = (it / (6 * D / 64)) % (NB + 1), n = (it % (6 * D / 64)) * 64 + lane;
        const float* w = INP(I_MODW) + (size_t)l * D * 6 * D + n; const float* cv = b < NB ? INP(I_C) + b * D : INP(I_CCTX);
        float acc = 0.f;
#pragma unroll 16
        for (int k = 0; k < D; ++k) acc += siluf_(cv[k]) * w[(size_t)k * 6 * D];
        WSP(float, WS_MOD)[((size_t)l * (NB + 1) + b) * 6 * D + n] = acc + INP(I_MODB)[l * 6 * D + n];
    }
    const int gt = gw * 64 + lane, NGT = NGW * 64;
    for (int i = gt; i < 256; i += NGT) { const float a0 = INP(I_HGLB)[i], a1 = INP(I_HGLB)[256 + i], mx = fmaxf(a0, a1), e0 = __expf(a0 - mx), e1 = __expf(a1 - mx);
        WSP(float, WS_LB)[i] = 0.f; WSP(float, WS_LB)[256 + i] = e1 / (e0 + e1); }
    for (int i = gt; i < DEPTH * 32 * D; i += NGT) { const int l = i / (32 * D), j = (i / D) % 32, k = i % D; const int col = j < 16 ? 2304 + j : 4112 + (j - 16);
        WSP(float, WS_WG)[i] = INP(I_WIN)[((size_t)l * D + k) * IN_W + col]; }
    for (int i = gt; i < DEPTH * NE * D; i += NGT) { const int l = i / (NE * D), e = (i / D) % NE, k = i % D;
        WSP(float, WS_WR)[i] = INP(I_RW)[((size_t)l * D + k) * NE + e]; }
    for (int i = gw; i < DEPTH * (SEQ + LC); i += NGW) {
        const int l = i / (SEQ + LC), p = i % (SEQ + LC); const bool isc = p >= SEQ; const int pos = isc ? p - SEQ : p, len = isc ? LC : SEQ;
        const float *w1 = INP(I_HYW1) + l * 17 * 64, *b1 = INP(I_HYB1) + l * 64, *w2 = INP(I_HYW2) + l * 64 * 64, *b2 = INP(I_HYB2) + l * 64, *fr = INP(I_HYFR) + l * 128;
        float s = b1[lane] + ((float)pos / (float)(len - 1)) * w1[lane];
#pragma unroll
        for (int j = 0; j < 8; ++j) { const float band = 1e-4f + (7.0f - 1e-4f) * (float)j / 7.0f; const float ang = 6.283185307179586f * (float)pos * band / (float)len;
            s += cosf(ang) * w1[(1 + j) * 64 + lane] - sinf(ang) * w1[(9 + j) * 64 + lane]; }
        scr[lane] = sinf(fr[lane] * s);
        LDS_WAIT(); asm volatile("" ::: "memory");
        float s2 = b2[lane];
#pragma unroll 8
        for (int q = 0; q < 64; ++q) s2 += scr[q] * w2[q * 64 + lane];
        WSP(float, WS_HDN)[((size_t)l * (SEQ + LC) + p) * 64 + lane] = sinf(fr[64 + lane] * s2);
        LDS_WAIT(); asm volatile("" ::: "memory");
    }
}

__device__ __forceinline__ void rms_mod_row(const f32x4 (&xv)[4], const float* gain, const float* sh, const float* sc, bf16_t* orow, int lane, f32x4 (&hv)[4]) {
    float s = 0.f;
#pragma unroll
    for (int j = 0; j < 4; ++j) s += (xv[j].x * xv[j].x + xv[j].y * xv[j].y) + (xv[j].z * xv[j].z + xv[j].w * xv[j].w);
    const float rstd = 1.f / sqrtf(wave_sum(s) * (1.f / D) + EPS);
#pragma unroll
    for (int j = 0; j < 4; ++j) { const int c = 4 * lane + 256 * j; const f32x4 g = *(const f32x4*)(gain + c), a = *(const f32x4*)(sc + c), b = *(const f32x4*)(sh + c);
        hv[j] = xv[j] * rstd * g * (a + 1.0f) + b;
        u32x2 w; w.x = pk2(hv[j].x, hv[j].y); w.y = pk2(hv[j].z, hv[j].w); *(u32x2*)(orow + c) = w; }
}
__device__ __forceinline__ void load_w32(Ctx& C, const float* W, int n) {
    __syncthreads();
    f32x4 wv_[16];
#pragma unroll
    for (int k = 0; k < 16; ++k) { const int o = C.tid + 512 * k; if (o < n * 256) wv_[k] = *(const f32x4*)(W + (size_t)o * 4); }
#pragma unroll
    for (int k = 0; k < 16; ++k) { const int o = C.tid + 512 * k; if (o < n * 256) *(LAS f32x4*)(C.lds + (size_t)o * 16) = wv_[k]; }
    __syncthreads();
}
__device__ __forceinline__ float row2_dots(LAS unsigned char* lds, const f32x4 (&hv)[2][4], int lane, int n) {
    float v[64];
#pragma unroll
    for (int jj = 0; jj < 32; ++jj) { float s0 = 0.f, s1 = 0.f;
        if (jj < n) {
#pragma unroll
            for (int j = 0; j < 4; ++j) { const f32x4 w = *(const LAS f32x4*)(lds + (size_t)jj * 4096 + (size_t)(4 * lane + 256 * j) * 4);
                s0 += (hv[0][j].x * w.x + hv[0][j].y * w.y) + (hv[0][j].z * w.z + hv[0][j].w * w.w); s1 += (hv[1][j].x * w.x + hv[1][j].y * w.y) + (hv[1][j].z * w.z + hv[1][j].w * w.w); } }
        v[jj] = s0; v[32 + jj] = s1; }
#pragma unroll
    for (int st = 0; st < 6; ++st) { const int m = 32 >> st, nh = 32 >> st; const bool up = (lane & m) != 0;
#pragma unroll
        for (int i = 0; i < nh; ++i) { const float a = v[i], bb = v[i + nh]; const float send = up ? a : bb, keep = up ? bb : a; v[i] = keep + __shfl_xor(send, m); } }
    return v[0];
}
__device__ __forceinline__ void phase_rows_a(Ctx& C, int l) {
    const int gw = C.vcu * 8 + C.wave, NGW = C.G * 8, lane = C.lane;
    const int nrows = (l == DEPTH) ? NLAT : NT;
    float* xcur = WSP(float, WS_X);
    if (l < DEPTH) load_w32(C, WSP(float, WS_WG) + (size_t)l * 32 * D, 32);
    for (int r0 = 2 * gw; r0 < nrows; r0 += 2 * NGW) {
        f32x4 xv[2][4];
#pragma unroll
        for (int q = 0; q < 2; ++q) { const int r = r0 + q; const int bb = row_batch(r);
            if (l == 0) { const float* xr = xrow_l0(C, r);
#pragma unroll
                for (int j = 0; j < 4; ++j) xv[q][j] = *(const f32x4*)(xr + 4 * lane + 256 * j); }
            else {
                const int lp = l - 1; const int ntok = (lp == DEPTH - 1) ? NLAT : NT;
                const float* xr = xcur + (size_t)r * D;
#pragma unroll
                for (int j = 0; j < 4; ++j) xv[q][j] = *(const f32x4*)(xr + 4 * lane + 256 * j);
                if (r < ntok) {
                    const float* g2 = WSP(float, WS_MOD) + ((size_t)lp * (NB + 1) + bb) * 6 * D + 5 * D;
                    const int* te = WSP(int, WS_TOP) + (size_t)r * 4; const int* tp = WSP(int, WS_TOP) + (size_t)NT * 4 + (size_t)r * 4; const float* tg = WSP(float, WS_TOP) + (size_t)NT * 8 + (size_t)r * 4;
                    const LAS int* tbase = (const LAS int*)(C.lds + LDSX_OFF + LX_TILE) + MAXTILES;
                    f32x4 ys[4];
#pragma unroll
                    for (int j = 0; j < 4; ++j) ys[j] = (f32x4){0.f, 0.f, 0.f, 0.f};
#pragma unroll
                    for (int k = 0; k < TOPK; ++k) { const int e = te[k]; const size_t yr = (size_t)tbase[e] * 256 + tp[k]; const float gk = tg[k]; const bf16_t* yp = WSP(bf16_t, WS_Y) + yr * D;
#pragma unroll
                        for (int j = 0; j < 4; ++j) { const u32x2 w = *(const u32x2*)(yp + 4 * lane + 256 * j);
                            ys[j].x += gk * u2f(w.x << 16); ys[j].y += gk * u2f(w.x & 0xffff0000u); ys[j].z += gk * u2f(w.y << 16); ys[j].w += gk * u2f(w.y & 0xffff0000u); } }
#pragma unroll
                    for (int j = 0; j < 4; ++j) { const f32x4 g = *(const f32x4*)(g2 + 4 * lane + 256 * j); xv[q][j] = xv[q][j] + g * ys[j]; }
                    if (l < DEPTH) {
#pragma unroll
                        for (int j = 0; j < 4; ++j) *(f32x4*)(xcur + (size_t)r * D + 4 * lane + 256 * j) = xv[q][j]; }
                }
            }
        }
        if (l == DEPTH) {
#pragma unroll
            for (int q = 0; q < 2; ++q) { float s = 0.f;
#pragma unroll
                for (int j = 0; j < 4; ++j) s += (xv[q][j].x * xv[q][j].x + xv[q][j].y * xv[q][j].y) + (xv[q][j].z * xv[q][j].z + xv[q][j].w * xv[q][j].w);
                const float rstd = 1.f / sqrtf(wave_sum(s) * (1.f / D) + EPS);
#pragma unroll
                for (int j = 0; j < 4; ++j) { const f32x4 g = *(const f32x4*)(INP(I_FG) + 4 * lane + 256 * j); *(f32x4*)(C.a->out + (size_t)(r0 + q) * D + 4 * lane + 256 * j) = xv[q][j] * rstd * g; } }
            continue;
        }
        f32x4 hv[2][4];
#pragma unroll
        for (int q = 0; q < 2; ++q) { const int r = r0 + q; const float* mod = WSP(float, WS_MOD) + ((size_t)l * (NB + 1) + row_batch(r)) * 6 * D;
            rms_mod_row(xv[q], INP(I_N1) + l * D, mod, mod + D, WSP(bf16_t, WS_H) + (size_t)r * D, lane, hv[q]); }
        const float mine = row2_dots(C.lds, hv, lane, 32);
        WSP(float, WS_ZG)[(size_t)(r0 + (lane >> 5)) * 32 + (lane & 31)] = mine;
    }
}
__device__ __forceinline__ int build_tiles(Ctx& C, int l) {
    LAS int* tile_e = (LAS int*)(C.lds + LDSX_OFF + LX_TILE); LAS int* tbase = tile_e + MAXTILES;
    const unsigned* cnt = WSP(unsigned, WS_CTL) + CW_CNT + l * NE;
    __syncthreads();
    if (C.tid == 0) { int t = 0;
        for (int e = 0; e < NE; ++e) { const int c = (int)cnt[e], n = (c + 255) / 256; tbase[e] = t; for (int i = 0; i < n; ++i) tile_e[t + i] = e; t += n; }
        tbase[NE] = t; }
    __syncthreads();
    return tbase[NE];
}
__device__ __forceinline__ void phase_rows_b(Ctx& C, int l) {
    const int gw = C.vcu * 8 + C.wave, NGW = C.G * 8, lane = C.lane;
    const int ntok = (l == DEPTH - 1) ? NLAT : NT;
    const float* xcur = WSP(float, WS_X);
    unsigned* cnt = WSP(unsigned, WS_CTL) + CW_CNT + l * NE;
    static_assert(NE <= 32, "router width");
    LAS int* lcnt = (LAS int*)(C.lds + LDSX_OFF + 2048);
    LAS int* lbase = lcnt + 32;
    LAS int* rec = lbase + 32;
    constexpr int MAXIT = (NT / 2 + 2047) / 2048 + 1;
    static_assert((MAXIT * 16 * 4 * 2 + 64) * 4 + 2048 <= LDS_BYTES - LDSX_OFF, "routing records fit the control region");
    load_w32(C, WSP(float, WS_WR) + (size_t)l * NE * D, NE);
    if (C.tid < 32) lcnt[C.tid] = 0;
    __syncthreads();
    int itn = 0;
    for (int r0 = 2 * gw; r0 < ntok; r0 += 2 * NGW, ++itn) {
        f32x4 hv[2][4];
#pragma unroll
        for (int q = 0; q < 2; ++q) { const int r = r0 + q; f32x4 xv[4];
#pragma unroll
            for (int j = 0; j < 4; ++j) xv[j] = *(const f32x4*)(xcur + (size_t)r * D + 4 * lane + 256 * j);
            const float* mod = WSP(float, WS_MOD) + ((size_t)l * (NB + 1) + row_batch(r)) * 6 * D;
            rms_mod_row(xv, INP(I_N2) + l * D, mod + 3 * D, mod + 4 * D, WSP(bf16_t, WS_H) + (size_t)r * D, lane, hv[q]); }
        const float lgm = row2_dots(C.lds, hv, lane, NE);
        const int jl = lane & 31, r = r0 + (lane >> 5);
        float v = (jl < NE) ? lgm + INP(I_RB)[l * NE + (jl < NE ? jl : 0)] : -3.0e38f;
        float tv[4]; int ti[4];
#pragma unroll
        for (int k = 0; k < 4; ++k) { float bv = v; int bi = jl;
#pragma unroll
            for (int o = 1; o < 32; o <<= 1) { const float ov = __shfl_xor(bv, o); const int oi = __shfl_xor(bi, o); const bool take = (ov > bv) || (ov == bv && oi < bi); bv = take ? ov : bv; bi = take ? oi : bi; }
            tv[k] = bv; ti[k] = bi; v = (jl == bi) ? -3.4e38f : v; }
        const float e1 = __expf(tv[1] - tv[0]), e2 = __expf(tv[2] - tv[0]), e3 = __expf(tv[3] - tv[0]), inv = 1.f / (1.f + e1 + e2 + e3);
        const float gk[4] = {inv, e1 * inv, e2 * inv, e3 * inv};
        if (jl < 4) {
            int e = ti[0]; float g = gk[0];
#pragma unroll
            for (int k = 1; k < 4; ++k) { e = (jl == k) ? ti[k] : e; g = (jl == k) ? gk[k] : g; }
#ifdef HOST_EMU
            const int lr = lcnt[e]; lcnt[e] = lr + 1;
#else
            const int lr = __hip_atomic_fetch_add((LAS int*)(lcnt + e), 1, __ATOMIC_RELAXED, __HIP_MEMORY_SCOPE_WORKGROUP);
#endif
            rec[(((itn * 8 + C.wave) * 2 + (lane >> 5)) * 4 + jl) * 2] = e; rec[(((itn * 8 + C.wave) * 2 + (lane >> 5)) * 4 + jl) * 2 + 1] = lr;
            WSP(int, WS_TOP)[(size_t)r * 4 + jl] = e; WSP(float, WS_TOP)[(size_t)NT * 8 + (size_t)r * 4 + jl] = g;
        }
    }
    __syncthreads();
    if (C.tid < NE) lbase[C.tid] = (int)atomicAdd(cnt + C.tid, (unsigned)lcnt[C.tid]);
    __syncthreads();
    itn = 0;
    for (int r0 = 2 * gw; r0 < ntok; r0 += 2 * NGW, ++itn) { const int jl = lane & 31, r = r0 + (lane >> 5);
        if (jl < 4) { const int e = rec[(((itn * 8 + C.wave) * 2 + (lane >> 5)) * 4 + jl) * 2], lr = rec[(((itn * 8 + C.wave) * 2 + (lane >> 5)) * 4 + jl) * 2 + 1];
            WSP(int, WS_TOP)[(size_t)NT * 4 + (size_t)r * 4 + jl] = lbase[e] + lr; } }
}
__device__ __forceinline__ void phase_gather(Ctx& C, int l) {
    const int gw = C.vcu * 8 + C.wave, NGW = C.G * 8, lane = C.lane;
    const int ntok = (l == DEPTH - 1) ? NLAT : NT;
    (void)build_tiles(C, l);
    const LAS int* tbase = (const LAS int*)(C.lds + LDSX_OFF + LX_TILE) + MAXTILES;
    const unsigned* cnt = WSP(unsigned, WS_CTL) + CW_CNT + l * NE;
    for (int it = gw; it < ntok * 4; it += NGW) { const int r = it >> 2, k = it & 3;
        const int e = WSP(int, WS_TOP)[(size_t)r * 4 + k], pos = WSP(int, WS_TOP)[(size_t)NT * 4 + (size_t)r * 4 + k];
        const u32x4* s = (const u32x4*)(WSP(bf16_t, WS_H) + (size_t)r * D); u32x4* d = (u32x4*)(WSP(bf16_t, WS_HS) + ((size_t)tbase[e] * 256 + pos) * D);
        d[lane] = s[lane]; d[lane + 64] = s[lane + 64]; }
    for (int it = gw; it < NE * 256; it += NGW) { const int e = it >> 8, p = it & 255; const int c = (int)cnt[e], pad0 = c, pad1 = ((c + 255) / 256) * 256;
        if (pad0 + p < pad1) { u32x4* d = (u32x4*)(WSP(bf16_t, WS_HS) + ((size_t)tbase[e] * 256 + pad0 + p) * D); d[lane] = (u32x4){0u, 0u, 0u, 0u}; d[lane + 64] = (u32x4){0u, 0u, 0u, 0u}; } }
}

template <int MIX> __device__ __forceinline__ int scan_row(int b, int dir, int s) {
    if (s < LC) { const int t = dir ? LC - 1 - s : s; return NLAT + b * LC + t; }
    const int i0 = s - LC, i = dir ? SEQ - 1 - i0 : i0;
    const int t = (MIX == 1) ? (i % GROWS) * GW + (i / GROWS) : i;
    return b * SEQ + t;
}
typedef float f32x16 __attribute__((ext_vector_type(16)));
template <int NT_, int KS>
__device__ __forceinline__ void mm_nt(const LAS bf16_t* A, int lda, const LAS bf16_t* B, int ldb, f32x16 (&acc)[NT_], int lane) {
    const int r = lane & 31, kh = (lane >> 5) * 8;
#pragma unroll
    for (int kk = 0; kk < KS; ++kk) {
        const bf16x8 a = *(const LAS bf16x8*)(A + r * lda + 16 * kk + kh);
#pragma unroll
        for (int n = 0; n < NT_; ++n) { const bf16x8 b = *(const LAS bf16x8*)(B + (32 * n + r) * ldb + 16 * kk + kh); acc[n] = __builtin_amdgcn_mfma_f32_32x32x16_bf16(a, b, acc[n], 0, 0, 0); }
    }
}
#ifdef HOST_EMU
#define ITEM_IDS() const int tid = C.tid, lane = C.lane, w = C.wave
#else
#define ITEM_IDS() int tid_ = C.tid; asm volatile("" : "+v"(tid_)); const int tid = tid_, lane = tid_ & 63, w = __builtin_amdgcn_readfirstlane(tid_ >> 6)
#endif
#define CROW(ri, lane) (((ri) & 3) + 8 * ((ri) >> 2) + 4 * ((lane) >> 5))
constexpr int LS = 72, LF = 65;
constexpr int GA_Q = 0, GA_K = 9216, GA_BVT = 18432, GA_BKGT = 27648, GA_KDT = 36864, GA_QKM = 46080, GA_TB = 55296, GA_UT = 64512, GA_WT = 73728, GA_AM = 82944, GA_AMB = 99584, GA_TT = 108800, GA_DG = 118016, GA_XT = 122368, GA_G = 124928;
__device__ __forceinline__ void gdn_a_item(Ctx& C, int l, int b, int h, int dir, int c) {
    LAS unsigned char* lds = C.lds; ITEM_IDS();
    LAS bf16_t* Qb = (LAS bf16_t*)(lds + GA_Q); LAS bf16_t* Kb = (LAS bf16_t*)(lds + GA_K); LAS bf16_t* BVT = (LAS bf16_t*)(lds + GA_BVT); LAS bf16_t* BKGT = (LAS bf16_t*)(lds + GA_BKGT);
    LAS bf16_t* KDT = (LAS bf16_t*)(lds + GA_KDT); LAS bf16_t* QKM = (LAS bf16_t*)(lds + GA_QKM); LAS bf16_t* TB = (LAS bf16_t*)(lds + GA_TB); LAS bf16_t* UT = (LAS bf16_t*)(lds + GA_UT); LAS bf16_t* WT = (LAS bf16_t*)(lds + GA_WT);
    LAS float* AM = (LAS float*)(lds + GA_AM); LAS bf16_t* AMb = (LAS bf16_t*)(lds + GA_AMB); LAS bf16_t* TT = (LAS bf16_t*)(lds + GA_TT); LAS float* Dg = (LAS float*)(lds + GA_DG); LAS bf16_t* XT = (LAS bf16_t*)(lds + GA_XT); LAS float* G = (LAS float*)(lds + GA_G);
    const bf16_t* zb = WSP(bf16_t, WS_Z); const float* zg = WSP(float, WS_ZG);
    unsigned char* blob = C.ws + WS_GD + ((size_t)((b * NH + h) * 2 + dir) * NCH + c) * GD_BLOB;
    const int i = tid >> 3, d0 = (tid & 7) * 8; const int row = scan_row<2>(b, dir, 64 * c + i);
    float qv[8], kv[8], vv[8];
    { const bf16_t* zr = zb + (size_t)row * ZW; const bool isc = row >= NLAT; const int t = isc ? (row - NLAT) % LC : row % SEQ, len = isc ? LC : SEQ;
        const bool hp = t > 0, hn = t < len - 1; const float* cw = INP(I_GDCW) + l * 3 * 768;
        float sq = 0.f, sk = 0.f;
#pragma unroll
        for (int a = 0; a < 3; ++a) { const int cc = a * 256 + h * 64 + d0; const bf16_t* zp = zr + GDB + cc;
            const f32x4 wa0 = *(const f32x4*)(cw + cc), wa1 = *(const f32x4*)(cw + cc + 4), wb0 = *(const f32x4*)(cw + 768 + cc), wb1 = *(const f32x4*)(cw + 768 + cc + 4), wc0 = *(const f32x4*)(cw + 1536 + cc), wc1 = *(const f32x4*)(cw + 1536 + cc + 4);
            const float cwa[8] = {wa0.x, wa0.y, wa0.z, wa0.w, wa1.x, wa1.y, wa1.z, wa1.w}, cwb[8] = {wb0.x, wb0.y, wb0.z, wb0.w, wb1.x, wb1.y, wb1.z, wb1.w}, cwc[8] = {wc0.x, wc0.y, wc0.z, wc0.w, wc1.x, wc1.y, wc1.z, wc1.w};
            const u32x4 z1 = *(const u32x4*)zp, z0 = *(const u32x4*)(zp - (hp ? ZW : 0)), z2 = *(const u32x4*)(zp + (hn ? ZW : 0));
            const unsigned u0[4] = {z0.x, z0.y, z0.z, z0.w}, u1[4] = {z1.x, z1.y, z1.z, z1.w}, u2[4] = {z2.x, z2.y, z2.z, z2.w};
#pragma unroll
            for (int j = 0; j < 8; ++j) { const int jj = j >> 1; const bool hi = j & 1;
                const float x0 = hi ? u2f(u0[jj] & 0xffff0000u) : u2f(u0[jj] << 16), x1 = hi ? u2f(u1[jj] & 0xffff0000u) : u2f(u1[jj] << 16), x2 = hi ? u2f(u2[jj] & 0xffff0000u) : u2f(u2[jj] << 16);
                float sacc = (hp ? cwa[j] : 0.f) * x0 + cwb[j] * x1 + (hn ? cwc[j] : 0.f) * x2;
                sacc = siluf_(sacc);
                if (a == 0) { qv[j] = sacc; sq += sacc * sacc; } else if (a == 1) { kv[j] = sacc; sk += sacc * sacc; } else vv[j] = sacc; } }
#pragma unroll
        for (int o = 1; o < 8; o <<= 1) { sq += __shfl_xor(sq, o); sk += __shfl_xor(sk, o); }
        const float rq = 0.125f / sqrtf(sq + EPS), rk = 1.f / sqrtf(sk + EPS);
#pragma unroll
        for (int j = 0; j < 8; ++j) { qv[j] *= rq; kv[j] *= rk; }
        if ((tid & 7) == 0) { const float* g = zg + (size_t)row * 32 + 16;
            G[128 + i] = -__expf(INP(I_GDAL)[l * 8 + dir * 4 + h]) * softplusf_(g[(2 * dir) * 4 + h] + INP(I_GDDT)[l * 8 + dir * 4 + h]); G[64 + i] = sigmoidf_(g[(2 * dir + 1) * 4 + h]); }
        u32x4 wq, wk; wq.x = pk2(qv[0], qv[1]); wq.y = pk2(qv[2], qv[3]); wq.z = pk2(qv[4], qv[5]); wq.w = pk2(qv[6], qv[7]); wk.x = pk2(kv[0], kv[1]); wk.y = pk2(kv[2], kv[3]); wk.z = pk2(kv[4], kv[5]); wk.w = pk2(kv[6], kv[7]);
        *(LAS u32x4*)(Qb + i * LS + d0) = wq; *(LAS u32x4*)(Kb + i * LS + d0) = wk;
        for (int o = tid; o < 64 * LS / 2; o += 512) ((LAS unsigned*)TT)[o] = 0u;
    }
    __syncthreads();
    if (w == 0) { float gsum = G[128 + lane];
#pragma unroll
        for (int o = 1; o < 64; o <<= 1) { const float t = __shfl(gsum, lane - o); if (lane >= o) gsum += t; }
        G[lane] = gsum; }
    __syncthreads();
    { const float gi = G[i], be = G[64 + i], gl = G[63]; const float eg = __expf(gi), ed = __expf(gl - gi);
#pragma unroll
        for (int j = 0; j < 8; ++j) { BVT[(d0 + j) * LS + i] = (bf16_t)f2bf(be * vv[j]); BKGT[(d0 + j) * LS + i] = (bf16_t)f2bf(be * kv[j] * eg); KDT[(d0 + j) * LS + i] = (bf16_t)f2bf(kv[j] * ed); } }
    for (int rep_ = 0; rep_ < 1 + ((REPMASK >> 18) & 1); ++rep_)
    if (w < 4) { f32x16 acc[2]; acc[0] = (f32x16)(0.f); acc[1] = (f32x16)(0.f);
        const int rh = (w & 1) * 32; mm_nt<2, 4>((w >> 1) ? Qb + rh * LS : Kb + rh * LS, LS, Kb, LS, acc, lane);
        float gi[16], bi[16], gj[2];
#pragma unroll
        for (int ri = 0; ri < 16; ++ri) { gi[ri] = G[rh + CROW(ri, lane)]; bi[ri] = G[64 + rh + CROW(ri, lane)]; }
        gj[0] = G[lane & 31]; gj[1] = G[32 + (lane & 31)];
        if (w >> 1) {
#pragma unroll
            for (int n = 0; n < 2; ++n)
#pragma unroll
                for (int ri = 0; ri < 16; ++ri) { const int ii = rh + CROW(ri, lane), jj = 32 * n + (lane & 31); QKM[ii * LS + jj] = (bf16_t)f2bf(jj <= ii ? acc[n][ri] * __expf(gi[ri] - gj[n]) : 0.f); }
        } else {
#pragma unroll
            for (int n = 0; n < 2; ++n)
#pragma unroll
                for (int ri = 0; ri < 16; ++ri) { const int ii = rh + CROW(ri, lane), jj = 32 * n + (lane & 31); const float av = (jj < ii) ? bi[ri] * acc[n][ri] * __expf(gi[ri] - gj[n]) : 0.f; AM[ii * LF + jj] = av; AMb[ii * LS + jj] = (bf16_t)f2bf(av); }
        } }
    __syncthreads();
    for (int rep_ = 0; rep_ < 1 + ((REPMASK >> 19) & 1); ++rep_) {
    if (w == 0) { const int bb = lane >> 4, cc = lane & 15; float t[16];
#pragma unroll
        for (int r = 0; r < 16; ++r) { float x = (r == cc) ? 1.f : 0.f;
#pragma unroll
            for (int r2 = 0; r2 < r; ++r2) x -= AM[(16 * bb + r) * LF + 16 * bb + r2] * t[r2];
            t[r] = x; Dg[(bb * 16 + r) * 17 + cc] = x; asm volatile("" ::: "memory"); } }
    __syncthreads();
    if (w < 4) { const int cl = lane & 15, q4 = lane >> 4; LAS bf16_t* XTw = XT + w * 256;
#pragma unroll
        for (int bb = 0; bb < 4; ++bb) {
            f32x4 acc = (f32x4){0.f, 0.f, 0.f, 0.f};
#pragma unroll
            for (int kk = 0; kk < 2; ++kk) { const bf16x8 a = *(const LAS bf16x8*)(AMb + (16 * bb + cl) * LS + 32 * kk + 8 * q4), tb = *(const LAS bf16x8*)(TT + (16 * w + cl) * LS + 32 * kk + 8 * q4);
                acc = __builtin_amdgcn_mfma_f32_16x16x32_bf16(a, tb, acc, 0, 0, 0); }
            float x[4];
#pragma unroll
            for (int r = 0; r < 4; ++r) x[r] = ((16 * bb + 4 * q4 + r) == (16 * w + cl) ? 1.f : 0.f) - acc[r];
            *(LAS u32x2*)(XTw + cl * 16 + 4 * q4) = (u32x2){pk2(x[0], x[1]), pk2(x[2], x[3])};
            LDS_WAIT(); asm volatile("" ::: "memory");
            bf16x8 da = (bf16x8)(0), xb = (bf16x8)(0);
            if (q4 < 2) { const LAS float* dp = Dg + (bb * 16 + cl) * 17 + 8 * q4; u32x4 dv; dv.x = pk2(dp[0], dp[1]); dv.y = pk2(dp[2], dp[3]); dv.z = pk2(dp[4], dp[5]); dv.w = pk2(dp[6], dp[7]);
                __builtin_memcpy(&da, &dv, 16); xb = *(const LAS bf16x8*)(XTw + cl * 16 + 8 * q4); }
            const f32x4 z4 = (f32x4){0.f, 0.f, 0.f, 0.f}; const f32x4 tt = __builtin_amdgcn_mfma_f32_16x16x32_bf16(da, xb, z4, 0, 0, 0);
            *(LAS u32x2*)(TT + (16 * w + cl) * LS + 16 * bb + 4 * q4) = (u32x2){pk2(tt[0], tt[1]), pk2(tt[2], tt[3])};
#pragma unroll
            for (int r = 0; r < 4; ++r) TB[(16 * bb + 4 * q4 + r) * LS + 16 * w + cl] = (bf16_t)f2bf(tt[r]);
            LDS_WAIT(); asm volatile("" ::: "memory");
        } }
    }
    __syncthreads();
    for (int rep_ = 0; rep_ < 1 + ((REPMASK >> 20) & 1); ++rep_)
    if (w < 4) { f32x16 acc[2]; acc[0] = (f32x16)(0.f); acc[1] = (f32x16)(0.f);
        const int rh = (w & 1) * 32; mm_nt<2, 4>(((w >> 1) ? BKGT : BVT) + rh * LS, LS, TB, LS, acc, lane);
        LAS bf16_t* dst = (w >> 1) ? WT : UT;
#pragma unroll
        for (int n = 0; n < 2; ++n)
#pragma unroll
            for (int ri = 0; ri < 16; ++ri) dst[(rh + CROW(ri, lane)) * LS + 32 * n + (lane & 31)] = (bf16_t)f2bf(acc[n][ri]); }
    __syncthreads();
    for (int rep_ = 0; rep_ < 1 + ((REPMASK >> 21) & 1); ++rep_)
    { f32x16 acc[2]; acc[0] = (f32x16)(0.f); acc[1] = (f32x16)(0.f);
        const int pr = w >> 1, rh = (w & 1) * 32;
        const LAS bf16_t* Ap = (pr == 0 || pr == 1) ? QKM : (pr == 2 ? KDT : UT); const LAS bf16_t* Bp = (pr == 0 || pr == 2) ? WT : (pr == 1 ? UT : KDT);
        mm_nt<2, 4>(Ap + rh * LS, LS, Bp, LS, acc, lane);
        const float egl = __expf(G[63]);
        LAS bf16_t* OUT = (LAS bf16_t*)(lds + GA_AM) + ((pr == 2) ? 0 : (pr == 0) ? 4096 : (pr == 3) ? 8192 : 12288);
        float qe[2][16];
        if (pr == 0) {
#pragma unroll
            for (int ri = 0; ri < 16; ++ri) { const int rr = rh + CROW(ri, lane); const float eg = __expf(G[rr]); qe[0][ri] = bf2f(Qb[rr * LS + (lane & 31)]) * eg; qe[1][ri] = bf2f(Qb[rr * LS + 32 + (lane & 31)]) * eg; } }
#pragma unroll
        for (int n = 0; n < 2; ++n)
#pragma unroll
            for (int ri = 0; ri < 16; ++ri) { const int rr = rh + CROW(ri, lane), cc = 32 * n + (lane & 31); const float a = acc[n][ri];
                const float v = (pr == 0) ? qe[n][ri] - a : (pr == 2) ? ((rr == cc ? egl : 0.f) - a) : a;
                OUT[rr * 64 + cc] = (bf16_t)f2bf(v); } }
    __syncthreads();
#pragma unroll
    for (int k = 0; k < 4; ++k) { const int o = tid + 512 * k; *(u32x4*)(blob + (size_t)o * 16) = *(const LAS u32x4*)(lds + GA_AM + o * 16); }
    __syncthreads();
}
__device__ __forceinline__ void gdn_b_scan(Ctx& C, int sidx) {
    LAS unsigned char* lds = C.lds; const int tid = C.tid, lane = C.lane, w = C.wave;
    LAS bf16_t* STb = (LAS bf16_t*)lds;
    LAS bf16_t* Pb = (LAS bf16_t*)(lds + 18432);
    for (int o = tid; o < 2 * 64 * LS; o += 512) STb[o] = 0;
    __syncthreads();
    int cur = 0;
    LAS bf16_t* QTl = (LAS bf16_t*)(lds + 27648);
    const int pr = tid >> 3, pc8 = (tid & 7) * 8, eh = (w & 1) * 32, dh = (w >> 1) * 32;
    u32x4 pv = *(const u32x4*)((const bf16_t*)(C.ws + WS_GD + ((size_t)sidx * NCH) * GD_BLOB) + pr * 64 + pc8);
    u32x4 qv4 = *(const u32x4*)((const bf16_t*)(C.ws + WS_GD + ((size_t)sidx * NCH) * GD_BLOB + 16384) + pr * 64 + pc8);
    for (int c = 0; c < NCH; ++c) {
        bf16_t* gst = WSP(bf16_t, WS_GST) + ((size_t)sidx * NCH + c) * 4096;
        *(LAS u32x4*)(Pb + pr * LS + pc8) = pv; *(LAS u32x4*)(QTl + pr * LS + pc8) = qv4;
        *(u32x4*)(gst + pr * 64 + pc8) = *(const LAS u32x4*)(STb + cur * 64 * LS + pr * LS + pc8);
        const int cn = (c + 1 < NCH) ? c + 1 : c; const unsigned char* nblob = C.ws + WS_GD + ((size_t)sidx * NCH + cn) * GD_BLOB;
        pv = *(const u32x4*)((const bf16_t*)nblob + pr * 64 + pc8);
        qv4 = *(const u32x4*)((const bf16_t*)(nblob + 16384) + pr * 64 + pc8);
        __syncthreads();
        if (w < 4) { f32x16 acc[1];
#pragma unroll
            for (int ri = 0; ri < 16; ++ri) acc[0][ri] = bf2f(QTl[(eh + CROW(ri, lane)) * LS + dh + (lane & 31)]);
            mm_nt<1, 4>(STb + cur * 64 * LS + eh * LS, LS, Pb + dh * LS, LS, acc, lane);
#pragma unroll
            for (int ri = 0; ri < 16; ++ri) STb[(cur ^ 1) * 64 * LS + (eh + CROW(ri, lane)) * LS + dh + (lane & 31)] = (bf16_t)f2bf(acc[0][ri]); }
        __syncthreads();
        cur ^= 1;
    }
}
__device__ __forceinline__ void gdn_c_item(Ctx& C, int l, int b, int h, int jt) {
    LAS unsigned char* lds = C.lds; ITEM_IDS();
    LAS bf16_t* Rb = (LAS bf16_t*)lds;
    LAS bf16_t* Sb = (LAS bf16_t*)(lds + 18432);
    LAS float* OF = (LAS float*)(lds + 36864);
    const bool isc = jt < NCHC; const int jl = jt - NCHC;
    int cidx[2]; cidx[0] = jt; cidx[1] = isc ? (NCHC - 1 - jt) : NCHC + (SEQ / 64 - 1 - jl);
    const unsigned char* blob[2];
    const int dirw = w >> 2, qw = w & 3, ihw = (qw & 1) * 32, ehw = (qw >> 1) * 32;
    LAS bf16_t* OL = (LAS bf16_t*)(lds + 70144);
    const int tokf = tid >> 3, e0f = (tid & 7) * 8; const int rowf = isc ? NLAT + b * LC + 64 * jt + tokf : b * SEQ + 64 * jl + tokf;
    const u32x4 gzv = *(const u32x4*)(WSP(bf16_t, WS_Z) + (size_t)rowf * ZW + GDB + 768 + h * 64 + e0f);
    const f32x4 ngv0 = *(const f32x4*)(INP(I_GDNG) + l * 256 + h * 64 + e0f), ngv1 = *(const f32x4*)(INP(I_GDNG) + l * 256 + h * 64 + e0f + 4);
#pragma unroll
    for (int dir = 0; dir < 2; ++dir) { const size_t sc = (size_t)((b * NH + h) * 2 + dir) * NCH + cidx[dir]; blob[dir] = C.ws + WS_GD + sc * GD_BLOB;
        const bf16_t* gst = WSP(bf16_t, WS_GST) + sc * 4096; const int r = tid >> 3, c8 = (tid & 7) * 8;
        *(LAS u32x4*)(Rb + dir * 64 * LS + r * LS + c8) = *(const u32x4*)((const bf16_t*)(blob[dir] + 8192) + r * 64 + c8);
        *(LAS u32x4*)(Sb + dir * 64 * LS + r * LS + c8) = *(const u32x4*)(gst + r * 64 + c8);
        *(LAS u32x4*)(OL + dir * 64 * LS + r * LS + c8) = *(const u32x4*)((const bf16_t*)(blob[dir] + 24576) + r * 64 + c8); }
    __syncthreads();
    { const int dir = dirw, ih = ihw, eh = ehw; f32x16 acc[1];
#pragma unroll
        for (int ri = 0; ri < 16; ++ri) acc[0][ri] = bf2f(OL[dir * 64 * LS + (ih + CROW(ri, lane)) * LS + eh + (lane & 31)]);
        mm_nt<1, 4>(Rb + dir * 64 * LS + ih * LS, LS, Sb + dir * 64 * LS + eh * LS, LS, acc, lane);
#pragma unroll
        for (int ri = 0; ri < 16; ++ri) { const int ii = ih + CROW(ri, lane), tok = dir ? 63 - ii : ii; OF[dir * 64 * LF + tok * LF + eh + (lane & 31)] = acc[0][ri]; } }
    __syncthreads();
    { const int tok = tid >> 3, e0 = (tid & 7) * 8; const int row = isc ? NLAT + b * LC + 64 * jt + tok : b * SEQ + 64 * jl + tok;
        float o[8]; float ss = 0.f;
#pragma unroll
        for (int j = 0; j < 8; ++j) { o[j] = OF[tok * LF + e0 + j] + OF[64 * LF + tok * LF + e0 + j]; ss += o[j] * o[j]; }
#pragma unroll
        for (int k = 1; k < 8; k <<= 1) ss += __shfl_xor(ss, k);
        const float rs = 1.f / sqrtf(ss * (1.f / 64.f) + EPS);
        const float ng[8] = {ngv0.x, ngv0.y, ngv0.z, ngv0.w, ngv1.x, ngv1.y, ngv1.z, ngv1.w}; const unsigned gu[4] = {gzv.x, gzv.y, gzv.z, gzv.w};
        unsigned pk[4];
#pragma unroll
        for (int j = 0; j < 4; ++j) pk[j] = pk2(o[2 * j] * rs * ng[2 * j] * siluf_(u2f(gu[j] << 16)), o[2 * j + 1] * rs * ng[2 * j + 1] * siluf_(u2f(gu[j] & 0xffff0000u)));
        *(u32x4*)(WSP(bf16_t, WS_MIX) + (size_t)row * D + 768 + h * 64 + e0) = (u32x4){pk[0], pk[1], pk[2], pk[3]}; }
    __syncthreads();
}
constexpr int MA_Q = 0, MA_K = 9216, MA_VT = 18432, MA_KWT = 27648, MA_P = 36864, MA_ONE = 46080  , MA_S = 50688  ;
struct MlIn { u32x4 q, k, v; float g0, g1; };
__device__ __forceinline__ void mlstm_a_load(Ctx& C, int l, int b, int h, int dir, int c, MlIn& in) {
    const int tid = C.tid, i = tid >> 3, d0 = (tid & 7) * 8; const int row = scan_row<1>(b, dir, 64 * c + i);
    const bf16_t* zr = WSP(bf16_t, WS_Z) + (size_t)row * ZW + MLB + h * 64 + d0; const float* g = WSP(float, WS_ZG) + (size_t)row * 32;
    in.q = *(const u32x4*)zr; in.k = *(const u32x4*)(zr + 256); in.v = *(const u32x4*)(zr + 512);
    in.g0 = g[(2 * dir) * 4 + h]; in.g1 = g[(2 * dir + 1) * 4 + h];
}
__device__ __forceinline__ void mlstm_a_item(Ctx& C, int l, int b, int h, int dir, int c, const MlIn& in) {
    LAS unsigned char* lds = C.lds; ITEM_IDS();
    LAS bf16_t* Qb = (LAS bf16_t*)(lds + MA_Q); LAS bf16_t* Kb = (LAS bf16_t*)(lds + MA_K); LAS bf16_t* VT = (LAS bf16_t*)(lds + MA_VT); LAS bf16_t* KWT = (LAS bf16_t*)(lds + MA_KWT);
    LAS bf16_t* Pm = (LAS bf16_t*)(lds + MA_P); LAS bf16_t* ONE = (LAS bf16_t*)(lds + MA_ONE); LAS float* Sc = (LAS float*)(lds + MA_S);
    const bf16_t* zb = WSP(bf16_t, WS_Z); const float* zg = WSP(float, WS_ZG);
    unsigned char* blob = C.ws + WS_ML + ((size_t)((b * NH + h) * 2 + dir) * NCH + c) * ML_BLOB;
    const int i = tid >> 3, d0 = (tid & 7) * 8; const int row = scan_row<1>(b, dir, 64 * c + i);
    float kv[8];
    { (void)zb; (void)zg; (void)row;
        *(LAS u32x4*)(Qb + i * LS + d0) = in.q;
        const u32x4 kr = in.k, vr = in.v;
        const unsigned ku[4] = {kr.x, kr.y, kr.z, kr.w}, vu[4] = {vr.x, vr.y, vr.z, vr.w};
#pragma unroll
        for (int j = 0; j < 4; ++j) { kv[2 * j] = u2f(ku[j] << 16) * 0.125f; kv[2 * j + 1] = u2f(ku[j] & 0xffff0000u) * 0.125f; VT[(d0 + 2 * j) * LS + i] = (bf16_t)(vu[j] & 0xffffu); VT[(d0 + 2 * j + 1) * LS + i] = (bf16_t)(vu[j] >> 16); }
        u32x4 wk; wk.x = pk2(kv[0], kv[1]); wk.y = pk2(kv[2], kv[3]); wk.z = pk2(kv[4], kv[5]); wk.w = pk2(kv[6], kv[7]); *(LAS u32x4*)(Kb + i * LS + d0) = wk;
        if ((tid & 7) == 0) { const float* gb = INP(I_MLGB) + l * 16;
            Sc[i] = in.g0 + gb[(2 * dir) * 4 + h]; Sc[64 + i] = logsigmoidf_(in.g1 + gb[(2 * dir + 1) * 4 + h]); }
        for (int o = tid; o < 32 * LS; o += 512) ONE[o] = (bf16_t)((o < LS) ? 0x3f80 : 0);
    }
    __syncthreads();
    if (w == 0) { float fc = Sc[64 + lane];
#pragma unroll
        for (int o = 1; o < 64; o <<= 1) { const float t = __shfl(fc, lane - o); if (lane >= o) fc += t; }
        const float li = Sc[lane]; float pm = li - fc;
#pragma unroll
        for (int o = 1; o < 64; o <<= 1) { const float t = __shfl(pm, lane - o); if (lane >= o) pm = fmaxf(pm, t); }
        const float fl = __shfl(fc, 63); const float gg = fl - fc + li; float gm = gg;
#pragma unroll
        for (int o = 1; o < 64; o <<= 1) gm = fmaxf(gm, __shfl_xor(gm, o));
        Sc[128 + lane] = fc; Sc[192 + lane] = gg - gm; Sc[256 + lane] = fc + pm;
        if (lane == 0) { ((float*)(blob + 17408))[0] = gm; ((float*)(blob + 17408))[1] = fl; }
        ((float*)(blob + 16384))[64 + lane] = fc + pm; ((float*)(blob + 16384))[128 + lane] = fc; }
    __syncthreads();
    { const float e = __expf(Sc[192 + i]);
#pragma unroll
        for (int j = 0; j < 8; ++j) KWT[(d0 + j) * LS + i] = (bf16_t)f2bf(kv[j] * e); }
    if (w < 2) { f32x16 acc[2]; acc[0] = (f32x16)(0.f); acc[1] = (f32x16)(0.f);
        const int rh = w * 32; mm_nt<2, 4>(Qb + rh * LS, LS, Kb, LS, acc, lane);
        float fi[16], cj[2];
#pragma unroll
        for (int ri = 0; ri < 16; ++ri) { const int ii = rh + CROW(ri, lane); fi[ri] = Sc[128 + ii] - Sc[256 + ii]; }
        cj[0] = Sc[lane & 31] - Sc[128 + (lane & 31)]; cj[1] = Sc[32 + (lane & 31)] - Sc[128 + 32 + (lane & 31)];
#pragma unroll
        for (int n = 0; n < 2; ++n)
#pragma unroll
            for (int ri = 0; ri < 16; ++ri) { const int ii = rh + CROW(ri, lane), jj = 32 * n + (lane & 31);
                Pm[ii * LS + jj] = (bf16_t)f2bf(jj <= ii ? acc[n][ri] * __expf(fi[ri] + cj[n]) : 0.f); } }
    __syncthreads();
    { const int pr = w >> 2, q = w & 3, rh = (q & 1) * 32, ch = (q >> 1) * 32; f32x16 acc[1]; acc[0] = (f32x16)(0.f);
        const LAS bf16_t* Ap = pr ? VT : Pm; const LAS bf16_t* Bp = pr ? KWT : VT;
        mm_nt<1, 4>(Ap + rh * LS, LS, Bp + ch * LS, LS, acc, lane);
        LAS bf16_t* OUT = (LAS bf16_t*)(lds + MA_Q) + (pr ? 4096 : 0);
#pragma unroll
        for (int ri = 0; ri < 16; ++ri) OUT[(rh + CROW(ri, lane)) * 64 + ch + (lane & 31)] = (bf16_t)f2bf(acc[0][ri]);
        if (q < 2) {
            f32x16 a2[1]; a2[0] = (f32x16)(0.f);
            if (pr == 0) { mm_nt<1, 4>(Pm + (q * 32) * LS, LS, ONE, LS, a2, lane);
                if ((lane & 31) == 0) {
#pragma unroll
                    for (int ri = 0; ri < 16; ++ri) ((float*)(blob + 16384))[q * 32 + CROW(ri, lane)] = a2[0][ri]; } }
            else { mm_nt<1, 4>(ONE, LS, KWT + (q * 32) * LS, LS, a2, lane);
                if (lane < 32) ((float*)(blob + 16384))[192 + q * 32 + lane] = a2[0][0]; } } }
    __syncthreads();
#pragma unroll
    for (int k = 0; k < 2; ++k) { const int o = tid + 512 * k; *(u32x4*)(blob + (size_t)o * 16) = *(const LAS u32x4*)(lds + MA_Q + o * 16); }
    __syncthreads();
}
__device__ __forceinline__ void mlstm_b_scan(Ctx& C, int sidx) {
    const int tid = C.tid, e = tid >> 3, d0 = (tid & 7) * 8;
    float ct[8], nn[8]; float m = 0.f;
#pragma unroll
    for (int j = 0; j < 8; ++j) { ct[j] = 0.f; nn[j] = 0.f; }
    u32x4 uq; f32x4 n0, n1; float gm, fl;
    { const unsigned char* blob = C.ws + WS_ML + ((size_t)sidx * NCH) * ML_BLOB;
        uq = *(const u32x4*)((const bf16_t*)(blob + 8192) + e * 64 + d0);
        n0 = *(const f32x4*)((const float*)(blob + 16384) + 192 + d0); n1 = *(const f32x4*)((const float*)(blob + 16384) + 192 + d0 + 4); gm = ((const float*)(blob + 17408))[0]; fl = ((const float*)(blob + 17408))[1]; }
    for (int c = 0; c < NCH; ++c) {
        unsigned char* st = C.ws + WS_MST + ((size_t)sidx * NCH + c) * ML_ST;
        const int cn = (c + 1 < NCH) ? c + 1 : c; const unsigned char* blob = C.ws + WS_ML + ((size_t)sidx * NCH + cn) * ML_BLOB;
        const u32x4 puq = *(const u32x4*)((const bf16_t*)(blob + 8192) + e * 64 + d0);
        const f32x4 pn0 = *(const f32x4*)((const float*)(blob + 16384) + 192 + d0), pn1 = *(const f32x4*)((const float*)(blob + 16384) + 192 + d0 + 4);
        const float pgm = ((const float*)(blob + 17408))[0], pfl = ((const float*)(blob + 17408))[1];
        u32x4 wv; wv.x = pk2(ct[0], ct[1]); wv.y = pk2(ct[2], ct[3]); wv.z = pk2(ct[4], ct[5]); wv.w = pk2(ct[6], ct[7]);
        *(u32x4*)((bf16_t*)st + e * 64 + d0) = wv;
        if (e == 0) { *(f32x4*)((float*)(st + 8192) + d0) = (f32x4){nn[0], nn[1], nn[2], nn[3]}; *(f32x4*)((float*)(st + 8192) + d0 + 4) = (f32x4){nn[4], nn[5], nn[6], nn[7]}; if (d0 == 0) ((float*)(st + 8192))[64] = m; }
        const float mn = fmaxf(fl + m, gm), ao = __expf(fl + m - mn), an = __expf(gm - mn); m = mn;
        const unsigned uw[4] = {uq.x, uq.y, uq.z, uq.w}; const float un[8] = {n0.x, n0.y, n0.z, n0.w, n1.x, n1.y, n1.z, n1.w};
#pragma unroll
        for (int j = 0; j < 4; ++j) { ct[2 * j] = ao * ct[2 * j] + an * u2f(uw[j] << 16); ct[2 * j + 1] = ao * ct[2 * j + 1] + an * u2f(uw[j] & 0xffff0000u); }
#pragma unroll
        for (int j = 0; j < 8; ++j) nn[j] = ao * nn[j] + an * un[j];
        uq = puq; n0 = pn0; n1 = pn1; gm = pgm; fl = pfl;
    }
}
__device__ __forceinline__ void mlstm_c_item(Ctx& C, int l, int b, int h, int jt) {
    LAS unsigned char* lds = C.lds; ITEM_IDS();
    LAS bf16_t* Qb = (LAS bf16_t*)lds;
    LAS bf16_t* Sb = (LAS bf16_t*)(lds + 18432);
    LAS float* OF = (LAS float*)(lds + 36864);
    LAS float* Sc = (LAS float*)(lds + 70144);
    const bool isc = jt < NCHC; const int jl = jt - NCHC;
    int cidx[2]; cidx[0] = jt; cidx[1] = isc ? (NCHC - 1 - jt) : NCHC + (SEQ / 64 - 1 - jl);
    const unsigned char* blob[2]; const bf16_t* zb = WSP(bf16_t, WS_Z);
    const int i = tid >> 3, d0 = (tid & 7) * 8;
    const int dirw = w >> 2, qw = w & 3, ihw = (qw & 1) * 32, ehw = (qw >> 1) * 32;
    LAS bf16_t* NL = (LAS bf16_t*)(lds + 72192);
    const int rowf = scan_row<1>(b, 0, 64 * cidx[0] + i);
    const u32x4 gzv = *(const u32x4*)(zb + (size_t)rowf * ZW + MLB + 768 + h * 64 + d0);
    const f32x4 ngv0 = *(const f32x4*)(INP(I_MLNG) + l * 256 + h * 64 + d0), ngv1 = *(const f32x4*)(INP(I_MLNG) + l * 256 + h * 64 + d0 + 4);
#pragma unroll
    for (int dir = 0; dir < 2; ++dir) { const size_t sc = (size_t)((b * NH + h) * 2 + dir) * NCH + cidx[dir]; blob[dir] = C.ws + WS_ML + sc * ML_BLOB;
        const unsigned char* st = C.ws + WS_MST + sc * ML_ST; const int row = scan_row<1>(b, dir, 64 * cidx[dir] + i);
        const u32x4 qr = *(const u32x4*)(zb + (size_t)row * ZW + MLB + h * 64 + d0);
        *(LAS u32x4*)(Qb + dir * 64 * LS + i * LS + d0) = qr;
        *(LAS u32x4*)(Sb + dir * 64 * LS + i * LS + d0) = *(const u32x4*)((const bf16_t*)st + i * 64 + d0);
        *(LAS u32x4*)(NL + dir * 64 * LS + i * LS + d0) = *(const u32x4*)((const bf16_t*)blob[dir] + i * 64 + d0);
        const float* n0 = (const float*)(st + 8192) + d0; const unsigned qu[4] = {qr.x, qr.y, qr.z, qr.w}; float qn = 0.f;
#pragma unroll
        for (int j = 0; j < 4; ++j) qn += u2f(qu[j] << 16) * n0[2 * j] + u2f(qu[j] & 0xffff0000u) * n0[2 * j + 1];
#pragma unroll
        for (int k = 1; k < 8; k <<= 1) qn += __shfl_xor(qn, k);
        if ((tid & 7) == 0) { const float* sv = (const float*)(blob[dir] + 16384); const float m0 = ((const float*)(st + 8192))[64];
            const float mloc = sv[64 + i], ainit = sv[128 + i] + m0, M = fmaxf(mloc, ainit), s1 = __expf(mloc - M), s2 = __expf(ainit - M);
            LAS float* o = Sc + dir * 256; o[i] = s1; o[64 + i] = s2; o[128 + i] = s1 * sv[i] + s2 * qn; o[192 + i] = __expf(-M); } }
    __syncthreads();
    { const int dir = dirw, ih = ihw, eh = ehw; f32x16 acc[1]; acc[0] = (f32x16)(0.f);
        mm_nt<1, 4>(Qb + dir * 64 * LS + ih * LS, LS, Sb + dir * 64 * LS + eh * LS, LS, acc, lane);
        const LAS float* o = Sc + dir * 256; float s1[16], s2[16], dn[16];
#pragma unroll
        for (int ri = 0; ri < 16; ++ri) { const int ii = ih + CROW(ri, lane); s1[ri] = o[ii] * bf2f(NL[dir * 64 * LS + ii * LS + eh + (lane & 31)]); s2[ri] = o[64 + ii]; dn[ri] = 1.f / fmaxf(fabsf(o[128 + ii]), o[192 + ii]); }
#pragma unroll
        for (int ri = 0; ri < 16; ++ri) { const int ii = ih + CROW(ri, lane), tok = dir ? 63 - ii : ii, ee = eh + (lane & 31);
            OF[dir * 64 * LF + tok * LF + ee] = (s1[ri] + s2[ri] * acc[0][ri]) * dn[ri]; } }
    __syncthreads();
    { const int tok = tid >> 3, e0 = (tid & 7) * 8; const int row = scan_row<1>(b, 0, 64 * cidx[0] + tok);
        float o[8]; float ss = 0.f;
#pragma unroll
        for (int j = 0; j < 8; ++j) { o[j] = OF[tok * LF + e0 + j] + OF[64 * LF + tok * LF + e0 + j]; ss += o[j] * o[j]; }
#pragma unroll
        for (int k = 1; k < 8; k <<= 1) ss += __shfl_xor(ss, k);
        const float rs = 1.f / sqrtf(ss * (1.f / 64.f) + EPS);
        const float ng[8] = {ngv0.x, ngv0.y, ngv0.z, ngv0.w, ngv1.x, ngv1.y, ngv1.z, ngv1.w}; const unsigned gu[4] = {gzv.x, gzv.y, gzv.z, gzv.w};
        unsigned pk[4];
#pragma unroll
        for (int j = 0; j < 4; ++j) pk[j] = pk2(o[2 * j] * rs * ng[2 * j] * sigmoidf_(u2f(gu[j] << 16)), o[2 * j + 1] * rs * ng[2 * j + 1] * sigmoidf_(u2f(gu[j] & 0xffff0000u)));
        *(u32x4*)(WSP(bf16_t, WS_MIX) + (size_t)row * D + 256 + h * 64 + e0) = (u32x4){pk[0], pk[1], pk[2], pk[3]}; }
    __syncthreads();
}
constexpr int HA_Q = 0, HA_K = 16640, HA_CUM = 33280, HA_V = 49920, HA_SC = 66560  , HA_VT = 70912, HA_KDT = 80128, HA_QT = 89344, HA_KT = 98560;
__device__ __forceinline__ void hgrn_a_item(Ctx& C, int l, int b, int h, int dir, int c) {
    LAS unsigned char* lds = C.lds; ITEM_IDS();
    LAS float* Qf = (LAS float*)(lds + HA_Q); LAS float* Kf = (LAS float*)(lds + HA_K); LAS float* CUM = (LAS float*)(lds + HA_CUM); LAS float* Vf = (LAS float*)(lds + HA_V); LAS float* SC = (LAS float*)(lds + HA_SC);
    LAS bf16_t* VT = (LAS bf16_t*)(lds + HA_VT); LAS bf16_t* KDT = (LAS bf16_t*)(lds + HA_KDT); LAS bf16_t* QTb = (LAS bf16_t*)(lds + HA_QT); LAS bf16_t* KTb = (LAS bf16_t*)(lds + HA_KT);
    const bf16_t* zb = WSP(bf16_t, WS_Z);
    unsigned char* blob = C.ws + WS_HG + ((size_t)((b * NH + h) * 2 + dir) * NCH + c) * HG_BLOB;
    const int i = tid >> 3, d0 = (tid & 7) * 8; const int row = scan_row<0>(b, dir, 64 * c + i);
    { const bf16_t* zr = zb + (size_t)row * ZW + HGB + h * 64 + d0; const float* lbp = WSP(float, WS_LB) + l * 256 + h * 64 + d0;
        const u32x4 zq4 = *(const u32x4*)zr, zi4 = *(const u32x4*)(zr + 256), zf4 = *(const u32x4*)(zr + 512 + dir * 256); const f32x4 lb0 = *(const f32x4*)lbp, lb1 = *(const f32x4*)(lbp + 4);
        const unsigned zqu[4] = {zq4.x, zq4.y, zq4.z, zq4.w}, ziu[4] = {zi4.x, zi4.y, zi4.z, zi4.w}, zfu[4] = {zf4.x, zf4.y, zf4.z, zf4.w}; const float lbv[8] = {lb0.x, lb0.y, lb0.z, lb0.w, lb1.x, lb1.y, lb1.z, lb1.w};
#pragma unroll
        for (int j = 0; j < 8; ++j) { const int jj = j >> 1; const bool hi = j & 1;
            const float qz = hi ? u2f(zqu[jj] & 0xffff0000u) : u2f(zqu[jj] << 16), iz = hi ? u2f(ziu[jj] & 0xffff0000u) : u2f(ziu[jj] << 16), fz = hi ? u2f(zfu[jj] & 0xffff0000u) : u2f(zfu[jj] << 16), lb = lbv[j];
            const float sg = 1.f / (1.f + __expf(-fz)), sgn = 1.f / (1.f + __expf(fz));
            Qf[i * LF + d0 + j] = siluf_(qz); Kf[i * LF + d0 + j] = (1.f - lb) * sgn; CUM[i * LF + d0 + j] = __logf(lb + (1.f - lb) * sg); Vf[i * LF + d0 + j] = iz; VT[(d0 + j) * LS + i] = (bf16_t)f2bf(iz); } }
    __syncthreads();
    if (tid < 256) { const int sub = tid >> 6, d = tid & 63; float cv[16];
#pragma unroll
        for (int t = 0; t < 16; ++t) cv[t] = CUM[(16 * sub + t) * LF + d];
#pragma unroll
        for (int t = 1; t < 16; ++t) cv[t] += cv[t - 1];
#pragma unroll
        for (int t = 0; t < 16; ++t) CUM[(16 * sub + t) * LF + d] = cv[t]; }
    __syncthreads();
    { const int sub = i >> 4; u32x4 wq, wk; float qt[8], kt[8], cmv[8], lsv[8], kkv[8], qqv[8];
#pragma unroll
        for (int j = 0; j < 8; ++j) { cmv[j] = CUM[i * LF + d0 + j]; lsv[j] = CUM[(16 * sub + 15) * LF + d0 + j]; kkv[j] = Kf[i * LF + d0 + j]; qqv[j] = Qf[i * LF + d0 + j]; }
#pragma unroll
        for (int j = 0; j < 8; ++j) { const float cm = cmv[j], last = lsv[j], kk = kkv[j];
            KDT[(d0 + j) * LS + i] = (bf16_t)f2bf(kk * __expf(last - cm)); qt[j] = qqv[j] * __expf(cm); kt[j] = kk * __expf(fminf(-cm, 80.f));
            if ((i & 15) == 15) ((float*)(blob + 32768))[sub * 64 + d0 + j] = __expf(last); }
        wq.x = pk2(qt[0], qt[1]); wq.y = pk2(qt[2], qt[3]); wq.z = pk2(qt[4], qt[5]); wq.w = pk2(qt[6], qt[7]);
        wk.x = pk2(kt[0], kt[1]); wk.y = pk2(kt[2], kt[3]); wk.z = pk2(kt[4], kt[5]); wk.w = pk2(kt[6], kt[7]);
        *(u32x4*)((bf16_t*)(blob + 33792) + i * 64 + d0) = wq; *(LAS u32x4*)(QTb + i * LS + d0) = wq; *(LAS u32x4*)(KTb + i * LS + d0) = wk; }
    __syncthreads();
    if (w < 4) { const int sub = w, cl = lane & 15, q4 = lane >> 4; f32x4 acc = (f32x4){0.f, 0.f, 0.f, 0.f};
#pragma unroll
        for (int kk = 0; kk < 2; ++kk) { const bf16x8 a = *(const LAS bf16x8*)(QTb + (16 * sub + cl) * LS + 32 * kk + 8 * q4), bb = *(const LAS bf16x8*)(KTb + (16 * sub + cl) * LS + 32 * kk + 8 * q4);
            acc = __builtin_amdgcn_mfma_f32_16x16x32_bf16(a, bb, acc, 0, 0, 0); }
#pragma unroll
        for (int r = 0; r < 4; ++r) { const int t = 4 * q4 + r; SC[(sub * 16 + t) * 17 + cl] = (cl <= t) ? acc[r] : 0.f; } }
    __syncthreads();
    { const int sub = i >> 4, t = i & 15; float o[8];
#pragma unroll
        for (int j = 0; j < 8; ++j) o[j] = 0.f;
#pragma unroll
        for (int s2 = 0; s2 < 16; ++s2) { const float sc = SC[(sub * 16 + t) * 17 + s2];
#pragma unroll
            for (int j = 0; j < 8; ++j) o[j] += sc * Vf[(16 * sub + s2) * LF + d0 + j]; }
        u32x4 ow; ow.x = pk2(o[0], o[1]); ow.y = pk2(o[2], o[3]); ow.z = pk2(o[4], o[5]); ow.w = pk2(o[6], o[7]); *(u32x4*)((bf16_t*)(blob + 41984) + i * 64 + d0) = ow; }
    { const int sub = w >> 1, eh = (w & 1) * 32; f32x16 acc[2]; acc[0] = (f32x16)(0.f); acc[1] = (f32x16)(0.f);
        mm_nt<2, 1>(VT + eh * LS + 16 * sub, LS, KDT + 16 * sub, LS, acc, lane);
        LAS bf16_t* ut = (LAS bf16_t*)(lds + HA_Q) + sub * 4096;
#pragma unroll
        for (int n = 0; n < 2; ++n)
#pragma unroll
            for (int ri = 0; ri < 16; ++ri) ut[(eh + CROW(ri, lane)) * 64 + 32 * n + (lane & 31)] = (bf16_t)f2bf(acc[n][ri]); }
    __syncthreads();
#pragma unroll
    for (int k = 0; k < 4; ++k) { const int o = tid + 512 * k; *(u32x4*)(blob + (size_t)o * 16) = *(const LAS u32x4*)(lds + HA_Q + o * 16); }
    __syncthreads();
}
__device__ __forceinline__ void hgrn_b_scan(Ctx& C, int sidx) {
    const int tid = C.tid, e = tid >> 3, d0 = (tid & 7) * 8;
    LAS float* LAM = (LAS float*)C.lds;
    __syncthreads();
    for (int o = tid; o < NCH * 64; o += 512) { const int c = o >> 6, q = o & 63; *(LAS f32x4*)(LAM + c * 256 + q * 4) = *(const f32x4*)((const float*)(C.ws + WS_HG + ((size_t)sidx * NCH + c) * HG_BLOB + 32768) + q * 4); }
    __syncthreads();
    float st[8];
#pragma unroll
    for (int j = 0; j < 8; ++j) st[j] = 0.f;
    u32x4 ur[3][4];
#define HGB_LOAD(slot, cc) do { const int c_ = (cc) < NCH ? (cc) : NCH - 1; const unsigned char* blob_ = C.ws + WS_HG + ((size_t)sidx * NCH + c_) * HG_BLOB; \
        _Pragma("unroll") for (int sub = 0; sub < 4; ++sub) ur[slot][sub] = *(const u32x4*)((const bf16_t*)blob_ + sub * 4096 + e * 64 + d0); } while (0)
#define HGB_APPLY(slot, cc) do { bf16_t* so_ = WSP(bf16_t, WS_HST) + ((size_t)sidx * NCH + (cc)) * 4 * 4096; \
        _Pragma("unroll") for (int sub = 0; sub < 4; ++sub) { u32x4 wv; wv.x = pk2(st[0], st[1]); wv.y = pk2(st[2], st[3]); wv.z = pk2(st[4], st[5]); wv.w = pk2(st[6], st[7]); \
            *(u32x4*)(so_ + sub * 4096 + e * 64 + d0) = wv; \
            const f32x4 la_ = *(const LAS f32x4*)(LAM + ((cc) * 4 + sub) * 64 + d0), lb_ = *(const LAS f32x4*)(LAM + ((cc) * 4 + sub) * 64 + d0 + 4); \
            const unsigned uu[4] = {ur[slot][sub].x, ur[slot][sub].y, ur[slot][sub].z, ur[slot][sub].w}; const float lam[8] = {la_.x, la_.y, la_.z, la_.w, lb_.x, lb_.y, lb_.z, lb_.w}; \
            _Pragma("unroll") for (int j = 0; j < 4; ++j) { st[2 * j] = lam[2 * j] * st[2 * j] + u2f(uu[j] << 16); st[2 * j + 1] = lam[2 * j + 1] * st[2 * j + 1] + u2f(uu[j] & 0xffff0000u); } } } while (0)
    HGB_LOAD(0, 0); HGB_LOAD(1, 1);
    int c = 0;
    for (; c + 3 <= NCH; c += 3) {
        HGB_LOAD(2, c + 2); HGB_APPLY(0, c);
        HGB_LOAD(0, c + 3); HGB_APPLY(1, c + 1);
        HGB_LOAD(1, c + 4); HGB_APPLY(2, c + 2);
    }
    if (c < NCH) { HGB_APPLY(0, c); ++c; }
    if (c < NCH) { HGB_APPLY(1, c); ++c; }
#undef HGB_LOAD
#undef HGB_APPLY
    __syncthreads();
}
__device__ __forceinline__ void hgrn_c_item(Ctx& C, int l, int b, int h, int jt) {
    LAS unsigned char* lds = C.lds; ITEM_IDS();
    LAS bf16_t* STw = (LAS bf16_t*)(lds + w * 11520);
    LAS bf16_t* QTw = STw + 64 * LS;
    LAS float* OF = (LAS float*)(lds + 92160);
    const bool isc = jt < NCHC; const int jl = jt - NCHC;
    int cidx[2]; cidx[0] = jt; cidx[1] = isc ? (NCHC - 1 - jt) : NCHC + (SEQ / 64 - 1 - jl);
    const int tokf = tid >> 3, e0f = (tid & 7) * 8; const int rowf = scan_row<0>(b, 0, 64 * cidx[0] + tokf);
    const u32x4 gzv = *(const u32x4*)(WSP(bf16_t, WS_Z) + (size_t)rowf * ZW + HGB + 1024 + h * 64 + e0f);
    const f32x4 ngv0 = *(const f32x4*)(INP(I_HGNG) + l * 256 + h * 64 + e0f), ngv1 = *(const f32x4*)(INP(I_HGNG) + l * 256 + h * 64 + e0f + 4);
    { const int dir = w >> 2, sub = w & 3; const size_t sc = (size_t)((b * NH + h) * 2 + dir) * NCH + cidx[dir]; const unsigned char* blob = C.ws + WS_HG + sc * HG_BLOB;
        const bf16_t* st = WSP(bf16_t, WS_HST) + (sc * 4 + sub) * 4096; const bf16_t* qt = (const bf16_t*)(blob + 33792) + (16 * sub) * 64;
#pragma unroll
        for (int k = 0; k < 8; ++k) { const int o = lane + 64 * k, r = o >> 3, c8 = (o & 7) * 8; *(LAS u32x4*)(STw + r * LS + c8) = *(const u32x4*)(st + r * 64 + c8); }
#pragma unroll
        for (int k = 0; k < 2; ++k) { const int o = lane + 64 * k, r = o >> 3, c8 = (o & 7) * 8; *(LAS u32x4*)(QTw + r * LS + c8) = *(const u32x4*)(qt + r * 64 + c8); }
        const bf16_t* oi = (const bf16_t*)(blob + 41984) + (16 * sub) * 64;
        u32x4 oiq[2];
#pragma unroll
        for (int k = 0; k < 2; ++k) { const int o = lane + 64 * k, r = o >> 3, c8 = (o & 7) * 8; oiq[k] = *(const u32x4*)(oi + r * 64 + c8); }
        LDS_WAIT(); asm volatile("" ::: "memory");
        const int tr = lane & 15, kq = (lane >> 4) * 8;
        f32x4 accs[4];
#pragma unroll
        for (int nt = 0; nt < 4; ++nt) { f32x4 acc = (f32x4){0.f, 0.f, 0.f, 0.f};
#pragma unroll
            for (int kk = 0; kk < 2; ++kk) { const bf16x8 a = *(const LAS bf16x8*)(QTw + tr * LS + 32 * kk + kq), bb = *(const LAS bf16x8*)(STw + (16 * nt + tr) * LS + 32 * kk + kq);
                acc = __builtin_amdgcn_mfma_f32_16x16x32_bf16(a, bb, acc, 0, 0, 0); }
            accs[nt] = acc; }
        LDS_WAIT(); asm volatile("" ::: "memory");
#pragma unroll
        for (int k = 0; k < 2; ++k) { const int o = lane + 64 * k, r = o >> 3, c8 = (o & 7) * 8; *(LAS u32x4*)(QTw + r * LS + c8) = oiq[k]; }
        LDS_WAIT(); asm volatile("" ::: "memory");
        float oiv[16];
#pragma unroll
        for (int nt = 0; nt < 4; ++nt)
#pragma unroll
            for (int r = 0; r < 4; ++r) oiv[4 * nt + r] = bf2f(QTw[(4 * (lane >> 4) + r) * LS + 16 * nt + (lane & 15)]);
#pragma unroll
        for (int nt = 0; nt < 4; ++nt)
#pragma unroll
            for (int r = 0; r < 4; ++r) { const int t = 4 * (lane >> 4) + r, ii = 16 * sub + t, tok = dir ? 63 - ii : ii, ee = 16 * nt + (lane & 15);
                OF[dir * 64 * LF + tok * LF + ee] = accs[nt][r] + oiv[4 * nt + r]; } }
    __syncthreads();
    { const int tok = tid >> 3, e0 = (tid & 7) * 8; const int row = scan_row<0>(b, 0, 64 * cidx[0] + tok);
        float o[8]; float ss = 0.f;
#pragma unroll
        for (int j = 0; j < 8; ++j) { o[j] = OF[tok * LF + e0 + j] + OF[64 * LF + tok * LF + e0 + j]; ss += o[j] * o[j]; }
#pragma unroll
        for (int k = 1; k < 8; k <<= 1) ss += __shfl_xor(ss, k);
        const float rs = 1.f / sqrtf(ss * (1.f / 64.f) + EPS);
        const float ng[8] = {ngv0.x, ngv0.y, ngv0.z, ngv0.w, ngv1.x, ngv1.y, ngv1.z, ngv1.w}; const unsigned gu[4] = {gzv.x, gzv.y, gzv.z, gzv.w};
        unsigned pk[4];
#pragma unroll
        for (int j = 0; j < 4; ++j) pk[j] = pk2(o[2 * j] * rs * ng[2 * j] * siluf_(u2f(gu[j] << 16)), o[2 * j + 1] * rs * ng[2 * j + 1] * siluf_(u2f(gu[j] & 0xffff0000u)));
        *(u32x4*)(WSP(bf16_t, WS_MIX) + (size_t)row * D + h * 64 + e0) = (u32x4){pk[0], pk[1], pk[2], pk[3]}; }
    __syncthreads();
}
__device__ __forceinline__ void phase_gdn_a(Ctx& C, int l) {
    for (int rep = 0; rep < 1 + ((REPMASK >> 10) & 1); ++rep)
    for (int it = C.bid; it < NSCAN * NCH; it += C.G) { const int sidx = it / NCH, c = it % NCH; gdn_a_item(C, l, sidx / (NH * 2), (sidx / 2) % NH, sidx & 1, c); }
    for (int rep = 0; rep < 1 + ((REPMASK >> 11) & 1); ++rep)
    { MlIn cur, nxt; int it = (C.bid + C.G / 3) % C.G;
        if (it < NSCAN * NCH) { const int sidx = it / NCH; mlstm_a_load(C, l, sidx / (NH * 2), (sidx / 2) % NH, sidx & 1, it % NCH, cur); }
        for (; it < NSCAN * NCH; it += C.G) { const int sidx = it / NCH, c = it % NCH; const int itn = (it + C.G < NSCAN * NCH) ? it + C.G : it, sn = itn / NCH;
            mlstm_a_load(C, l, sn / (NH * 2), (sn / 2) % NH, sn & 1, itn % NCH, nxt);
            mlstm_a_item(C, l, sidx / (NH * 2), (sidx / 2) % NH, sidx & 1, c, cur); cur = nxt; } }
    for (int rep = 0; rep < 1 + ((REPMASK >> 12) & 1); ++rep)
    for (int it = (C.bid + 2 * (C.G / 3)) % C.G; it < NSCAN * NCH; it += C.G) { const int sidx = it / NCH, c = it % NCH; hgrn_a_item(C, l, sidx / (NH * 2), (sidx / 2) % NH, sidx & 1, c); }
}
__device__ __forceinline__ void phase_hy_transpose(Ctx& C) {
    const int gw = C.vcu * 8 + C.wave, NGW = C.G * 8, lane = C.lane;
    LAS bf16_t* scr = (LAS bf16_t*)(C.lds + C.wave * 8448);
    const bf16_t* zb = WSP(bf16_t, WS_Z); bf16_t* zt = WSP(bf16_t, WS_ZT);
    for (int it = gw; it < (NT / 64) * 12; it += NGW) { const int r0 = (it / 12) * 64, cb = (it % 12) * 64;
#pragma unroll 8
        for (int rr = 0; rr < 64; rr += 2) { const int r = rr + (lane >> 5), c2 = (lane & 31) * 2; const unsigned v = *(const unsigned*)(zb + (size_t)(r0 + r) * ZW + HYB + cb + c2);
            scr[r * 66 + c2] = (bf16_t)(v & 0xffffu); scr[r * 66 + c2 + 1] = (bf16_t)(v >> 16); }
        LDS_WAIT(); asm volatile("" ::: "memory");
#pragma unroll 8
        for (int cc = 0; cc < 64; cc += 2) { const int c = cc + (lane >> 5), r2 = (lane & 31) * 2;
            *(unsigned*)(zt + (size_t)(cb + c) * NT + r0 + r2) = (unsigned)scr[r2 * 66 + c] | ((unsigned)scr[(r2 + 1) * 66 + c] << 16); }
        LDS_WAIT(); asm volatile("" ::: "memory"); }
}
__device__ __forceinline__ void phase_gdn_c(Ctx& C, int l) {
    const int j0 = (l == 0) ? 0 : NCHC, nj = NCH - j0;
    for (int it = C.bid; it < NB * NH * nj; it += C.G) { const int bh = it / nj, jt = j0 + it % nj; gdn_c_item(C, l, bh / NH, bh % NH, jt); }
    for (int it = (C.bid + C.G / 3) % C.G; it < NB * NH * nj; it += C.G) { const int bh = it / nj, jt = j0 + it % nj; mlstm_c_item(C, l, bh / NH, bh % NH, jt); }
    for (int it = (C.bid + 2 * (C.G / 3)) % C.G; it < NB * NH * nj; it += C.G) { const int bh = it / nj, jt = j0 + it % nj; hgrn_c_item(C, l, bh / NH, bh % NH, jt); }
}

__device__ __forceinline__ f32x2 cmul(f32x2 a, f32x2 w) { return (f32x2){a.x * w.x - a.y * w.y, a.x * w.y + a.y * w.x}; }
__device__ __forceinline__ f32x2 cmulc(f32x2 a, f32x2 w) { return (f32x2){a.x * w.x + a.y * w.y, a.y * w.x - a.x * w.y}; }
template <int N> __device__ __forceinline__ void fft_fwd(LAS f32x2* X, const LAS f32x2* tw, int tid) {
    constexpr int NG = (N / 4 + 511) / 512, NB2 = (N / 2 + 511) / 512;
    int h = N >> 1;
#pragma unroll 1
    for (; h >= 2; h >>= 2) { const float tf = 3.14159265358979f / (float)h; const int hh = h >> 1;
        f32x2 x0[NG], x1[NG], x2[NG], x3[NG], w1[NG]; int bs[NG];
#pragma unroll
        for (int q = 0; q < NG; ++q) { const int j = tid + 512 * q; const int jm = j & (hh - 1); bs[q] = ((j - jm) << 2) + jm;
            if (j < (N >> 2)) { x0[q] = X[bs[q]]; x1[q] = X[bs[q] + hh]; x2[q] = X[bs[q] + h]; x3[q] = X[bs[q] + h + hh]; const float ang = (float)jm * tf; w1[q] = (f32x2){__cosf(ang), -__sinf(ang)}; } }
#pragma unroll
        for (int q = 0; q < NG; ++q) { const int j = tid + 512 * q; if (j < (N >> 2)) {
            const f32x2 w2 = cmul(w1[q], w1[q]);
            const f32x2 a0 = x0[q] + x2[q], a2 = cmul(x0[q] - x2[q], w1[q]), a1 = x1[q] + x3[q]; const f32x2 d13 = cmul(x1[q] - x3[q], w1[q]); const f32x2 a3 = (f32x2){d13.y, -d13.x};
            X[bs[q]] = a0 + a1; X[bs[q] + hh] = cmul(a0 - a1, w2); X[bs[q] + h] = a2 + a3; X[bs[q] + h + hh] = cmul(a2 - a3, w2); } }
        __syncthreads(); }
    if (h == 1) {
        f32x2 a[NB2], b[NB2];
#pragma unroll
        for (int q = 0; q < NB2; ++q) { const int j = tid + 512 * q; if (j < (N >> 1)) { a[q] = X[2 * j]; b[q] = X[2 * j + 1]; } }
#pragma unroll
        for (int q = 0; q < NB2; ++q) { const int j = tid + 512 * q; if (j < (N >> 1)) { X[2 * j] = a[q] + b[q]; X[2 * j + 1] = a[q] - b[q]; } }
        __syncthreads(); }
}
template <int N> __device__ __forceinline__ void fft_inv(LAS f32x2* X, const LAS f32x2* tw, int tid) {
    constexpr int NG = (N / 4 + 511) / 512, NB2 = (N / 2 + 511) / 512;
    constexpr int LOG2N = (N == 8192) ? 13 : (N == 4096) ? 12 : (N == 2048) ? 11 : (N == 1024) ? 10 : (N == 512) ? 9 : (N == 256) ? 8 : (N == 128) ? 7 : (N == 64) ? 6 : -1;
    static_assert(LOG2N > 0, "fft size");
    int h = 2;
    if (LOG2N & 1) {
        f32x2 a[NB2], b[NB2];
#pragma unroll
        for (int q = 0; q < NB2; ++q) { const int j = tid + 512 * q; if (j < (N >> 1)) { a[q] = X[2 * j]; b[q] = X[2 * j + 1]; } }
#pragma unroll
        for (int q = 0; q < NB2; ++q) { const int j = tid + 512 * q; if (j < (N >> 1)) { X[2 * j] = a[q] + b[q]; X[2 * j + 1] = a[q] - b[q]; } }
        __syncthreads(); h = 4; }
#pragma unroll 1
    for (; h <= (N >> 1); h <<= 2) { const float tf = 3.14159265358979f / (float)h; const int hh = h >> 1;
        f32x2 x0[NG], x1[NG], x2[NG], x3[NG], w1[NG]; int bs[NG];
#pragma unroll
        for (int q = 0; q < NG; ++q) { const int j = tid + 512 * q; const int jm = j & (hh - 1); bs[q] = ((j - jm) << 2) + jm;
            if (j < (N >> 2)) { x0[q] = X[bs[q]]; x1[q] = X[bs[q] + hh]; x2[q] = X[bs[q] + h]; x3[q] = X[bs[q] + h + hh]; const float ang = (float)jm * tf; w1[q] = (f32x2){__cosf(ang), -__sinf(ang)}; } }
#pragma unroll
        for (int q = 0; q < NG; ++q) { const int j = tid + 512 * q; if (j < (N >> 2)) {
            const f32x2 w2 = cmul(w1[q], w1[q]);
            const f32x2 b1 = cmulc(x1[q], w2), b3 = cmulc(x3[q], w2); const f32x2 a0 = x0[q] + b1, a1 = x0[q] - b1, a2 = x2[q] + b3, a3 = x2[q] - b3;
            const f32x2 c2 = cmulc(a2, w1[q]); const f32x2 t3 = cmulc(a3, w1[q]); const f32x2 c3 = (f32x2){-t3.y, t3.x};
            X[bs[q]] = a0 + c2; X[bs[q] + h] = a0 - c2; X[bs[q] + hh] = a1 + c3; X[bs[q] + h + hh] = a1 - c3; } }
        __syncthreads(); }
}
__device__ __forceinline__ float block_sum(Ctx& C, float v, LAS float* red) {
    v = wave_sum(v); __syncthreads(); if (C.lane == 0) red[C.wave] = v; __syncthreads();
    float s = 0.f;
#pragma unroll
    for (int i = 0; i < 8; ++i) s += red[i];
    return s;
}
#define FFT_FWD_P(X) do { fft_fwd<N>(X, tw, tid); if ((REPMASK >> 15) & 1) { fft_inv<N>(X, tw, tid); for (int i_ = tid; i_ < N; i_ += 512) X[i_] = X[i_] * (1.0f / (float)N); __syncthreads(); fft_fwd<N>(X, tw, tid); } } while (0)
template <int LEN>
__device__ __forceinline__ void hyena_channel(Ctx& C, int l, int c, int row0, int hoff  ) {
    LAS f32x2* X = (LAS f32x2*)C.lds; LAS f32x2* Y1 = (LAS f32x2*)(C.lds + 65536); const LAS f32x2* tw = (const LAS f32x2*)(C.lds + 98304); LAS float* red = (LAS float*)(C.lds + LDSX_OFF + 128);
    constexpr int N = 2 * LEN, len = LEN, NI = (LEN + 511) / 512;
#ifdef HOST_EMU
    const int tid = C.tid;
#else
    int tid_ = C.tid; asm volatile("" : "+v"(tid_)); const int tid = tid_;
#endif
    f32x2* Ks = WSP(f32x2, WS_KS) + (size_t)C.bid * 2 * FFTN;
    const float* hd = WSP(float, WS_HDN) + ((size_t)l * (SEQ + LC) + hoff) * 64;
    const float* w3 = INP(I_HYW3) + (size_t)l * 64 * 1024;
    const float delta = (-4.605170185988091f / 1.5f + (-4.605170185988091f / 0.3f + 4.605170185988091f / 1.5f) * (float)c / 255.0f);
    const float ad = fabsf(delta);
    LAS f32x4* W3c = (LAS f32x4*)(C.lds + 98304);
    __syncthreads();
    if (tid < 256) { const int j = tid >> 2, q = tid & 3; ((LAS float*)W3c)[tid] = w3[j * 1024 + (q & 1) * 512 + (q >> 1) * 256 + c]; }
    __syncthreads();
    float ss0 = 0.f, ss1 = 0.f;
    for (int p = tid; p < len; p += 512) { const float* hr = hd + (size_t)p * 64; f32x4 acc = (f32x4){0.f, 0.f, 0.f, 0.f};
#pragma unroll 16
        for (int j = 0; j < 64; ++j) acc = acc + W3c[j] * hr[j];
        const float win = __expf(-((float)p / (float)(len - 1)) * ad); acc = acc * win;
        X[p] = (f32x2){acc.x, 0.f}; ss0 += acc.x * acc.x; ss1 += acc.z * acc.z;
        if (p >= 1) { X[N - p] = (f32x2){acc.y, 0.f}; ss0 += acc.y * acc.y; ss1 += acc.w * acc.w; }
        Y1[p] = (f32x2){acc.z, acc.w}; }
    if (tid == 0) X[len] = (f32x2){0.f, 0.f};
    const float scale0 = 1.f / sqrtf(block_sum(C, ss0, red) + EPS), scale1 = 1.f / sqrtf(block_sum(C, ss1, red) + EPS);
    __syncthreads();
    for (int n = 0; n < 2 + 2 * ((REPMASK >> 16) & 1); ++n) {
        if (n & 1) { for (int p = tid; p < len; p += 512) { const f32x2 t1 = Y1[p]; X[p] = (f32x2){t1.x, 0.f}; if (p >= 1) X[N - p] = (f32x2){t1.y, 0.f}; } if (tid == 0) X[len] = (f32x2){0.f, 0.f}; __syncthreads(); }
        FFT_FWD_P(X);
        const float scale = (n & 1) ? scale1 : scale0;
        for (int i = tid; i < N; i += 512) Ks[(size_t)(n & 1) * FFTN + i] = X[i] * scale;
        __syncthreads();
    }
    const bf16_t* zt = WSP(bf16_t, WS_ZT); const float* cw = INP(I_HYCW) + l * 3 * 768; const float* cb = INP(I_HYCB) + l * 768;
    const float bias0 = INP(I_HYBI)[l * 512 + c], bias1 = INP(I_HYBI)[l * 512 + 256 + c];
    float* hyt = WSP(float, WS_HYT) + (size_t)c * NT;
    const float inv_n = 1.0f / (float)N;
    const float cw0[3] = {cw[c], cw[768 + c], cw[1536 + c]}, cw1[3] = {cw[256 + c], cw[768 + 256 + c], cw[1536 + 256 + c]}, cw2[3] = {cw[512 + c], cw[768 + 512 + c], cw[1536 + 512 + c]};
    const float cb0 = cb[c], cb1 = cb[256 + c], cb2 = cb[512 + c];
    const bf16_t* z0 = zt + (size_t)c * NT; const bf16_t* z1 = zt + (size_t)(256 + c) * NT; const bf16_t* z2 = zt + (size_t)(512 + c) * NT;
    LAS f32x2* X1 = Y1;
    LAS f32x2* X2 = (LAS f32x2*)(C.lds + 98304);
    LAS bf16_t* RAW = (LAS bf16_t*)(X + len);
    constexpr int RS = LEN + 16;
    for (int q2 = 0; q2 < NB * (1 + ((REPMASK >> 17) & 1)); q2 += 2) { const int q = q2 % NB;
        const int ra = row0 + q * len, rb = ra + len;
        float va[NI], vb[NI];
#pragma unroll
        for (int col = 0; col < 3; ++col) { const bf16_t* zc = col == 0 ? z0 : (col == 1 ? z1 : z2); const float* wv = col == 0 ? cw0 : (col == 1 ? cw1 : cw2); const float bv = col == 0 ? cb0 : (col == 1 ? cb1 : cb2);
            if (8 * tid < len) { *(LAS u32x4*)(RAW + 8 + 8 * tid) = *(const u32x4*)(zc + ra + 8 * tid); *(LAS u32x4*)(RAW + RS + 8 + 8 * tid) = *(const u32x4*)(zc + rb + 8 * tid); }
            if (tid == 0) { RAW[7] = 0; RAW[8 + len] = 0; RAW[RS + 7] = 0; RAW[RS + 8 + len] = 0; }
            __syncthreads();
#pragma unroll
            for (int k = 0; k < NI; ++k) { const int t = tid + 512 * k; if (t < len) {
                const float ca = bv + wv[0] * bf2f(RAW[7 + t]) + wv[1] * bf2f(RAW[8 + t]) + wv[2] * bf2f(RAW[9 + t]);
                const float cbv = bv + wv[0] * bf2f(RAW[RS + 7 + t]) + wv[1] * bf2f(RAW[RS + 8 + t]) + wv[2] * bf2f(RAW[RS + 9 + t]);
                if (col == 0) { va[k] = ca; vb[k] = cbv; X[t] = (f32x2){ca, cbv}; } else if (col == 1) X1[t] = (f32x2){ca, cbv}; else X2[t] = (f32x2){ca, cbv}; } }
            __syncthreads(); }
#pragma unroll
        for (int k = 0; k < NI; ++k) { const int t = tid + 512 * k; if (t < len) X[len + t] = (f32x2){0.f, 0.f}; }
        __syncthreads();
        FFT_FWD_P(X);
#pragma unroll 1
        for (int k0 = 0; k0 < 2 * NI; k0 += 8) { f32x2 kv_[8], xv_[8];
#pragma unroll
        for (int k = 0; k < 8; ++k) { const int i = tid + 512 * (k0 + k); if (i < N) { kv_[k] = Ks[i]; xv_[k] = X[i]; } }
#pragma unroll
        for (int k = 0; k < 8; ++k) { const int i = tid + 512 * (k0 + k); if (i < N) X[i] = cmul(xv_[k], kv_[k]); } }
        __syncthreads();
        fft_inv<N>(X, tw, tid);
        f32x2 y1[NI];
#pragma unroll
        for (int k = 0; k < NI; ++k) { const int t = tid + 512 * k; if (t < len) { const f32x2 cv = X[t] * inv_n, x1 = X1[t];
            y1[k] = (f32x2){x1.x * (cv.x + bias0 * va[k]), x1.y * (cv.y + bias0 * vb[k])}; } }
        __syncthreads();
#pragma unroll
        for (int k = 0; k < NI; ++k) { const int t = tid + 512 * k; if (t < len) { X[t] = y1[k]; X[len + t] = (f32x2){0.f, 0.f}; } }
        __syncthreads();
        FFT_FWD_P(X);
#pragma unroll 1
        for (int k0 = 0; k0 < 2 * NI; k0 += 8) { f32x2 kv_[8], xv_[8];
#pragma unroll
        for (int k = 0; k < 8; ++k) { const int i = tid + 512 * (k0 + k); if (i < N) { kv_[k] = Ks[FFTN + i]; xv_[k] = X[i]; } }
#pragma unroll
        for (int k = 0; k < 8; ++k) { const int i = tid + 512 * (k0 + k); if (i < N) X[i] = cmul(xv_[k], kv_[k]); } }
        __syncthreads();
        fft_inv<N>(X, tw, tid);
#pragma unroll
        for (int k = 0; k < NI; ++k) { const int t = tid + 512 * k; if (t < len) { const f32x2 cv = X[t] * inv_n, yy = y1[k], x2 = X2[t];
            hyt[ra + t] = x2.x * (cv.x + bias1 * yy.x); hyt[rb + t] = x2.y * (cv.y + bias1 * yy.y); } }
        __syncthreads();
    }
}
__device__ __forceinline__ void phase_mixers(Ctx& C, int l, int parts = 3) {
    const int G = C.G, me = C.bid;
    const int nscan = 3 * NSCAN, nsw = G > nscan ? nscan : G;
    if (parts & 1) for (int j = me; j < nscan; j += nsw) { if (me >= nsw) break;
        const int mix = j / NSCAN, r = j % NSCAN;
        if (mix == 0) { if (!(parts & 32) || (parts & 4)) hgrn_b_scan(C, r); } else if (mix == 1) { if (!(parts & 32) || (parts & 8)) mlstm_b_scan(C, r); } else { if (!(parts & 32) || (parts & 16)) gdn_b_scan(C, r); } }
    if (parts & 2) {
        LAS f32x2* tw = (LAS f32x2*)(C.lds + 98304); volatile LAS int* jobw = (volatile LAS int*)(C.lds + LDSX_OFF + 192);
        __syncthreads();
        for (int k = C.tid; k < TWN; k += 512) { float s, c; sincospi_((float)k / (float)TWN, &s, &c); tw[k] = (f32x2){c, -s}; }
        __syncthreads();
        unsigned* qh = WSP(unsigned, WS_CTL) + CW_HYQ + 64 * l + ((parts == 2) ? 32 : 0) + ((parts & 64) ? 16 : 0);
        for (;;) {
            if (C.tid == 0) jobw[0] = (int)atomicAdd(qh, 1u);
            __syncthreads();
            const int c = jobw[0];
            __syncthreads();
            if (c >= 256) break;
            hyena_channel<SEQ>(C, l, c, 0, 0); if (l == 0) hyena_channel<LC>(C, l, c, NLAT, SEQ);
        }
    }
}
__device__ __forceinline__ void phase_finalize(Ctx& C, int l) {
    const int gw = C.vcu * 8 + C.wave, NGW = C.G * 8, lane = C.lane;
    const int nrows = (l == 0) ? NT : NLAT;
    const bf16_t* zb = WSP(bf16_t, WS_Z); bf16_t* mix = WSP(bf16_t, WS_MIX);
    LAS float* scr = (LAS float*)(C.lds + C.wave * 8448);
    const int ntr = nrows / 64;
    for (int it = gw; it < ntr * 8; it += NGW) { const int rt = it / 8, cb = (it % 8) * 32; const float* src = WSP(float, WS_HYT) + (size_t)cb * NT + rt * 64;
#pragma unroll 8
        for (int cc = 0; cc < 32; ++cc) scr[cc * 65 + lane] = src[(size_t)cc * NT + lane];
        LDS_WAIT(); asm volatile("" ::: "memory");
        for (int rr = 0; rr < 64; rr += 4) { const int r = rr + (lane >> 4), c2 = (lane & 15) * 2;
            *(unsigned*)(mix + (size_t)(rt * 64 + r) * D + 512 + cb + c2) = pk2(scr[c2 * 65 + r], scr[(c2 + 1) * 65 + r]); }
        LDS_WAIT(); asm volatile("" ::: "memory"); }
}

enum { PH_PRO = 0, PH_L0 = 1, PH_PER_LAYER = 10, PH_FINAL = PH_L0 + DEPTH * PH_PER_LAYER, PH_COUNT };
__global__ void __launch_bounds__(512, 2) fwd_kernel(Args args) {
#ifdef HOST_EMU
    unsigned char* lds = emu::cur->blk->lds;
#else
    extern __shared__ __attribute__((aligned(16))) unsigned char lds[];
#endif
#ifdef HOST_EMU
    Ctx C; C.lds = (LAS unsigned char*)lds; C.a = &args; C.ws = args.ws;
#else
    Ctx C; C.lds = (LAS unsigned char*)lds; C.a = (const __attribute__((address_space(4))) Args*)__builtin_amdgcn_kernarg_segment_ptr(); C.ws = C.a->ws;
#endif
    C.tid = threadIdx.x; C.lane = C.tid & 63; C.wave = __builtin_amdgcn_readfirstlane(C.tid >> 6);
    C.bid = blockIdx.x; C.G = gridDim.x; { const int bx = blockIdx.x; C.vcu = (C.G % 8 == 0) ? (bx % 8) * (C.G / 8) + bx / 8 : bx; }
    volatile LAS unsigned* MISC = (volatile LAS unsigned*)(C.lds + LDSX_OFF + LX_MISC);
    for (int u = C.tid; u < 64; u += 512) MISC[u] = 0u;
    __syncthreads();
    const int lo = C.a->ph_lo, hi = C.a->ph_hi;
    const bool multi = (hi - lo) > 1;
    XcdBarrier bar; bar.bar = WSP(unsigned, WS_CTL) + CW_BAR; bar.x = 0; bar.st = nullptr;
    if (multi) bar = xcd_barrier_post(WSP(unsigned, WS_CTL) + CW_BAR, MISC + 8);
#ifndef HOST_EMU
    if (multi) { cooperative_groups::this_grid().sync(); }
#endif
    const Ctx C0 = C;
#ifdef HOST_EMU
#define LAUNDER_CTX() Ctx C = C0; C.tid = threadIdx.x; C.lane = C.tid & 63; C.wave = C.tid >> 6;
#else
#define LAUNDER_CTX() Ctx C = C0; C.tid = threadIdx.x; \
        {   unsigned long long pw = (unsigned long long)C.ws, pa = (unsigned long long)C.a; unsigned w0 = (unsigned)pw, w1 = (unsigned)(pw >> 32), a0 = (unsigned)pa, a1 = (unsigned)(pa >> 32), v0 = (unsigned)C.vcu, g0 = (unsigned)C.G, b0 = (unsigned)C.bid; \
            asm volatile("" : "+v"(w0), "+v"(w1), "+v"(a0), "+v"(a1), "+v"(v0), "+v"(g0), "+v"(b0), "+v"(C.tid)); \
            w0 = __builtin_amdgcn_readfirstlane(w0); w1 = __builtin_amdgcn_readfirstlane(w1); a0 = __builtin_amdgcn_readfirstlane(a0); a1 = __builtin_amdgcn_readfirstlane(a1); \
            C.vcu = (int)__builtin_amdgcn_readfirstlane(v0); C.G = (int)__builtin_amdgcn_readfirstlane(g0); C.bid = (int)__builtin_amdgcn_readfirstlane(b0); \
            C.ws = (unsigned char*)(((unsigned long long)w1 << 32) | w0); C.a = (const __attribute__((address_space(4))) Args*)(((unsigned long long)a1 << 32) | a0); } \
        C.lane = C.tid & 63; C.wave = __builtin_amdgcn_readfirstlane(C.tid >> 6);
#endif
#define PH_KIND(k) ((k) == PH_PRO ? 10 : ((k) == PH_FINAL ? 11 : ((k) - PH_L0) % PH_PER_LAYER))
#define PH_BEGIN(k) if (lo <= (k) && (k) < hi) { const unsigned long long t0_ = (TMASK != 0) ? __builtin_amdgcn_s_memrealtime() : 0ull; LAUNDER_CTX()
#define PH_END(k) if ((k) + 1 < hi) { XcdBarrier b2 = bar; b2.bar = WSP(unsigned, WS_CTL) + CW_BAR; xcd_barrier(b2); if ((REPMASK >> 22) & 1) xcd_barrier(b2); \
        if ((TMASK >> PH_KIND(k)) & 1) { if (threadIdx.x == 0) { const unsigned long long t1_ = __builtin_amdgcn_s_memrealtime(); while (__builtin_amdgcn_s_memrealtime() - t1_ < (t1_ - t0_)) __builtin_amdgcn_s_sleep(8); } __syncthreads(); } } }
#define REP(b) ((REPMASK >> (b)) & 1)
    PH_BEGIN(PH_PRO) p0_prologue(C); if (REP(0)) { __syncthreads(); p0_prologue(C); } PH_END(PH_PRO)
#define LAYER_PHASES(l) { constexpr int pb = PH_L0 + (l) * PH_PER_LAYER; \
    PH_BEGIN(pb + 0) if ((l) > 0) (void)build_tiles(C, (l) > 0 ? (l) - 1 : 0); phase_rows_a(C, (l)); if (REP(13) && (l) == 0) { __syncthreads(); phase_rows_a(C, (l)); } PH_END(pb + 0) \
    PH_BEGIN(pb + 1) pg8::Gemm g{WSP(bf16_t, WS_H), WSP(bf16_t, WS_WIN) + (size_t)(l) * ZW * D, D, 0}; pg8::StaticOrder S; S.init(NT, ZW, C.G, C.bid); \
        pg8::EpiBf16 E{WSP(bf16_t, WS_Z), ZW, nullptr, 0}; pg8::gemm_phase(C.lds, g, S, E, C.tid); if (REP(1)) { __syncthreads(); pg8::gemm_phase(C.lds, g, S, E, C.tid); } PH_END(pb + 1) \
    PH_BEGIN(pb + 2) phase_hy_transpose(C); __syncthreads(); phase_gdn_a(C, (l)); if (REP(8)) { __syncthreads(); phase_gdn_a(C, (l)); } PH_END(pb + 2) \
    PH_BEGIN(pb + 3) phase_mixers(C, (l)); if (REP(2)) { __syncthreads(); phase_mixers(C, (l), 1); } if (REP(26)) { __syncthreads(); phase_mixers(C, (l), 3 | 64); } if (REP(23)) { __syncthreads(); phase_mixers(C, (l), 1 | 32 | 4); } if (REP(24)) { __syncthreads(); phase_mixers(C, (l), 1 | 32 | 8); } if (REP(25)) { __syncthreads(); phase_mixers(C, (l), 1 | 32 | 16); } if (REP(3)) { __syncthreads(); phase_mixers(C, (l), 2); } PH_END(pb + 3) \
    PH_BEGIN(pb + 4) phase_finalize(C, (l)); __syncthreads(); phase_gdn_c(C, (l)); if (REP(4)) { __syncthreads(); phase_finalize(C, (l)); } if (REP(9)) { __syncthreads(); phase_gdn_c(C, (l)); } PH_END(pb + 4) \
    PH_BEGIN(pb + 5) pg8::Gemm g{WSP(bf16_t, WS_MIX), WSP(bf16_t, WS_WOUT) + (size_t)(l) * D * D, D, 0}; pg8::StaticOrder S; S.init((l) == 0 ? NT : NLAT, D, C.G, C.bid); \
        pg8::EpiResid E{(l) == 0 ? INP(I_X) : WSP(float, WS_X), (l) == 0 ? INP(I_CTX) : WSP(float, WS_X) + (size_t)NLAT * D, WSP(float, WS_X), WSP(float, WS_MOD) + (size_t)(l) * (NB + 1) * 6 * D + 2 * D}; \
        pg8::gemm_phase(C.lds, g, S, E, C.tid); if (REP(14) && (l) == 0) { __syncthreads(); pg8::gemm_phase(C.lds, g, S, E, C.tid); } PH_END(pb + 5) \
    PH_BEGIN(pb + 6) phase_rows_b(C, (l)); PH_END(pb + 6) \
    PH_BEGIN(pb + 7) phase_gather(C, (l)); if (REP(5)) { __syncthreads(); phase_gather(C, (l)); } PH_END(pb + 7) \
    PH_BEGIN(pb + 8) const int ntiles = build_tiles(C, (l)); \
        pg8::Gemm g{WSP(bf16_t, WS_HS), WSP(bf16_t, WS_W1) + (size_t)(l) * NE * 2 * DE * D, D, (size_t)2 * DE * D}; pg8::MoeOrder S; S.init(ntiles, 2 * DE, C.G, C.bid, (const LAS int*)(C.lds + LDSX_OFF + LX_TILE)); \
        pg8::EpiSwiglu E{WSP(bf16_t, WS_A2), INP(I_EB1) + (size_t)(l) * NE * 2 * DE}; pg8::gemm_phase(C.lds, g, S, E, C.tid); if (REP(6)) { __syncthreads(); pg8::gemm_phase(C.lds, g, S, E, C.tid); } PH_END(pb + 8) \
    PH_BEGIN(pb + 9) const int ntiles = build_tiles(C, (l)); \
        pg8::Gemm g{WSP(bf16_t, WS_A2), WSP(bf16_t, WS_W2) + (size_t)(l) * NE * D * DE, DE, (size_t)D * DE}; pg8::MoeOrder S; S.init(ntiles, D, C.G, C.bid, (const LAS int*)(C.lds + LDSX_OFF + LX_TILE)); \
        pg8::EpiBf16 E{WSP(bf16_t, WS_Y), D, INP(I_EB2) + (size_t)(l) * NE * D, D}; pg8::gemm_phase(C.lds, g, S, E, C.tid); if (REP(7)) { __syncthreads(); pg8::gemm_phase(C.lds, g, S, E, C.tid); } PH_END(pb + 9) }
    LAYER_PHASES(0)
    LAYER_PHASES(1)
    static_assert(DEPTH == 2, "two layers written out");
    PH_BEGIN(PH_FINAL) (void)build_tiles(C, DEPTH - 1); phase_rows_a(C, DEPTH); PH_END(PH_FINAL)
}

#ifndef MK_PER_PHASE
#define MK_PER_PHASE 0
#endif
extern "C" void kernel_launch(void* const* d_in, const int* in_sizes, int n_in, void* d_out, int out_size, void* d_ws, size_t ws_size, hipStream_t stream) {
    static int grid = 0;
#ifndef HOST_EMU
    if (grid == 0) {
        if (n_in != 34 || ws_size < WS_END) { fprintf(stderr, "kernel_launch: unexpected n_in %d / ws %zu (need %zu)\n", n_in, ws_size, (size_t)WS_END); grid = -1; return; }
        int dev = 0, cus = 0, per_cu = 0;
        hipGetDevice(&dev); hipDeviceGetAttribute(&cus, hipDeviceAttributeMultiprocessorCount, dev);
        hipFuncSetAttribute((const void*)fwd_kernel, hipFuncAttributeMaxDynamicSharedMemorySize, LDS_BYTES);
        hipOccupancyMaxActiveBlocksPerMultiprocessor(&per_cu, (const void*)fwd_kernel, 512, LDS_BYTES);
        if (per_cu < 1) { fprintf(stderr, "kernel_launch: occupancy query says %d blocks per CU\n", per_cu); per_cu = 1; }
        grid = cus;
        (void)hipGetLastError();
    }
    if (grid < 0) return;
#else
    grid = EMU_GRID;
#endif
    hipMemsetAsync((char*)d_ws + WS_CTL, 0, CTL_BYTES, stream);
    Args a{};
    for (int i = 0; i < 34; ++i) a.in[i] = (const float*)d_in[i];
    a.out = (float*)d_out; a.ws = (unsigned char*)d_ws;
#ifdef HOST_EMU
    a.ph_lo = 0; a.ph_hi = PH_COUNT;
    if (getenv("EMU_PH_HI")) a.ph_hi = atoi(getenv("EMU_PH_HI"));
    emu::launch([&]() { fwd_kernel(a); }, dim3(grid), dim3(512), LDS_BYTES);
#else
#if MK_PER_PHASE
    for (int ph = 0; ph < PH_COUNT; ++ph) { a.ph_lo = ph; a.ph_hi = ph + 1; hipLaunchKernelGGL(fwd_kernel, dim3(grid), dim3(512), LDS_BYTES, stream, a); }
#else
    a.ph_lo = 0; a.ph_hi = PH_COUNT;
    void* kargs[] = {&a};
    hipError_t e = hipLaunchCooperativeKernel((const void*)fwd_kernel, dim3(grid), dim3(512), kargs, LDS_BYTES, stream);
    if (e != hipSuccess) fprintf(stderr, "cooperative launch failed: %s (grid %d)\n", hipGetErrorString(e), grid);
#endif
#endif
}
```

```cpp
#ifdef HOST_EMU
#include "host/emu.h"
#else
#include <hip/hip_runtime.h>
#include <hip/hip_cooperative_groups.h>
#endif
#include <cstdio>
#include <cstdint>
#include <cmath>
#ifndef REPMASK
#define REPMASK 0
#endif
#ifndef TMASK
#define TMASK 0
#endif

#ifndef CFG_B
#define CFG_B 4
#define CFG_L 4096
#define CFG_GW 64
#define CFG_LC 256
#define CFG_NE 32
#endif
constexpr int NB = CFG_B, SEQ = CFG_L, GW = CFG_GW, GROWS = SEQ / GW, LC = CFG_LC, NE = CFG_NE, TOPK = 4, DEPTH = 2;
constexpr int D = 1024, WG_ = 256, NH = 4, DH = 64;
constexpr int NLAT = NB * SEQ, NCTX = NB * LC, NT = NLAT + NCTX;
constexpr int IN_W = 4128, ZW = 4096;
constexpr int HGB = 0, MLB = 1280, HYB = 2304, GDB = 3072;
constexpr int DE = 1024;
constexpr float EPS = 1e-6f;
constexpr int FFTN = 2 * SEQ, FFTNC = 2 * LC, TWN = FFTN / 2;
static_assert(NT % 256 == 0 && NLAT % 256 == 0, "row counts must be multiples of 256");
static_assert(SEQ % 16 == 0 && LC % 16 == 0, "chunking");
constexpr int MAXTILES = (NT * TOPK + NE * 255) / 256 + 1;

constexpr size_t al256(size_t x) { return (x + 255) & ~(size_t)255; }
constexpr size_t WS_CTL = 0, CTL_BYTES = 1 << 20;
constexpr size_t WS_WIN = WS_CTL + CTL_BYTES;
constexpr size_t WS_WOUT = WS_WIN + (size_t)DEPTH * ZW * D * 2;
constexpr size_t WS_W1 = WS_WOUT + (size_t)DEPTH * D * D * 2;
constexpr size_t WS_W2 = WS_W1 + (size_t)DEPTH * NE * 2 * DE * D * 2;
constexpr size_t WS_WG = WS_W2 + (size_t)DEPTH * NE * D * DE * 2;
constexpr size_t WS_WR = WS_WG + (size_t)DEPTH * 32 * D * 4;
constexpr size_t WS_MOD = WS_WR + (size_t)DEPTH * NE * D * 4;
constexpr size_t WS_LB = WS_MOD + al256((size_t)DEPTH * (NB + 1) * 6 * D * 4);
constexpr size_t WS_HDN = WS_LB + (size_t)DEPTH * 256 * 4;
constexpr size_t WS_X = WS_HDN + (size_t)DEPTH * (SEQ + LC) * 64 * 4;
constexpr size_t WS_H = WS_X + (size_t)NT * D * 4;
constexpr size_t WS_Z = WS_H + (size_t)NT * D * 2;
constexpr size_t WS_ZG = WS_Z + (size_t)NT * ZW * 2;
constexpr size_t WS_MIX = WS_ZG + (size_t)NT * 32 * 4;
constexpr size_t WS_OB = WS_MIX + (size_t)NT * D * 2;
constexpr size_t WS_HYT = WS_OB + (size_t)6 * NT * 256 * 4;
constexpr size_t WS_KS = WS_HYT + (size_t)256 * NT * 4;
constexpr size_t WS_TOP = WS_KS + (size_t)256 * 2 * FFTN * 8;
constexpr size_t WS_HS = WS_TOP + (size_t)NT * 4 * 12;
constexpr size_t WS_A2 = WS_HS + (size_t)MAXTILES * 256 * D * 2;
constexpr size_t WS_Y = WS_A2 + (size_t)MAXTILES * 256 * DE * 2;
constexpr int NCH = (LC + SEQ) / 64, NCHC = LC / 64, NSCAN = NB * NH * 2;
constexpr size_t GD_BLOB = 32768;
constexpr size_t WS_GD = WS_Y + (size_t)MAXTILES * 256 * D * 2;
constexpr size_t WS_GST = WS_GD + (size_t)NSCAN * NCH * GD_BLOB;
constexpr size_t ML_BLOB = 17920;
constexpr size_t WS_ML = WS_GST + (size_t)NSCAN * NCH * 8192;
constexpr size_t ML_ST = 8192 + 512;
constexpr size_t WS_MST = WS_ML + (size_t)NSCAN * NCH * ML_BLOB;
constexpr size_t HG_BLOB = 50176;
constexpr size_t WS_HG = WS_MST + (size_t)NSCAN * NCH * ML_ST;
constexpr size_t WS_HST = WS_HG + (size_t)NSCAN * NCH * HG_BLOB;
constexpr size_t WS_ZT = WS_HST + (size_t)NSCAN * NCH * 4 * 8192;
constexpr size_t WS_KSC = WS_ZT + (size_t)768 * NT * 2;
constexpr size_t WS_END = WS_KSC + (size_t)256 * 2 * FFTNC * 8;
static_assert(SEQ % 64 == 0 && LC % 64 == 0, "64-token chunks");
constexpr int CW_CNT = 64;
constexpr int CW_HYQ = 192;
constexpr int CW_BAR = 4096;

constexpr int RING_BYTES = 131072, LDSX_OFF = RING_BYTES, LDS_BYTES = 147456;
constexpr int LX_MISC = 0, LX_TILE = 256;

#ifdef HOST_EMU
#define __expf expf
#define __logf logf
#define __sinf sinf
#define __cosf cosf
#define LAS
#define GAS
#define DEV_ASM(x) ((void)0)
#define VM_WAIT() ((void)0)
#define LDS_WAIT() do { int _s; (void)emu::wave_xchg(&_s, 4, _s); } while (0)
#else
#define LAS __attribute__((address_space(3)))
#define GAS __attribute__((address_space(1)))
#define VM_WAIT() asm volatile("s_waitcnt vmcnt(0)" ::: "memory")
#define LDS_WAIT() asm volatile("s_waitcnt lgkmcnt(0)" ::: "memory")
#endif
typedef unsigned short bf16_t;
typedef short bf16x8 __attribute__((ext_vector_type(8)));
typedef float f32x4 __attribute__((ext_vector_type(4)));
typedef float f32x2 __attribute__((ext_vector_type(2)));
typedef unsigned u32x4 __attribute__((ext_vector_type(4)));
typedef unsigned u32x2 __attribute__((ext_vector_type(2)));

__device__ __forceinline__ float u2f(unsigned u) { float f; __builtin_memcpy(&f, &u, 4); return f; }
__device__ __forceinline__ unsigned f2u(float f) { unsigned u; __builtin_memcpy(&u, &f, 4); return u; }
__device__ __forceinline__ float bf2f(bf16_t b) { return u2f((unsigned)b << 16); }
#ifdef HOST_EMU
__device__ __forceinline__ unsigned f2bf(float f) { unsigned u = f2u(f); return (u + 0x7fffu + ((u >> 16) & 1u)) >> 16; }
__device__ __forceinline__ unsigned pk2(float lo, float hi) { return f2bf(lo) | (f2bf(hi) << 16); }
__device__ __forceinline__ unsigned pk2_sw(float lo, float hi) { return pk2(lo, hi); }
#else
__device__ __forceinline__ unsigned f2bf_sw(float f) { unsigned u = f2u(f); return (u + 0x7fffu + ((u >> 16) & 1u)) >> 16; }
__device__ __forceinline__ unsigned pk2_sw(float lo, float hi) { return f2bf_sw(lo) | (f2bf_sw(hi) << 16); }
typedef __bf16 bf16n2 __attribute__((ext_vector_type(2)));
__device__ __forceinline__ unsigned f2bf(float f) { const __bf16 b = (__bf16)f; unsigned short u; __builtin_memcpy(&u, &b, 2); return u; }
__device__ __forceinline__ unsigned pk2(float lo, float hi) { bf16n2 v; v.x = (__bf16)lo; v.y = (__bf16)hi; unsigned u; __builtin_memcpy(&u, &v, 4); return u; }
#endif
__device__ __forceinline__ unsigned cvt_pk_bf16(float lo, float hi) {
#ifdef HOST_EMU
    return pk2(lo, hi);
#else
    unsigned r; asm volatile("v_cvt_pk_bf16_f32 %0, %1, %2" : "=v"(r) : "v"(lo), "v"(hi)); return r;
#endif
}
#ifdef HOST_EMU
__device__ __forceinline__ int hw_tid(int wave_s) { (void)wave_s; return (int)threadIdx.x; }
#else
__device__ __forceinline__ int hw_tid(int wave_s) { unsigned l_; asm volatile("v_mbcnt_lo_u32_b32 %0, -1, 0\n\tv_mbcnt_hi_u32_b32 %0, -1, %0" : "=v"(l_)); return (wave_s << 6) | (int)l_; }
#endif
__device__ __forceinline__ float wave_sum(float v) {
#pragma unroll
    for (int o = 1; o < 64; o <<= 1) v += __shfl_xor(v, o);
    return v;
}
template <int M> __device__ __forceinline__ int shx_i(int xi, int lane) {
#ifdef HOST_EMU
    return __shfl_xor(xi, M);
#else
    if constexpr (M == 1) return __builtin_amdgcn_mov_dpp(xi, 0xB1, 0xF, 0xF, true);
    else if constexpr (M == 2) return __builtin_amdgcn_mov_dpp(xi, 0x4E, 0xF, 0xF, true);
    else if constexpr (M == 4) return __builtin_amdgcn_mov_dpp(__builtin_amdgcn_mov_dpp(xi, 0x141, 0xF, 0xF, true), 0x1B, 0xF, 0xF, true);
    else if constexpr (M == 8) return __builtin_amdgcn_mov_dpp(xi, 0x128, 0xF, 0xF, true);
    else if constexpr (M == 16) { const auto r = __builtin_amdgcn_permlane16_swap((unsigned)xi, (unsigned)xi, false, false); return (int)((lane & 16) ? r[0] : r[1]); }
    else { const auto r = __builtin_amdgcn_permlane32_swap((unsigned)xi, (unsigned)xi, false, false); return (int)((lane & 32) ? r[0] : r[1]); }
#endif
}
template <int M> __device__ __forceinline__ float shx(float x, int lane) { return __int_as_float(shx_i<M>(__float_as_int(x), lane)); }
__device__ __forceinline__ float wave_sum_x(float v, int lane) {
    v += shx<1>(v, lane); v += shx<2>(v, lane); v += shx<4>(v, lane); v += shx<8>(v, lane); v += shx<16>(v, lane); v += shx<32>(v, lane);
    return v;
}
__device__ __forceinline__ float sigmoidf_(float x) { return __builtin_amdgcn_rcpf(1.f + __expf(-x)); }
__device__ __forceinline__ float siluf_(float x) { return x * sigmoidf_(x); }
__device__ __forceinline__ float softplusf_(float x) { return x > 20.f ? x : log1pf(__expf(x)); }
__device__ __forceinline__ float logsigmoidf_(float x) { return x < -20.f ? x : -log1pf(__expf(-x)); }
#ifdef HOST_EMU
static inline void sincospi_(float x, float* s, float* c) { *s = (float)sin(M_PI * (double)x); *c = (float)cos(M_PI * (double)x); }
#else
__device__ __forceinline__ void sincospi_(float x, float* s, float* c) { sincospif(x, s, c); }
#endif

namespace pg8 {
constexpr int BM = 256, BK = 64, HALF = 128, HTB = HALF * BK * 2, STAGE_BYTES = 8 * HTB, NXCD = 8, WGM = 8;
__host__ __device__ __forceinline__ int lds_byte(int r, int c) { const int st = (r >> 4) * 2 + (c >> 5), rr = r & 15, cc = c & 31, ob = rr * 64 + cc * 2; return st * 1024 + (ob ^ (((ob >> 9) & 1) << 5)); }
__host__ __device__ __forceinline__ void stage_rc(int b, int& R, int& C) { const int st = b / 1024, sb = b % 1024, swz = sb ^ (((sb >> 9) & 1) << 5); R = (st >> 1) * 16 + swz / 64; C = (st & 1) * 32 + (swz % 64) / 2; }
__host__ __device__ __forceinline__ int perm32(int rho) { const int n = rho >> 4, i = rho & 15; return 8 * (i >> 2) + 4 * n + (i & 3); }

struct Unit { int pm, pn, e; };
struct Gemm { const bf16_t* A; const bf16_t* Bt; int K; size_t bexp; };

__host__ __device__ __forceinline__ int xcd_remap(int L, int nwg) { const int q = nwg / NXCD, r = nwg % NXCD, xcd = L % NXCD, off = L / NXCD; return (xcd < r ? xcd * (q + 1) : r * (q + 1) + (xcd - r) * q) + off; }
struct StaticOrder {
    int nM, nN, nwg, G, c;
    __host__ __device__ void init(int M, int N, int G_, int c_) { nM = M / BM; nN = N / BM; nwg = nM * nN; G = G_; c = c_; }
    __host__ __device__ bool next(int i, Unit& u) const {
        const long L = (long)i * G + c; if (L >= nwg) return false;
        const int wgid = xcd_remap((int)L, nwg);
        const int nig = WGM * nN, gid = wgid / nig, fm = gid * WGM, gsz = (nM - fm) < WGM ? (nM - fm) : WGM;
        u.pm = fm + ((wgid % nig) % gsz); u.pn = (wgid % nig) / gsz; u.e = 0; return true;
    }
};
struct MoeOrder {
    int ntiles, nN, nwg, G, c; const LAS int* tile_e;
    __device__ void init(int ntiles_, int N, int G_, int c_, const LAS int* te) { ntiles = ntiles_; nN = N / BM; nwg = ntiles * nN; G = G_; c = c_; tile_e = te; }
    __device__ bool next(int i, Unit& u) const {
        const long L = (long)i * G + c; if (L >= nwg) return false;
        const int wgid = xcd_remap((int)L, nwg);
        u.pm = wgid / nN; u.pn = wgid % nN; u.e = __builtin_amdgcn_readfirstlane(tile_e[u.pm]); return true;
    }
};

struct EpiBf16 {
    static constexpr bool PERM = true;
    bf16_t* O; int ldc; const float* bias; int bias_estride;
    __device__ __forceinline__ void operator()(const f32x4 (&acc)[2][2][4][2], const Unit& u, int wr, int wc, int fr, int fq) const {
        const int row0 = u.pm * BM + wr * 64 + fr, col0 = u.pn * BM + wc * 32 + 8 * fq;
        f32x4 bv[2][2];
#pragma unroll
        for (int bj = 0; bj < 2; ++bj)
#pragma unroll
            for (int n = 0; n < 2; ++n) bv[bj][n] = bias ? *(const f32x4*)(bias + (size_t)u.e * bias_estride + col0 + bj * HALF + 4 * n) : (f32x4){0.f, 0.f, 0.f, 0.f};
#pragma unroll
        for (int ai = 0; ai < 2; ++ai)
#pragma unroll
            for (int m = 0; m < 4; ++m) { bf16_t* rowp = O + (size_t)(row0 + ai * HALF + m * 16) * ldc + col0;
#pragma unroll
                for (int bj = 0; bj < 2; ++bj) { const f32x4 v0 = acc[ai][bj][m][0] + bv[bj][0], v1 = acc[ai][bj][m][1] + bv[bj][1];
                    u32x4 w; w.x = cvt_pk_bf16(v0[0], v0[1]); w.y = cvt_pk_bf16(v0[2], v0[3]); w.z = cvt_pk_bf16(v1[0], v1[1]); w.w = cvt_pk_bf16(v1[2], v1[3]);
                    *(u32x4*)(rowp + bj * HALF) = w; } }
    }
};
struct EpiSwiglu {
    static constexpr bool PERM = true;
    bf16_t* O; const float* b1;
    __device__ __forceinline__ void operator()(const f32x4 (&acc)[2][2][4][2], const Unit& u, int wr, int wc, int fr, int fq) const {
        const int row0 = u.pm * BM + wr * 64 + fr, cj = u.pn * HALF + wc * 32 + 8 * fq;
        const float* bb = b1 + (size_t)u.e * 2 * DE;
        f32x4 bg[2], bl[2];
#pragma unroll
        for (int n = 0; n < 2; ++n) { bg[n] = *(const f32x4*)(bb + cj + 4 * n); bl[n] = *(const f32x4*)(bb + DE + cj + 4 * n); }
#pragma unroll
        for (int ai = 0; ai < 2; ++ai)
#pragma unroll
            for (int m = 0; m < 4; ++m) { bf16_t* rowp = O + (size_t)(row0 + ai * HALF + m * 16) * DE + cj;
                float y[8];
#pragma unroll
                for (int n = 0; n < 2; ++n) { const f32x4 g = acc[ai][0][m][n] + bg[n], l = acc[ai][1][m][n] + bl[n];
#pragma unroll
                    for (int j = 0; j < 4; ++j) { const float gg = fminf(g[j], 7.0f), ll = fminf(fmaxf(l[j], -7.0f), 7.0f); y[4 * n + j] = (ll + 1.0f) * gg * __builtin_amdgcn_rcpf(1.f + __expf(-1.702f * gg)); } }
                u32x4 w; w.x = cvt_pk_bf16(y[0], y[1]); w.y = cvt_pk_bf16(y[2], y[3]); w.z = cvt_pk_bf16(y[4], y[5]); w.w = cvt_pk_bf16(y[6], y[7]);
                *(u32x4*)rowp = w; }
    }
};
struct EpiResid {
    static constexpr bool PERM = false;
    const float* base0; const float* base1; float* out; const float* g;
    __device__ __forceinline__ void operator()(const f32x4 (&acc)[2][2][4][2], const Unit& u, int wr, int wc, int fr, int fq) const {
        const int col0 = u.pn * BM + wc * 32 + 4 * fq;
#pragma unroll
        for (int ai = 0; ai < 2; ++ai)
#pragma unroll
            for (int m = 0; m < 4; ++m) { const int r = u.pm * BM + ai * HALF + wr * 64 + m * 16 + fr;
                const float* bp = (r < NLAT) ? base0 + (size_t)r * D : base1 + (size_t)(r - NLAT) * D; const int bb = (r < NLAT) ? r / SEQ : NB;
                const float* gp = g + (size_t)bb * 6 * D;
#pragma unroll
                for (int bj = 0; bj < 2; ++bj)
#pragma unroll
                    for (int n = 0; n < 2; ++n) { const int c = col0 + bj * HALF + n * 16; const f32x4 bs = *(const f32x4*)(bp + c), gv = *(const f32x4*)(gp + c);
                        *(f32x4*)(out + (size_t)r * D + c) = bs + gv * acc[ai][bj][m][n]; } }
    }
};

#ifdef HOST_EMU
#define PG8_WAIT_V(n) ((void)0)
#define PG8_WAIT_L(n) ((void)0)
#else
#define PG8_WAIT_V(n) asm volatile("s_waitcnt vmcnt(" #n ")" ::: "memory")
#define PG8_WAIT_L(n) asm volatile("s_waitcnt lgkmcnt(" #n ")" ::: "memory")
#endif
template <class Epi, class Sched>
__device__ __forceinline__ void gemm_phase(LAS unsigned char* lds, const Gemm g, const Sched& S, const Epi& E, const int tid) {
    const int wid = __builtin_amdgcn_readfirstlane(tid >> 6), lane = tid & 63, wr = wid >> 2, wc = wid & 3, fr = lane & 15, fq = lane >> 4;
    const int K = g.K, nt = K / BK;
    unsigned voffA[2], voffB[2];
#pragma unroll
    for (int i = 0; i < 2; ++i) { int R, C; stage_rc(tid * 16 + i * 8192, R, C); const int Rb = Epi::PERM ? ((R & ~31) + perm32(R & 31)) : R;
        voffA[i] = (unsigned)(R * K + C) * 2u; voffB[i] = (unsigned)(Rb * K + C) * 2u; }
    const size_t kstep = (size_t)(BK * 2);
    const size_t hstep = (size_t)HALF * K * 2;
    const size_t tstep = 2 * hstep;
    const unsigned ldsw = (unsigned)wid * 1024u;
    const int aoff = lds_byte(wr * 64 + fr, fq * 8), boff = lds_byte(wc * 32 + fr, fq * 8);
#define PG8_SA(b, h) (((b) * 2 + (h)) * HTB)
#define PG8_SB(b, h) ((4 + (b) * 2 + (h)) * HTB)
#define PG8_STAGE(bufoff, gbase, voff) do { _Pragma("unroll") for (int _i = 0; _i < 2; ++_i) \
        __builtin_amdgcn_global_load_lds((const unsigned*)((const char*)(gbase) + (voff)[_i]), (LAS unsigned*)(lds + (bufoff) + ldsw + _i * 8192), 16, 0, 0); } while (0)
#define PG8_LDA(dst, b, h) do { _Pragma("unroll") for (int m = 0; m < 4; ++m) _Pragma("unroll") for (int k = 0; k < 2; ++k) dst[m][k] = *(const LAS bf16x8*)(lds + PG8_SA(b, h) + aoff + m * 2048 + k * 1024); } while (0)
#define PG8_LDB(dst, b, h) do { _Pragma("unroll") for (int n = 0; n < 2; ++n) _Pragma("unroll") for (int k = 0; k < 2; ++k) dst[n][k] = *(const LAS bf16x8*)(lds + PG8_SB(b, h) + boff + n * 2048 + k * 1024); } while (0)
#define PG8_MMA(ai, bj, At, Bt) do { __builtin_amdgcn_s_setprio(1); _Pragma("unroll") for (int m = 0; m < 4; ++m) _Pragma("unroll") for (int n = 0; n < 2; ++n) _Pragma("unroll") for (int k = 0; k < 2; ++k) \
        acc[ai][bj][m][n] = __builtin_amdgcn_mfma_f32_16x16x32_bf16(Bt[n][k], At[m][k], acc[ai][bj][m][n], 0, 0, 0); __builtin_amdgcn_s_setprio(0); } while (0)
#define PG8_BAR __builtin_amdgcn_s_barrier()
#define PG8_SCHED __builtin_amdgcn_sched_barrier(0)
    Unit cur, nxt; int ui = 0;
    if (!S.next(0, cur)) return;
    f32x4 acc[2][2][4][2];
#pragma unroll
    for (int a = 0; a < 2; ++a)
#pragma unroll
        for (int b = 0; b < 2; ++b)
#pragma unroll
            for (int m = 0; m < 4; ++m)
#pragma unroll
                for (int n = 0; n < 2; ++n) acc[a][b][m][n] = (f32x4){0.f, 0.f, 0.f, 0.f};
    bf16x8 At[4][2], B0[2][2], B1[2][2];
    const char* cA = (const char*)g.A + (size_t)cur.pm * tstep; const char* cB = (const char*)(g.Bt + (size_t)cur.e * g.bexp) + (size_t)cur.pn * tstep;
    PG8_STAGE(PG8_SB(0, 0), cB, voffB); PG8_STAGE(PG8_SB(0, 1), cB + hstep, voffB); PG8_STAGE(PG8_SA(0, 0), cA, voffA); PG8_STAGE(PG8_SA(0, 1), cA + hstep, voffA);
    if (wr == 1) PG8_BAR;
    PG8_WAIT_V(2); PG8_BAR;
    PG8_STAGE(PG8_SB(1, 0), cB + kstep, voffB); PG8_STAGE(PG8_SA(1, 0), cA + kstep, voffA); PG8_STAGE(PG8_SB(1, 1), cB + hstep + kstep, voffB);
    PG8_WAIT_V(6); PG8_BAR;
    for (;;) {
        const bool has_next = S.next(ui + 1, nxt);
        const char* nA = has_next ? (const char*)g.A + (size_t)nxt.pm * tstep : cA; const char* nB = has_next ? (const char*)(g.Bt + (size_t)nxt.e * g.bexp) + (size_t)nxt.pn * tstep : cB;
        for (int t = 0; t < nt; t += 2) {
            const bool last = (t == nt - 2);
            const char* a1 = cA + (size_t)(t + 1) * kstep;
            const char* a2 = last ? nA : cA + (size_t)(t + 2) * kstep; const char* b2 = last ? nB : cB + (size_t)(t + 2) * kstep;
            const char* a3 = a2 + kstep; const char* b3 = b2 + kstep;
            PG8_LDB(B0, 0, 0); PG8_LDB(B1, 0, 1); PG8_SCHED; PG8_LDA(At, 0, 0); PG8_STAGE(PG8_SA(1, 1), a1 + hstep, voffA);
            PG8_WAIT_V(8); PG8_WAIT_L(0); PG8_BAR; PG8_MMA(0, 0, At, B0); PG8_MMA(0, 1, At, B1); PG8_BAR; PG8_SCHED;
            PG8_LDA(At, 0, 1); PG8_STAGE(PG8_SB(0, 0), b2, voffB); PG8_STAGE(PG8_SB(0, 1), b2 + hstep, voffB); PG8_STAGE(PG8_SA(0, 0), a2, voffA);
            PG8_WAIT_V(8); PG8_WAIT_L(0); PG8_BAR; PG8_MMA(1, 0, At, B0); PG8_MMA(1, 1, At, B1); PG8_BAR; PG8_SCHED;
            PG8_LDB(B0, 1, 0); PG8_LDB(B1, 1, 1); PG8_SCHED; PG8_LDA(At, 1, 0); PG8_STAGE(PG8_SA(0, 1), a2 + hstep, voffA);
            PG8_WAIT_V(8); PG8_WAIT_L(0); PG8_BAR; PG8_MMA(0, 0, At, B0); PG8_MMA(0, 1, At, B1); PG8_BAR; PG8_SCHED;
            PG8_LDA(At, 1, 1); PG8_STAGE(PG8_SB(1, 0), b3, voffB); PG8_STAGE(PG8_SB(1, 1), b3 + hstep, voffB); PG8_STAGE(PG8_SA(1, 0), a3, voffA);
            PG8_WAIT_V(8); PG8_WAIT_L(0); PG8_BAR; PG8_MMA(1, 0, At, B0); PG8_MMA(1, 1, At, B1); PG8_BAR; PG8_SCHED;
        }
        if (wr == 0) PG8_BAR;
        {
            int t2 = hw_tid(wid);
#ifndef HOST_EMU
            asm volatile("" : "+v"(t2));
#endif
            const int wid2 = __builtin_amdgcn_readfirstlane(t2 >> 6), lane2 = t2 & 63;
            E(acc, cur, wid2 >> 2, wid2 & 3, lane2 & 15, lane2 >> 4);
        }
        if (!has_next) break;
#pragma unroll
        for (int a = 0; a < 2; ++a)
#pragma unroll
            for (int b = 0; b < 2; ++b)
#pragma unroll
                for (int m = 0; m < 4; ++m)
#pragma unroll
                    for (int n = 0; n < 2; ++n) acc[a][b][m][n] = (f32x4){0.f, 0.f, 0.f, 0.f};
        cur = nxt; cA = nA; cB = nB; ++ui;
        if (wr == 1) PG8_BAR;
    }
    PG8_WAIT_V(0);
    PG8_BAR;
#undef PG8_SA
#undef PG8_SB
#undef PG8_STAGE
#undef PG8_LDA
#undef PG8_LDB
#undef PG8_MMA
#undef PG8_BAR
#undef PG8_SCHED
}
}

#define XB_TMO      128
#define XB_XCNT(j)  (256  + 64 * (j))
#define XB_XSUB(j)  (1280 + 64 * (j))
#define XB_XGEN(j)  (2304 + 64 * (j))
#define XB_TOP      3328
#define XB_TOPGEN   3392
#define XCD_BAR_WORDS 3456
#define XB_SPIN_CAP (1u << 22)
#ifdef HOST_EMU
__device__ __forceinline__ unsigned xb_ld(unsigned* p) { return *(volatile unsigned*)p; }
__device__ __forceinline__ unsigned xb_add(unsigned* p, unsigned v) { unsigned o = *p; *p = o + v; return o; }
__device__ __forceinline__ unsigned xb_xcc_id() { return blockIdx.x % 8; }
__device__ __forceinline__ unsigned atomicAdd(unsigned* p, unsigned v) { unsigned o = *p; *p = o + v; return o; }
__device__ __forceinline__ int atomicAdd(int* p, int v) { int o = *p; *p = o + v; return o; }
#else
__device__ __forceinline__ unsigned xb_ld(unsigned* p)              { return __hip_atomic_load(p, __ATOMIC_RELAXED, __HIP_MEMORY_SCOPE_AGENT); }
__device__ __forceinline__ unsigned xb_add(unsigned* p, unsigned v) { return __hip_atomic_fetch_add(p, v, __ATOMIC_RELAXED, __HIP_MEMORY_SCOPE_AGENT); }
__device__ __forceinline__ unsigned xb_xcc_id() { return (unsigned)__builtin_amdgcn_s_getreg((3 << 11) | 20) & 0xFu; }
#endif
#define XB_SPIN(cond, bar) do { unsigned _sp = 0; while (cond) { __builtin_amdgcn_s_sleep(1); \
    if ((++_sp & 255u) == 0u) { if (xb_ld(&(bar)[XB_TMO])) break; if (_sp > XB_SPIN_CAP) { atomicAdd(&(bar)[XB_TMO], 1u); break; } } } } while (0)
struct XcdBarrier { unsigned* bar; unsigned x; volatile LAS unsigned* st; int wave_s; };
__device__ __forceinline__ XcdBarrier xcd_barrier_post(unsigned* bar, volatile LAS unsigned* st) {
    XcdBarrier b; b.bar = bar; b.x = xb_xcc_id(); b.st = st; b.wave_s = 0;
    if (threadIdx.x == 0) (void)xb_add(&bar[XB_XCNT(b.x)], 1u);
    return b;
}
__device__ __forceinline__ void xcd_barrier_complete(unsigned* bar, unsigned x, unsigned& nloc, unsigned& nx) {
    const unsigned G = gridDim.x;
    unsigned sum, cnt, mine, sp = 0u;
    for (;;) {
        sum = 0u; cnt = 0u; mine = 0u;
#pragma unroll
        for (unsigned j = 0; j < 16; ++j) { const unsigned c = xb_ld(&bar[XB_XCNT(j)]); sum += c; cnt += (c > 0u) ? 1u : 0u; mine = (j == x) ? c : mine; }
        if (sum == G) break;
        __builtin_amdgcn_s_sleep(1);
        if ((++sp & 255u) == 0u) { if (xb_ld(&bar[XB_TMO])) break; if (sp > XB_SPIN_CAP) { atomicAdd(&bar[XB_TMO], 1u); break; } }
    }
    nloc = mine > 0u ? mine : 1u; nx = cnt > 0u ? cnt : 1u;
}
__device__ __forceinline__ void xcd_barrier(const XcdBarrier& b) {
    VM_WAIT();
    __syncthreads();
    if (hw_tid(b.wave_s) == 0) {
        unsigned* bar = b.bar;
        __builtin_amdgcn_s_waitcnt(0);
        unsigned nloc = b.st[0], nx = b.st[1];
        if (nloc == 0u) { xcd_barrier_complete(bar, b.x, nloc, nx); b.st[0] = nloc; b.st[1] = nx; }
        const unsigned old = xb_add(&bar[XB_XSUB(b.x)], 1u);
        const unsigned gen = old / nloc;
        if (old + 1u == (gen + 1u) * nloc) {
            __builtin_amdgcn_fence(__ATOMIC_RELEASE, "agent");
            VM_WAIT();
            const unsigned og = xb_add(&bar[XB_TOP], 1u);
            const unsigned tg = og / nx;
            if (og + 1u == (tg + 1u) * nx) xb_add(&bar[XB_TOPGEN], 1u);
            else XB_SPIN(xb_ld(&bar[XB_TOPGEN]) == tg, bar);
            __builtin_amdgcn_fence(__ATOMIC_ACQUIRE, "agent");
            xb_add(&bar[XB_XGEN(b.x)], 1u);
            VM_WAIT();
        } else {
            XB_SPIN(xb_ld(&bar[XB_XGEN(b.x)]) == gen, bar);
            __builtin_amdgcn_fence(__ATOMIC_ACQUIRE, "agent");
            VM_WAIT();
        }
    }
    __syncthreads();
}

struct Args {
    const float* in[34]; float* out; unsigned char* ws; int ph_lo, ph_hi;
};
enum { I_X = 0, I_C, I_CTX, I_CCTX, I_MODW, I_MODB, I_N1, I_N2, I_WIN, I_WOUT, I_HGLB, I_HGNG, I_MLGB, I_MLNG, I_HYCW, I_HYCB, I_HYW1, I_HYB1, I_HYW2, I_HYB2, I_HYFR, I_HYW3,
       I_HYBI, I_GDCW, I_GDAL, I_GDDT, I_GDNG, I_RW, I_RB, I_EW1, I_EB1, I_EW2, I_EB2, I_FG };
struct Ctx {
#ifdef HOST_EMU
    LAS unsigned char* lds; const Args* a; unsigned char* ws;
#else
    LAS unsigned char* lds; const __attribute__((address_space(4))) Args* a; unsigned char* ws;
#endif
    int tid, lane, wave, vcu, G, bid;
};
#define WSP(T, off) ((T*)(C.ws + (off)))
#define INP(i) (C.a->in[i])

__device__ __forceinline__ const float* xrow_l0(const Ctx& C, int r) { return r < NLAT ? INP(I_X) + (size_t)r * D : INP(I_CTX) + (size_t)(r - NLAT) * D; }
__device__ __forceinline__ int row_batch(int r) { return r < NLAT ? r / SEQ : NB; }

template <bool NTS>
__device__ __forceinline__ void transpose_item(const float* W, int ldw, int K, bf16_t* WT, int k0, int nsrc0, int ndst0, LAS float* scr, int lane) {
#pragma unroll 8
    for (int i = 0; i < 32; ++i) { const int kk = 2 * i + (lane >> 5); scr[kk * 33 + (lane & 31)] = __builtin_nontemporal_load(W + (size_t)(k0 + kk) * ldw + nsrc0 + (lane & 31)); }
    LDS_WAIT(); asm volatile("" ::: "memory");
    const int c = lane & 7;
#pragma unroll
    for (int j = 0; j < 4; ++j) { const int n = (lane >> 3) + 8 * j; const LAS float* s = scr + (8 * c) * 33 + n;
        u32x4 o; o.x = pk2(s[0 * 33], s[1 * 33]); o.y = pk2(s[2 * 33], s[3 * 33]); o.z = pk2(s[4 * 33], s[5 * 33]); o.w = pk2(s[6 * 33], s[7 * 33]);
        if (NTS) __builtin_nontemporal_store(o, (u32x4*)(WT + (size_t)(ndst0 + n) * K + k0 + 8 * c)); else *(u32x4*)(WT + (size_t)(ndst0 + n) * K + k0 + 8 * c) = o; }
    LDS_WAIT(); asm volatile("" ::: "memory");
}
__device__ __forceinline__ void p0_prologue(Ctx& C) {
    LAS float* scr = (LAS float*)(C.lds + C.wave * 16384);
    const int gw = C.vcu * 8 + C.wave, NGW = C.G * 8, lane = C.lane;
    constexpr int I_IN = 16 * (ZW / 32), I_OUT = 16 * (D / 32), I_1 = 16 * (2 * DE / 32), I_2 = (DE / 64) * (D / 32);
    constexpr int PER_L = I_IN + I_OUT + NE * (I_1 + I_2);
    for (int it = gw; it < DEPTH * PER_L; it += NGW) {
        const int l = it / PER_L; int r = it % PER_L;
        if (r < I_IN) { const int kb = r / (ZW / 32), nb = r % (ZW / 32), nd = 32 * nb, ns = nd < 2304 ? nd : nd + 16;
            transpose_item<false>(INP(I_WIN) + (size_t)l * D * IN_W, IN_W, D, WSP(bf16_t, WS_WIN) + (size_t)l * ZW * D, 64 * kb, ns, nd, scr, lane); continue; }
        r -= I_IN;
        if (r < I_OUT) { const int kb = r / (D / 32), nb = r % (D / 32);
            transpose_item<false>(INP(I_WOUT) + (size_t)l * D * D, D, D, WSP(bf16_t, WS_WOUT) + (size_t)l * D * D, 64 * kb, 32 * nb, 32 * nb, scr, lane); continue; }
        r -= I_OUT;
        const int e = r / (I_1 + I_2); r %= (I_1 + I_2);
        if (r < I_1) { const int kb = r / (2 * DE / 32), nb = r % (2 * DE / 32), nd = 32 * nb;
            const int ntile = nd / 256, hh = (nd % 256) / 128, j = nd % 128, ns = DE * hh + 128 * ntile + j;
            transpose_item<true>(INP(I_EW1) + ((size_t)l * NE + e) * D * 2 * DE, 2 * DE, D, WSP(bf16_t, WS_W1) + ((size_t)l * NE + e) * 2 * DE * D, 64 * kb, ns, nd, scr, lane); continue; }
        r -= I_1;
        { const int kb = r / (D / 32), nb = r % (D / 32);
            transpose_item<true>(INP(I_EW2) + ((size_t)l * NE + e) * DE * D, D, DE, WSP(bf16_t, WS_W2) + ((size_t)l * NE + e) * D * DE, 64 * kb, 32 * nb, 32 * nb, scr, lane); }
    }
    for (int it = gw; it < DEPTH * (NB + 1) * (6 * D / 64); it += NGW) {
        const int l = it / ((NB + 1) * (6 * D / 64)), b = (it / (6 * D / 64)) % (NB + 1), n = (it % (6 * D / 64)) * 64 + lane;
        const float* w = INP(I_MODW) + (size_t)l * D * 6 * D + n; const float* cv = b < NB ? INP(I_C) + b * D : INP(I_CCTX);
        float acc = 0.f;
#pragma unroll
        for (int q = 0; q < D / 64; ++q) scr[lane + 64 * q] = siluf_(cv[lane + 64 * q]);
        LDS_WAIT(); asm volatile("" ::: "memory");
#pragma unroll 16
        for (int k = 0; k < D; ++k) acc += scr[k] * w[(size_t)k * 6 * D];
        LDS_WAIT(); asm volatile("" ::: "memory");
        WSP(float, WS_MOD)[((size_t)l * (NB + 1) + b) * 6 * D + n] = acc + INP(I_MODB)[l * 6 * D + n];
    }
    const int gt = gw * 64 + lane, NGT = NGW * 64;
    for (int i = gt; i < 256; i += NGT) { const float a0 = INP(I_HGLB)[i], a1 = INP(I_HGLB)[256 + i], mx = fmaxf(a0, a1), e0 = __expf(a0 - mx), e1 = __expf(a1 - mx);
        WSP(float, WS_LB)[i] = 0.f; WSP(float, WS_LB)[256 + i] = e1 / (e0 + e1); }
    for (int i = gt; i < DEPTH * 32 * D; i += NGT) { const int l = i / (32 * D), j = (i / D) % 32, k = i % D; const int col = j < 16 ? 2304 + j : 4112 + (j - 16);
        WSP(float, WS_WG)[i] = INP(I_WIN)[((size_t)l * D + k) * IN_W + col]; }
    for (int i = gt; i < DEPTH * NE * D; i += NGT) { const int l = i / (NE * D), e = (i / D) % NE, k = i % D;
        WSP(float, WS_WR)[i] = INP(I_RW)[((size_t)l * D + k) * NE + e]; }
    for (int i = gw; i < DEPTH * (SEQ + LC); i += NGW) {
        const int l = i / (SEQ + LC), p = i % (SEQ + LC); const bool isc = p >= SEQ; const int pos = isc ? p - SEQ : p, len = isc ? LC : SEQ;
        const float *w1 = INP(I_HYW1) + l * 17 * 64, *b1 = INP(I_HYB1) + l * 64, *w2 = INP(I_HYW2) + l * 64 * 64, *b2 = INP(I_HYB2) + l * 64, *fr = INP(I_HYFR) + l * 128;
        float s = b1[lane] + ((float)pos / (float)(len - 1)) * w1[lane];
#pragma unroll
        for (int j = 0; j < 8; ++j) { const float band = 1e-4f + (7.0f - 1e-4f) * (float)j / 7.0f; const float ang = 6.283185307179586f * (float)pos * band / (float)len;
            s += cosf(ang) * w1[(1 + j) * 64 + lane] - sinf(ang) * w1[(9 + j) * 64 + lane]; }
        scr[lane] = sinf(fr[lane] * s);
        LDS_WAIT(); asm volatile("" ::: "memory");
        float s2 = b2[lane];
#pragma unroll 8
        for (int q = 0; q < 64; ++q) s2 += scr[q] * w2[q * 64 + lane];
        WSP(float, WS_HDN)[((size_t)l * (SEQ + LC) + p) * 64 + lane] = sinf(fr[64 + lane] * s2);
        LDS_WAIT(); asm volatile("" ::: "memory");
    }
}

__device__ __forceinline__ void rms_mod_row(const f32x4 (&xv)[4], const float* gain, const float* sh, const float* sc, bf16_t* orow, int lane, f32x4 (&hv)[4]) {
    float s = 0.f;
#pragma unroll
    for (int j = 0; j < 4; ++j) s += (xv[j].x * xv[j].x + xv[j].y * xv[j].y) + (xv[j].z * xv[j].z + xv[j].w * xv[j].w);
    const float rstd = 1.f / sqrtf(wave_sum_x(s, lane) * (1.f / D) + EPS);
#pragma unroll
    for (int j = 0; j < 4; ++j) { const int c = 4 * lane + 256 * j; const f32x4 g = *(const f32x4*)(gain + c), a = *(const f32x4*)(sc + c), b = *(const f32x4*)(sh + c);
        hv[j] = xv[j] * rstd * g * (a + 1.0f) + b;
        u32x2 w; w.x = pk2(hv[j].x, hv[j].y); w.y = pk2(hv[j].z, hv[j].w); *(u32x2*)(orow + c) = w; }
}
__device__ __forceinline__ void load_w32(Ctx& C, const float* W, int n) {
    __syncthreads();
#pragma unroll 1
    for (int k0 = 0; k0 < 16; k0 += 8) { f32x4 wv_[8];
#pragma unroll
        for (int k = 0; k < 8; ++k) { const int o = C.tid + 512 * (k0 + k); if (o < n * 256) wv_[k] = *(const f32x4*)(W + (size_t)o * 4); }
#pragma unroll
        for (int k = 0; k < 8; ++k) { const int o = C.tid + 512 * (k0 + k); if (o < n * 256) *(LAS f32x4*)(C.lds + (size_t)o * 16) = wv_[k]; } }
    __syncthreads();
}
template <bool PK> __device__ __forceinline__ float row2_dots(LAS unsigned char* lds, const f32x4 (&hv)[2][4], int lane, int n) {
    float v[64];
#pragma unroll
    for (int jj = 0; jj < 32; ++jj) { f32x2 s0 = {0.f, 0.f}, s1 = {0.f, 0.f};
        if (jj < n) {
#pragma unroll
            for (int j = 0; j < 4; ++j) { const f32x4 w = *(const LAS f32x4*)(lds + (size_t)jj * 4096 + (size_t)(4 * lane + 256 * j) * 4);
                if (PK) { s0 = __builtin_elementwise_fma(hv[0][j].xy, w.xy, s0); s1 = __builtin_elementwise_fma(hv[1][j].xy, w.xy, s1);
                          s0 = __builtin_elementwise_fma(hv[0][j].zw, w.zw, s0); s1 = __builtin_elementwise_fma(hv[1][j].zw, w.zw, s1); }
                else {
                    s0.x = __builtin_fmaf(hv[0][j].x, w.x, s0.x); s1.x = __builtin_fmaf(hv[1][j].x, w.x, s1.x); s0.x = __builtin_fmaf(hv[0][j].y, w.y, s0.x); s1.x = __builtin_fmaf(hv[1][j].y, w.y, s1.x);
                    s0.x = __builtin_fmaf(hv[0][j].z, w.z, s0.x); s1.x = __builtin_fmaf(hv[1][j].z, w.z, s1.x); s0.x = __builtin_fmaf(hv[0][j].w, w.w, s0.x); s1.x = __builtin_fmaf(hv[1][j].w, w.w, s1.x); } } }
#ifndef HOST_EMU
        { const auto r = __builtin_amdgcn_permlane32_swap(__float_as_uint(s0.x + s0.y), __float_as_uint(s1.x + s1.y), false, false); v[jj] = __uint_as_float(r[0]) + __uint_as_float(r[1]); } }
#else
        v[jj] = s0.x + s0.y; v[32 + jj] = s1.x + s1.y; }
#endif
#ifndef HOST_EMU
    constexpr int ST0 = 1;
#else
    constexpr int ST0 = 0;
#endif
#pragma unroll
    for (int st = ST0; st < 6; ++st) { const int m = 32 >> st, nh = 32 >> st; const bool up = (lane & m) != 0;
#ifndef HOST_EMU
        if (st == 1) {
#pragma unroll
            for (int i = 0; i < nh; ++i) { const auto r = __builtin_amdgcn_permlane16_swap(__float_as_uint(v[i]), __float_as_uint(v[i + nh]), false, false); v[i] = __uint_as_float(r[0]) + __uint_as_float(r[1]); }
            continue; }
#endif
#ifndef HOST_EMU
        if (st >= 2) continue;
#endif
#pragma unroll
        for (int i = 0; i < nh; ++i) { const float a = v[i], bb = v[i + nh]; const float send = up ? a : bb, keep = up ? bb : a; v[i] = keep + __shfl_xor(send, m); } }
#ifndef HOST_EMU
#define RED_LVL(M_) { const bool up = (lane & M_) != 0; _Pragma("unroll") for (int i = 0; i < M_; ++i) { const float a = v[i], bb = v[i + M_]; const float send = up ? a : bb, keep = up ? bb : a; v[i] = keep + shx<M_>(send, lane); } }
    RED_LVL(8) RED_LVL(4) RED_LVL(2) RED_LVL(1)
#undef RED_LVL
#endif
    return v[0];
}
__device__ __forceinline__ int row_pair_of(const Ctx& C, int it, int nrows) {
    const int NGW = C.G * 8, nfull = nrows / (2 * NGW);
    if (it < nfull) return 2 * (C.vcu * 8 + C.wave) + it * 2 * NGW;
    if (it > nfull) return -1;
    const int r0 = nfull * 2 * NGW + 2 * (C.wave * C.G + C.vcu);
    return r0 < nrows ? r0 : -1;
}
__device__ __forceinline__ void phase_rows_a(Ctx& C, int l) {
    const int gw = C.vcu * 8 + C.wave, NGW = C.G * 8, lane = C.lane;
    const int nrows = (l == DEPTH) ? NLAT : NT;
    float* xcur = WSP(float, WS_X);
    if (l < DEPTH) load_w32(C, WSP(float, WS_WG) + (size_t)l * 32 * D, 32);
    for (int it_ = 0;; ++it_) { const int r0 = row_pair_of(C, it_, nrows); if (r0 < 0) break;
        f32x4 xv[2][4];
#pragma unroll
        for (int q = 0; q < 2; ++q) { const int r = r0 + q; const int bb = row_batch(r);
            if (l == 0) { const float* xr = xrow_l0(C, r);
#pragma unroll
                for (int j = 0; j < 4; ++j) xv[q][j] = __builtin_nontemporal_load((const f32x4*)(xr + 4 * lane + 256 * j)); }
            else {
                const int lp = l - 1; const int ntok = (lp == DEPTH - 1) ? NLAT : NT;
                const float* xr = xcur + (size_t)r * D;
#pragma unroll
                for (int j = 0; j < 4; ++j) xv[q][j] = *(const f32x4*)(xr + 4 * lane + 256 * j);
                if (r < ntok) {
                    const float* g2 = WSP(float, WS_MOD) + ((size_t)lp * (NB + 1) + bb) * 6 * D + 5 * D;
                    const int* te = WSP(int, WS_TOP) + (size_t)r * 4; const int* tp = WSP(int, WS_TOP) + (size_t)NT * 4 + (size_t)r * 4; const float* tg = WSP(float, WS_TOP) + (size_t)NT * 8 + (size_t)r * 4;
                    const LAS int* tbase = (const LAS int*)(C.lds + LDSX_OFF + LX_TILE) + MAXTILES;
                    f32x4 ys[4];
#pragma unroll
                    for (int j = 0; j < 4; ++j) ys[j] = (f32x4){0.f, 0.f, 0.f, 0.f};
#pragma unroll
                    for (int k = 0; k < TOPK; ++k) { const int e = te[k]; const size_t yr = (size_t)tbase[e] * 256 + tp[k]; const float gk = tg[k]; const bf16_t* yp = WSP(bf16_t, WS_Y) + yr * D;
#pragma unroll
                        for (int j = 0; j < 4; ++j) { const u32x2 w = __builtin_nontemporal_load((const u32x2*)(yp + 4 * lane + 256 * j));
                            ys[j].x += gk * u2f(w.x << 16); ys[j].y += gk * u2f(w.x & 0xffff0000u); ys[j].z += gk * u2f(w.y << 16); ys[j].w += gk * u2f(w.y & 0xffff0000u); } }
#pragma unroll
                    for (int j = 0; j < 4; ++j) { const f32x4 g = *(const f32x4*)(g2 + 4 * lane + 256 * j); xv[q][j] = xv[q][j] + g * ys[j]; }
                    if (l < DEPTH) {
#pragma unroll
                        for (int j = 0; j < 4; ++j) *(f32x4*)(xcur + (size_t)r * D + 4 * lane + 256 * j) = xv[q][j]; }
                }
            }
        }
        if (l == DEPTH) {
#pragma unroll
            for (int q = 0; q < 2; ++q) { float s = 0.f;
#pragma unroll
                for (int j = 0; j < 4; ++j) s += (xv[q][j].x * xv[q][j].x + xv[q][j].y * xv[q][j].y) + (xv[q][j].z * xv[q][j].z + xv[q][j].w * xv[q][j].w);
                const float rstd = 1.f / sqrtf(wave_sum_x(s, lane) * (1.f / D) + EPS);
#pragma unroll
                for (int j = 0; j < 4; ++j) { const f32x4 g = *(const f32x4*)(INP(I_FG) + 4 * lane + 256 * j); *(f32x4*)(C.a->out + (size_t)(r0 + q) * D + 4 * lane + 256 * j) = xv[q][j] * rstd * g; } }
            continue;
        }
        f32x4 hv[2][4];
#pragma unroll
        for (int q = 0; q < 2; ++q) { const int r = r0 + q; const float* mod = WSP(float, WS_MOD) + ((size_t)l * (NB + 1) + row_batch(r)) * 6 * D;
            rms_mod_row(xv[q], INP(I_N1) + l * D, mod, mod + D, WSP(bf16_t, WS_H) + (size_t)r * D, lane, hv[q]); }
        const float mine = row2_dots<false>(C.lds, hv, lane, 32);
        WSP(float, WS_ZG)[(size_t)(r0 + (lane >> 5)) * 32 + (lane & 31)] = mine;
    }
}
__device__ __forceinline__ int build_tiles(Ctx& C, int l) {
    LAS int* tile_e = (LAS int*)(C.lds + LDSX_OFF + LX_TILE); LAS int* tbase = tile_e + MAXTILES;
    const unsigned* cnt = WSP(unsigned, WS_CTL) + CW_CNT + l * NE;
    __syncthreads();
    if (C.tid == 0) { int t = 0;
        for (int e = 0; e < NE; ++e) { const int c = (int)cnt[e], n = (c + 255) / 256; tbase[e] = t; for (int i = 0; i < n; ++i) tile_e[t + i] = e; t += n; }
        tbase[NE] = t; }
    __syncthreads();
    return tbase[NE];
}
__device__ __forceinline__ void phase_rows_b(Ctx& C, int l) {
    const int gw = C.vcu * 8 + C.wave, NGW = C.G * 8, lane = C.lane;
    const int ntok = (l == DEPTH - 1) ? NLAT : NT;
    const float* xcur = WSP(float, WS_X);
    unsigned* cnt = WSP(unsigned, WS_CTL) + CW_CNT + l * NE;
    static_assert(NE <= 32, "router width");
    LAS int* lcnt = (LAS int*)(C.lds + LDSX_OFF + 2048);
    LAS int* lbase = lcnt + 32;
    LAS int* rec = lbase + 32;
    constexpr int MAXIT = (NT / 2 + 2047) / 2048 + 1;
    static_assert((MAXIT * 16 * 4 * 2 + 64) * 4 + 2048 <= LDS_BYTES - LDSX_OFF, "routing records fit the control region");
    load_w32(C, WSP(float, WS_WR) + (size_t)l * NE * D, NE);
    if (C.tid < 32) lcnt[C.tid] = 0;
    __syncthreads();
    int itn = 0;
    for (;; ++itn) { const int r0 = row_pair_of(C, itn, ntok); if (r0 < 0) break;
        f32x4 hv[2][4];
#pragma unroll
        for (int q = 0; q < 2; ++q) { const int r = r0 + q; f32x4 xv[4];
#pragma unroll
            for (int j = 0; j < 4; ++j) xv[j] = *(const f32x4*)(xcur + (size_t)r * D + 4 * lane + 256 * j);
            const float* mod = WSP(float, WS_MOD) + ((size_t)l * (NB + 1) + row_batch(r)) * 6 * D;
            rms_mod_row(xv, INP(I_N2) + l * D, mod + 3 * D, mod + 4 * D, WSP(bf16_t, WS_H) + (size_t)r * D, lane, hv[q]); }
        const float lgm = row2_dots<false>(C.lds, hv, lane, NE);
        const int jl = lane & 31, r = r0 + (lane >> 5);
        float v = (jl < NE) ? lgm + INP(I_RB)[l * NE + (jl < NE ? jl : 0)] : -3.0e38f;
        float tv[4]; int ti[4];
#pragma unroll
        for (int k = 0; k < 4; ++k) { float bv = v; int bi = jl;
#ifdef HOST_EMU
#pragma unroll
            for (int o = 1; o < 32; o <<= 1) { const float ov = __shfl_xor(bv, o); const int oi = __shfl_xor(bi, o); const bool take = (ov > bv) || (ov == bv && oi < bi); bv = take ? ov : bv; bi = take ? oi : bi; }
#else
#define TOP_LVL(O_) { const float ov = shx<O_>(bv, lane); const int oi = shx_i<O_>(bi, lane); const bool take = (ov > bv) || (ov == bv && oi < bi); bv = take ? ov : bv; bi = take ? oi : bi; }
            TOP_LVL(1) TOP_LVL(2) TOP_LVL(4) TOP_LVL(8) TOP_LVL(16)
#undef TOP_LVL
#endif
            tv[k] = bv; ti[k] = bi; v = (jl == bi) ? -3.4e38f : v; }
        const float e1 = __expf(tv[1] - tv[0]), e2 = __expf(tv[2] - tv[0]), e3 = __expf(tv[3] - tv[0]), inv = __builtin_amdgcn_rcpf(1.f + e1 + e2 + e3);
        const float gk[4] = {inv, e1 * inv, e2 * inv, e3 * inv};
        if (jl < 4) {
            int e = ti[0]; float g = gk[0];
#pragma unroll
            for (int k = 1; k < 4; ++k) { e = (jl == k) ? ti[k] : e; g = (jl == k) ? gk[k] : g; }
#ifdef HOST_EMU
            const int lr = lcnt[e]; lcnt[e] = lr + 1;
#else
            const int lr = __hip_atomic_fetch_add((LAS int*)(lcnt + e), 1, __ATOMIC_RELAXED, __HIP_MEMORY_SCOPE_WORKGROUP);
#endif
            rec[(((itn * 8 + C.wave) * 2 + (lane >> 5)) * 4 + jl) * 2] = e; rec[(((itn * 8 + C.wave) * 2 + (lane >> 5)) * 4 + jl) * 2 + 1] = lr;
            WSP(int, WS_TOP)[(size_t)r * 4 + jl] = e; WSP(float, WS_TOP)[(size_t)NT * 8 + (size_t)r * 4 + jl] = g;
        }
    }
    __syncthreads();
    if (C.tid < NE) lbase[C.tid] = (int)atomicAdd(cnt + C.tid, (unsigned)lcnt[C.tid]);
    __syncthreads();
    itn = 0;
    for (;; ++itn) { const int r0 = row_pair_of(C, itn, ntok); if (r0 < 0) break; const int jl = lane & 31, r = r0 + (lane >> 5);
        if (jl < 4) { const int e = rec[(((itn * 8 + C.wave) * 2 + (lane >> 5)) * 4 + jl) * 2], lr = rec[(((itn * 8 + C.wave) * 2 + (lane >> 5)) * 4 + jl) * 2 + 1];
            WSP(int, WS_TOP)[(size_t)NT * 4 + (size_t)r * 4 + jl] = lbase[e] + lr; } }
}
__device__ __forceinline__ void phase_gather(Ctx& C, int l) {
    const int gw = C.vcu * 8 + C.wave, NGW = C.G * 8, lane = C.lane;
    const int ntok = (l == DEPTH - 1) ? NLAT : NT;
    (void)build_tiles(C, l);
    const LAS int* tbase = (const LAS int*)(C.lds + LDSX_OFF + LX_TILE) + MAXTILES;
    const unsigned* cnt = WSP(unsigned, WS_CTL) + CW_CNT + l * NE;
    for (int it = gw; it < ntok * 4; it += NGW) { const int r = it >> 2, k = it & 3;
        const int e = WSP(int, WS_TOP)[(size_t)r * 4 + k], pos = WSP(int, WS_TOP)[(size_t)NT * 4 + (size_t)r * 4 + k];
        const u32x4* s = (const u32x4*)(WSP(bf16_t, WS_H) + (size_t)r * D); u32x4* d = (u32x4*)(WSP(bf16_t, WS_HS) + ((size_t)tbase[e] * 256 + pos) * D);
        d[lane] = s[lane]; d[lane + 64] = s[lane + 64]; }
    for (int it = gw; it < NE * 256; it += NGW) { const int e = it >> 8, p = it & 255; const int c = (int)cnt[e], pad0 = c, pad1 = ((c + 255) / 256) * 256;
        if (pad0 + p < pad1) { u32x4* d = (u32x4*)(WSP(bf16_t, WS_HS) + ((size_t)tbase[e] * 256 + pad0 + p) * D); d[lane] = (u32x4){0u, 0u, 0u, 0u}; d[lane + 64] = (u32x4){0u, 0u, 0u, 0u}; } }
}

template <int MIX> __device__ __forceinline__ int scan_row(int b, int dir, int s) {
    if (s < LC) { const int t = dir ? LC - 1 - s : s; return NLAT + b * LC + t; }
    const int i0 = s - LC, i = dir ? SEQ - 1 - i0 : i0;
    const int t = (MIX == 1) ? (i % GROWS) * GW + (i / GROWS) : i;
    return b * SEQ + t;
}
typedef float f32x16 __attribute__((ext_vector_type(16)));
template <int NT_, int KS>
__device__ __forceinline__ void mm_nt(const LAS bf16_t* A, int lda, const LAS bf16_t* B, int ldb, f32x16 (&acc)[NT_], int lane) {
    const int r = lane & 31, kh = (lane >> 5) * 8;
#pragma unroll
    for (int kk = 0; kk < KS; ++kk) {
        const bf16x8 a = *(const LAS bf16x8*)(A + r * lda + 16 * kk + kh);
#pragma unroll
        for (int n = 0; n < NT_; ++n) { const bf16x8 b = *(const LAS bf16x8*)(B + (32 * n + r) * ldb + 16 * kk + kh); acc[n] = __builtin_amdgcn_mfma_f32_32x32x16_bf16(a, b, acc[n], 0, 0, 0); }
    }
}
#ifdef HOST_EMU
#define ITEM_IDS() const int tid = C.tid, lane = C.lane, w = C.wave
#else
#define ITEM_IDS() int tid_ = C.tid; asm volatile("" : "+v"(tid_)); const int tid = tid_, lane = tid_ & 63, w = __builtin_amdgcn_readfirstlane(tid_ >> 6)
#endif
#define CROW(ri, lane) (((ri) & 3) + 8 * ((ri) >> 2) + 4 * ((lane) >> 5))
constexpr int LS = 72, LF = 65;
constexpr int GA_Q = 0, GA_K = 9216, GA_BVT = 18432, GA_BKGT = 27648, GA_KDT = 36864, GA_QKM = 46080, GA_TB = 55296, GA_UT = 64512, GA_WT = 73728, GA_AM = 82944, GA_AMB = 99584, GA_TT = 108800, GA_DG = 118016, GA_XT = 122368, GA_G = 124928;
__device__ __forceinline__ void gdn_a_item(Ctx& C, int l, int b, int h, int dir, int c) {
    LAS unsigned char* lds = C.lds; ITEM_IDS();
    LAS bf16_t* Qb = (LAS bf16_t*)(lds + GA_Q); LAS bf16_t* Kb = (LAS bf16_t*)(lds + GA_K); LAS bf16_t* BVT = (LAS bf16_t*)(lds + GA_BVT); LAS bf16_t* BKGT = (LAS bf16_t*)(lds + GA_BKGT);
    LAS bf16_t* KDT = (LAS bf16_t*)(lds + GA_KDT); LAS bf16_t* QKM = (LAS bf16_t*)(lds + GA_QKM); LAS bf16_t* TB = (LAS bf16_t*)(lds + GA_TB); LAS bf16_t* UT = (LAS bf16_t*)(lds + GA_UT); LAS bf16_t* WT = (LAS bf16_t*)(lds + GA_WT);
    LAS float* AM = (LAS float*)(lds + GA_AM); LAS bf16_t* AMb = (LAS bf16_t*)(lds + GA_AMB); LAS bf16_t* TT = (LAS bf16_t*)(lds + GA_TT); LAS float* Dg = (LAS float*)(lds + GA_DG); LAS bf16_t* XT = (LAS bf16_t*)(lds + GA_XT); LAS float* G = (LAS float*)(lds + GA_G);
    const bf16_t* zb = WSP(bf16_t, WS_Z); const float* zg = WSP(float, WS_ZG);
    unsigned char* blob = C.ws + WS_GD + ((size_t)((b * NH + h) * 2 + dir) * NCH + c) * GD_BLOB;
    const int i = tid >> 3, d0 = (tid & 7) * 8; const int row = scan_row<2>(b, dir, 64 * c + i);
    float qv[8], kv[8], vv[8];
    { const bf16_t* zr = zb + (size_t)row * ZW; const bool isc = row >= NLAT; const int t = isc ? (row - NLAT) % LC : row % SEQ, len = isc ? LC : SEQ;
        const bool hp = t > 0, hn = t < len - 1; const float* cw = INP(I_GDCW) + l * 3 * 768;
        float sq = 0.f, sk = 0.f;
#pragma unroll
        for (int a = 0; a < 3; ++a) { const int cc = a * 256 + h * 64 + d0; const bf16_t* zp = zr + GDB + cc;
            const f32x4 wa0 = *(const f32x4*)(cw + cc), wa1 = *(const f32x4*)(cw + cc + 4), wb0 = *(const f32x4*)(cw + 768 + cc), wb1 = *(const f32x4*)(cw + 768 + cc + 4), wc0 = *(const f32x4*)(cw + 1536 + cc), wc1 = *(const f32x4*)(cw + 1536 + cc + 4);
            const float cwa[8] = {wa0.x, wa0.y, wa0.z, wa0.w, wa1.x, wa1.y, wa1.z, wa1.w}, cwb[8] = {wb0.x, wb0.y, wb0.z, wb0.w, wb1.x, wb1.y, wb1.z, wb1.w}, cwc[8] = {wc0.x, wc0.y, wc0.z, wc0.w, wc1.x, wc1.y, wc1.z, wc1.w};
            const u32x4 z1 = *(const u32x4*)zp, z0 = *(const u32x4*)(zp - (hp ? ZW : 0)), z2 = *(const u32x4*)(zp + (hn ? ZW : 0));
            const unsigned u0[4] = {z0.x, z0.y, z0.z, z0.w}, u1[4] = {z1.x, z1.y, z1.z, z1.w}, u2[4] = {z2.x, z2.y, z2.z, z2.w};
#pragma unroll
            for (int j = 0; j < 8; ++j) { const int jj = j >> 1; const bool hi = j & 1;
                const float x0 = hi ? u2f(u0[jj] & 0xffff0000u) : u2f(u0[jj] << 16), x1 = hi ? u2f(u1[jj] & 0xffff0000u) : u2f(u1[jj] << 16), x2 = hi ? u2f(u2[jj] & 0xffff0000u) : u2f(u2[jj] << 16);
                float sacc = (hp ? cwa[j] : 0.f) * x0 + cwb[j] * x1 + (hn ? cwc[j] : 0.f) * x2;
                sacc = siluf_(sacc);
                if (a == 0) { qv[j] = sacc; sq += sacc * sacc; } else if (a == 1) { kv[j] = sacc; sk += sacc * sacc; } else vv[j] = sacc; } }
#pragma unroll
        for (int o = 1; o < 8; o <<= 1) { sq += __shfl_xor(sq, o); sk += __shfl_xor(sk, o); }
        const float rq = 0.125f * __builtin_amdgcn_rsqf(sq + EPS), rk = __builtin_amdgcn_rsqf(sk + EPS);
#pragma unroll
        for (int j = 0; j < 8; ++j) { qv[j] *= rq; kv[j] *= rk; }
        if ((tid & 7) == 0) { const float* g = zg + (size_t)row * 32 + 16;
            G[128 + i] = -__expf(INP(I_GDAL)[l * 8 + dir * 4 + h]) * softplusf_(g[(2 * dir) * 4 + h] + INP(I_GDDT)[l * 8 + dir * 4 + h]); G[64 + i] = sigmoidf_(g[(2 * dir + 1) * 4 + h]); }
        u32x4 wq, wk; wq.x = pk2(qv[0], qv[1]); wq.y = pk2(qv[2], qv[3]); wq.z = pk2(qv[4], qv[5]); wq.w = pk2(qv[6], qv[7]); wk.x = pk2(kv[0], kv[1]); wk.y = pk2(kv[2], kv[3]); wk.z = pk2(kv[4], kv[5]); wk.w = pk2(kv[6], kv[7]);
        *(LAS u32x4*)(Qb + i * LS + d0) = wq; *(LAS u32x4*)(Kb + i * LS + d0) = wk;
        for (int o = tid; o < 64 * LS / 2; o += 512) ((LAS unsigned*)TT)[o] = 0u;
    }
    __syncthreads();
    if (w == 0) { float gsum = G[128 + lane];
#pragma unroll
        for (int o = 1; o < 64; o <<= 1) { const float t = __shfl(gsum, lane - o); if (lane >= o) gsum += t; }
        G[lane] = gsum; }
    __syncthreads();
    { const float gi = G[i], be = G[64 + i], gl = G[63]; const float eg = __expf(gi), ed = __expf(gl - gi);
#pragma unroll
        for (int j = 0; j < 8; ++j) { BVT[(d0 + j) * LS + i] = (bf16_t)f2bf(be * vv[j]); BKGT[(d0 + j) * LS + i] = (bf16_t)f2bf(be * kv[j] * eg); KDT[(d0 + j) * LS + i] = (bf16_t)f2bf(kv[j] * ed); } }
    for (int rep_ = 0; rep_ < 1 + ((REPMASK >> 18) & 1); ++rep_)
    if (w < 4) { f32x16 acc[2]; acc[0] = (f32x16)(0.f); acc[1] = (f32x16)(0.f);
        const int rh = (w & 1) * 32; mm_nt<2, 4>((w >> 1) ? Qb + rh * LS : Kb + rh * LS, LS, Kb, LS, acc, lane);
        float gi[16], bi[16], gj[2];
#pragma unroll
        for (int ri = 0; ri < 16; ++ri) { gi[ri] = G[rh + CROW(ri, lane)]; bi[ri] = G[64 + rh + CROW(ri, lane)]; }
        gj[0] = G[lane & 31]; gj[1] = G[32 + (lane & 31)];
        if (w >> 1) {
#pragma unroll
            for (int n = 0; n < 2; ++n)
#pragma unroll
                for (int ri = 0; ri < 16; ++ri) { const int ii = rh + CROW(ri, lane), jj = 32 * n + (lane & 31); QKM[ii * LS + jj] = (bf16_t)f2bf(jj <= ii ? acc[n][ri] * __expf(gi[ri] - gj[n]) : 0.f); }
        } else {
#pragma unroll
            for (int n = 0; n < 2; ++n)
#pragma unroll
                for (int ri = 0; ri < 16; ++ri) { const int ii = rh + CROW(ri, lane), jj = 32 * n + (lane & 31); const float av = (jj < ii) ? bi[ri] * acc[n][ri] * __expf(gi[ri] - gj[n]) : 0.f; AM[ii * LF + jj] = av; AMb[ii * LS + jj] = (bf16_t)f2bf(av); }
        } }
    __syncthreads();
    for (int rep_ = 0; rep_ < 1 + ((REPMASK >> 19) & 1); ++rep_) {
    if (w == 0) { const int bb = lane >> 4, cc = lane & 15; float t[16], a[120];
        const LAS float* ab = AM + (16 * bb) * LF + 16 * bb;
#pragma unroll
        for (int r = 1; r < 16; ++r)
#pragma unroll
            for (int r2 = 0; r2 < r; ++r2) a[r * (r - 1) / 2 + r2] = ab[r * LF + r2];
#pragma unroll
        for (int r = 0; r < 16; ++r) { float x = (r == cc) ? 1.f : 0.f;
#pragma unroll
            for (int r2 = 0; r2 < r; ++r2) x -= a[r * (r - 1) / 2 + r2] * t[r2];
            t[r] = x; }
#pragma unroll
        for (int r = 0; r < 16; ++r) Dg[(bb * 16 + r) * 17 + cc] = t[r]; }
    __syncthreads();
    if (w < 4) { const int cl = lane & 15, q4 = lane >> 4; LAS bf16_t* XTw = XT + w * 256;
#pragma unroll
        for (int bb = 0; bb < 4; ++bb) {
            f32x4 acc = (f32x4){0.f, 0.f, 0.f, 0.f};
#pragma unroll
            for (int kk = 0; kk < 2; ++kk) { const bf16x8 a = *(const LAS bf16x8*)(AMb + (16 * bb + cl) * LS + 32 * kk + 8 * q4), tb = *(const LAS bf16x8*)(TT + (16 * w + cl) * LS + 32 * kk + 8 * q4);
                acc = __builtin_amdgcn_mfma_f32_16x16x32_bf16(a, tb, acc, 0, 0, 0); }
            float x[4];
#pragma unroll
            for (int r = 0; r < 4; ++r) x[r] = ((16 * bb + 4 * q4 + r) == (16 * w + cl) ? 1.f : 0.f) - acc[r];
            *(LAS u32x2*)(XTw + cl * 16 + 4 * q4) = (u32x2){pk2(x[0], x[1]), pk2(x[2], x[3])};
            LDS_WAIT(); asm volatile("" ::: "memory");
            bf16x8 da = (bf16x8)(0), xb = (bf16x8)(0);
            if (q4 < 2) { const LAS float* dp = Dg + (bb * 16 + cl) * 17 + 8 * q4; u32x4 dv; dv.x = pk2(dp[0], dp[1]); dv.y = pk2(dp[2], dp[3]); dv.z = pk2(dp[4], dp[5]); dv.w = pk2(dp[6], dp[7]);
                __builtin_memcpy(&da, &dv, 16); xb = *(const LAS bf16x8*)(XTw + cl * 16 + 8 * q4); }
            const f32x4 z4 = (f32x4){0.f, 0.f, 0.f, 0.f}; const f32x4 tt = __builtin_amdgcn_mfma_f32_16x16x32_bf16(da, xb, z4, 0, 0, 0);
            *(LAS u32x2*)(TT + (16 * w + cl) * LS + 16 * bb + 4 * q4) = (u32x2){pk2(tt[0], tt[1]), pk2(tt[2], tt[3])};
#pragma unroll
            for (int r = 0; r < 4; ++r) TB[(16 * bb + 4 * q4 + r) * LS + 16 * w + cl] = (bf16_t)f2bf(tt[r]);
            LDS_WAIT(); asm volatile("" ::: "memory");
        } }
    }
    __syncthreads();
    for (int rep_ = 0; rep_ < 1 + ((REPMASK >> 20) & 1); ++rep_)
    if (w < 4) { f32x16 acc[2]; acc[0] = (f32x16)(0.f); acc[1] = (f32x16)(0.f);
        const int rh = (w & 1) * 32; mm_nt<2, 4>(((w >> 1) ? BKGT : BVT) + rh * LS, LS, TB, LS, acc, lane);
        LAS bf16_t* dst = (w >> 1) ? WT : UT;
#pragma unroll
        for (int n = 0; n < 2; ++n)
#pragma unroll
            for (int ri = 0; ri < 16; ++ri) dst[(rh + CROW(ri, lane)) * LS + 32 * n + (lane & 31)] = (bf16_t)f2bf(acc[n][ri]); }
    __syncthreads();
    for (int rep_ = 0; rep_ < 1 + ((REPMASK >> 21) & 1); ++rep_)
    { f32x16 acc[2]; acc[0] = (f32x16)(0.f); acc[1] = (f32x16)(0.f);
        const int pr = w >> 1, rh = (w & 1) * 32;
        const LAS bf16_t* Ap = (pr == 0 || pr == 1) ? QKM : (pr == 2 ? KDT : UT); const LAS bf16_t* Bp = (pr == 0 || pr == 2) ? WT : (pr == 1 ? UT : KDT);
        mm_nt<2, 4>(Ap + rh * LS, LS, Bp, LS, acc, lane);
        const float egl = __expf(G[63]);
        LAS bf16_t* OUT = (LAS bf16_t*)(lds + GA_AM) + ((pr == 2) ? 0 : (pr == 0) ? 4096 : (pr == 3) ? 8192 : 12288);
        float qe[2][16];
        if (pr == 0) {
#pragma unroll
            for (int ri = 0; ri < 16; ++ri) { const int rr = rh + CROW(ri, lane); const float eg = __expf(G[rr]); qe[0][ri] = bf2f(Qb[rr * LS + (lane & 31)]) * eg; qe[1][ri] = bf2f(Qb[rr * LS + 32 + (lane & 31)]) * eg; } }
#pragma unroll
        for (int n = 0; n < 2; ++n)
#pragma unroll
            for (int ri = 0; ri < 16; ++ri) { const int rr = rh + CROW(ri, lane), cc = 32 * n + (lane & 31); const float a = acc[n][ri];
                const float v = (pr == 0) ? qe[n][ri] - a : (pr == 2) ? ((rr == cc ? egl : 0.f) - a) : a;
                OUT[rr * 64 + cc] = (bf16_t)f2bf(v); } }
    __syncthreads();
#pragma unroll
    for (int k = 0; k < 4; ++k) { const int o = tid + 512 * k; *(u32x4*)(blob + (size_t)o * 16) = *(const LAS u32x4*)(lds + GA_AM + o * 16); }
    __syncthreads();
}
__device__ __forceinline__ void gdn_b_scan(Ctx& C, int sidx) {
    LAS unsigned char* lds = C.lds; const int tid = C.tid, lane = C.lane, w = C.wave;
    LAS bf16_t* STb = (LAS bf16_t*)lds;
    LAS bf16_t* Pb = (LAS bf16_t*)(lds + 18432);
    for (int o = tid; o < 2 * 64 * LS; o += 512) STb[o] = 0;
    __syncthreads();
    int cur = 0;
    LAS bf16_t* QTl = (LAS bf16_t*)(lds + 27648);
    const int pr = tid >> 3, pc8 = (tid & 7) * 8, eh = (w & 1) * 32, dh = (w >> 1) * 32;
    u32x4 pv = *(const u32x4*)((const bf16_t*)(C.ws + WS_GD + ((size_t)sidx * NCH) * GD_BLOB) + pr * 64 + pc8);
    u32x4 qv4 = *(const u32x4*)((const bf16_t*)(C.ws + WS_GD + ((size_t)sidx * NCH) * GD_BLOB + 16384) + pr * 64 + pc8);
    for (int c = 0; c < NCH; ++c) {
        bf16_t* gst = WSP(bf16_t, WS_GST) + ((size_t)sidx * NCH + c) * 4096;
        *(LAS u32x4*)(Pb + pr * LS + pc8) = pv; *(LAS u32x4*)(QTl + pr * LS + pc8) = qv4;
        *(u32x4*)(gst + pr * 64 + pc8) = *(const LAS u32x4*)(STb + cur * 64 * LS + pr * LS + pc8);
        const int cn = (c + 1 < NCH) ? c + 1 : c; const unsigned char* nblob = C.ws + WS_GD + ((size_t)sidx * NCH + cn) * GD_BLOB;
        pv = *(const u32x4*)((const bf16_t*)nblob + pr * 64 + pc8);
        qv4 = *(const u32x4*)((const bf16_t*)(nblob + 16384) + pr * 64 + pc8);
        __syncthreads();
        if (w < 4) { f32x16 acc[1];
#pragma unroll
            for (int ri = 0; ri < 16; ++ri) acc[0][ri] = bf2f(QTl[(eh + CROW(ri, lane)) * LS + dh + (lane & 31)]);
            mm_nt<1, 4>(STb + cur * 64 * LS + eh * LS, LS, Pb + dh * LS, LS, acc, lane);
#pragma unroll
            for (int ri = 0; ri < 16; ++ri) STb[(cur ^ 1) * 64 * LS + (eh + CROW(ri, lane)) * LS + dh + (lane & 31)] = (bf16_t)f2bf(acc[0][ri]); }
        __syncthreads();
        cur ^= 1;
    }
}
__device__ __forceinline__ void gdn_c_item(Ctx& C, int l, int b, int h, int jt) {
    LAS unsigned char* lds = C.lds; ITEM_IDS();
    LAS bf16_t* Rb = (LAS bf16_t*)lds;
    LAS bf16_t* Sb = (LAS bf16_t*)(lds + 18432);
    LAS float* OF = (LAS float*)(lds + 36864);
    const bool isc = jt < NCHC; const int jl = jt - NCHC;
    int cidx[2]; cidx[0] = jt; cidx[1] = isc ? (NCHC - 1 - jt) : NCHC + (SEQ / 64 - 1 - jl);
    const unsigned char* blob[2];
    const int dirw = w >> 2, qw = w & 3, ihw = (qw & 1) * 32, ehw = (qw >> 1) * 32;
    LAS bf16_t* OL = (LAS bf16_t*)(lds + 70144);
    const int tokf = tid >> 3, e0f = (tid & 7) * 8; const int rowf = isc ? NLAT + b * LC + 64 * jt + tokf : b * SEQ + 64 * jl + tokf;
    const u32x4 gzv = *(const u32x4*)(WSP(bf16_t, WS_Z) + (size_t)rowf * ZW + GDB + 768 + h * 64 + e0f);
    const f32x4 ngv0 = *(const f32x4*)(INP(I_GDNG) + l * 256 + h * 64 + e0f), ngv1 = *(const f32x4*)(INP(I_GDNG) + l * 256 + h * 64 + e0f + 4);
#pragma unroll
    for (int dir = 0; dir < 2; ++dir) { const size_t sc = (size_t)((b * NH + h) * 2 + dir) * NCH + cidx[dir]; blob[dir] = C.ws + WS_GD + sc * GD_BLOB;
        const bf16_t* gst = WSP(bf16_t, WS_GST) + sc * 4096; const int r = tid >> 3, c8 = (tid & 7) * 8;
        *(LAS u32x4*)(Rb + dir * 64 * LS + r * LS + c8) = *(const u32x4*)((const bf16_t*)(blob[dir] + 8192) + r * 64 + c8);
        *(LAS u32x4*)(Sb + dir * 64 * LS + r * LS + c8) = *(const u32x4*)(gst + r * 64 + c8);
        *(LAS u32x4*)(OL + dir * 64 * LS + r * LS + c8) = *(const u32x4*)((const bf16_t*)(blob[dir] + 24576) + r * 64 + c8); }
    __syncthreads();
    { const int dir = dirw, ih = ihw, eh = ehw; f32x16 acc[1];
#pragma unroll
        for (int ri = 0; ri < 16; ++ri) acc[0][ri] = bf2f(OL[dir * 64 * LS + (ih + CROW(ri, lane)) * LS + eh + (lane & 31)]);
        mm_nt<1, 4>(Rb + dir * 64 * LS + ih * LS, LS, Sb + dir * 64 * LS + eh * LS, LS, acc, lane);
#pragma unroll
        for (int ri = 0; ri < 16; ++ri) { const int ii = ih + CROW(ri, lane), tok = dir ? 63 - ii : ii; OF[dir * 64 * LF + tok * LF + eh + (lane & 31)] = acc[0][ri]; } }
    __syncthreads();
    { const int tok = tid >> 3, e0 = (tid & 7) * 8; const int row = isc ? NLAT + b * LC + 64 * jt + tok : b * SEQ + 64 * jl + tok;
        float o[8]; float ss = 0.f;
#pragma unroll
        for (int j = 0; j < 8; ++j) { o[j] = OF[tok * LF + e0 + j] + OF[64 * LF + tok * LF + e0 + j]; ss += o[j] * o[j]; }
#pragma unroll
        for (int k = 1; k < 8; k <<= 1) ss += __shfl_xor(ss, k);
        const float rs = __builtin_amdgcn_rsqf(ss * (1.f / 64.f) + EPS);
        const float ng[8] = {ngv0.x, ngv0.y, ngv0.z, ngv0.w, ngv1.x, ngv1.y, ngv1.z, ngv1.w}; const unsigned gu[4] = {gzv.x, gzv.y, gzv.z, gzv.w};
        unsigned pk[4];
#pragma unroll
        for (int j = 0; j < 4; ++j) pk[j] = pk2(o[2 * j] * rs * ng[2 * j] * siluf_(u2f(gu[j] << 16)), o[2 * j + 1] * rs * ng[2 * j + 1] * siluf_(u2f(gu[j] & 0xffff0000u)));
        *(u32x4*)(WSP(bf16_t, WS_MIX) + (size_t)row * D + 768 + h * 64 + e0) = (u32x4){pk[0], pk[1], pk[2], pk[3]}; }
    __syncthreads();
}
constexpr int MA_Q = 0, MA_K = 9216, MA_VT = 18432, MA_KWT = 27648, MA_P = 36864, MA_ONE = 46080  , MA_S = 50688  ;
struct MlIn { u32x4 q, k, v; float g0, g1; };
__device__ __forceinline__ void mlstm_a_load(Ctx& C, int l, int b, int h, int dir, int c, MlIn& in) {
    const int tid = C.tid, i = tid >> 3, d0 = (tid & 7) * 8; const int row = scan_row<1>(b, dir, 64 * c + i);
    const bf16_t* zr = WSP(bf16_t, WS_Z) + (size_t)row * ZW + MLB + h * 64 + d0; const float* g = WSP(float, WS_ZG) + (size_t)row * 32;
    in.q = *(const u32x4*)zr; in.k = *(const u32x4*)(zr + 256); in.v = *(const u32x4*)(zr + 512);
    in.g0 = g[(2 * dir) * 4 + h]; in.g1 = g[(2 * dir + 1) * 4 + h];
}
__device__ __forceinline__ void mlstm_a_item(Ctx& C, int l, int b, int h, int dir, int c, const MlIn& in) {
    LAS unsigned char* lds = C.lds; ITEM_IDS();
    LAS bf16_t* Qb = (LAS bf16_t*)(lds + MA_Q); LAS bf16_t* Kb = (LAS bf16_t*)(lds + MA_K); LAS bf16_t* VT = (LAS bf16_t*)(lds + MA_VT); LAS bf16_t* KWT = (LAS bf16_t*)(lds + MA_KWT);
    LAS bf16_t* Pm = (LAS bf16_t*)(lds + MA_P); LAS bf16_t* ONE = (LAS bf16_t*)(lds + MA_ONE); LAS float* Sc = (LAS float*)(lds + MA_S);
    const bf16_t* zb = WSP(bf16_t, WS_Z); const float* zg = WSP(float, WS_ZG);
    unsigned char* blob = C.ws + WS_ML + ((size_t)((b * NH + h) * 2 + dir) * NCH + c) * ML_BLOB;
    const int i = tid >> 3, d0 = (tid & 7) * 8; const int row = scan_row<1>(b, dir, 64 * c + i);
    float kv[8];
    { (void)zb; (void)zg; (void)row;
        *(LAS u32x4*)(Qb + i * LS + d0) = in.q;
        const u32x4 kr = in.k, vr = in.v;
        const unsigned ku[4] = {kr.x, kr.y, kr.z, kr.w}, vu[4] = {vr.x, vr.y, vr.z, vr.w};
#pragma unroll
        for (int j = 0; j < 4; ++j) { kv[2 * j] = u2f(ku[j] << 16) * 0.125f; kv[2 * j + 1] = u2f(ku[j] & 0xffff0000u) * 0.125f; VT[(d0 + 2 * j) * LS + i] = (bf16_t)(vu[j] & 0xffffu); VT[(d0 + 2 * j + 1) * LS + i] = (bf16_t)(vu[j] >> 16); }
        u32x4 wk; wk.x = pk2(kv[0], kv[1]); wk.y = pk2(kv[2], kv[3]); wk.z = pk2(kv[4], kv[5]); wk.w = pk2(kv[6], kv[7]); *(LAS u32x4*)(Kb + i * LS + d0) = wk;
        if ((tid & 7) == 0) { const float* gb = INP(I_MLGB) + l * 16;
            Sc[i] = in.g0 + gb[(2 * dir) * 4 + h]; Sc[64 + i] = logsigmoidf_(in.g1 + gb[(2 * dir + 1) * 4 + h]); }
        for (int o = tid; o < 32 * LS; o += 512) ONE[o] = (bf16_t)((o < LS) ? 0x3f80 : 0);
    }
    __syncthreads();
    if (w == 0) { float fc = Sc[64 + lane];
#pragma unroll
        for (int o = 1; o < 64; o <<= 1) { const float t = __shfl(fc, lane - o); if (lane >= o) fc += t; }
        const float li = Sc[lane]; float pm = li - fc;
#pragma unroll
        for (int o = 1; o < 64; o <<= 1) { const float t = __shfl(pm, lane - o); if (lane >= o) pm = fmaxf(pm, t); }
        const float fl = __shfl(fc, 63); const float gg = fl - fc + li; float gm = gg;
#pragma unroll
        for (int o = 1; o < 64; o <<= 1) gm = fmaxf(gm, __shfl_xor(gm, o));
        Sc[128 + lane] = fc; Sc[192 + lane] = gg - gm; Sc[256 + lane] = fc + pm;
        if (lane == 0) { ((float*)(blob + 17408))[0] = gm; ((float*)(blob + 17408))[1] = fl; }
        ((float*)(blob + 16384))[64 + lane] = fc + pm; ((float*)(blob + 16384))[128 + lane] = fc; }
    __syncthreads();
    { const float e = __expf(Sc[192 + i]);
#pragma unroll
        for (int j = 0; j < 8; ++j) KWT[(d0 + j) * LS + i] = (bf16_t)f2bf(kv[j] * e); }
    if (w < 2) { f32x16 acc[2]; acc[0] = (f32x16)(0.f); acc[1] = (f32x16)(0.f);
        const int rh = w * 32; mm_nt<2, 4>(Qb + rh * LS, LS, Kb, LS, acc, lane);
        float fi[16], cj[2];
#pragma unroll
        for (int ri = 0; ri < 16; ++ri) { const int ii = rh + CROW(ri, lane); fi[ri] = Sc[128 + ii] - Sc[256 + ii]; }
        cj[0] = Sc[lane & 31] - Sc[128 + (lane & 31)]; cj[1] = Sc[32 + (lane & 31)] - Sc[128 + 32 + (lane & 31)];
#pragma unroll
        for (int n = 0; n < 2; ++n)
#pragma unroll
            for (int ri = 0; ri < 16; ++ri) { const int ii = rh + CROW(ri, lane), jj = 32 * n + (lane & 31);
                Pm[ii * LS + jj] = (bf16_t)f2bf(jj <= ii ? acc[n][ri] * __expf(fi[ri] + cj[n]) : 0.f); } }
    __syncthreads();
    { const int pr = w >> 2, q = w & 3, rh = (q & 1) * 32, ch = (q >> 1) * 32; f32x16 acc[1]; acc[0] = (f32x16)(0.f);
        const LAS bf16_t* Ap = pr ? VT : Pm; const LAS bf16_t* Bp = pr ? KWT : VT;
        mm_nt<1, 4>(Ap + rh * LS, LS, Bp + ch * LS, LS, acc, lane);
        LAS bf16_t* OUT = (LAS bf16_t*)(lds + MA_Q) + (pr ? 4096 : 0);
#pragma unroll
        for (int ri = 0; ri < 16; ++ri) OUT[(rh + CROW(ri, lane)) * 64 + ch + (lane & 31)] = (bf16_t)f2bf(acc[0][ri]);
        if (q < 2) {
            f32x16 a2[1]; a2[0] = (f32x16)(0.f);
            if (pr == 0) { mm_nt<1, 4>(Pm + (q * 32) * LS, LS, ONE, LS, a2, lane);
                if ((lane & 31) == 0) {
#pragma unroll
                    for (int ri = 0; ri < 16; ++ri) ((float*)(blob + 16384))[q * 32 + CROW(ri, lane)] = a2[0][ri]; } }
            else { mm_nt<1, 4>(ONE, LS, KWT + (q * 32) * LS, LS, a2, lane);
                if (lane < 32) ((float*)(blob + 16384))[192 + q * 32 + lane] = a2[0][0]; } } }
    __syncthreads();
#pragma unroll
    for (int k = 0; k < 2; ++k) { const int o = tid + 512 * k; *(u32x4*)(blob + (size_t)o * 16) = *(const LAS u32x4*)(lds + MA_Q + o * 16); }
    __syncthreads();
}
__device__ __forceinline__ void mlstm_b_scan(Ctx& C, int sidx) {
    const int tid = C.tid, e = tid >> 3, d0 = (tid & 7) * 8;
    float ct[8], nn[8]; float m = 0.f;
#pragma unroll
    for (int j = 0; j < 8; ++j) { ct[j] = 0.f; nn[j] = 0.f; }
    u32x4 uq; f32x4 n0, n1; float gm, fl;
    { const unsigned char* blob = C.ws + WS_ML + ((size_t)sidx * NCH) * ML_BLOB;
        uq = *(const u32x4*)((const bf16_t*)(blob + 8192) + e * 64 + d0);
        n0 = *(const f32x4*)((const float*)(blob + 16384) + 192 + d0); n1 = *(const f32x4*)((const float*)(blob + 16384) + 192 + d0 + 4); gm = ((const float*)(blob + 17408))[0]; fl = ((const float*)(blob + 17408))[1]; }
    for (int c = 0; c < NCH; ++c) {
        unsigned char* st = C.ws + WS_MST + ((size_t)sidx * NCH + c) * ML_ST;
        const int cn = (c + 1 < NCH) ? c + 1 : c; const unsigned char* blob = C.ws + WS_ML + ((size_t)sidx * NCH + cn) * ML_BLOB;
        const u32x4 puq = *(const u32x4*)((const bf16_t*)(blob + 8192) + e * 64 + d0);
        const f32x4 pn0 = *(const f32x4*)((const float*)(blob + 16384) + 192 + d0), pn1 = *(const f32x4*)((const float*)(blob + 16384) + 192 + d0 + 4);
        const float pgm = ((const float*)(blob + 17408))[0], pfl = ((const float*)(blob + 17408))[1];
        u32x4 wv; wv.x = pk2(ct[0], ct[1]); wv.y = pk2(ct[2], ct[3]); wv.z = pk2(ct[4], ct[5]); wv.w = pk2(ct[6], ct[7]);
        *(u32x4*)((bf16_t*)st + e * 64 + d0) = wv;
        if (e == 0) { *(f32x4*)((float*)(st + 8192) + d0) = (f32x4){nn[0], nn[1], nn[2], nn[3]}; *(f32x4*)((float*)(st + 8192) + d0 + 4) = (f32x4){nn[4], nn[5], nn[6], nn[7]}; if (d0 == 0) ((float*)(st + 8192))[64] = m; }
        const float mn = fmaxf(fl + m, gm), ao = __expf(fl + m - mn), an = __expf(gm - mn); m = mn;
        const unsigned uw[4] = {uq.x, uq.y, uq.z, uq.w}; const float un[8] = {n0.x, n0.y, n0.z, n0.w, n1.x, n1.y, n1.z, n1.w};
#pragma unroll
        for (int j = 0; j < 4; ++j) { ct[2 * j] = ao * ct[2 * j] + an * u2f(uw[j] << 16); ct[2 * j + 1] = ao * ct[2 * j + 1] + an * u2f(uw[j] & 0xffff0000u); }
#pragma unroll
        for (int j = 0; j < 8; ++j) nn[j] = ao * nn[j] + an * un[j];
        uq = puq; n0 = pn0; n1 = pn1; gm = pgm; fl = pfl;
    }
}
__device__ __forceinline__ void mlstm_c_item(Ctx& C, int l, int b, int h, int jt) {
    LAS unsigned char* lds = C.lds; ITEM_IDS();
    LAS bf16_t* Qb = (LAS bf16_t*)lds;
    LAS bf16_t* Sb = (LAS bf16_t*)(lds + 18432);
    LAS float* OF = (LAS float*)(lds + 36864);
    LAS float* Sc = (LAS float*)(lds + 70144);
    const bool isc = jt < NCHC; const int jl = jt - NCHC;
    int cidx[2]; cidx[0] = jt; cidx[1] = isc ? (NCHC - 1 - jt) : NCHC + (SEQ / 64 - 1 - jl);
    const unsigned char* blob[2]; const bf16_t* zb = WSP(bf16_t, WS_Z);
    const int i = tid >> 3, d0 = (tid & 7) * 8;
    const int dirw = w >> 2, qw = w & 3, ihw = (qw & 1) * 32, ehw = (qw >> 1) * 32;
    LAS bf16_t* NL = (LAS bf16_t*)(lds + 72192);
    const int rowf = scan_row<1>(b, 0, 64 * cidx[0] + i);
    const u32x4 gzv = *(const u32x4*)(zb + (size_t)rowf * ZW + MLB + 768 + h * 64 + d0);
    const f32x4 ngv0 = *(const f32x4*)(INP(I_MLNG) + l * 256 + h * 64 + d0), ngv1 = *(const f32x4*)(INP(I_MLNG) + l * 256 + h * 64 + d0 + 4);
#pragma unroll
    for (int dir = 0; dir < 2; ++dir) { const size_t sc = (size_t)((b * NH + h) * 2 + dir) * NCH + cidx[dir]; blob[dir] = C.ws + WS_ML + sc * ML_BLOB;
        const unsigned char* st = C.ws + WS_MST + sc * ML_ST; const int row = scan_row<1>(b, dir, 64 * cidx[dir] + i);
        const u32x4 qr = *(const u32x4*)(zb + (size_t)row * ZW + MLB + h * 64 + d0);
        *(LAS u32x4*)(Qb + dir * 64 * LS + i * LS + d0) = qr;
        *(LAS u32x4*)(Sb + dir * 64 * LS + i * LS + d0) = *(const u32x4*)((const bf16_t*)st + i * 64 + d0);
        *(LAS u32x4*)(NL + dir * 64 * LS + i * LS + d0) = *(const u32x4*)((const bf16_t*)blob[dir] + i * 64 + d0);
        const float* n0 = (const float*)(st + 8192) + d0; const unsigned qu[4] = {qr.x, qr.y, qr.z, qr.w}; float qn = 0.f;
#pragma unroll
        for (int j = 0; j < 4; ++j) qn += u2f(qu[j] << 16) * n0[2 * j] + u2f(qu[j] & 0xffff0000u) * n0[2 * j + 1];
#pragma unroll
        for (int k = 1; k < 8; k <<= 1) qn += __shfl_xor(qn, k);
        if ((tid & 7) == 0) { const float* sv = (const float*)(blob[dir] + 16384); const float m0 = ((const float*)(st + 8192))[64];
            const float mloc = sv[64 + i], ainit = sv[128 + i] + m0, M = fmaxf(mloc, ainit), s1 = __expf(mloc - M), s2 = __expf(ainit - M);
            LAS float* o = Sc + dir * 256; o[i] = s1; o[64 + i] = s2; o[128 + i] = s1 * sv[i] + s2 * qn; o[192 + i] = __expf(-M); } }
    __syncthreads();
    { const int dir = dirw, ih = ihw, eh = ehw; f32x16 acc[1]; acc[0] = (f32x16)(0.f);
        mm_nt<1, 4>(Qb + dir * 64 * LS + ih * LS, LS, Sb + dir * 64 * LS + eh * LS, LS, acc, lane);
        const LAS float* o = Sc + dir * 256; float s1[16], s2[16], dn[16];
#pragma unroll
        for (int ri = 0; ri < 16; ++ri) { const int ii = ih + CROW(ri, lane); s1[ri] = o[ii] * bf2f(NL[dir * 64 * LS + ii * LS + eh + (lane & 31)]); s2[ri] = o[64 + ii]; dn[ri] = __builtin_amdgcn_rcpf(fmaxf(fabsf(o[128 + ii]), o[192 + ii])); }
#pragma unroll
        for (int ri = 0; ri < 16; ++ri) { const int ii = ih + CROW(ri, lane), tok = dir ? 63 - ii : ii, ee = eh + (lane & 31);
            OF[dir * 64 * LF + tok * LF + ee] = (s1[ri] + s2[ri] * acc[0][ri]) * dn[ri]; } }
    __syncthreads();
    { const int tok = tid >> 3, e0 = (tid & 7) * 8; const int row = scan_row<1>(b, 0, 64 * cidx[0] + tok);
        float o[8]; float ss = 0.f;
#pragma unroll
        for (int j = 0; j < 8; ++j) { o[j] = OF[tok * LF + e0 + j] + OF[64 * LF + tok * LF + e0 + j]; ss += o[j] * o[j]; }
#pragma unroll
        for (int k = 1; k < 8; k <<= 1) ss += __shfl_xor(ss, k);
        const float rs = __builtin_amdgcn_rsqf(ss * (1.f / 64.f) + EPS);
        const float ng[8] = {ngv0.x, ngv0.y, ngv0.z, ngv0.w, ngv1.x, ngv1.y, ngv1.z, ngv1.w}; const unsigned gu[4] = {gzv.x, gzv.y, gzv.z, gzv.w};
        unsigned pk[4];
#pragma unroll
        for (int j = 0; j < 4; ++j) pk[j] = pk2(o[2 * j] * rs * ng[2 * j] * sigmoidf_(u2f(gu[j] << 16)), o[2 * j + 1] * rs * ng[2 * j + 1] * sigmoidf_(u2f(gu[j] & 0xffff0000u)));
        *(u32x4*)(WSP(bf16_t, WS_MIX) + (size_t)row * D + 256 + h * 64 + e0) = (u32x4){pk[0], pk[1], pk[2], pk[3]}; }
    __syncthreads();
}
constexpr int HA_Q = 0, HA_K = 16640, HA_CUM = 33280, HA_V = 49920, HA_SC = 66560  , HA_VT = 70912, HA_KDT = 80128, HA_QT = 89344, HA_KT = 98560;
__device__ __forceinline__ void hgrn_a_item(Ctx& C, int l, int b, int h, int dir, int c) {
    LAS unsigned char* lds = C.lds; ITEM_IDS();
    LAS float* Qf = (LAS float*)(lds + HA_Q); LAS float* Kf = (LAS float*)(lds + HA_K); LAS float* CUM = (LAS float*)(lds + HA_CUM); LAS float* Vf = (LAS float*)(lds + HA_V); LAS float* SC = (LAS float*)(lds + HA_SC);
    LAS bf16_t* VT = (LAS bf16_t*)(lds + HA_VT); LAS bf16_t* KDT = (LAS bf16_t*)(lds + HA_KDT); LAS bf16_t* QTb = (LAS bf16_t*)(lds + HA_QT); LAS bf16_t* KTb = (LAS bf16_t*)(lds + HA_KT);
    const bf16_t* zb = WSP(bf16_t, WS_Z);
    unsigned char* blob = C.ws + WS_HG + ((size_t)((b * NH + h) * 2 + dir) * NCH + c) * HG_BLOB;
    const int i = tid >> 3, d0 = (tid & 7) * 8; const int row = scan_row<0>(b, dir, 64 * c + i);
    { const bf16_t* zr = zb + (size_t)row * ZW + HGB + h * 64 + d0; const float* lbp = WSP(float, WS_LB) + l * 256 + h * 64 + d0;
        const u32x4 zq4 = *(const u32x4*)zr, zi4 = *(const u32x4*)(zr + 256), zf4 = *(const u32x4*)(zr + 512 + dir * 256); const f32x4 lb0 = *(const f32x4*)lbp, lb1 = *(const f32x4*)(lbp + 4);
        const unsigned zqu[4] = {zq4.x, zq4.y, zq4.z, zq4.w}, ziu[4] = {zi4.x, zi4.y, zi4.z, zi4.w}, zfu[4] = {zf4.x, zf4.y, zf4.z, zf4.w}; const float lbv[8] = {lb0.x, lb0.y, lb0.z, lb0.w, lb1.x, lb1.y, lb1.z, lb1.w};
#pragma unroll
        for (int j = 0; j < 8; ++j) { const int jj = j >> 1; const bool hi = j & 1;
            const float qz = hi ? u2f(zqu[jj] & 0xffff0000u) : u2f(zqu[jj] << 16), iz = hi ? u2f(ziu[jj] & 0xffff0000u) : u2f(ziu[jj] << 16), fz = hi ? u2f(zfu[jj] & 0xffff0000u) : u2f(zfu[jj] << 16), lb = lbv[j];
            const float et = __expf(-fz), sg = __builtin_amdgcn_rcpf(1.f + et), sgn = et * sg;
            Qf[i * LF + d0 + j] = siluf_(qz); Kf[i * LF + d0 + j] = (1.f - lb) * sgn; CUM[i * LF + d0 + j] = __logf(lb + (1.f - lb) * sg); Vf[i * LF + d0 + j] = iz; VT[(d0 + j) * LS + i] = (bf16_t)f2bf(iz); } }
    __syncthreads();
    if (tid < 256) { const int sub = tid >> 6, d = tid & 63; float cv[16];
#pragma unroll
        for (int t = 0; t < 16; ++t) cv[t] = CUM[(16 * sub + t) * LF + d];
#pragma unroll
        for (int t = 1; t < 16; ++t) cv[t] += cv[t - 1];
#pragma unroll
        for (int t = 0; t < 16; ++t) CUM[(16 * sub + t) * LF + d] = cv[t]; }
    __syncthreads();
    { const int sub = i >> 4; u32x4 wq, wk; float qt[8], kt[8], cmv[8], lsv[8], kkv[8], qqv[8];
#pragma unroll
        for (int j = 0; j < 8; ++j) { cmv[j] = CUM[i * LF + d0 + j]; lsv[j] = CUM[(16 * sub + 15) * LF + d0 + j]; kkv[j] = Kf[i * LF + d0 + j]; qqv[j] = Qf[i * LF + d0 + j]; }
#pragma unroll
        for (int j = 0; j < 8; ++j) { const float cm = cmv[j], last = lsv[j], kk = kkv[j];
            KDT[(d0 + j) * LS + i] = (bf16_t)f2bf(kk * __expf(last - cm)); qt[j] = qqv[j] * __expf(cm); kt[j] = kk * __expf(fminf(-cm, 80.f));
            if ((i & 15) == 15) ((float*)(blob + 32768))[sub * 64 + d0 + j] = __expf(last); }
        wq.x = pk2(qt[0], qt[1]); wq.y = pk2(qt[2], qt[3]); wq.z = pk2(qt[4], qt[5]); wq.w = pk2(qt[6], qt[7]);
        wk.x = pk2(kt[0], kt[1]); wk.y = pk2(kt[2], kt[3]); wk.z = pk2(kt[4], kt[5]); wk.w = pk2(kt[6], kt[7]);
        *(u32x4*)((bf16_t*)(blob + 33792) + i * 64 + d0) = wq; *(LAS u32x4*)(QTb + i * LS + d0) = wq; *(LAS u32x4*)(KTb + i * LS + d0) = wk; }
    __syncthreads();
    if (w < 4) { const int sub = w, cl = lane & 15, q4 = lane >> 4; f32x4 acc = (f32x4){0.f, 0.f, 0.f, 0.f};
#pragma unroll
        for (int kk = 0; kk < 2; ++kk) { const bf16x8 a = *(const LAS bf16x8*)(QTb + (16 * sub + cl) * LS + 32 * kk + 8 * q4), bb = *(const LAS bf16x8*)(KTb + (16 * sub + cl) * LS + 32 * kk + 8 * q4);
            acc = __builtin_amdgcn_mfma_f32_16x16x32_bf16(a, bb, acc, 0, 0, 0); }
#pragma unroll
        for (int r = 0; r < 4; ++r) { const int t = 4 * q4 + r; SC[(sub * 16 + t) * 17 + cl] = (cl <= t) ? acc[r] : 0.f; } }
    __syncthreads();
    { const int sub = i >> 4, t = i & 15; float o[8];
#pragma unroll
        for (int j = 0; j < 8; ++j) o[j] = 0.f;
#pragma unroll
        for (int s2 = 0; s2 < 16; ++s2) { const float sc = SC[(sub * 16 + t) * 17 + s2];
#pragma unroll
            for (int j = 0; j < 8; ++j) o[j] += sc * Vf[(16 * sub + s2) * LF + d0 + j]; }
        u32x4 ow; ow.x = pk2(o[0], o[1]); ow.y = pk2(o[2], o[3]); ow.z = pk2(o[4], o[5]); ow.w = pk2(o[6], o[7]); *(u32x4*)((bf16_t*)(blob + 41984) + i * 64 + d0) = ow; }
    { const int sub = w >> 1, eh = (w & 1) * 32; f32x16 acc[2]; acc[0] = (f32x16)(0.f); acc[1] = (f32x16)(0.f);
        mm_nt<2, 1>(VT + eh * LS + 16 * sub, LS, KDT + 16 * sub, LS, acc, lane);
        LAS bf16_t* ut = (LAS bf16_t*)(lds + HA_Q) + sub * 4096;
#pragma unroll
        for (int n = 0; n < 2; ++n)
#pragma unroll
            for (int ri = 0; ri < 16; ++ri) ut[(eh + CROW(ri, lane)) * 64 + 32 * n + (lane & 31)] = (bf16_t)f2bf(acc[n][ri]); }
    __syncthreads();
#pragma unroll
    for (int k = 0; k < 4; ++k) { const int o = tid + 512 * k; *(u32x4*)(blob + (size_t)o * 16) = *(const LAS u32x4*)(lds + HA_Q + o * 16); }
    __syncthreads();
}
__device__ __forceinline__ void hgrn_b_scan(Ctx& C, int sidx) {
    const int tid = C.tid, e = tid >> 3, d0 = (tid & 7) * 8;
    LAS float* LAM = (LAS float*)C.lds;
    __syncthreads();
    for (int o = tid; o < NCH * 64; o += 512) { const int c = o >> 6, q = o & 63; *(LAS f32x4*)(LAM + c * 256 + q * 4) = *(const f32x4*)((const float*)(C.ws + WS_HG + ((size_t)sidx * NCH + c) * HG_BLOB + 32768) + q * 4); }
    __syncthreads();
    float st[8];
#pragma unroll
    for (int j = 0; j < 8; ++j) st[j] = 0.f;
    u32x4 ur[3][4];
#define HGB_LOAD(slot, cc) do { const int c_ = (cc) < NCH ? (cc) : NCH - 1; const unsigned char* blob_ = C.ws + WS_HG + ((size_t)sidx * NCH + c_) * HG_BLOB; \
        _Pragma("unroll") for (int sub = 0; sub < 4; ++sub) ur[slot][sub] = *(const u32x4*)((const bf16_t*)blob_ + sub * 4096 + e * 64 + d0); } while (0)
#define HGB_APPLY(slot, cc) do { bf16_t* so_ = WSP(bf16_t, WS_HST) + ((size_t)sidx * NCH + (cc)) * 4 * 4096; \
        _Pragma("unroll") for (int sub = 0; sub < 4; ++sub) { u32x4 wv; wv.x = pk2(st[0], st[1]); wv.y = pk2(st[2], st[3]); wv.z = pk2(st[4], st[5]); wv.w = pk2(st[6], st[7]); \
            *(u32x4*)(so_ + sub * 4096 + e * 64 + d0) = wv; \
            const f32x4 la_ = *(const LAS f32x4*)(LAM + ((cc) * 4 + sub) * 64 + d0), lb_ = *(const LAS f32x4*)(LAM + ((cc) * 4 + sub) * 64 + d0 + 4); \
            const unsigned uu[4] = {ur[slot][sub].x, ur[slot][sub].y, ur[slot][sub].z, ur[slot][sub].w}; const float lam[8] = {la_.x, la_.y, la_.z, la_.w, lb_.x, lb_.y, lb_.z, lb_.w}; \
            _Pragma("unroll") for (int j = 0; j < 4; ++j) { st[2 * j] = lam[2 * j] * st[2 * j] + u2f(uu[j] << 16); st[2 * j + 1] = lam[2 * j + 1] * st[2 * j + 1] + u2f(uu[j] & 0xffff0000u); } } } while (0)
    HGB_LOAD(0, 0); HGB_LOAD(1, 1);
    int c = 0;
    for (; c + 3 <= NCH; c += 3) {
        HGB_LOAD(2, c + 2); HGB_APPLY(0, c);
        HGB_LOAD(0, c + 3); HGB_APPLY(1, c + 1);
        HGB_LOAD(1, c + 4); HGB_APPLY(2, c + 2);
    }
    if (c < NCH) { HGB_APPLY(0, c); ++c; }
    if (c < NCH) { HGB_APPLY(1, c); ++c; }
#undef HGB_LOAD
#undef HGB_APPLY
    __syncthreads();
}
__device__ __forceinline__ void hgrn_c_item(Ctx& C, int l, int b, int h, int jt) {
    LAS unsigned char* lds = C.lds; ITEM_IDS();
    LAS bf16_t* STw = (LAS bf16_t*)(lds + w * 11520);
    LAS bf16_t* QTw = STw + 64 * LS;
    LAS float* OF = (LAS float*)(lds + 92160);
    const bool isc = jt < NCHC; const int jl = jt - NCHC;
    int cidx[2]; cidx[0] = jt; cidx[1] = isc ? (NCHC - 1 - jt) : NCHC + (SEQ / 64 - 1 - jl);
    const int tokf = tid >> 3, e0f = (tid & 7) * 8; const int rowf = scan_row<0>(b, 0, 64 * cidx[0] + tokf);
    const u32x4 gzv = *(const u32x4*)(WSP(bf16_t, WS_Z) + (size_t)rowf * ZW + HGB + 1024 + h * 64 + e0f);
    const f32x4 ngv0 = *(const f32x4*)(INP(I_HGNG) + l * 256 + h * 64 + e0f), ngv1 = *(const f32x4*)(INP(I_HGNG) + l * 256 + h * 64 + e0f + 4);
    { const int dir = w >> 2, sub = w & 3; const size_t sc = (size_t)((b * NH + h) * 2 + dir) * NCH + cidx[dir]; const unsigned char* blob = C.ws + WS_HG + sc * HG_BLOB;
        const bf16_t* st = WSP(bf16_t, WS_HST) + (sc * 4 + sub) * 4096; const bf16_t* qt = (const bf16_t*)(blob + 33792) + (16 * sub) * 64;
#pragma unroll
        for (int k = 0; k < 8; ++k) { const int o = lane + 64 * k, r = o >> 3, c8 = (o & 7) * 8; *(LAS u32x4*)(STw + r * LS + c8) = *(const u32x4*)(st + r * 64 + c8); }
#pragma unroll
        for (int k = 0; k < 2; ++k) { const int o = lane + 64 * k, r = o >> 3, c8 = (o & 7) * 8; *(LAS u32x4*)(QTw + r * LS + c8) = *(const u32x4*)(qt + r * 64 + c8); }
        const bf16_t* oi = (const bf16_t*)(blob + 41984) + (16 * sub) * 64;
        u32x4 oiq[2];
#pragma unroll
        for (int k = 0; k < 2; ++k) { const int o = lane + 64 * k, r = o >> 3, c8 = (o & 7) * 8; oiq[k] = *(const u32x4*)(oi + r * 64 + c8); }
        LDS_WAIT(); asm volatile("" ::: "memory");
        const int tr = lane & 15, kq = (lane >> 4) * 8;
        f32x4 accs[4];
#pragma unroll
        for (int nt = 0; nt < 4; ++nt) { f32x4 acc = (f32x4){0.f, 0.f, 0.f, 0.f};
#pragma unroll
            for (int kk = 0; kk < 2; ++kk) { const bf16x8 a = *(const LAS bf16x8*)(QTw + tr * LS + 32 * kk + kq), bb = *(const LAS bf16x8*)(STw + (16 * nt + tr) * LS + 32 * kk + kq);
                acc = __builtin_amdgcn_mfma_f32_16x16x32_bf16(a, bb, acc, 0, 0, 0); }
            accs[nt] = acc; }
        LDS_WAIT(); asm volatile("" ::: "memory");
#pragma unroll
        for (int k = 0; k < 2; ++k) { const int o = lane + 64 * k, r = o >> 3, c8 = (o & 7) * 8; *(LAS u32x4*)(QTw + r * LS + c8) = oiq[k]; }
        LDS_WAIT(); asm volatile("" ::: "memory");
        float oiv[16];
#pragma unroll
        for (int nt = 0; nt < 4; ++nt)
#pragma unroll
            for (int r = 0; r < 4; ++r) oiv[4 * nt + r] = bf2f(QTw[(4 * (lane >> 4) + r) * LS + 16 * nt + (lane & 15)]);
#pragma unroll
        for (int nt = 0; nt < 4; ++nt)
#pragma unroll
            for (int r = 0; r < 4; ++r) { const int t = 4 * (lane >> 4) + r, ii = 16 * sub + t, tok = dir ? 63 - ii : ii, ee = 16 * nt + (lane & 15);
                OF[dir * 64 * LF + tok * LF + ee] = accs[nt][r] + oiv[4 * nt + r]; } }
    __syncthreads();
    { const int tok = tid >> 3, e0 = (tid & 7) * 8; const int row = scan_row<0>(b, 0, 64 * cidx[0] + tok);
        float o[8]; float ss = 0.f;
#pragma unroll
        for (int j = 0; j < 8; ++j) { o[j] = OF[tok * LF + e0 + j] + OF[64 * LF + tok * LF + e0 + j]; ss += o[j] * o[j]; }
#pragma unroll
        for (int k = 1; k < 8; k <<= 1) ss += __shfl_xor(ss, k);
        const float rs = __builtin_amdgcn_rsqf(ss * (1.f / 64.f) + EPS);
        const float ng[8] = {ngv0.x, ngv0.y, ngv0.z, ngv0.w, ngv1.x, ngv1.y, ngv1.z, ngv1.w}; const unsigned gu[4] = {gzv.x, gzv.y, gzv.z, gzv.w};
        unsigned pk[4];
#pragma unroll
        for (int j = 0; j < 4; ++j) pk[j] = pk2(o[2 * j] * rs * ng[2 * j] * siluf_(u2f(gu[j] << 16)), o[2 * j + 1] * rs * ng[2 * j + 1] * siluf_(u2f(gu[j] & 0xffff0000u)));
        *(u32x4*)(WSP(bf16_t, WS_MIX) + (size_t)row * D + h * 64 + e0) = (u32x4){pk[0], pk[1], pk[2], pk[3]}; }
    __syncthreads();
}
__device__ __forceinline__ void phase_gdn_a(Ctx& C, int l) {
    for (int rep = 0; rep < 1 + ((REPMASK >> 10) & 1); ++rep)
    for (int it = C.bid; it < NSCAN * NCH; it += C.G) { const int sidx = it / NCH, c = it % NCH; gdn_a_item(C, l, sidx / (NH * 2), (sidx / 2) % NH, sidx & 1, c); }
    for (int rep = 0; rep < 1 + ((REPMASK >> 11) & 1); ++rep)
    { MlIn cur, nxt; int it = (C.bid + C.G / 3) % C.G;
        if (it < NSCAN * NCH) { const int sidx = it / NCH; mlstm_a_load(C, l, sidx / (NH * 2), (sidx / 2) % NH, sidx & 1, it % NCH, cur); }
        for (; it < NSCAN * NCH; it += C.G) { const int sidx = it / NCH, c = it % NCH; const int itn = (it + C.G < NSCAN * NCH) ? it + C.G : it, sn = itn / NCH;
            mlstm_a_load(C, l, sn / (NH * 2), (sn / 2) % NH, sn & 1, itn % NCH, nxt);
            mlstm_a_item(C, l, sidx / (NH * 2), (sidx / 2) % NH, sidx & 1, c, cur); cur = nxt; } }
    for (int rep = 0; rep < 1 + ((REPMASK >> 12) & 1); ++rep)
    for (int it = (C.bid + 2 * (C.G / 3)) % C.G; it < NSCAN * NCH; it += C.G) { const int sidx = it / NCH, c = it % NCH; hgrn_a_item(C, l, sidx / (NH * 2), (sidx / 2) % NH, sidx & 1, c); }
}
__device__ __forceinline__ void phase_hy_transpose(Ctx& C) {
    const int gw = C.vcu * 8 + C.wave, NGW = C.G * 8, lane = C.lane;
    LAS bf16_t* scr = (LAS bf16_t*)(C.lds + C.wave * 8448);
    const bf16_t* zb = WSP(bf16_t, WS_Z); bf16_t* zt = WSP(bf16_t, WS_ZT);
    for (int it = gw; it < (NT / 64) * 12; it += NGW) { const int r0 = (it / 12) * 64, cb = (it % 12) * 64;
#pragma unroll 8
        for (int rr = 0; rr < 64; rr += 2) { const int r = rr + (lane >> 5), c2 = (lane & 31) * 2; const unsigned v = *(const unsigned*)(zb + (size_t)(r0 + r) * ZW + HYB + cb + c2);
            scr[r * 66 + c2] = (bf16_t)(v & 0xffffu); scr[r * 66 + c2 + 1] = (bf16_t)(v >> 16); }
        LDS_WAIT(); asm volatile("" ::: "memory");
#pragma unroll 8
        for (int cc = 0; cc < 64; cc += 2) { const int c = cc + (lane >> 5), r2 = (lane & 31) * 2;
            *(unsigned*)(zt + (size_t)(cb + c) * NT + r0 + r2) = (unsigned)scr[r2 * 66 + c] | ((unsigned)scr[(r2 + 1) * 66 + c] << 16); }
        LDS_WAIT(); asm volatile("" ::: "memory"); }
}
__device__ __forceinline__ void phase_gdn_c(Ctx& C, int l) {
    const int j0 = (l == 0) ? 0 : NCHC, nj = NCH - j0;
    for (int it = C.bid; it < NB * NH * nj; it += C.G) { const int bh = it / nj, jt = j0 + it % nj; gdn_c_item(C, l, bh / NH, bh % NH, jt); }
    for (int it = (C.bid + C.G / 3) % C.G; it < NB * NH * nj; it += C.G) { const int bh = it / nj, jt = j0 + it % nj; mlstm_c_item(C, l, bh / NH, bh % NH, jt); }
    for (int it = (C.bid + 2 * (C.G / 3)) % C.G; it < NB * NH * nj; it += C.G) { const int bh = it / nj, jt = j0 + it % nj; hgrn_c_item(C, l, bh / NH, bh % NH, jt); }
}

__device__ __forceinline__ f32x2 cmul(f32x2 a, f32x2 w) { return (f32x2){a.x * w.x - a.y * w.y, a.x * w.y + a.y * w.x}; }
__device__ __forceinline__ f32x2 cmulc(f32x2 a, f32x2 w) { return (f32x2){a.x * w.x + a.y * w.y, a.y * w.x - a.x * w.y}; }
template <int N> __device__ __forceinline__ void fft_fwd(LAS f32x2* X, const LAS f32x2* tw, int tid) {
    constexpr int NG = (N / 4 + 511) / 512, NB2 = (N / 2 + 511) / 512;
    int h = N >> 1;
#pragma unroll 1
    for (; h >= 2; h >>= 2) { const float tf = 3.14159265358979f / (float)h; const int hh = h >> 1;
        f32x2 x0[NG], x1[NG], x2[NG], x3[NG], w1[NG]; int bs[NG];
#pragma unroll
        for (int q = 0; q < NG; ++q) { const int j = tid + 512 * q; const int jm = j & (hh - 1); bs[q] = ((j - jm) << 2) + jm;
            if (j < (N >> 2)) { x0[q] = X[bs[q]]; x1[q] = X[bs[q] + hh]; x2[q] = X[bs[q] + h]; x3[q] = X[bs[q] + h + hh]; const float ang = (float)jm * tf; w1[q] = (f32x2){__cosf(ang), -__sinf(ang)}; } }
#pragma unroll
        for (int q = 0; q < NG; ++q) { const int j = tid + 512 * q; if (j < (N >> 2)) {
            const f32x2 w2 = cmul(w1[q], w1[q]);
            const f32x2 a0 = x0[q] + x2[q], a2 = cmul(x0[q] - x2[q], w1[q]), a1 = x1[q] + x3[q]; const f32x2 d13 = cmul(x1[q] - x3[q], w1[q]); const f32x2 a3 = (f32x2){d13.y, -d13.x};
            X[bs[q]] = a0 + a1; X[bs[q] + hh] = cmul(a0 - a1, w2); X[bs[q] + h] = a2 + a3; X[bs[q] + h + hh] = cmul(a2 - a3, w2); } }
        __syncthreads(); }
    if (h == 1) {
        f32x2 a[NB2], b[NB2];
#pragma unroll
        for (int q = 0; q < NB2; ++q) { const int j = tid + 512 * q; if (j < (N >> 1)) { a[q] = X[2 * j]; b[q] = X[2 * j + 1]; } }
#pragma unroll
        for (int q = 0; q < NB2; ++q) { const int j = tid + 512 * q; if (j < (N >> 1)) { X[2 * j] = a[q] + b[q]; X[2 * j + 1] = a[q] - b[q]; } }
        __syncthreads(); }
}
template <int N> __device__ __forceinline__ void fft_inv(LAS f32x2* X, const LAS f32x2* tw, int tid) {
    constexpr int NG = (N / 4 + 511) / 512, NB2 = (N / 2 + 511) / 512;
    constexpr int LOG2N = (N == 8192) ? 13 : (N == 4096) ? 12 : (N == 2048) ? 11 : (N == 1024) ? 10 : (N == 512) ? 9 : (N == 256) ? 8 : (N == 128) ? 7 : (N == 64) ? 6 : -1;
    static_assert(LOG2N > 0, "fft size");
    int h = 2;
    if (LOG2N & 1) {
        f32x2 a[NB2], b[NB2];
#pragma unroll
        for (int q = 0; q < NB2; ++q) { const int j = tid + 512 * q; if (j < (N >> 1)) { a[q] = X[2 * j]; b[q] = X[2 * j + 1]; } }
#pragma unroll
        for (int q = 0; q < NB2; ++q) { const int j = tid + 512 * q; if (j < (N >> 1)) { X[2 * j] = a[q] + b[q]; X[2 * j + 1] = a[q] - b[q]; } }
        __syncthreads(); h = 4; }
#pragma unroll 1
    for (; h <= (N >> 1); h <<= 2) { const float tf = 3.14159265358979f / (float)h; const int hh = h >> 1;
        f32x2 x0[NG], x1[NG], x2[NG], x3[NG], w1[NG]; int bs[NG];
#pragma unroll
        for (int q = 0; q < NG; ++q) { const int j = tid + 512 * q; const int jm = j & (hh - 1); bs[q] = ((j - jm) << 2) + jm;
            if (j < (N >> 2)) { x0[q] = X[bs[q]]; x1[q] = X[bs[q] + hh]; x2[q] = X[bs[q] + h]; x3[q] = X[bs[q] + h + hh]; const float ang = (float)jm * tf; w1[q] = (f32x2){__cosf(ang), -__sinf(ang)}; } }
#pragma unroll
        for (int q = 0; q < NG; ++q) { const int j = tid + 512 * q; if (j < (N >> 2)) {
            const f32x2 w2 = cmul(w1[q], w1[q]);
            const f32x2 b1 = cmulc(x1[q], w2), b3 = cmulc(x3[q], w2); const f32x2 a0 = x0[q] + b1, a1 = x0[q] - b1, a2 = x2[q] + b3, a3 = x2[q] - b3;
            const f32x2 c2 = cmulc(a2, w1[q]); const f32x2 t3 = cmulc(a3, w1[q]); const f32x2 c3 = (f32x2){-t3.y, t3.x};
            X[bs[q]] = a0 + c2; X[bs[q] + h] = a0 - c2; X[bs[q] + hh] = a1 + c3; X[bs[q] + h + hh] = a1 - c3; } }
        __syncthreads(); }
}
__device__ __forceinline__ float block_sum(Ctx& C, float v, LAS float* red) {
    v = wave_sum(v); __syncthreads(); if (C.lane == 0) red[C.wave] = v; __syncthreads();
    float s = 0.f;
#pragma unroll
    for (int i = 0; i < 8; ++i) s += red[i];
    return s;
}
#define FFT_FWD_P(X) do { fft_fwd<N>(X, tw, tid); if ((REPMASK >> 15) & 1) { fft_inv<N>(X, tw, tid); for (int i_ = tid; i_ < N; i_ += 512) X[i_] = X[i_] * (1.0f / (float)N); __syncthreads(); fft_fwd<N>(X, tw, tid); } } while (0)
template <int LEN, int MODE>
__device__ __forceinline__ void hyena_channel(Ctx& C, int l, int c, int row0, int hoff  , int qsel) {
    LAS f32x2* X = (LAS f32x2*)C.lds; LAS f32x2* Y1 = (LAS f32x2*)(C.lds + 65536); const LAS f32x2* tw = (const LAS f32x2*)(C.lds + 98304); LAS float* red = (LAS float*)(C.lds + LDSX_OFF + 128);
    constexpr int N = 2 * LEN, len = LEN, NI = (LEN + 511) / 512;
#ifdef HOST_EMU
    const int tid = C.tid;
#else
    int tid_ = C.tid; asm volatile("" : "+v"(tid_)); const int tid = tid_;
#endif
    constexpr int KST = 2 * LEN;
    f32x2* Ks = WSP(f32x2, (LEN == SEQ ? WS_KS : WS_KSC)) + (size_t)c * 2 * KST;
    if constexpr ((MODE & 1) != 0) {
    const float* hd = WSP(float, WS_HDN) + ((size_t)l * (SEQ + LC) + hoff) * 64;
    const float* w3 = INP(I_HYW3) + (size_t)l * 64 * 1024;
    const float delta = (-4.605170185988091f / 1.5f + (-4.605170185988091f / 0.3f + 4.605170185988091f / 1.5f) * (float)c / 255.0f);
    const float ad = fabsf(delta);
    LAS f32x4* W3c = (LAS f32x4*)(C.lds + 98304);
    __syncthreads();
    if (tid < 256) { const int j = tid >> 2, q = tid & 3; ((LAS float*)W3c)[tid] = w3[j * 1024 + (q & 1) * 512 + (q >> 1) * 256 + c]; }
    __syncthreads();
    float ss0 = 0.f, ss1 = 0.f;
    for (int p = tid; p < len; p += 512) { const float* hr = hd + (size_t)p * 64; f32x4 acc = (f32x4){0.f, 0.f, 0.f, 0.f};
#pragma unroll 16
        for (int j = 0; j < 64; ++j) acc = acc + W3c[j] * hr[j];
        const float win = __expf(-((float)p * (1.0f / (float)(len - 1))) * ad); acc = acc * win;
        X[p] = (f32x2){acc.x, 0.f}; ss0 += acc.x * acc.x; ss1 += acc.z * acc.z;
        if (p >= 1) { X[N - p] = (f32x2){acc.y, 0.f}; ss0 += acc.y * acc.y; ss1 += acc.w * acc.w; }
        Y1[p] = (f32x2){acc.z, acc.w}; }
    if (tid == 0) X[len] = (f32x2){0.f, 0.f};
    const float scale0 = 1.f / sqrtf(block_sum(C, ss0, red) + EPS), scale1 = 1.f / sqrtf(block_sum(C, ss1, red) + EPS);
    __syncthreads();
    for (int n = 0; n < 2 + 2 * ((REPMASK >> 16) & 1); ++n) {
        if (n & 1) { for (int p = tid; p < len; p += 512) { const f32x2 t1 = Y1[p]; X[p] = (f32x2){t1.x, 0.f}; if (p >= 1) X[N - p] = (f32x2){t1.y, 0.f}; } if (tid == 0) X[len] = (f32x2){0.f, 0.f}; __syncthreads(); }
        FFT_FWD_P(X);
        const float scale = (n & 1) ? scale1 : scale0;
        for (int i = tid; i < N; i += 512) Ks[(size_t)(n & 1) * KST + i] = X[i] * scale;
        __syncthreads();
    }
    }
    if constexpr ((MODE & 2) != 0) {
    const bf16_t* zt = WSP(bf16_t, WS_ZT); const float* cw = INP(I_HYCW) + l * 3 * 768; const float* cb = INP(I_HYCB) + l * 768;
    const float bias0 = INP(I_HYBI)[l * 512 + c], bias1 = INP(I_HYBI)[l * 512 + 256 + c];
    float* hyt = WSP(float, WS_HYT) + (size_t)c * NT;
    const float inv_n = 1.0f / (float)N;
    const float cw0[3] = {cw[c], cw[768 + c], cw[1536 + c]}, cw1[3] = {cw[256 + c], cw[768 + 256 + c], cw[1536 + 256 + c]}, cw2[3] = {cw[512 + c], cw[768 + 512 + c], cw[1536 + 512 + c]};
    const float cb0 = cb[c], cb1 = cb[256 + c], cb2 = cb[512 + c];
    const bf16_t* z0 = zt + (size_t)c * NT; const bf16_t* z1 = zt + (size_t)(256 + c) * NT; const bf16_t* z2 = zt + (size_t)(512 + c) * NT;
    LAS f32x2* X1 = Y1;
    LAS f32x2* X2 = (LAS f32x2*)(C.lds + 98304);
    LAS bf16_t* RAW = (LAS bf16_t*)(X + len);
    constexpr int RS = LEN + 16;
    for (int q2 = 0; q2 < 1 + ((REPMASK >> 17) & 1); ++q2) { const int q = qsel;
        const int ra = row0 + q * len, rb = ra + len;
        float va[NI], vb[NI];
#pragma unroll
        for (int col = 0; col < 3; ++col) { const bf16_t* zc = col == 0 ? z0 : (col == 1 ? z1 : z2); const float* wv = col == 0 ? cw0 : (col == 1 ? cw1 : cw2); const float bv = col == 0 ? cb0 : (col == 1 ? cb1 : cb2);
            if (8 * tid < len) { *(LAS u32x4*)(RAW + 8 + 8 * tid) = *(const u32x4*)(zc + ra + 8 * tid); *(LAS u32x4*)(RAW + RS + 8 + 8 * tid) = *(const u32x4*)(zc + rb + 8 * tid); }
            if (tid == 0) { RAW[7] = 0; RAW[8 + len] = 0; RAW[RS + 7] = 0; RAW[RS + 8 + len] = 0; }
            __syncthreads();
#pragma unroll
            for (int k = 0; k < NI; ++k) { const int t = tid + 512 * k; if (t < len) {
                const float ca = bv + wv[0] * bf2f(RAW[7 + t]) + wv[1] * bf2f(RAW[8 + t]) + wv[2] * bf2f(RAW[9 + t]);
                const float cbv = bv + wv[0] * bf2f(RAW[RS + 7 + t]) + wv[1] * bf2f(RAW[RS + 8 + t]) + wv[2] * bf2f(RAW[RS + 9 + t]);
                if (col == 0) { va[k] = ca; vb[k] = cbv; X[t] = (f32x2){ca, cbv}; } else if (col == 1) X1[t] = (f32x2){ca, cbv}; else X2[t] = (f32x2){ca, cbv}; } }
            __syncthreads(); }
#pragma unroll
        for (int k = 0; k < NI; ++k) { const int t = tid + 512 * k; if (t < len) X[len + t] = (f32x2){0.f, 0.f}; }
        __syncthreads();
        FFT_FWD_P(X);
#pragma unroll 1
        for (int k0 = 0; k0 < 2 * NI; k0 += 8) { f32x2 kv_[8], xv_[8];
#pragma unroll
        for (int k = 0; k < 8; ++k) { const int i = tid + 512 * (k0 + k); if (i < N) { kv_[k] = Ks[i]; xv_[k] = X[i]; } }
#pragma unroll
        for (int k = 0; k < 8; ++k) { const int i = tid + 512 * (k0 + k); if (i < N) X[i] = cmul(xv_[k], kv_[k]); } }
        __syncthreads();
        fft_inv<N>(X, tw, tid);
        f32x2 y1[NI];
#pragma unroll
        for (int k = 0; k < NI; ++k) { const int t = tid + 512 * k; if (t < len) { const f32x2 cv = X[t] * inv_n, x1 = X1[t];
            y1[k] = (f32x2){x1.x * (cv.x + bias0 * va[k]), x1.y * (cv.y + bias0 * vb[k])}; } }
        __syncthreads();
#pragma unroll
        for (int k = 0; k < NI; ++k) { const int t = tid + 512 * k; if (t < len) { X[t] = y1[k]; X[len + t] = (f32x2){0.f, 0.f}; } }
        __syncthreads();
        FFT_FWD_P(X);
#pragma unroll 1
        for (int k0 = 0; k0 < 2 * NI; k0 += 8) { f32x2 kv_[8], xv_[8];
#pragma unroll
        for (int k = 0; k < 8; ++k) { const int i = tid + 512 * (k0 + k); if (i < N) { kv_[k] = Ks[KST + i]; xv_[k] = X[i]; } }
#pragma unroll
        for (int k = 0; k < 8; ++k) { const int i = tid + 512 * (k0 + k); if (i < N) X[i] = cmul(xv_[k], kv_[k]); } }
        __syncthreads();
        fft_inv<N>(X, tw, tid);
#pragma unroll
        for (int k = 0; k < NI; ++k) { const int t = tid + 512 * k; if (t < len) { const f32x2 cv = X[t] * inv_n, yy = y1[k], x2 = X2[t];
            hyt[ra + t] = x2.x * (cv.x + bias1 * yy.x); hyt[rb + t] = x2.y * (cv.y + bias1 * yy.y); } }
        __syncthreads();
    }
    }
}
__device__ __forceinline__ void phase_hy_filters(Ctx& C, int l) {
    for (int c = C.bid; c < 256; c += C.G) { __syncthreads(); hyena_channel<SEQ, 1>(C, l, c, 0, 0, 0); if (l == 0) hyena_channel<LC, 1>(C, l, c, NLAT, SEQ, 0); }
}
__device__ __forceinline__ void phase_mixers(Ctx& C, int l, int parts = 3) {
    const int G = C.G, me = C.bid;
    const int nscan = 3 * NSCAN, nsw = G > nscan ? nscan : G;
    if (parts & 1) for (int j = me; j < nscan; j += nsw) { if (me >= nsw) break;
        const int mix = j / NSCAN, r = j % NSCAN;
        if (mix == 0) { if (!(parts & 32) || (parts & 4)) hgrn_b_scan(C, r); } else if (mix == 1) { if (!(parts & 32) || (parts & 8)) mlstm_b_scan(C, r); } else { if (!(parts & 32) || (parts & 16)) gdn_b_scan(C, r); } }
    if (parts & 2) {
        LAS f32x2* tw = (LAS f32x2*)(C.lds + 98304); volatile LAS int* jobw = (volatile LAS int*)(C.lds + LDSX_OFF + 192);
        __syncthreads();
        __syncthreads();
        unsigned* qh = WSP(unsigned, WS_CTL) + CW_HYQ + 64 * l + ((parts == 2) ? 32 : 0) + ((parts & 64) ? 16 : 0);
        for (;;) {
            if (C.tid == 0) jobw[0] = (int)atomicAdd(qh, 1u);
            __syncthreads();
            const int c = jobw[0];
            __syncthreads();
            if (c >= 512) break;
            hyena_channel<SEQ, 2>(C, l, c >> 1, 0, 0, 2 * (c & 1)); if (l == 0) hyena_channel<LC, 2>(C, l, c >> 1, NLAT, SEQ, 2 * (c & 1));
        }
    }
}
__device__ __forceinline__ void phase_finalize(Ctx& C, int l) {
    const int gw = C.vcu * 8 + C.wave, NGW = C.G * 8, lane = C.lane;
    const int nrows = (l == 0) ? NT : NLAT;
    const bf16_t* zb = WSP(bf16_t, WS_Z); bf16_t* mix = WSP(bf16_t, WS_MIX);
    LAS float* scr = (LAS float*)(C.lds + C.wave * 8448);
    const int ntr = nrows / 64;
    for (int it = gw; it < ntr * 8; it += NGW) { const int rt = it / 8, cb = (it % 8) * 32; const float* src = WSP(float, WS_HYT) + (size_t)cb * NT + rt * 64;
#pragma unroll 8
        for (int cc = 0; cc < 32; ++cc) scr[cc * 65 + lane] = __builtin_nontemporal_load(src + (size_t)cc * NT + lane);
        LDS_WAIT(); asm volatile("" ::: "memory");
        for (int rr = 0; rr < 64; rr += 4) { const int r = rr + (lane >> 4), c2 = (lane & 15) * 2;
            *(unsigned*)(mix + (size_t)(rt * 64 + r) * D + 512 + cb + c2) = pk2(scr[c2 * 65 + r], scr[(c2 + 1) * 65 + r]); }
        LDS_WAIT(); asm volatile("" ::: "memory"); }
}

enum { PH_PRO = 0, PH_L0 = 1, PH_PER_LAYER = 10, PH_FINAL = PH_L0 + DEPTH * PH_PER_LAYER, PH_COUNT };
__global__ void __launch_bounds__(512, 2) fwd_kernel(Args args) {
#ifdef HOST_EMU
    unsigned char* lds = emu::cur->blk->lds;
#else
    extern __shared__ __attribute__((aligned(16))) unsigned char lds[];
#endif
#ifdef HOST_EMU
    Ctx C; C.lds = (LAS unsigned char*)lds; C.a = &args; C.ws = args.ws;
#else
    Ctx C; C.lds = (LAS unsigned char*)lds; C.a = (const __attribute__((address_space(4))) Args*)__builtin_amdgcn_kernarg_segment_ptr(); C.ws = C.a->ws;
#endif
    C.tid = threadIdx.x; C.lane = C.tid & 63; C.wave = __builtin_amdgcn_readfirstlane(C.tid >> 6);
    C.bid = blockIdx.x; C.G = gridDim.x; { const int bx = blockIdx.x; C.vcu = (C.G % 8 == 0) ? (bx % 8) * (C.G / 8) + bx / 8 : bx; }
    volatile LAS unsigned* MISC = (volatile LAS unsigned*)(C.lds + LDSX_OFF + LX_MISC);
    for (int u = C.tid; u < 64; u += 512) MISC[u] = 0u;
    __syncthreads();
    const int lo = C.a->ph_lo, hi = C.a->ph_hi;
    const bool multi = (hi - lo) > 1;
    XcdBarrier bar; bar.bar = WSP(unsigned, WS_CTL) + CW_BAR; bar.x = 0; bar.st = nullptr; bar.wave_s = 0;
    if (multi) bar = xcd_barrier_post(WSP(unsigned, WS_CTL) + CW_BAR, MISC + 8);
    bar.wave_s = C.wave;
#ifndef HOST_EMU
    if (multi) { cooperative_groups::this_grid().sync(); }
#endif
    const Ctx C0 = C;
#ifdef HOST_EMU
#define LAUNDER_CTX() Ctx C = C0; C.tid = threadIdx.x; C.lane = C.tid & 63; C.wave = C.tid >> 6;
#else
#define LAUNDER_CTX() Ctx C = C0; C.tid = hw_tid(C0.wave); \
        {   unsigned long long pw = (unsigned long long)C.ws, pa = (unsigned long long)C.a; unsigned w0 = (unsigned)pw, w1 = (unsigned)(pw >> 32), a0 = (unsigned)pa, a1 = (unsigned)(pa >> 32), v0 = (unsigned)C.vcu, g0 = (unsigned)C.G, b0 = (unsigned)C.bid; \
            asm volatile("" : "+v"(w0), "+v"(w1), "+v"(a0), "+v"(a1), "+v"(v0), "+v"(g0), "+v"(b0), "+v"(C.tid)); \
            w0 = __builtin_amdgcn_readfirstlane(w0); w1 = __builtin_amdgcn_readfirstlane(w1); a0 = __builtin_amdgcn_readfirstlane(a0); a1 = __builtin_amdgcn_readfirstlane(a1); \
            C.vcu = (int)__builtin_amdgcn_readfirstlane(v0); C.G = (int)__builtin_amdgcn_readfirstlane(g0); C.bid = (int)__builtin_amdgcn_readfirstlane(b0); \
            C.ws = (unsigned char*)(((unsigned long long)w1 << 32) | w0); C.a = (const __attribute__((address_space(4))) Args*)(((unsigned long long)a1 << 32) | a0); } \
        C.lane = C.tid & 63; C.wave = __builtin_amdgcn_readfirstlane(C.tid >> 6);
#endif
#define PH_KIND(k) ((k) == PH_PRO ? 10 : ((k) == PH_FINAL ? 11 : ((k) - PH_L0) % PH_PER_LAYER))
#define PH_BEGIN(k) if (lo <= (k) && (k) < hi) { const unsigned long long t0_ = (TMASK != 0) ? __builtin_amdgcn_s_memrealtime() : 0ull; LAUNDER_CTX()
#define PH_END(k) if ((k) + 1 < hi) { XcdBarrier b2 = bar; b2.bar = WSP(unsigned, WS_CTL) + CW_BAR; xcd_barrier(b2); if ((REPMASK >> 22) & 1) xcd_barrier(b2); \
        if ((TMASK >> PH_KIND(k)) & 1) { if (hw_tid(C0.wave) == 0) { const unsigned long long t1_ = __builtin_amdgcn_s_memrealtime(); while (__builtin_amdgcn_s_memrealtime() - t1_ < (t1_ - t0_)) __builtin_amdgcn_s_sleep(8); } __syncthreads(); } } }
#define REP(b) ((REPMASK >> (b)) & 1)
    PH_BEGIN(PH_PRO) p0_prologue(C); if (REP(0)) { __syncthreads(); p0_prologue(C); } PH_END(PH_PRO)
#define LAYER_PHASES(l) { constexpr int pb = PH_L0 + (l) * PH_PER_LAYER; \
    PH_BEGIN(pb + 0) if ((l) > 0) (void)build_tiles(C, (l) > 0 ? (l) - 1 : 0); phase_rows_a(C, (l)); if (REP(13) && (l) == 0) { __syncthreads(); phase_rows_a(C, (l)); } PH_END(pb + 0) \
    PH_BEGIN(pb + 1) pg8::Gemm g{WSP(bf16_t, WS_H), WSP(bf16_t, WS_WIN) + (size_t)(l) * ZW * D, D, 0}; pg8::StaticOrder S; S.init(NT, ZW, C.G, C.bid); \
        pg8::EpiBf16 E{WSP(bf16_t, WS_Z), ZW, nullptr, 0}; pg8::gemm_phase(C.lds, g, S, E, C.tid); if (REP(1)) { __syncthreads(); pg8::gemm_phase(C.lds, g, S, E, C.tid); } PH_END(pb + 1) \
    PH_BEGIN(pb + 2) phase_hy_transpose(C); __syncthreads(); phase_gdn_a(C, (l)); __syncthreads(); phase_hy_filters(C, (l)); if (REP(8)) { __syncthreads(); phase_gdn_a(C, (l)); } PH_END(pb + 2) \
    PH_BEGIN(pb + 3) phase_mixers(C, (l)); if (REP(2)) { __syncthreads(); phase_mixers(C, (l), 1); } if (REP(26)) { __syncthreads(); phase_mixers(C, (l), 3 | 64); } if (REP(23)) { __syncthreads(); phase_mixers(C, (l), 1 | 32 | 4); } if (REP(24)) { __syncthreads(); phase_mixers(C, (l), 1 | 32 | 8); } if (REP(25)) { __syncthreads(); phase_mixers(C, (l), 1 | 32 | 16); } if (REP(3)) { __syncthreads(); phase_mixers(C, (l), 2); } PH_END(pb + 3) \
    PH_BEGIN(pb + 4) phase_finalize(C, (l)); __syncthreads(); phase_gdn_c(C, (l)); if (REP(4)) { __syncthreads(); phase_finalize(C, (l)); } if (REP(9)) { __syncthreads(); phase_gdn_c(C, (l)); } PH_END(pb + 4) \
    PH_BEGIN(pb + 5) pg8::Gemm g{WSP(bf16_t, WS_MIX), WSP(bf16_t, WS_WOUT) + (size_t)(l) * D * D, D, 0}; pg8::StaticOrder S; S.init((l) == 0 ? NT : NLAT, D, C.G, C.bid); \
        pg8::EpiResid E{(l) == 0 ? INP(I_X) : WSP(float, WS_X), (l) == 0 ? INP(I_CTX) : WSP(float, WS_X) + (size_t)NLAT * D, WSP(float, WS_X), WSP(float, WS_MOD) + (size_t)(l) * (NB + 1) * 6 * D + 2 * D}; \
        pg8::gemm_phase(C.lds, g, S, E, C.tid); if (REP(14) && (l) == 0) { __syncthreads(); pg8::gemm_phase(C.lds, g, S, E, C.tid); } PH_END(pb + 5) \
    PH_BEGIN(pb + 6) phase_rows_b(C, (l)); PH_END(pb + 6) \
    PH_BEGIN(pb + 7) phase_gather(C, (l)); if (REP(5)) { __syncthreads(); phase_gather(C, (l)); } PH_END(pb + 7) \
    PH_BEGIN(pb + 8) const int ntiles = build_tiles(C, (l)); \
        pg8::Gemm g{WSP(bf16_t, WS_HS), WSP(bf16_t, WS_W1) + (size_t)(l) * NE * 2 * DE * D, D, (size_t)2 * DE * D}; pg8::MoeOrder S; S.init(ntiles, 2 * DE, C.G, C.bid, (const LAS int*)(C.lds + LDSX_OFF + LX_TILE)); \
        pg8::EpiSwiglu E{WSP(bf16_t, WS_A2), INP(I_EB1) + (size_t)(l) * NE * 2 * DE}; pg8::gemm_phase(C.lds, g, S, E, C.tid); if (REP(6)) { __syncthreads(); pg8::gemm_phase(C.lds, g, S, E, C.tid); } PH_END(pb + 8) \
    PH_BEGIN(pb + 9) const int ntiles = build_tiles(C, (l)); \
        pg8::Gemm g{WSP(bf16_t, WS_A2), WSP(bf16_t, WS_W2) + (size_t)(l) * NE * D * DE, DE, (size_t)D * DE}; pg8::MoeOrder S; S.init(ntiles, D, C.G, C.bid, (const LAS int*)(C.lds + LDSX_OFF + LX_TILE)); \
        pg8::EpiBf16 E{WSP(bf16_t, WS_Y), D, INP(I_EB2) + (size_t)(l) * NE * D, D}; pg8::gemm_phase(C.lds, g, S, E, C.tid); if (REP(7)) { __syncthreads(); pg8::gemm_phase(C.lds, g, S, E, C.tid); } PH_END(pb + 9) }
    LAYER_PHASES(0)
    LAYER_PHASES(1)
    static_assert(DEPTH == 2, "two layers written out");
    PH_BEGIN(PH_FINAL) (void)build_tiles(C, DEPTH - 1); phase_rows_a(C, DEPTH); PH_END(PH_FINAL)
}

#ifndef MK_PER_PHASE
#define MK_PER_PHASE 0
#endif
extern "C" void kernel_launch(void* const* d_in, const int* in_sizes, int n_in, void* d_out, int out_size, void* d_ws, size_t ws_size, hipStream_t stream) {
    static int grid = 0;
#ifndef HOST_EMU
    if (grid == 0) {
        if (n_in != 34 || ws_size < WS_END) { fprintf(stderr, "kernel_launch: unexpected n_in %d / ws %zu (need %zu)\n", n_in, ws_size, (size_t)WS_END); grid = -1; return; }
        int dev = 0, cus = 0, per_cu = 0;
        hipGetDevice(&dev); hipDeviceGetAttribute(&cus, hipDeviceAttributeMultiprocessorCount, dev);
        hipFuncSetAttribute((const void*)fwd_kernel, hipFuncAttributeMaxDynamicSharedMemorySize, LDS_BYTES);
        hipOccupancyMaxActiveBlocksPerMultiprocessor(&per_cu, (const void*)fwd_kernel, 512, LDS_BYTES);
        if (per_cu < 1) { fprintf(stderr, "kernel_launch: occupancy query says %d blocks per CU\n", per_cu); per_cu = 1; }
        grid = cus;
        (void)hipGetLastError();
    }
    if (grid < 0) return;
#else
    grid = EMU_GRID;
#endif
    hipMemsetAsync((char*)d_ws + WS_CTL, 0, CTL_BYTES, stream);
    Args a{};
    for (int i = 0; i < 34; ++i) a.in[i] = (const float*)d_in[i];
    a.out = (float*)d_out; a.ws = (unsigned char*)d_ws;
#ifdef HOST_EMU
    a.ph_lo = 0; a.ph_hi = PH_COUNT;
    if (getenv("EMU_PH_HI")) a.ph_hi = atoi(getenv("EMU_PH_HI"));
    emu::launch([&]() { fwd_kernel(a); }, dim3(grid), dim3(512), LDS_BYTES);
#else
#if MK_PER_PHASE
    for (int ph = 0; ph < PH_COUNT; ++ph) { a.ph_lo = ph; a.ph_hi = ph + 1; hipLaunchKernelGGL(fwd_kernel, dim3(grid), dim3(512), LDS_BYTES, stream, a); }
#else
    a.ph_lo = 0; a.ph_hi = PH_COUNT;
    void* kargs[] = {&a};
    hipError_t e = hipLaunchCooperativeKernel((const void*)fwd_kernel, dim3(grid), dim3(512), kargs, LDS_BYTES, stream);
    if (e != hipSuccess) fprintf(stderr, "cooperative launch failed: %s (grid %d)\n", hipGetErrorString(e), grid);
#endif
#endif
}
```
